# Optimizing an MI355X kernel written in HIP

```python
import jax, jax.numpy as jnp
from jax import lax
import numpy as np

D_MODEL = 1024
BATCH = 8
SEQ = 8192
DEPTH = 4

CHUNK = 64
MIX_WIDTH = D_MODEL
N_MIXERS = 4
GROUP_WIDTH = MIX_WIDTH // N_MIXERS
POOL_WINDOWS = (2, 4, 8, 16)
POOL_GROUP = GROUP_WIDTH // len(POOL_WINDOWS)
SGU_HEADS = 4
SGU_BLOCK = 128
SGU_HEAD_DIM = GROUP_WIDTH // SGU_HEADS
LRU_BLOCKS = 4
LRU_BLOCK_DIM = GROUP_WIDTH // LRU_BLOCKS
CONV_WIDTH = 4
LRU_C = 8.0
HGRN_HEADS = 4
HGRN_HEAD_DIM = GROUP_WIDTH // HGRN_HEADS
N_IN_SLICES = 9
IN_WIDTH = N_IN_SLICES * GROUP_WIDTH
D_FF = 7 * D_MODEL // 2
N_EXPERTS = 8
TOP_K = 2
N_DENSE = (DEPTH + 1) // 2
N_MOE = DEPTH // 2
EPS = 1e-6
MIN_FORGET = 1e-30

kernel_name = 'hybrid_stream_block'


def rms_norm(x, g):
    xf = x.astype(jnp.float32)
    y = xf * lax.rsqrt(jnp.mean(xf * xf, axis=-1, keepdims=True) + EPS)
    return (y * g.astype(jnp.float32)).astype(x.dtype)


def modulate(h, shift, scale):
    return h * (1.0 + scale[:, None, :]) + shift[:, None, :]


def swiglu(h, w1, w3, w2):
    return (jax.nn.silu(h @ w1) * (h @ w3)) @ w2


def pool_mixer(x, w, scale):
    bsz, slen, _ = x.shape
    xf = x.astype(jnp.float32)
    cs = jnp.pad(jnp.cumsum(xf, axis=1), ((0, 0), (1, 0), (0, 0)))
    pos = jnp.arange(1, slen + 1, dtype=jnp.float32)[None, :, None]
    means = []
    for gi, win in enumerate(POOL_WINDOWS):
        csg = cs[..., gi * POOL_GROUP:(gi + 1) * POOL_GROUP]
        lo = jnp.pad(csg, ((0, 0), (win - 1, 0), (0, 0)))[:, :slen]
        means.append((csg[:, 1:] - lo) / jnp.minimum(pos, float(win)))
    d = (jnp.concatenate(means, axis=-1) - xf).reshape(bsz, slen, len(POOL_WINDOWS), POOL_GROUP)
    y = jnp.einsum('bsgi,gij->bsgj', d, w.astype(jnp.float32)).reshape(bsz, slen, GROUP_WIDTH)
    return (y * scale.astype(jnp.float32)).astype(x.dtype)


def sgu_mixer(u, v, ws, bias):
    bsz, slen, _ = u.shape
    u = jax.nn.gelu(u)
    vf = jax.nn.gelu(v).astype(jnp.float32)
    mu = jnp.mean(vf, axis=-1, keepdims=True)
    var = jnp.mean(jnp.square(vf - mu), axis=-1, keepdims=True)
    vn = ((vf - mu) * lax.rsqrt(var + EPS)).astype(u.dtype)
    vb = vn.reshape(bsz, slen // SGU_BLOCK, SGU_BLOCK, SGU_HEADS, SGU_HEAD_DIM)
    tri = jnp.tril(jnp.ones((SGU_BLOCK, SGU_BLOCK), dtype=ws.dtype))
    z = jnp.einsum('hts,bnshd->bnthd', ws * tri, vb) + bias.T[None, None, :, :, None]
    return u * z.reshape(bsz, slen, GROUP_WIDTH)


def _linear_combine(left, right):
    a1, b1 = left
    a2, b2 = right
    return a1 * a2, a2 * b1 + b2


def lru_mixer(xb, gate, conv_w, conv_b, wa, ba, wx, bx, lam):
    bsz, slen, _ = xb.shape
    xp = jnp.pad(xb, ((0, 0), (CONV_WIDTH - 1, 0), (0, 0)))
    xc = conv_b + sum(conv_w[k] * xp[:, k:k + slen] for k in range(CONV_WIDTH))
    xh = xc.reshape(bsz, slen, LRU_BLOCKS, LRU_BLOCK_DIM)
    r = jax.nn.sigmoid(jnp.einsum('bshi,hij->bshj', xh, wa).reshape(bsz, slen, GROUP_WIDTH) + ba)
    i = jax.nn.sigmoid(jnp.einsum('bshi,hij->bshj', xh, wx).reshape(bsz, slen, GROUP_WIDTH) + bx)
    log_a = LRU_C * r.astype(jnp.float32) * jax.nn.log_sigmoid(lam.astype(jnp.float32))
    a = jnp.exp(log_a)
    b = jnp.sqrt(jnp.maximum(-jnp.expm1(2.0 * log_a), 0.0)) * (i * xc).astype(jnp.float32)
    _, h = lax.associative_scan(_linear_combine, (a, b), axis=1)
    return jax.nn.gelu(gate) * h.astype(xb.dtype)


def hgrn_mixer(q, fz, inp, g, lb, norm_g):
    bsz, slen, _ = q.shape
    n_chunks = slen // CHUNK
    lb = lb.astype(jnp.float32)
    z = fz.astype(jnp.float32)
    qf = jax.nn.silu(q.astype(jnp.float32))
    sig = jax.nn.sigmoid(z)
    f = lb + (1.0 - lb) * sig
    log_f = jnp.log(jnp.maximum(f, MIN_FORGET))
    k = (1.0 - lb) * (1.0 - sig)
    v = inp.astype(jnp.float32)

    def to_chunks(t):
        return t.reshape(bsz, n_chunks, CHUNK, HGRN_HEADS, HGRN_HEAD_DIM).transpose(1, 0, 3, 2, 4)

    causal = jnp.tril(jnp.ones((CHUNK, CHUNK), dtype=bool))[:, :, None]
    causal_f = causal.astype(jnp.float32)

    def step(state, xs):
        qc, kc, vc, gc = xs
        b = jnp.cumsum(gc, axis=2)
        o_inter = jnp.einsum('bhtk,bhkv->bhtv', qc * jnp.exp(b), state)
        diff = b[:, :, :, None, :] - b[:, :, None, :, :]
        decay = jnp.exp(jnp.where(causal, diff, 0.0)) * causal_f
        scores = jnp.einsum('bhtk,bhtsk,bhsk->bhts', qc, decay, kc)
        o = o_inter + jnp.einsum('bhts,bhsv->bhtv', scores, vc)
        b_last = b[:, :, -1:, :]
        state = (jnp.exp(b_last[:, :, 0, :])[..., None] * state
                 + jnp.einsum('bhsk,bhsv->bhkv', kc * jnp.exp(b_last - b), vc))
        return state, o

    s0 = jnp.zeros((bsz, HGRN_HEADS, HGRN_HEAD_DIM, HGRN_HEAD_DIM), jnp.float32)
    _, o = lax.scan(step, s0, (to_chunks(qf), to_chunks(k), to_chunks(v), to_chunks(log_f)))
    o = o.transpose(1, 0, 3, 2, 4).reshape(bsz, slen, HGRN_HEADS, HGRN_HEAD_DIM)
    o = o * lax.rsqrt(jnp.mean(o * o, axis=-1, keepdims=True) + EPS)
    o = o * norm_g.astype(jnp.float32).reshape(HGRN_HEADS, HGRN_HEAD_DIM)
    return (o.reshape(bsz, slen, GROUP_WIDTH) * jax.nn.silu(g.astype(jnp.float32))).astype(q.dtype)


def moe_ffn(h, router_w, router_b, w1, w3, w2):
    logits = h.astype(jnp.float32) @ router_w.astype(jnp.float32) + router_b.astype(jnp.float32)
    top_v, top_i = lax.top_k(logits, TOP_K)
    top_w = jax.nn.softmax(top_v, axis=-1)
    combine = jnp.sum(jax.nn.one_hot(top_i, N_EXPERTS, dtype=jnp.float32) * top_w[..., None], axis=-2)
    combine = combine.astype(h.dtype)
    y = jnp.zeros_like(h)
    for e in range(N_EXPERTS):
        y = y + combine[..., e:e + 1] * swiglu(h, w1[e], w3[e], w2[e])
    return y


def setup_inputs(seed: int = 0) -> dict:
    key = jax.random.key(seed)
    ks = jax.random.split(key, 40)
    counter = [0]

    def nxt():
        k = ks[counter[0]]
        counter[0] += 1
        return k

    def nrm(shape, scale):
        return scale * jax.random.normal(nxt(), shape, jnp.float32)

    def gain(shape):
        return 1.0 + nrm(shape, 0.02)

    G = GROUP_WIDTH
    gate_pattern = jnp.repeat(jnp.array([0.0, 0.0, 1.0, 0.0, 0.0, 1.0], jnp.float32), D_MODEL)
    a0 = jax.random.uniform(nxt(), (DEPTH, G), jnp.float32, 0.9, 0.999)
    p = a0 ** (1.0 / LRU_C)
    lam = jnp.log(p) - jnp.log1p(-p)
    return {
        'x': nrm((BATCH, SEQ, D_MODEL), 1.0),
        'c': nrm((BATCH, D_MODEL), 1.0),
        'w_mod': nrm((DEPTH, D_MODEL, 6 * D_MODEL), 0.2 * D_MODEL ** -0.5),
        'b_mod': gate_pattern + nrm((DEPTH, 6 * D_MODEL), 0.02),
        'norm_mix': gain((DEPTH, D_MODEL)),
        'norm_ffn': gain((DEPTH, D_MODEL)),
        'norm_final': gain((D_MODEL,)),
        'w_in': nrm((DEPTH, D_MODEL, IN_WIDTH), D_MODEL ** -0.5),
        'w_out': nrm((DEPTH, MIX_WIDTH, D_MODEL), MIX_WIDTH ** -0.5),
        'pool_w': nrm((DEPTH, len(POOL_WINDOWS), POOL_GROUP, POOL_GROUP), POOL_GROUP ** -0.5),
        'pool_scale': 1.0 + nrm((DEPTH, G), 0.05),
        'pool_out_norm': gain((DEPTH, G)),
        'sgu_ws': nrm((DEPTH, SGU_HEADS, SGU_BLOCK, SGU_BLOCK), 0.5 * SGU_BLOCK ** -0.5),
        'sgu_b': 1.0 + nrm((DEPTH, SGU_HEADS, SGU_BLOCK), 0.02),
        'sgu_out_norm': gain((DEPTH, G)),
        'conv_w': nrm((DEPTH, CONV_WIDTH, G), CONV_WIDTH ** -0.5),
        'conv_b': nrm((DEPTH, G), 0.02),
        'lru_wa': nrm((DEPTH, LRU_BLOCKS, LRU_BLOCK_DIM, LRU_BLOCK_DIM), LRU_BLOCK_DIM ** -0.5),
        'lru_ba': nrm((DEPTH, G), 0.02),
        'lru_wx': nrm((DEPTH, LRU_BLOCKS, LRU_BLOCK_DIM, LRU_BLOCK_DIM), LRU_BLOCK_DIM ** -0.5),
        'lru_bx': nrm((DEPTH, G), 0.02),
        'lru_lambda': lam,
        'lru_out_norm': gain((DEPTH, G)),
        'hgrn_gamma': nrm((DEPTH, G), 0.5),
        'hgrn_out_norm': gain((DEPTH, G)),
        'ffn_w1': nrm((N_DENSE, D_MODEL, D_FF), D_MODEL ** -0.5),
        'ffn_w3': nrm((N_DENSE, D_MODEL, D_FF), D_MODEL ** -0.5),
        'ffn_w2': nrm((N_DENSE, D_FF, D_MODEL), D_FF ** -0.5),
        'router_w': nrm((N_MOE, D_MODEL, N_EXPERTS), D_MODEL ** -0.5),
        'router_b': nrm((N_MOE, N_EXPERTS), 0.01),
        'moe_w1': nrm((N_MOE, N_EXPERTS, D_MODEL, D_FF), D_MODEL ** -0.5),
        'moe_w3': nrm((N_MOE, N_EXPERTS, D_MODEL, D_FF), D_MODEL ** -0.5),
        'moe_w2': nrm((N_MOE, N_EXPERTS, D_FF, D_MODEL), D_FF ** -0.5),
    }


def reference(x, c, w_mod, b_mod, norm_mix, norm_ffn, norm_final, w_in, w_out,
              pool_w, pool_scale, pool_out_norm, sgu_ws, sgu_b, sgu_out_norm,
              conv_w, conv_b, lru_wa, lru_ba, lru_wx, lru_bx, lru_lambda, lru_out_norm,
              hgrn_gamma, hgrn_out_norm, ffn_w1, ffn_w3, ffn_w2,
              router_w, router_b, moe_w1, moe_w3, moe_w2):
    p_layers = jax.nn.softmax(hgrn_gamma.astype(jnp.float32), axis=0)
    lower_bounds = jnp.cumsum(p_layers, axis=0) - p_layers[0:1]
    c_act = jax.nn.silu(c)
    for l in range(DEPTH):
        mod = c_act @ w_mod[l] + b_mod[l]
        sh1, sc1, g1, sh2, sc2, g2 = jnp.split(mod, 6, axis=-1)
        h = modulate(rms_norm(x, norm_mix[l]), sh1, sc1)
        proj = h @ w_in[l]
        pa, pu, pv, px, pg, dq, dfz, di, dg = jnp.split(proj, N_IN_SLICES, axis=-1)
        ya = rms_norm(pool_mixer(pa, pool_w[l], pool_scale[l]), pool_out_norm[l])
        yb = rms_norm(sgu_mixer(pu, pv, sgu_ws[l], sgu_b[l]), sgu_out_norm[l])
        yc = rms_norm(lru_mixer(px, pg, conv_w[l], conv_b[l], lru_wa[l], lru_ba[l],
                                lru_wx[l], lru_bx[l], lru_lambda[l]), lru_out_norm[l])
        yd = hgrn_mixer(dq, dfz, di, dg, lower_bounds[l], hgrn_out_norm[l])
        y = jnp.concatenate([ya, yb, yc, yd], axis=-1) @ w_out[l]
        x = x + g1[:, None, :] * y
        h = modulate(rms_norm(x, norm_ffn[l]), sh2, sc2)
        if l % 2 == 0:
            f = swiglu(h, ffn_w1[l // 2], ffn_w3[l // 2], ffn_w2[l // 2])
        else:
            f = moe_ffn(h, router_w[l // 2], router_b[l // 2], moe_w1[l // 2], moe_w3[l // 2], moe_w2[l // 2])
        x = x + g2[:, None, :] * f
    return rms_norm(x, norm_final)
```

```cpp
#include <hip/hip_runtime.h>
#include <cstdio>
#include <cstdint>

namespace pg8 {
#define PG8_LAS __attribute__((address_space(3)))
typedef unsigned short bf16_t;
typedef short bf16x8 __attribute__((ext_vector_type(8)));
typedef float f32x4 __attribute__((ext_vector_type(4)));
typedef unsigned u32x4 __attribute__((ext_vector_type(4)));
constexpr int BM = 256, BK = 64, HALF = 128, HTB = HALF * BK * 2  , STAGE_BYTES = 8 * HTB, NXCD = 8, WGM = 8;

__host__ __device__ __forceinline__ int lds_byte(int r, int c) { const int st = (r >> 4) * 2 + (c >> 5), rr = r & 15, cc = c & 31, ob = rr * 64 + cc * 2; return st * 1024 + (ob ^ (((ob >> 9) & 1) << 5)); }
__host__ __device__ __forceinline__ void stage_rc(int b, int& R, int& C) { const int st = b / 1024, sb = b % 1024, swz = sb ^ (((sb >> 9) & 1) << 5); R = (st >> 1) * 16 + swz / 64; C = (st & 1) * 32 + (swz % 64) / 2; }
__host__ __device__ __forceinline__ int perm32(int rho) { const int n = rho >> 4, i = rho & 15; return 8 * (i >> 2) + 4 * n + (i & 3); }

struct Unit { int pa, pn, pm, pc; };
struct Gemm { const bf16_t* A; const bf16_t* Bt; int K; };

template <int NN>
struct TileOrder {
    int nM, nwg, G, c, pm0, a_rel; const int* tile_e;
    __device__ __forceinline__ void init(int nM_, int G_, int c_, int pm0_, int a_rel_, const int* te) { nM = nM_; nwg = nM_ * NN; G = G_; c = c_; pm0 = pm0_; a_rel = a_rel_; tile_e = te; }
    __device__ __forceinline__ bool next(int i, Unit& u) const {
        const int L = i * G + c; if (L >= nwg) return false;
        int wgid = L; { const int q = nwg >> 3, r = nwg & 7, xcd = wgid & 7, off = wgid >> 3; wgid = (xcd < r ? xcd * (q + 1) : r * (q + 1) + (xcd - r) * q) + off; }
        constexpr int nig = WGM * NN;
        const int gid = wgid / nig, x = wgid - gid * nig, fm = gid * WGM, rem = nM - fm;
        int pml, pc;
        if (rem >= WGM) { pml = fm + (x & (WGM - 1)); pc = x >> 3; } else { pml = fm + (x % rem); pc = x / rem; }
        u.pm = pm0 + pml; u.pc = pc; u.pa = a_rel ? pml : u.pm;
        int e = 0; if (tile_e) e = __builtin_amdgcn_readfirstlane(__hip_atomic_load(tile_e + u.pm, __ATOMIC_RELAXED, __HIP_MEMORY_SCOPE_AGENT));
        u.pn = e * NN + pc; return true;
    }
    __device__ __forceinline__ void a_ready(const Unit&) const {}
    __device__ __forceinline__ void done(const Unit&) const {}
};
typedef int v8i32 __attribute__((ext_vector_type(8)));
typedef int v4i32 __attribute__((ext_vector_type(4)));
__device__ __forceinline__ unsigned cvt_pk_bf16(float lo, float hi) { unsigned r; asm("v_cvt_pk_bf16_f32 %0, %1, %2" : "=v"(r) : "v"(lo), "v"(hi)); return r; }

template <class Epi, class Sched, bool ALIGN_EPI = false, bool SP2 = false, bool F8 = false>
__device__ __forceinline__ void gemm_phase(PG8_LAS unsigned char* lds, const Gemm g, const Sched& S, const Epi& E) {
    int tid = threadIdx.x; asm volatile("" : "+v"(tid));
    const int wid = __builtin_amdgcn_readfirstlane(tid >> 6), lane = tid & 63, wr = wid >> 2, wc = wid & 3, fr = lane & 15, fq = lane >> 4;
    const int K = g.K, nt = K / BK;
    unsigned voffA[2], voffB[2];
#pragma unroll
    for (int i = 0; i < 2; ++i) { int R, C; stage_rc(tid * 16 + i * 8192, R, C); const int Rb = Epi::PERM ? ((R & ~31) + perm32(R & 31)) : R;
        voffA[i] = (unsigned)(R * K + C) * 2u; voffB[i] = (unsigned)(Rb * K + C) * 2u; }
    const size_t kstep = (size_t)(BK * 2);
    const size_t hstep = (size_t)HALF * K * 2;
    const size_t tstep = 2 * hstep;
    const unsigned ldsw = (unsigned)wid * 1024u;
    const int aoff = lds_byte(wr * 64 + fr, fq * 8), boff = lds_byte(wc * 32 + fr, fq * 8);
#define PG8_SA(b, h) (((b) * 2 + (h)) * HTB)
#define PG8_SB(b, h) ((4 + (b) * 2 + (h)) * HTB)
#define PG8_STAGE(bufoff, gbase, voff) do { _Pragma("unroll") for (int _i = 0; _i < 2; ++_i) \
        __builtin_amdgcn_global_load_lds((const unsigned*)((const char*)(gbase) + (voff)[_i]), (PG8_LAS unsigned*)(lds + (bufoff) + ldsw + _i * 8192), 16, 0, 0); } while (0)
#define PG8_LD16(off_) (*(const PG8_LAS v4i32*)(lds + (off_)))
#define PG8_LDA(dst, b, h) do { _Pragma("unroll") for (int m = 0; m < 4; ++m) { if constexpr (F8) dst##8[m] = __builtin_shufflevector(PG8_LD16(PG8_SA(b, h) + aoff + m * 2048), PG8_LD16(PG8_SA(b, h) + aoff + m * 2048 + 1024), 0, 1, 2, 3, 4, 5, 6, 7); \
        else { _Pragma("unroll") for (int k = 0; k < 2; ++k) dst[m][k] = *(const PG8_LAS bf16x8*)(lds + PG8_SA(b, h) + aoff + m * 2048 + k * 1024); } } } while (0)
#define PG8_LDB(dst, b, h) do { _Pragma("unroll") for (int n = 0; n < 2; ++n) { if constexpr (F8) dst##8[n] = __builtin_shufflevector(PG8_LD16(PG8_SB(b, h) + boff + n * 2048), PG8_LD16(PG8_SB(b, h) + boff + n * 2048 + 1024), 0, 1, 2, 3, 4, 5, 6, 7); \
        else { _Pragma("unroll") for (int k = 0; k < 2; ++k) dst[n][k] = *(const PG8_LAS bf16x8*)(lds + PG8_SB(b, h) + boff + n * 2048 + k * 1024); } } } while (0)
#define PG8_MMA(ai, bj, At, Bt) do { __builtin_amdgcn_s_setprio(1); _Pragma("unroll") for (int m = 0; m < 4; ++m) _Pragma("unroll") for (int n = 0; n < 2; ++n) { \
        if constexpr (F8) asm volatile("v_mfma_scale_f32_16x16x128_f8f6f4 %0, %1, %2, %0, %3, %3 op_sel_hi:[0,0,0]" : "+v"(acc[ai][bj][m][n]) : "v"(Bt##8[n]), "v"(At##8[m]), "v"(f8scale)); \
        else { _Pragma("unroll") for (int k = 0; k < 2; ++k) acc[ai][bj][m][n] = __builtin_amdgcn_mfma_f32_16x16x32_bf16(Bt[n][k], At[m][k], acc[ai][bj][m][n], 0, 0, 0); } } __builtin_amdgcn_s_setprio(0); } while (0)
#define PG8_WAIT_V(n) asm volatile("s_waitcnt vmcnt(" #n ")" ::: "memory")
#define PG8_WAIT_L(n) asm volatile("s_waitcnt lgkmcnt(" #n ")" ::: "memory")
#define PG8_BAR __builtin_amdgcn_s_barrier()
#define PG8_SCHED __builtin_amdgcn_sched_barrier(0)
    Unit cur, nxt; int ui = 0;
    if (!S.next(0, cur)) return;
    f32x4 acc[2][2][4][2];
#pragma unroll
    for (int a = 0; a < 2; ++a)
#pragma unroll
        for (int b = 0; b < 2; ++b)
#pragma unroll
            for (int m = 0; m < 4; ++m)
#pragma unroll
                for (int n = 0; n < 2; ++n) acc[a][b][m][n] = (f32x4){0.f, 0.f, 0.f, 0.f};
    bf16x8 At[4][2], B0[2][2], B1[2][2];
    const int f8scale = 0x7f7f7f7f;
    v8i32 At8[4], B08[2], B18[2];
    const char* cA = (const char*)g.A + (size_t)cur.pa * tstep; const char* cB = (const char*)g.Bt + (size_t)cur.pn * tstep;
    S.a_ready(cur);
    if constexpr (SP2) {
        PG8_STAGE(PG8_SB(0, 0), cB, voffB); PG8_STAGE(PG8_SB(0, 1), cB + hstep, voffB); PG8_STAGE(PG8_SA(0, 0), cA, voffA); PG8_STAGE(PG8_SA(0, 1), cA + hstep, voffA);
        if (wr == 1) PG8_BAR;
        PG8_WAIT_V(2); PG8_BAR;
        PG8_STAGE(PG8_SB(1, 0), cB + kstep, voffB); PG8_STAGE(PG8_SA(1, 0), cA + kstep, voffA); PG8_STAGE(PG8_SB(1, 1), cB + hstep + kstep, voffB);
        PG8_WAIT_V(6); PG8_BAR;
    } else {
        PG8_STAGE(PG8_SB(0, 0), cB, voffB); PG8_STAGE(PG8_SA(0, 0), cA, voffA); PG8_STAGE(PG8_SB(0, 1), cB + hstep, voffB); PG8_STAGE(PG8_SA(0, 1), cA + hstep, voffA);
        if (wr == 1) PG8_BAR;
        PG8_WAIT_V(4); PG8_BAR;
        PG8_STAGE(PG8_SB(1, 0), cB + kstep, voffB); PG8_STAGE(PG8_SA(1, 0), cA + kstep, voffA); PG8_STAGE(PG8_SB(1, 1), cB + hstep + kstep, voffB);
        PG8_WAIT_V(6); PG8_BAR;
    }
    for (;;) {
        const bool has_next = S.next(ui + 1, nxt);
        const char* nA = has_next ? (const char*)g.A + (size_t)nxt.pa * tstep : cA; const char* nB = has_next ? (const char*)g.Bt + (size_t)nxt.pn * tstep : cB;
        for (int t = 0; t < nt; t += 2) {
            const bool last = (t == nt - 2);
            const char* a1 = cA + (size_t)(t + 1) * kstep;
            const char* a2 = last ? nA : cA + (size_t)(t + 2) * kstep; const char* b2 = last ? nB : cB + (size_t)(t + 2) * kstep;
            const char* a3 = a2 + kstep; const char* b3 = b2 + kstep;
            if (last && has_next) S.a_ready(nxt);
            if constexpr (SP2) {
            PG8_LDB(B0, 0, 0); PG8_LDB(B1, 0, 1); PG8_SCHED; PG8_LDA(At, 0, 0); PG8_STAGE(PG8_SA(1, 1), a1 + hstep, voffA);
            PG8_WAIT_V(8); PG8_WAIT_L(0); PG8_BAR; PG8_MMA(0, 0, At, B0); PG8_MMA(0, 1, At, B1); PG8_BAR; PG8_SCHED;
            PG8_LDA(At, 0, 1); PG8_STAGE(PG8_SB(0, 0), b2, voffB); PG8_STAGE(PG8_SB(0, 1), b2 + hstep, voffB); PG8_STAGE(PG8_SA(0, 0), a2, voffA);
            PG8_WAIT_V(8); PG8_WAIT_L(0); PG8_BAR; PG8_MMA(1, 0, At, B0); PG8_MMA(1, 1, At, B1); PG8_BAR; PG8_SCHED;
            PG8_LDB(B0, 1, 0); PG8_LDB(B1, 1, 1); PG8_SCHED; PG8_LDA(At, 1, 0); PG8_STAGE(PG8_SA(0, 1), a2 + hstep, voffA);
            PG8_WAIT_V(8); PG8_WAIT_L(0); PG8_BAR; PG8_MMA(0, 0, At, B0); PG8_MMA(0, 1, At, B1); PG8_BAR; PG8_SCHED;
            PG8_LDA(At, 1, 1); PG8_STAGE(PG8_SB(1, 0), b3, voffB); PG8_STAGE(PG8_SB(1, 1), b3 + hstep, voffB); PG8_STAGE(PG8_SA(1, 0), a3, voffA);
            PG8_WAIT_V(8); PG8_WAIT_L(0); PG8_BAR; PG8_MMA(1, 0, At, B0); PG8_MMA(1, 1, At, B1); PG8_BAR; PG8_SCHED;
            } else {
            PG8_LDB(B0, 0, 0); PG8_SCHED; PG8_LDA(At, 0, 0); PG8_STAGE(PG8_SA(1, 1), a1 + hstep, voffA);
            PG8_WAIT_L(8); PG8_BAR; PG8_WAIT_L(0); PG8_MMA(0, 0, At, B0); PG8_BAR; PG8_SCHED;
            PG8_LDB(B1, 0, 1); PG8_STAGE(PG8_SB(0, 0), b2, voffB);
            PG8_BAR; PG8_WAIT_L(0); PG8_MMA(0, 1, At, B1); PG8_BAR;
            PG8_LDA(At, 0, 1); PG8_STAGE(PG8_SA(0, 0), a2, voffA);
            PG8_BAR; PG8_WAIT_L(0); PG8_MMA(1, 0, At, B0); PG8_BAR; PG8_SCHED;
            PG8_STAGE(PG8_SB(0, 1), b2 + hstep, voffB);
            PG8_WAIT_V(6); PG8_BAR; PG8_MMA(1, 1, At, B1); PG8_BAR;
            PG8_LDB(B0, 1, 0); PG8_SCHED; PG8_LDA(At, 1, 0); PG8_STAGE(PG8_SA(0, 1), a2 + hstep, voffA);
            PG8_WAIT_L(8); PG8_BAR; PG8_WAIT_L(0); PG8_MMA(0, 0, At, B0); PG8_BAR; PG8_SCHED;
            PG8_LDB(B1, 1, 1); PG8_STAGE(PG8_SB(1, 0), b3, voffB);
            PG8_BAR; PG8_WAIT_L(0); PG8_MMA(0, 1, At, B1); PG8_BAR;
            PG8_LDA(At, 1, 1); PG8_STAGE(PG8_SA(1, 0), a3, voffA);
            PG8_BAR; PG8_WAIT_L(0); PG8_MMA(1, 0, At, B0); PG8_BAR; PG8_SCHED;
            PG8_STAGE(PG8_SB(1, 1), b3 + hstep, voffB);
            PG8_WAIT_V(6); PG8_BAR; PG8_MMA(1, 1, At, B1); PG8_BAR;
            }
        }
        if constexpr (ALIGN_EPI) { if (wr == 0) PG8_BAR; }
        if constexpr (F8) asm volatile("s_nop 15\n\ts_nop 15" ::: "memory");
        if constexpr (!Epi::AFTER_DRAIN) { E(acc, cur, wr, wc, fr, fq); S.done(cur); }
        if (!has_next) break;
#pragma unroll
        for (int a = 0; a < 2; ++a)
#pragma unroll
            for (int b = 0; b < 2; ++b)
#pragma unroll
                for (int m = 0; m < 4; ++m)
#pragma unroll
                    for (int n = 0; n < 2; ++n) acc[a][b][m][n] = (f32x4){0.f, 0.f, 0.f, 0.f};
        cur = nxt; cA = nA; cB = nB; ++ui;
        if constexpr (ALIGN_EPI) { if (wr == 1) PG8_BAR; }
    }
    PG8_WAIT_V(0);
    if constexpr (!ALIGN_EPI) { if (wr == 0) PG8_BAR; }
    PG8_BAR;
    if constexpr (Epi::AFTER_DRAIN) { E.fused(acc, cur, wr, wc, fr, fq, lds, wid, lane); S.done(cur); }
#undef PG8_SA
#undef PG8_SB
#undef PG8_STAGE
#undef PG8_LDA
#undef PG8_LD16
#undef PG8_LDB
#undef PG8_MMA
#undef PG8_WAIT_V
#undef PG8_WAIT_L
#undef PG8_BAR
#undef PG8_SCHED
}
}

constexpr int NWAVES = 8, NTHR = NWAVES * 64;
constexpr int BATCH = 8, SEQ = 8192, D = 1024, M = BATCH * SEQ, DEPTH = 4, GWD = 256, INW = 2304, DFF = 3584, NE = 8;
constexpr float EPS = 1e-6f;
constexpr int MODW = 6 * D;
constexpr int CH = 128, NCH = SEQ / CH;
#ifndef F8_MASK
#define F8_MASK 0xE
#endif
#define IS_F8(l_) (((F8_MASK) >> (l_)) & 1)
constexpr int F8_LAYER = 3;
constexpr float F8_S13 = 32.f, F8_S2 = 64.f;
constexpr int MAXPAIR = 2 * M + NE * 256;

constexpr size_t MiB = 1u << 20;
constexpr size_t WS_CTL = 0, CTL_ZERO_BYTES = 1 * MiB;
constexpr size_t WS_MOD = 1 * MiB;
constexpr size_t WS_LB = WS_MOD + 786432;
constexpr size_t WS_POOLWT = 2 * MiB;
constexpr size_t WS_LRUWAT = WS_POOLWT + 131072;
constexpr size_t WS_LRUWXT = WS_LRUWAT + 131072;
constexpr size_t WS_SGUW = 3 * MiB;
constexpr size_t WS_TOKE = 4 * MiB;
constexpr size_t WS_TOKW = WS_TOKE + 262144;
constexpr size_t WS_HISTW = 5 * MiB;
constexpr size_t WS_TILEE = WS_HISTW + 65536;
constexpr size_t WS_NT = WS_TILEE + 4096;
constexpr size_t WS_PAIR = 6 * MiB;
constexpr size_t WS_AGG = 8 * MiB;
constexpr size_t WS_H0 = 9 * MiB;
constexpr size_t WS_DEC = 10 * MiB;
constexpr size_t WS_W = 16 * MiB;
constexpr size_t WS_WIN = WS_W, WS_WOUT = WS_W + 5 * MiB, WS_W13 = WS_W + 8 * MiB, WS_W2 = WS_W + 120 * MiB;
constexpr size_t WS_XN = 192 * MiB;
constexpr size_t WS_PROJ = 320 * MiB;
constexpr size_t WS_CAT = 608 * MiB;
constexpr size_t WS_ST = 736 * MiB;
constexpr size_t WS_LAB = 768 * MiB;
constexpr size_t WS_Y1 = 864 * MiB;
constexpr size_t WS_XB = 992 * MiB;
constexpr size_t WS_END = 1120 * MiB;
constexpr int CW_BAR = 4096;
constexpr int CW_ZT = 16384;
constexpr int RING_BYTES = 131072, MISC_OFF = RING_BYTES + 320, LDS_BYTES = 147456;

#define DI __device__ __forceinline__
#define LAS __attribute__((address_space(3)))
typedef unsigned short bf16;
typedef unsigned v4u __attribute__((ext_vector_type(4)));
typedef unsigned v2u __attribute__((ext_vector_type(2)));
typedef int v4i __attribute__((ext_vector_type(4)));
typedef int v2i __attribute__((ext_vector_type(2)));
typedef float f32x4 __attribute__((ext_vector_type(4)));
typedef float f32x2 __attribute__((ext_vector_type(2)));
typedef short bf16x8 __attribute__((ext_vector_type(8)));
#define LDS_WAIT() asm volatile("s_waitcnt lgkmcnt(0)" ::: "memory")
#define GAS __attribute__((address_space(1)))
typedef GAS const float* gcf; typedef GAS float* gf; typedef GAS const bf16* gcb; typedef GAS bf16* gb; typedef GAS const int* gci; typedef GAS int* gi;
typedef GAS const v2i* gcv2i; typedef GAS v2i* gv2i; typedef GAS const unsigned* gcu; typedef GAS unsigned char* gws;

DI float bf2f(bf16 v) { return __builtin_bit_cast(float, (unsigned)v << 16); }
DI float lo_bf(unsigned w) { return __builtin_bit_cast(float, w << 16); }
DI float hi_bf(unsigned w) { return __builtin_bit_cast(float, w & 0xffff0000u); }
DI unsigned pk2(float lo, float hi) { return pg8::cvt_pk_bf16(lo, hi); }
DI bf16 f2bf(float f) { return (bf16)(pk2(f, 0.f) & 0xffffu); }
DI float sigm(float x) { return __builtin_amdgcn_rcpf(1.f + __expf(-x)); }
DI float siluf(float x) { return x * sigm(x); }
DI float gelu_t(float x) { return x * sigm(1.5957691216057308f * (x + 0.044715f * x * x * x)); }
DI float neg_expm1(float x) {
    const float p = -x * (1.f + x * (0.5f + x * (0.16666667f + x * (0.041666668f + x * (0.0083333338f + x * 0.0013888889f)))));
    return x > -0.25f ? p : 1.f - __expf(x);
}
DI float wave_sum(float v) {
#pragma unroll
    for (int o = 1; o < 64; o <<= 1) v += __shfl_xor(v, o);
    return v;
}
template <int D_> DI float row_shr0(float src) { return __builtin_bit_cast(float, __builtin_amdgcn_update_dpp(0, __builtin_bit_cast(int, src), 0x110 + D_, 0xf, 0xf, true)); }
DI float wave_sum_dpp(float v) {
    v += row_shr0<1>(v); v += row_shr0<2>(v); v += row_shr0<4>(v); v += row_shr0<8>(v);
    const int iv = __builtin_bit_cast(int, v);
    const float a = __builtin_bit_cast(float, __builtin_amdgcn_readlane(iv, 15)), b2 = __builtin_bit_cast(float, __builtin_amdgcn_readlane(iv, 31));
    const float c2 = __builtin_bit_cast(float, __builtin_amdgcn_readlane(iv, 47)), d2 = __builtin_bit_cast(float, __builtin_amdgcn_readlane(iv, 63));
    return (a + b2) + (c2 + d2);
}
DI int wave_sum_i(int v) {
#pragma unroll
    for (int o = 1; o < 64; o <<= 1) v += __shfl_xor(v, o);
    return v;
}
DI f32x4 ld4(gcf p) { return *(GAS const f32x4*)p; }
DI void unpack8(const v4u x, float (&o)[8]) { o[0] = lo_bf(x.x); o[1] = hi_bf(x.x); o[2] = lo_bf(x.y); o[3] = hi_bf(x.y); o[4] = lo_bf(x.z); o[5] = hi_bf(x.z); o[6] = lo_bf(x.w); o[7] = hi_bf(x.w); }
DI f32x4 unpack4(const v2u x) { return (f32x4){lo_bf(x.x), hi_bf(x.x), lo_bf(x.y), hi_bf(x.y)}; }
DI v2u pack4(const f32x4 v) { v2u r; r.x = pk2(v.x, v.y); r.y = pk2(v.z, v.w); return r; }
DI float clamp_f8(float v) { return __builtin_amdgcn_fmed3f(v, -448.f, 448.f); }
DI unsigned pk4_f8(float a, float b, float c, float d) { int r = __builtin_amdgcn_cvt_pk_fp8_f32(clamp_f8(a), clamp_f8(b), 0, false); r = __builtin_amdgcn_cvt_pk_fp8_f32(clamp_f8(c), clamp_f8(d), r, true); return (unsigned)r; }
DI f32x4 mfma16(const bf16x8 a, const bf16x8 b, const f32x4 c) { return __builtin_amdgcn_mfma_f32_16x16x32_bf16(a, b, c, 0, 0, 0); }

#define XB_TMO      128
#define XB_XCNT(j)  (256  + 64 * (j))
#define XB_XSUB(j)  (1280 + 64 * (j))
#define XB_XGEN(j)  (2304 + 64 * (j))
#define XB_TOP      3328
#define XB_TOPGEN   3392
#define XCD_BAR_WORDS 3456
#define XB_SPIN_CAP (1u << 18)
__device__ __forceinline__ unsigned xb_ld(unsigned* p)              { return __hip_atomic_load(p, __ATOMIC_RELAXED, __HIP_MEMORY_SCOPE_AGENT); }
__device__ __forceinline__ unsigned xb_add(unsigned* p, unsigned v) { return __hip_atomic_fetch_add(p, v, __ATOMIC_RELAXED, __HIP_MEMORY_SCOPE_AGENT); }
__device__ __forceinline__ unsigned xb_xcc_id() { return (unsigned)__builtin_amdgcn_s_getreg((3 << 11) | 20) & 0xFu; }
#define XB_SPIN(cond, bar) do { unsigned _sp = 0; while (cond) { __builtin_amdgcn_s_sleep(1); \
    if ((++_sp & 255u) == 0u) { if (xb_ld(&(bar)[XB_TMO])) break; if (_sp > XB_SPIN_CAP) { atomicAdd(&(bar)[XB_TMO], 1u); break; } } } } while (0)
struct XcdBarrier { unsigned* bar; unsigned x; volatile LAS unsigned* st; };
__device__ __forceinline__ XcdBarrier xcd_barrier_post(unsigned* bar, volatile LAS unsigned* st) {
    XcdBarrier b; b.bar = bar; b.x = xb_xcc_id(); b.st = st;
    if (threadIdx.x == 0) (void)xb_add(&bar[XB_XCNT(b.x)], 1u);
    return b;
}
__device__ __forceinline__ void xcd_barrier_complete(unsigned* bar, unsigned x, unsigned& nloc, unsigned& nx) {
    const unsigned G = gridDim.x * gridDim.y * gridDim.z;
    unsigned sum, cnt, mine, sp = 0u;
    for (;;) {
        sum = 0u; cnt = 0u; mine = 0u;
#pragma unroll
        for (unsigned j = 0; j < 16; ++j) { const unsigned c = xb_ld(&bar[XB_XCNT(j)]); sum += c; cnt += (c > 0u) ? 1u : 0u; mine = (j == x) ? c : mine; }
        if (sum == G) break;
        __builtin_amdgcn_s_sleep(1);
        if ((++sp & 255u) == 0u) { if (xb_ld(&bar[XB_TMO])) break; if (sp > XB_SPIN_CAP) { atomicAdd(&bar[XB_TMO], 1u); break; } }
    }
    nloc = mine > 0u ? mine : 1u; nx = cnt > 0u ? cnt : 1u;
}
__device__ __forceinline__ void xcd_barrier(const XcdBarrier& b) {
    asm volatile("s_waitcnt vmcnt(0)" ::: "memory");
    __syncthreads();
    if (threadIdx.x == 0) {
        unsigned* bar = b.bar;
        __builtin_amdgcn_s_waitcnt(0);
        unsigned nloc = b.st[0], nx = b.st[1];
        if (nloc == 0u) { xcd_barrier_complete(bar, b.x, nloc, nx); b.st[0] = nloc; b.st[1] = nx; }
        const unsigned old = xb_add(&bar[XB_XSUB(b.x)], 1u);
        const unsigned gen = old / nloc;
        if (old + 1u == (gen + 1u) * nloc) {
            __builtin_amdgcn_fence(__ATOMIC_RELEASE, "agent");
            asm volatile("s_waitcnt vmcnt(0)" ::: "memory");
            const unsigned og = xb_add(&bar[XB_TOP], 1u);
            const unsigned tg = og / nx;
            if (og + 1u == (tg + 1u) * nx) xb_add(&bar[XB_TOPGEN], 1u);
            else XB_SPIN(xb_ld(&bar[XB_TOPGEN]) == tg, bar);
            __builtin_amdgcn_fence(__ATOMIC_ACQUIRE, "agent");
            xb_add(&bar[XB_XGEN(b.x)], 1u);
            asm volatile("s_waitcnt vmcnt(0)" ::: "memory");
        } else {
            XB_SPIN(xb_ld(&bar[XB_XGEN(b.x)]) == gen, bar);
            __builtin_amdgcn_fence(__ATOMIC_ACQUIRE, "agent");
            asm volatile("s_waitcnt vmcnt(0)" ::: "memory");
        }
    }
    __syncthreads();
}

struct EpiProj {
    static constexpr bool PERM = true, AFTER_DRAIN = false, IDEMPOTENT = true;
    gb O;
    DI void operator()(const f32x4 (&acc)[2][2][4][2], const pg8::Unit& u, int wr, int wc, int fr, int fq) const {
        const int row0 = u.pm * 256 + wr * 64 + fr, col0 = u.pc * 256 + wc * 32 + 8 * fq;
#pragma unroll
        for (int ai = 0; ai < 2; ++ai)
#pragma unroll
            for (int m = 0; m < 4; ++m) { gb rowp = O + (size_t)(row0 + ai * 128 + m * 16) * INW + col0;
#pragma unroll
                for (int bj = 0; bj < 2; ++bj) { const f32x4 v0 = acc[ai][bj][m][0], v1 = acc[ai][bj][m][1];
                    v4u w; w.x = pk2(v0[0], v0[1]); w.y = pk2(v0[2], v0[3]); w.z = pk2(v1[0], v1[1]); w.w = pk2(v1[2], v1[3]);
                    *(GAS v4u*)(rowp + bj * 128) = w; } }
    }
};
struct EpiResid {
    static constexpr bool PERM = false, AFTER_DRAIN = false, IDEMPOTENT = false;
    gb x; gcf gate; float mul;
    DI void operator()(const f32x4 (&acc)[2][2][4][2], const pg8::Unit& u, int wr, int wc, int fr, int fq) const {
        const int b = u.pm >> 5, row0 = u.pm * 256 + wr * 64 + fr, col0 = u.pc * 256 + wc * 32 + 4 * fq;
        f32x4 gv[2][2];
#pragma unroll
        for (int bj = 0; bj < 2; ++bj)
#pragma unroll
            for (int n = 0; n < 2; ++n) gv[bj][n] = ld4(gate + (size_t)b * MODW + col0 + bj * 128 + n * 16) * mul;
#pragma unroll
        for (int ai = 0; ai < 2; ++ai) {
            v2u xr[4][2][2];
#pragma unroll
            for (int m = 0; m < 4; ++m)
#pragma unroll
                for (int bj = 0; bj < 2; ++bj)
#pragma unroll
                    for (int n = 0; n < 2; ++n) xr[m][bj][n] = *(GAS const v2u*)(x + (size_t)(row0 + ai * 128 + m * 16) * D + col0 + bj * 128 + n * 16);
#pragma unroll
            for (int m = 0; m < 4; ++m)
#pragma unroll
                for (int bj = 0; bj < 2; ++bj)
#pragma unroll
                    for (int n = 0; n < 2; ++n) *(GAS v2u*)(x + (size_t)(row0 + ai * 128 + m * 16) * D + col0 + bj * 128 + n * 16) = pack4(unpack4(xr[m][bj][n]) + gv[bj][n] * acc[ai][bj][m][n]);
            asm volatile("" ::: "memory"); }
    }
};
struct EpiSwiglu {
    static constexpr bool PERM = true, AFTER_DRAIN = false, IDEMPOTENT = true;
    gb ACT; int pm0;
    DI void operator()(const f32x4 (&acc)[2][2][4][2], const pg8::Unit& u, int wr, int wc, int fr, int fq) const {
        const int row0 = (u.pm - pm0) * 256 + wr * 64 + fr, col0 = u.pc * 128 + wc * 32 + 8 * fq;
#pragma unroll
        for (int ai = 0; ai < 2; ++ai)
#pragma unroll
            for (int m = 0; m < 4; ++m) { gb rowp = ACT + (size_t)(row0 + ai * 128 + m * 16) * DFF + col0;
                const f32x4 g0 = acc[ai][0][m][0], g1 = acc[ai][0][m][1], u0 = acc[ai][1][m][0], u1 = acc[ai][1][m][1];
                v4u w; w.x = pk2(siluf(g0[0]) * u0[0], siluf(g0[1]) * u0[1]); w.y = pk2(siluf(g0[2]) * u0[2], siluf(g0[3]) * u0[3]);
                w.z = pk2(siluf(g1[0]) * u1[0], siluf(g1[1]) * u1[1]); w.w = pk2(siluf(g1[2]) * u1[2], siluf(g1[3]) * u1[3]);
                *(GAS v4u*)rowp = w; }
    }
};
struct EpiSwiglu8 {
    static constexpr bool PERM = true, AFTER_DRAIN = false, IDEMPOTENT = true;
    GAS unsigned char* ACT; int pm0;
    DI void operator()(const f32x4 (&acc)[2][2][4][2], const pg8::Unit& u, int wr, int wc, int fr, int fq) const {
        const int row0 = (u.pm - pm0) * 256 + wr * 64 + fr, col0 = u.pc * 128 + wc * 32 + 8 * fq; constexpr float is = 1.0f / F8_S13;
#pragma unroll
        for (int ai = 0; ai < 2; ++ai)
#pragma unroll
            for (int m = 0; m < 4; ++m) { GAS unsigned char* rowp = ACT + (size_t)(row0 + ai * 128 + m * 16) * DFF + col0;
                const f32x4 g0 = acc[ai][0][m][0] * is, g1 = acc[ai][0][m][1] * is, u0 = acc[ai][1][m][0] * is, u1 = acc[ai][1][m][1] * is;
                v2u w; w.x = pk4_f8(siluf(g0[0]) * u0[0], siluf(g0[1]) * u0[1], siluf(g0[2]) * u0[2], siluf(g0[3]) * u0[3]);
                w.y = pk4_f8(siluf(g1[0]) * u1[0], siluf(g1[1]) * u1[1], siluf(g1[2]) * u1[2], siluf(g1[3]) * u1[3]);
                *(GAS v2u*)rowp = w; }
    }
};
struct EpiScatter {
    static constexpr bool PERM = true, AFTER_DRAIN = false, IDEMPOTENT = true;
    gcv2i pair; gb Y0; gb Y1; gci toke; gcf tokw; float sc;
    DI void operator()(const f32x4 (&acc)[2][2][4][2], const pg8::Unit& u, int wr, int wc, int fr, int fq) const {
        const int row0 = u.pm * 256 + wr * 64 + fr, col0 = u.pc * 256 + wc * 32 + 8 * fq;
#pragma unroll
        for (int ai = 0; ai < 2; ++ai)
#pragma unroll
            for (int m = 0; m < 4; ++m) { const v2i pi = pair[row0 + ai * 128 + m * 16];
                if (pi.x >= 0) { const int tok = pi.x & 0x3fffffff; float w = tokw[2 * tok + (pi.x >> 30)] * sc;

                    gb rowp = ((pi.x >> 30) ? Y1 : Y0) + (size_t)tok * D + col0;
#pragma unroll
                    for (int bj = 0; bj < 2; ++bj) { const f32x4 v0 = acc[ai][bj][m][0] * w, v1 = acc[ai][bj][m][1] * w;
                        v4u o; o.x = pk2(v0[0], v0[1]); o.y = pk2(v0[2], v0[3]); o.z = pk2(v1[0], v1[1]); o.w = pk2(v1[2], v1[3]);
                        *(GAS v4u*)(rowp + bj * 128) = o; } } }
    }
};


DI void p0_prologue(gcf c, gcf w_mod, gcf b_mod, gcf gamma, gcf pool_w, gcf lwa, gcf lwx, gcf sgu_ws,
                    gws ws, LAS unsigned char* lds, int wg, int G, int tid, int wave, int lane) {
    LAS float* CS = (LAS float*)lds; LAS float* RED = (LAS float*)(lds + 32768);
    gf MOD = (GAS float*)(ws + WS_MOD);
    if (wg < 96) {
        for (int idx = tid; idx < 8192; idx += NTHR) { const int k = idx >> 3, b = idx & 7; const float v = c[b * D + k]; CS[idx] = siluf(v); }
        __syncthreads();
        for (int item = wg; item < 96; item += G) {
            const int l = item / 24, jb = item % 24, col = jb * 256 + lane * 4;
            f32x4 acc[8];
#pragma unroll
            for (int b = 0; b < 8; ++b) acc[b] = (f32x4){0.f, 0.f, 0.f, 0.f};
            gcf wp = w_mod + ((size_t)(l * D + wave * 128)) * MODW + col;
#pragma unroll 8
            for (int kk = 0; kk < 128; ++kk) {
                const f32x4 w = ld4(wp + (size_t)kk * MODW);
                const f32x4 c0 = *(const LAS f32x4*)(CS + (wave * 128 + kk) * 8), c1 = *(const LAS f32x4*)(CS + (wave * 128 + kk) * 8 + 4);
                acc[0] += c0.x * w; acc[1] += c0.y * w; acc[2] += c0.z * w; acc[3] += c0.w * w; acc[4] += c1.x * w; acc[5] += c1.y * w; acc[6] += c1.z * w; acc[7] += c1.w * w;
            }
#pragma unroll
            for (int b = 0; b < 8; ++b) *(LAS f32x4*)(RED + (wave * 8 + b) * 256 + lane * 4) = acc[b];
            __syncthreads();
            for (int o = tid; o < 2048; o += NTHR) { const int b = o >> 8, cc = o & 255; float s = 0.f;
#pragma unroll
                for (int w = 0; w < 8; ++w) s += RED[(w * 8 + b) * 256 + cc];
                MOD[(size_t)(l * 8 + b) * MODW + jb * 256 + cc] = s + b_mod[l * MODW + jb * 256 + cc]; }
            __syncthreads();
        }
    }
    if (wg == G - 1 && tid < GWD) {
        gf LB = (GAS float*)(ws + WS_LB);
        const float g0 = gamma[tid], g1 = gamma[GWD + tid], g2 = gamma[2 * GWD + tid], g3 = gamma[3 * GWD + tid];
        const float mx = fmaxf(fmaxf(g0, g1), fmaxf(g2, g3));
        const float e0 = expf(g0 - mx), e1 = expf(g1 - mx), e2 = expf(g2 - mx), e3 = expf(g3 - mx), inv = 1.f / (e0 + e1 + e2 + e3);
        LB[tid] = 0.f; LB[GWD + tid] = e1 * inv; LB[2 * GWD + tid] = (e1 + e2) * inv; LB[3 * GWD + tid] = (e1 + e2 + e3) * inv;
    }
    gb POOLWT = (GAS bf16*)(ws + WS_POOLWT); gb LRUWAT = (GAS bf16*)(ws + WS_LRUWAT); gb LRUWXT = (GAS bf16*)(ws + WS_LRUWXT); gb SGUW = (GAS bf16*)(ws + WS_SGUW);
    const int gt = wg * NTHR + tid, NT = G * NTHR;
    for (int idx = gt; idx < 65536; idx += NT) { const int lg = idx >> 12, j = (idx >> 6) & 63, i = idx & 63, src = (lg * 64 + i) * 64 + j;
        POOLWT[idx] = f2bf(pool_w[src]); LRUWAT[idx] = f2bf(lwa[src]); LRUWXT[idx] = f2bf(lwx[src]); }
    for (int idx = gt; idx < 262144; idx += NT) { const int t = (idx >> 7) & 127, s = idx & 127; SGUW[idx] = (s <= t) ? f2bf(sgu_ws[idx]) : (bf16)0; }
}

struct CvItem { gcf W; gb WT; int K, N, mode, idx; float f8s; };
DI void cv_load(const CvItem& I, int lane, f32x4 (&v)[8]) {
    const int nblk = I.N / 32, kb = I.idx / nblk, nb = I.idx % nblk;
    gcf p = I.W + (size_t)(64 * kb + (lane >> 3)) * I.N + 32 * nb + 4 * (lane & 7);
#pragma unroll
    for (int i = 0; i < 8; ++i) v[i] = ld4(p + (size_t)(8 * i) * I.N);
}
DI void cv_store(const CvItem& I, LAS float* scr, int lane, const f32x4 (&v)[8]) {
    const int nblk = I.N / 32, kb = I.idx / nblk, nb = I.idx % nblk, k0 = 64 * kb, n0 = 32 * nb;
#pragma unroll
    for (int i = 0; i < 8; ++i) { LAS float* d = scr + (8 * i + (lane >> 3)) * 33 + 4 * (lane & 7); d[0] = v[i].x; d[1] = v[i].y; d[2] = v[i].z; d[3] = v[i].w; }
    LDS_WAIT();
    const int c = lane & 7;
    const int drow0 = (I.mode == 0) ? n0 : ((n0 >> 7) * 256 + (n0 & 127) + (I.mode == 2 ? 128 : 0));
    if (I.f8s > 0.f) { const float sc = I.f8s; GAS unsigned char* W8 = (GAS unsigned char*)I.WT;
#pragma unroll
        for (int j = 0; j < 4; ++j) { const int n = (lane >> 3) + 8 * j; const LAS float* s = scr + (8 * c) * 33 + n;
            v2u o; o.x = pk4_f8(s[0 * 33] * sc, s[1 * 33] * sc, s[2 * 33] * sc, s[3 * 33] * sc); o.y = pk4_f8(s[4 * 33] * sc, s[5 * 33] * sc, s[6 * 33] * sc, s[7 * 33] * sc);
            *(GAS v2u*)(W8 + (size_t)(drow0 + n) * I.K + k0 + 8 * c) = o; }
    } else {
#pragma unroll
    for (int j = 0; j < 4; ++j) { const int n = (lane >> 3) + 8 * j; const LAS float* s = scr + (8 * c) * 33 + n;
        v4u o; o.x = pk2(s[0 * 33], s[1 * 33]); o.y = pk2(s[2 * 33], s[3 * 33]); o.z = pk2(s[4 * 33], s[5 * 33]); o.w = pk2(s[6 * 33], s[7 * 33]);
        *(GAS v4u*)(I.WT + (size_t)(drow0 + n) * I.K + k0 + 8 * c) = o; }
    }
    LDS_WAIT();
}
DI void convert_weights(int l, gcf w_in, gcf w_out, gcf f1, gcf f3, gcf f2, gcf m1, gcf m3, gcf m2,
                        gws ws, LAS unsigned char* lds, int wg, int G, int wave, int lane) {
    LAS float* scr = (LAS float*)(lds + wave * 16384);
    gb WIN = (GAS bf16*)(ws + WS_WIN); gb WOUT = (GAS bf16*)(ws + WS_WOUT); gb W13 = (GAS bf16*)(ws + WS_W13); gb W2 = (GAS bf16*)(ws + WS_W2);
    constexpr int n_in = 16 * 72, n_out = 16 * 32, n13 = 16 * 112, n2 = 56 * 32, per_e = 2 * n13 + n2;
    const int moe = l & 1, E = moe ? NE : 1, total = n_in + n_out + E * per_e, stride = G * NWAVES, f8 = IS_F8(l) ? 1 : 0;
#define CV_DECODE(it_, I_) do { int r = (it_); \
        if (r < n_in) { I_ = CvItem{w_in + (size_t)l * D * INW, WIN, D, INW, 0, r, 0.f}; } \
        else if (r < n_in + n_out) { I_ = CvItem{w_out + (size_t)l * D * D, WOUT, D, D, 0, r - n_in, 0.f}; } \
        else { r -= n_in + n_out; const int e = r / per_e; r -= e * per_e; \
            const size_t mo = (size_t)((l >> 1) * (moe ? NE : 1) + e) * D * DFF; \
            const size_t o13 = ((size_t)e * 2 * DFF * D) >> f8, o2 = ((size_t)e * D * DFF) >> f8;     \
            if (r < n13) I_ = CvItem{(moe ? m1 : f1) + mo, W13 + o13, D, DFF, 1, r, f8 ? F8_S13 : 0.f}; \
            else if (r < 2 * n13) I_ = CvItem{(moe ? m3 : f3) + mo, W13 + o13, D, DFF, 2, r - n13, f8 ? F8_S13 : 0.f}; \
            else I_ = CvItem{(moe ? m2 : f2) + mo, W2 + o2, DFF, D, 0, r - 2 * n13, f8 ? F8_S2 : 0.f}; } } while (0)
    int it = wg * NWAVES + wave;
    if (it >= total) return;
    CvItem Ia, Ib; f32x4 va[8], vb[8];
    CV_DECODE(it, Ia); cv_load(Ia, lane, va);
    for (;;) {
        const bool hb = it + stride < total;
        if (hb) { CV_DECODE(it + stride, Ib); cv_load(Ib, lane, vb); }
        cv_store(Ia, scr, lane, va);
        if (!hb) break;
        it += stride;
        const bool ha = it + stride < total;
        if (ha) { CV_DECODE(it + stride, Ia); cv_load(Ia, lane, va); }
        cv_store(Ib, scr, lane, vb);
        if (!ha) break;
        it += stride;
    }
#undef CV_DECODE
}

template <bool COMBINE, bool ROUTER, bool FINAL, bool XF32, bool OUT8 = false>
DI void norm_phase(gcf xf, gb xb, gf outf, gcf gain, gcf shift, gcf scale, gcf gprev, gcb Y0, gcb Y1, gb XN,
                   gcf rw, gcf rb, gi toke, gf tokw, gi histw, gv2i pair, LAS unsigned char* lds, int wg, int G, int tid, int wave, int lane) {
    LAS float* RW = (LAS float*)lds;
    if (ROUTER) {
        for (int i = tid; i < 8192; i += NTHR) RW[i] = rw[i];
        for (int i = wg * NTHR + tid; i < MAXPAIR; i += G * NTHR) pair[i] = (v2i){-1, 0};
        __syncthreads();
    }
    for (int blk = wg; blk < M / 256; blk += G) {
        const int b = blk >> 5;
        f32x4 gm[4], sh[4], gp[4];
#pragma unroll
        for (int j = 0; j < 4; ++j) { const int col = 4 * lane + 256 * j;
            if (FINAL) { gm[j] = ld4(gain + col); sh[j] = (f32x4){0.f, 0.f, 0.f, 0.f}; }
            else { gm[j] = ld4(gain + col) * (ld4(scale + (size_t)b * MODW + col) + 1.0f); sh[j] = ld4(shift + (size_t)b * MODW + col); }
            if (COMBINE) gp[j] = ld4(gprev + (size_t)b * MODW + col); else gp[j] = (f32x4){0.f, 0.f, 0.f, 0.f}; }
        int cnt[8];
#pragma unroll
        for (int e = 0; e < 8; ++e) cnt[e] = 0;
        constexpr int RG = 2;
        for (int r0 = 0; r0 < 32; r0 += RG) {
            f32x4 vv[RG][4]; v2u ya[COMBINE ? RG : 1][4], yb[COMBINE ? RG : 1][4];
#pragma unroll
            for (int q = 0; q < RG; ++q)
#pragma unroll
                for (int j = 0; j < 4; ++j) { const size_t off = (size_t)(blk * 256 + wave * 32 + r0 + q) * D + 4 * lane + 256 * j; if (XF32) vv[q][j] = ld4(xf + off); else vv[q][j] = unpack4(*(GAS const v2u*)(xb + off));
                    if (COMBINE) { ya[q][j] = *(GAS const v2u*)(Y0 + off); yb[q][j] = *(GAS const v2u*)(Y1 + off); } }
#pragma unroll
            for (int q = 0; q < RG; ++q) {
            const int row = blk * 256 + wave * 32 + r0 + q;
            f32x4 v[4]; float ss = 0.f;
#pragma unroll
            for (int j = 0; j < 4; ++j) { const size_t off = (size_t)row * D + 4 * lane + 256 * j; v[j] = vv[q][j];
                if (COMBINE) v[j] += gp[j] * (unpack4(ya[q][j]) + unpack4(yb[q][j]));
                if ((COMBINE && !FINAL) || XF32) *(GAS v2u*)(xb + off) = pack4(v[j]);
                ss += (v[j].x * v[j].x + v[j].y * v[j].y) + (v[j].z * v[j].z + v[j].w * v[j].w); }
            const float rstd = rsqrtf(wave_sum_dpp(ss) * (1.f / D) + EPS);
            f32x4 h[4];
#pragma unroll
            for (int j = 0; j < 4; ++j) { const size_t off = (size_t)row * D + 4 * lane + 256 * j; h[j] = v[j] * rstd * gm[j] + sh[j];
                if (FINAL) *(GAS f32x4*)(outf + off) = h[j]; else if (OUT8) *(GAS unsigned*)((GAS unsigned char*)XN + off) = pk4_f8(h[j].x, h[j].y, h[j].z, h[j].w); else *(GAS v2u*)(XN + off) = pack4(h[j]); }
            if (ROUTER) {
                float lg[8];
#pragma unroll
                for (int e = 0; e < 8; ++e) lg[e] = 0.f;
#pragma unroll
                for (int j = 0; j < 4; ++j)
#pragma unroll
                    for (int i = 0; i < 4; ++i) { const int cc = 4 * lane + 256 * j + i; const f32x4 w0 = *(const LAS f32x4*)(RW + cc * 8), w1 = *(const LAS f32x4*)(RW + cc * 8 + 4); const float hv = h[j][i];
                        lg[0] += hv * w0.x; lg[1] += hv * w0.y; lg[2] += hv * w0.z; lg[3] += hv * w0.w; lg[4] += hv * w1.x; lg[5] += hv * w1.y; lg[6] += hv * w1.z; lg[7] += hv * w1.w; }
#pragma unroll
                for (int e = 0; e < 8; ++e) lg[e] = wave_sum_dpp(lg[e]) + rb[e];
                int i0 = 0; float v0 = lg[0];
#pragma unroll
                for (int e = 1; e < 8; ++e) if (lg[e] > v0) { v0 = lg[e]; i0 = e; }
                int i1 = -1; float v1 = -3.0e38f;
#pragma unroll
                for (int e = 0; e < 8; ++e) if (e != i0 && lg[e] > v1) { v1 = lg[e]; i1 = e; }
                const float w0 = 1.f / (1.f + expf(v1 - v0)), w1 = 1.f - w0;
                if (lane == 0) { toke[row] = i0 | (i1 << 8); tokw[2 * row] = w0; tokw[2 * row + 1] = w1; }
#pragma unroll
                for (int e = 0; e < 8; ++e) cnt[e] += (i0 == e) + (i1 == e);
            }
            }
        }
        if (ROUTER && lane == 0) {
#pragma unroll
            for (int e = 0; e < 8; ++e) histw[(blk * 8 + wave) * 8 + e] = cnt[e]; }
    }
}

DI void route_phase(gcb XN, gb XG, gci toke, gcf tokw, gci histw, gv2i pair, gi tilee, gi ntp,
                    LAS unsigned char* lds, int wg, int G, int tid, int wave, int lane, int f8) {
    LAS int* L = (LAS int*)lds;
    for (int blk = wg; blk < M / 256; blk += G) {
        int tot[8], pre[8];
#pragma unroll
        for (int e = 0; e < 8; ++e) { tot[e] = 0; pre[e] = 0; }
        for (int q = tid; q < 2048; q += NTHR) { const v4i h0 = *(GAS const v4i*)(histw + q * 8), h1 = *(GAS const v4i*)(histw + q * 8 + 4); const int m = (q < blk * 8) ? 1 : 0;
            tot[0] += h0.x; tot[1] += h0.y; tot[2] += h0.z; tot[3] += h0.w; tot[4] += h1.x; tot[5] += h1.y; tot[6] += h1.z; tot[7] += h1.w;
            pre[0] += m * h0.x; pre[1] += m * h0.y; pre[2] += m * h0.z; pre[3] += m * h0.w; pre[4] += m * h1.x; pre[5] += m * h1.y; pre[6] += m * h1.z; pre[7] += m * h1.w; }
#pragma unroll
        for (int e = 0; e < 8; ++e) { tot[e] = wave_sum_i(tot[e]); pre[e] = wave_sum_i(pre[e]); }
        if (lane == 0) {
#pragma unroll
            for (int e = 0; e < 8; ++e) { L[wave * 16 + e] = tot[e]; L[wave * 16 + 8 + e] = pre[e]; } }
        __syncthreads();
        int start[9]; start[0] = 0;
#pragma unroll
        for (int e = 0; e < 8; ++e) { int t = 0, p = 0;
#pragma unroll
            for (int w = 0; w < 8; ++w) { t += L[w * 16 + e]; p += L[w * 16 + 8 + e]; }
            tot[e] = t; pre[e] = p; start[e + 1] = start[e] + ((t + 255) & ~255); }
        int e0 = -1, e1 = -1; const int tok = blk * 256 + tid;
        if (tid < 256) { const int te = toke[tok]; e0 = te & 255; e1 = te >> 8; }
        const unsigned long long lt = (1ull << lane) - 1ull;
        int r0 = 0, r1 = 0;
#pragma unroll
        for (int e = 0; e < 8; ++e) { const unsigned long long m0 = __ballot(e0 == e), m1 = __ballot(e1 == e);
            const int rr = __popcll(m0 & lt) + __popcll(m1 & lt);
            if (e0 == e) r0 = rr; if (e1 == e) r1 = rr;
            if (lane == 0) L[128 + wave * 8 + e] = __popcll(m0) + __popcll(m1);
            if (tid == 0) L[192 + e] = start[e] + pre[e]; }
        __syncthreads();
        if (tid < 256) {
            int p0 = L[192 + e0] + r0, p1 = L[192 + e1] + r1;
            for (int w = 0; w < wave; ++w) { p0 += L[128 + w * 8 + e0]; p1 += L[128 + w * 8 + e1]; }
            const f32x2 wv = *(GAS const f32x2*)(tokw + 2 * tok);
            pair[p0] = (v2i){tok, __builtin_bit_cast(int, wv.x)}; pair[p1] = (v2i){tok | (1 << 30), __builtin_bit_cast(int, wv.y)};
            L[256 + 2 * tid] = p0; L[256 + 2 * tid + 1] = p1;
        }
        __syncthreads();
        for (int i0 = 0; i0 < 32; i0 += 4) {
            v4u ra[4], rb2[4]; int pp0[4], pp1[4];
#pragma unroll
            for (int q = 0; q < 4; ++q) { const int tl = wave * 32 + i0 + q; pp0[q] = L[256 + 2 * tl]; pp1[q] = L[256 + 2 * tl + 1];
                gcb srcp = XN + (size_t)(blk * 256 + tl) * D + lane * 16; ra[q] = *(GAS const v4u*)srcp; rb2[q] = *(GAS const v4u*)(srcp + 8); }
            if (f8) { GAS unsigned char* X8 = (GAS unsigned char*)XG;
#pragma unroll
                for (int q = 0; q < 4; ++q) { float xa[8], xb2[8]; unpack8(ra[q], xa); unpack8(rb2[q], xb2);
                    v4u o; o.x = pk4_f8(xa[0], xa[1], xa[2], xa[3]); o.y = pk4_f8(xa[4], xa[5], xa[6], xa[7]); o.z = pk4_f8(xb2[0], xb2[1], xb2[2], xb2[3]); o.w = pk4_f8(xb2[4], xb2[5], xb2[6], xb2[7]);
                    *(GAS v4u*)(X8 + (size_t)pp0[q] * D + lane * 16) = o; *(GAS v4u*)(X8 + (size_t)pp1[q] * D + lane * 16) = o; }
            } else {
#pragma unroll
            for (int q = 0; q < 4; ++q) { gb d0 = XG + (size_t)pp0[q] * D + lane * 16; gb d1 = XG + (size_t)pp1[q] * D + lane * 16;
                *(GAS v4u*)d0 = ra[q]; *(GAS v4u*)(d0 + 8) = rb2[q]; *(GAS v4u*)d1 = ra[q]; *(GAS v4u*)(d1 + 8) = rb2[q]; } } }
        if (blk == 0) { const int ntt = start[8] >> 8;
            for (int t = tid; t < ntt; t += NTHR) { int e = 0;
#pragma unroll
                for (int q = 1; q < 8; ++q) e += (t >= (start[q] >> 8)) ? 1 : 0;
                tilee[t] = e; }
            if (tid == 0) ntp[0] = ntt; }
        __syncthreads();
    }
}

DI void pool_unit(gcb PROJ, gb CAT, gcb WT, gcf pscale, gcf pnorm, LAS unsigned char* lds, int b, int t0, int tid, int wave, int lane) {
    asm volatile("" : "+v"(tid)); lane = tid & 63;
    LAS bf16* XT = (LAS bf16*)lds;
    LAS bf16* DT = (LAS bf16*)(lds + 80 * 264 * 2);
    LAS float* SSP = (LAS float*)(lds + (80 + 64) * 264 * 2);
    const int fr = lane & 15, fq = lane >> 4, tbh = wave & 3, gp = wave >> 2;
    bf16x8 Wf[2][2][4];
#pragma unroll
    for (int gl = 0; gl < 2; ++gl)
#pragma unroll
        for (int kk = 0; kk < 2; ++kk)
#pragma unroll
            for (int nb = 0; nb < 4; ++nb) Wf[gl][kk][nb] = *(GAS const bf16x8*)(WT + (((2 * gp + gl) * 64 + nb * 16 + fr) * 64 + kk * 32 + 8 * fq));
    for (int half = 0; half < 2; ++half) {
        const int t0h = t0 + 64 * half;
        __syncthreads();
        { v4u xr[5];
#pragma unroll
            for (int i = 0; i < 5; ++i) { const int cidx = tid + NTHR * i, row = cidx >> 5, cg = cidx & 31, tt = t0h - 16 + row, ttc = tt < 0 ? 0 : tt;
                xr[i] = *(GAS const v4u*)(PROJ + ((size_t)b * SEQ + ttc) * INW + cg * 8); }
#pragma unroll
            for (int i = 0; i < 5; ++i) { const int cidx = tid + NTHR * i, row = cidx >> 5, cg = cidx & 31, tt = t0h - 16 + row;
                *(LAS v4u*)(XT + row * 264 + cg * 8) = (tt < 0) ? (v4u){0u, 0u, 0u, 0u} : xr[i]; } }
        __syncthreads();
        { const int cg = tid & 31, run = tid >> 5, ch0 = cg * 8, win = 2 << (cg >> 3), tl0 = run * 4;
            float s[8];
#pragma unroll
            for (int k = 0; k < 8; ++k) s[k] = 0.f;
            for (int r = 1; r <= win; ++r) { float xv[8]; unpack8(*(const LAS v4u*)(XT + (tl0 + 16 - r) * 264 + ch0), xv);
#pragma unroll
                for (int k = 0; k < 8; ++k) s[k] += xv[k]; }
#pragma unroll
            for (int i = 0; i < 4; ++i) { float xv[8], yv[8]; unpack8(*(const LAS v4u*)(XT + (tl0 + i + 16) * 264 + ch0), xv); unpack8(*(const LAS v4u*)(XT + (tl0 + i + 16 - win) * 264 + ch0), yv);
                const int tt = t0h + tl0 + i; const float inv = 1.f / (float)((tt + 1 < win) ? tt + 1 : win);
#pragma unroll
                for (int k = 0; k < 8; ++k) s[k] += xv[k] - yv[k];
                v4u o; o.x = pk2(s[0] * inv - xv[0], s[1] * inv - xv[1]); o.y = pk2(s[2] * inv - xv[2], s[3] * inv - xv[3]); o.z = pk2(s[4] * inv - xv[4], s[5] * inv - xv[5]); o.w = pk2(s[6] * inv - xv[6], s[7] * inv - xv[7]);
                *(LAS v4u*)(DT + (tl0 + i) * 264 + ch0) = o; } }
        __syncthreads();
        f32x4 acc[2][4];
#pragma unroll
        for (int gl = 0; gl < 2; ++gl)
#pragma unroll
            for (int nb = 0; nb < 4; ++nb) acc[gl][nb] = (f32x4){0.f, 0.f, 0.f, 0.f};
#pragma unroll
        for (int gl = 0; gl < 2; ++gl)
#pragma unroll
            for (int kk = 0; kk < 2; ++kk) { const bf16x8 X = *(const LAS bf16x8*)(DT + (16 * tbh + fr) * 264 + (2 * gp + gl) * 64 + kk * 32 + 8 * fq);
#pragma unroll
                for (int nb = 0; nb < 4; ++nb) acc[gl][nb] = mfma16(Wf[gl][kk][nb], X, acc[gl][nb]); }
        float ss = 0.f;
#pragma unroll
        for (int gl = 0; gl < 2; ++gl)
#pragma unroll
            for (int nb = 0; nb < 4; ++nb) { const f32x4 y = acc[gl][nb] * ld4(pscale + (2 * gp + gl) * 64 + nb * 16 + 4 * fq); acc[gl][nb] = y; ss += (y.x * y.x + y.y * y.y) + (y.z * y.z + y.w * y.w); }
        ss += __shfl_xor(ss, 16); ss += __shfl_xor(ss, 32);
        if (fq == 0) SSP[gp * 64 + 16 * tbh + fr] = ss;
        __syncthreads();
        const float rstd = rsqrtf((SSP[16 * tbh + fr] + SSP[64 + 16 * tbh + fr]) * (1.f / GWD) + EPS);
        const size_t row = (size_t)b * SEQ + t0h + 16 * tbh + fr;
#pragma unroll
        for (int gl = 0; gl < 2; ++gl)
#pragma unroll
            for (int nb = 0; nb < 4; ++nb) { const int ch = (2 * gp + gl) * 64 + nb * 16 + 4 * fq; *(GAS v2u*)(CAT + row * D + ch) = pack4(acc[gl][nb] * rstd * ld4(pnorm + ch)); }
    }
}

DI void sgu_unit(gcb PROJ, gb CAT, gcb SW, gcf sbias, gcf snorm, LAS unsigned char* lds, int b, int t0, int tid, int wave, int lane) {
    asm volatile("" : "+v"(tid)); lane = tid & 63;
    __syncthreads();
    LAS bf16* VT = (LAS bf16*)lds;
    const int fr = lane & 15, fq = lane >> 4, tb = wave, nk = (tb >> 1) + 1;
    { v2u vr[16];
#pragma unroll
        for (int i = 0; i < 16; ++i) vr[i] = *(GAS const v2u*)(PROJ + ((size_t)b * SEQ + t0 + 16 * wave + i) * INW + 512 + 4 * lane);
#pragma unroll
        for (int i = 0; i < 8; ++i) { const int tl = 16 * wave + 2 * i;
            f32x4 va = unpack4(vr[2 * i]), vb = unpack4(vr[2 * i + 1]);
            va.x = gelu_t(va.x); va.y = gelu_t(va.y); va.z = gelu_t(va.z); va.w = gelu_t(va.w); vb.x = gelu_t(vb.x); vb.y = gelu_t(vb.y); vb.z = gelu_t(vb.z); vb.w = gelu_t(vb.w);
            const float mua = wave_sum_dpp((va.x + va.y) + (va.z + va.w)) * (1.f / GWD), mub = wave_sum_dpp((vb.x + vb.y) + (vb.z + vb.w)) * (1.f / GWD);
            va = va - mua; vb = vb - mub;
            const float vra = wave_sum_dpp((va.x * va.x + va.y * va.y) + (va.z * va.z + va.w * va.w)) * (1.f / GWD), vrb = wave_sum_dpp((vb.x * vb.x + vb.y * vb.y) + (vb.z * vb.z + vb.w * vb.w)) * (1.f / GWD);
            va = va * rsqrtf(vra + EPS); vb = vb * rsqrtf(vrb + EPS);
            *(LAS unsigned*)(VT + (4 * lane + 0) * 136 + tl) = pk2(va.x, vb.x); *(LAS unsigned*)(VT + (4 * lane + 1) * 136 + tl) = pk2(va.y, vb.y);
            *(LAS unsigned*)(VT + (4 * lane + 2) * 136 + tl) = pk2(va.z, vb.z); *(LAS unsigned*)(VT + (4 * lane + 3) * 136 + tl) = pk2(va.w, vb.w); } }
    const int tl = 16 * tb + fr; const size_t row = (size_t)b * SEQ + t0 + tl;
    v2u ur[4][4]; float bias4[4];
#pragma unroll
    for (int h = 0; h < 4; ++h) { bias4[h] = sbias[h * 128 + tl];
#pragma unroll
        for (int db = 0; db < 4; ++db) ur[h][db] = *(GAS const v2u*)(PROJ + row * INW + 256 + h * 64 + db * 16 + 4 * fq); }
    __syncthreads();
    f32x4 acc[4][4];
#pragma unroll
    for (int h = 0; h < 4; ++h)
#pragma unroll
        for (int db = 0; db < 4; ++db) acc[h][db] = (f32x4){0.f, 0.f, 0.f, 0.f};
    for (int kk = 0; kk < nk; ++kk) {
        bf16x8 Q[4];
#pragma unroll
        for (int h = 0; h < 4; ++h) Q[h] = *(GAS const bf16x8*)(SW + ((h * 128 + 16 * tb + fr) * 128 + kk * 32 + 8 * fq));
#pragma unroll
        for (int h = 0; h < 4; ++h)
#pragma unroll
            for (int db = 0; db < 4; ++db) { const bf16x8 P = *(const LAS bf16x8*)(VT + (h * 64 + db * 16 + fr) * 136 + kk * 32 + 8 * fq); acc[h][db] = mfma16(P, Q[h], acc[h][db]); } }
    float ss = 0.f;
#pragma unroll
    for (int h = 0; h < 4; ++h)
#pragma unroll
        for (int db = 0; db < 4; ++db) { f32x4 u = unpack4(ur[h][db]);
            u.x = gelu_t(u.x); u.y = gelu_t(u.y); u.z = gelu_t(u.z); u.w = gelu_t(u.w);
            const f32x4 y = u * (acc[h][db] + bias4[h]); acc[h][db] = y; ss += (y.x * y.x + y.y * y.y) + (y.z * y.z + y.w * y.w); }
    ss += __shfl_xor(ss, 16); ss += __shfl_xor(ss, 32);
    const float rstd = rsqrtf(ss * (1.f / GWD) + EPS);
#pragma unroll
    for (int h = 0; h < 4; ++h)
#pragma unroll
        for (int db = 0; db < 4; ++db) { const int ch = h * 64 + db * 16 + 4 * fq; *(GAS v2u*)(CAT + row * D + 256 + ch) = pack4(acc[h][db] * rstd * ld4(snorm + ch)); }
}

template <int D_> DI float row_shr(float ident, float src) {
    return __builtin_bit_cast(float, __builtin_amdgcn_update_dpp(__builtin_bit_cast(int, ident), __builtin_bit_cast(int, src), 0x110 + D_, 0xf, 0xf, false));
}
DI void lru_local_unit(gcb PROJ, gcf convw, gcf convb, gcf lba, gcf lbx, gcf lam, gcb WAT, gcb WXT, gf AGG, GAS unsigned* LAB, LAS unsigned char* lds, int b, int chunk, int tid, int wave, int lane) {
    asm volatile("" : "+v"(tid)); lane = tid & 63;
    __syncthreads();
    LAS bf16* TILE = (LAS bf16*)lds;
    const int t0 = chunk * CH;
    {
        const int cg = tid & 31, ch0 = cg * 8;
        f32x4 cw[4][2], cb[2];
#pragma unroll
        for (int k = 0; k < 4; ++k) { cw[k][0] = ld4(convw + k * GWD + ch0); cw[k][1] = ld4(convw + k * GWD + ch0 + 4); }
        cb[0] = ld4(convb + ch0); cb[1] = ld4(convb + ch0 + 4);
#pragma unroll
        for (int hb2 = 0; hb2 < 2; ++hb2) {
            v4u xr[4][4];
#pragma unroll
            for (int i = 0; i < 4; ++i) { const int tl = (tid >> 5) + 16 * (hb2 * 4 + i);
#pragma unroll
                for (int k = 0; k < 4; ++k) { const int tt = t0 + tl - 3 + k, ttc = tt < 0 ? 0 : tt; xr[i][k] = *(GAS const v4u*)(PROJ + ((size_t)b * SEQ + ttc) * INW + 768 + ch0); } }
#pragma unroll
            for (int i = 0; i < 4; ++i) { const int tl = (tid >> 5) + 16 * (hb2 * 4 + i);
                f32x4 x0 = cb[0], x1 = cb[1];
#pragma unroll
                for (int k = 0; k < 4; ++k) { const float m = (t0 + tl - 3 + k >= 0) ? 1.f : 0.f; float xv[8]; unpack8(xr[i][k], xv);
                    x0 += cw[k][0] * ((f32x4){xv[0], xv[1], xv[2], xv[3]} * m); x1 += cw[k][1] * ((f32x4){xv[4], xv[5], xv[6], xv[7]} * m); }
                v4u o; o.x = pk2(x0.x, x0.y); o.y = pk2(x0.z, x0.w); o.z = pk2(x1.x, x1.y); o.w = pk2(x1.z, x1.w);
                *(LAS v4u*)(TILE + tl * 264 + ch0) = o; }
        }
    }
    const int hb = wave & 3, nh = wave >> 2, fr = lane & 15, fq = lane >> 4;
    bf16x8 WA[2][2], WX[2][2];
#pragma unroll
    for (int kk = 0; kk < 2; ++kk)
#pragma unroll
        for (int nbl = 0; nbl < 2; ++nbl) { const int o = (hb * 64 + (2 * nh + nbl) * 16 + fr) * 64 + kk * 32 + 8 * fq; WA[kk][nbl] = *(GAS const bf16x8*)(WAT + o); WX[kk][nbl] = *(GAS const bf16x8*)(WXT + o); }
    f32x4 ba4[2], bx4[2], ls4[2], hc[2], ac[2];
#pragma unroll
    for (int nbl = 0; nbl < 2; ++nbl) { const int ch = hb * 64 + (2 * nh + nbl) * 16 + 4 * fq; ba4[nbl] = ld4(lba + ch); bx4[nbl] = ld4(lbx + ch);
        const f32x4 lm = ld4(lam + ch);
#pragma unroll
        for (int j = 0; j < 4; ++j) ls4[nbl][j] = -8.0f * log1pf(expf(-lm[j]));
        hc[nbl] = (f32x4){0.f, 0.f, 0.f, 0.f}; ac[nbl] = (f32x4){1.f, 1.f, 1.f, 1.f}; }
    __syncthreads();
#pragma unroll 1
    for (int tb = 0; tb < 8; ++tb) {
        const int tl = 16 * tb + fr; const size_t row = (size_t)b * SEQ + t0 + tl;
        bf16x8 X[2];
#pragma unroll
        for (int kk = 0; kk < 2; ++kk) X[kk] = *(const LAS bf16x8*)(TILE + tl * 264 + hb * 64 + kk * 32 + 8 * fq);
#pragma unroll
        for (int nbl = 0; nbl < 2; ++nbl) {
            f32x4 ra = (f32x4){0.f, 0.f, 0.f, 0.f}, rx = (f32x4){0.f, 0.f, 0.f, 0.f};
#pragma unroll
            for (int kk = 0; kk < 2; ++kk) { ra = mfma16(WA[kk][nbl], X[kk], ra); rx = mfma16(WX[kk][nbl], X[kk], rx); }
            const int ch = hb * 64 + (2 * nh + nbl) * 16 + 4 * fq;
            const f32x4 xcv = unpack4(*(const LAS v2u*)(TILE + tl * 264 + ch));
            v4u lab;
#pragma unroll
            for (int j = 0; j < 4; ++j) {
                const float e1 = __expf(-(ra[j] + ba4[nbl][j])), e2 = __expf(-(rx[j] + bx4[nbl][j]));
                const float rp = __builtin_amdgcn_rcpf((1.f + e1) * (1.f + e2)), r = (1.f + e2) * rp, ii = (1.f + e1) * rp;
                const float la = __builtin_bit_cast(float, pk2(r * ls4[nbl][j], 0.f) << 16);
                float a = __expf(la);
                float bb = sqrtf(fmaxf((la > -0.125f) ? neg_expm1(2.0f * la) : 1.f - a * a, 0.f)) * ii * xcv[j];
                const unsigned pr = pk2(la, bb); bb = __builtin_bit_cast(float, pr & 0xffff0000u);
                lab[j] = pr;
                { const float ap = row_shr<1>(1.f, a), bp = row_shr<1>(0.f, bb); bb = a * bp + bb; a = a * ap; }
                { const float ap = row_shr<2>(1.f, a), bp = row_shr<2>(0.f, bb); bb = a * bp + bb; a = a * ap; }
                { const float ap = row_shr<4>(1.f, a), bp = row_shr<4>(0.f, bb); bb = a * bp + bb; a = a * ap; }
                { const float ap = row_shr<8>(1.f, a), bp = row_shr<8>(0.f, bb); bb = a * bp + bb; a = a * ap; }
                const float h = a * hc[nbl][j] + bb;
                hc[nbl][j] = __shfl(h, 15, 16);
                ac[nbl][j] *= __shfl(a, 15, 16);
            }
            *(GAS v4u*)(LAB + row * GWD + ch) = lab;
        }
    }
    if (fr == 0) {
#pragma unroll
        for (int nbl = 0; nbl < 2; ++nbl) { const int ch = hb * 64 + (2 * nh + nbl) * 16 + 4 * fq; gf ap = AGG + ((size_t)(b * NCH + chunk) * GWD + ch) * 2;
            *(GAS f32x4*)ap = (f32x4){ac[nbl][0], hc[nbl][0], ac[nbl][1], hc[nbl][1]}; *(GAS f32x4*)(ap + 4) = (f32x4){ac[nbl][2], hc[nbl][2], ac[nbl][3], hc[nbl][3]}; }
    }
}
DI void lru_out_unit(gcb PROJ, gb CAT, gcf lnorm, gcf H0, const GAS unsigned* LAB, LAS unsigned char* lds, int b, int chunk, int tid, int wave, int lane) {
    asm volatile("" : "+v"(tid)); lane = tid & 63;
    LAS float* SS = (LAS float*)lds;
    const int t0 = chunk * CH, hb = wave & 3, nh = wave >> 2, fr = lane & 15, fq = lane >> 4;
    v4u lab[8][2]; v2u gt[8][2];
#pragma unroll
    for (int tb = 0; tb < 8; ++tb)
#pragma unroll
        for (int nbl = 0; nbl < 2; ++nbl) { const size_t row = (size_t)b * SEQ + t0 + 16 * tb + fr; const int ch = hb * 64 + (2 * nh + nbl) * 16 + 4 * fq;
            lab[tb][nbl] = *(GAS const v4u*)(LAB + row * GWD + ch); gt[tb][nbl] = *(GAS const v2u*)(PROJ + row * INW + 1024 + ch); }
    f32x4 hc[2];
#pragma unroll
    for (int nbl = 0; nbl < 2; ++nbl) hc[nbl] = ld4(H0 + ((size_t)(b * NCH + chunk) * GWD + hb * 64 + (2 * nh + nbl) * 16 + 4 * fq));
    v2u yk[8][2];
    __syncthreads();
#pragma unroll
    for (int tb = 0; tb < 8; ++tb) {
        float ssq = 0.f;
#pragma unroll
        for (int nbl = 0; nbl < 2; ++nbl) { const f32x4 gt4 = unpack4(gt[tb][nbl]); f32x4 yv;
#pragma unroll
            for (int j = 0; j < 4; ++j) { const unsigned pr = lab[tb][nbl][j];
                float a = __expf(__builtin_bit_cast(float, pr << 16)), bb = __builtin_bit_cast(float, pr & 0xffff0000u);
                { const float ap = row_shr<1>(1.f, a), bp = row_shr<1>(0.f, bb); bb = a * bp + bb; a = a * ap; }
                { const float ap = row_shr<2>(1.f, a), bp = row_shr<2>(0.f, bb); bb = a * bp + bb; a = a * ap; }
                { const float ap = row_shr<4>(1.f, a), bp = row_shr<4>(0.f, bb); bb = a * bp + bb; a = a * ap; }
                { const float ap = row_shr<8>(1.f, a), bp = row_shr<8>(0.f, bb); bb = a * bp + bb; a = a * ap; }
                const float h = a * hc[nbl][j] + bb;
                hc[nbl][j] = __shfl(h, 15, 16);
                const float y = gelu_t(gt4[j]) * h; yv[j] = y; ssq += y * y; }
            yk[tb][nbl] = pack4(yv); }
        ssq += __shfl_xor(ssq, 16); ssq += __shfl_xor(ssq, 32); if (fq == 0) SS[wave * 128 + 16 * tb + fr] = ssq;
    }
    __syncthreads();
#pragma unroll
    for (int tb = 0; tb < 8; ++tb) { const int tl = 16 * tb + fr; const size_t row = (size_t)b * SEQ + t0 + tl; float tot = 0.f;
#pragma unroll
        for (int w = 0; w < 8; ++w) tot += SS[w * 128 + tl];
        const float rstd = rsqrtf(tot * (1.f / GWD) + EPS);
#pragma unroll
        for (int nbl = 0; nbl < 2; ++nbl) { const int ch = hb * 64 + (2 * nh + nbl) * 16 + 4 * fq; *(GAS v2u*)(CAT + row * D + 512 + ch) = pack4(unpack4(yk[tb][nbl]) * rstd * ld4(lnorm + ch)); } }
}

DI f32x4 mfma_p2(const v2u a0, const v2u a1, const v2u b0, const v2u b1, const f32x4 c) {
    v4u A, B; A.x = a0.x; A.y = a0.y; A.z = a1.x; A.w = a1.y; B.x = b0.x; B.y = b0.y; B.z = b1.x; B.w = b1.y;
    return __builtin_amdgcn_mfma_f32_16x16x32_bf16(__builtin_bit_cast(bf16x8, A), __builtin_bit_cast(bf16x8, B), c, 0, 0, 0);
}
template <bool OUT>
DI void hgrn_wave_unit(gcb PROJ, gb CAT, gcf LBl, gcf normg, gf ST, gf DEC, LAS float* wlf, int u, int lane) {
    asm volatile("" : "+v"(lane));
    const int hh = u & 3, c = (u >> 2) & (NCH - 1), b = u >> 8, fr = lane & 15, fq = lane >> 4;
    LAS bf16* QT = (LAS bf16*)wlf;
    LAS bf16* KT = QT + 16 * 72;
    LAS bf16* KH = KT + 16 * 72;
    LAS bf16* VT = KH + 64 * 20;
    LAS float* DC = (LAS float*)(VT + 64 * 20);
    const float lbv = LBl[hh * 64 + lane], oml = 1.f - lbv;
    gf stp = ST + ((size_t)((b * NCH + c) * 4 + hh)) * 4096;
    f32x4 S[4][4];
#pragma unroll
    for (int mi = 0; mi < 4; ++mi)
#pragma unroll
        for (int ni = 0; ni < 4; ++ni) S[mi][ni] = OUT ? *(GAS const f32x4*)(stp + ((mi * 4 + ni) * 64 + lane) * 4) : (f32x4){0.f, 0.f, 0.f, 0.f};
    float Dtot = 1.f;
    f32x4 ng4[4];
#pragma unroll
    for (int nv = 0; nv < 4; ++nv) ng4[nv] = OUT ? ld4(normg + hh * 64 + 16 * nv + 4 * fq) : (f32x4){0.f, 0.f, 0.f, 0.f};
    bf16 zr[16], vr[16], qr[16]; v2u gr[4];
#define HG_LOAD(sbn) do { const size_t r0_ = (size_t)b * SEQ + c * CH + (sbn) * 16; \
        _Pragma("unroll") for (int t = 0; t < 16; ++t) { gcb p = PROJ + (r0_ + t) * INW + hh * 64 + lane; zr[t] = p[1536]; vr[t] = p[1792]; if (OUT) qr[t] = p[1280]; else qr[t] = 0; } \
        _Pragma("unroll") for (int nv = 0; nv < 4; ++nv) { if (OUT) gr[nv] = *(GAS const v2u*)(PROJ + (r0_ + fr) * INW + 2048 + hh * 64 + 16 * nv + 4 * fq); else gr[nv] = (v2u){0u, 0u}; } } while (0)
    HG_LOAD(0);
    for (int sb = 0; sb < CH / 16; ++sb) {
        const size_t row0 = (size_t)b * SEQ + c * CH + sb * 16;
        float kk[16], Bt[16]; float Bc = 0.f;
#pragma unroll
        for (int t = 0; t < 16; ++t) {
            const float z = fminf(fmaxf(bf2f(zr[t]), -30.f), 30.f), ez = __expf(-z), sg = __builtin_amdgcn_rcpf(1.f + ez);
            const float f = fmaxf(lbv + oml * sg, 1e-30f);
            Bc += __logf(f); Bt[t] = Bc; kk[t] = oml * ez * sg;
            VT[lane * 20 + t] = vr[t];
            if (OUT) { const float q = siluf(bf2f(qr[t])); QT[t * 72 + lane] = f2bf(q * __expf(Bc)); KT[t * 72 + lane] = f2bf(kk[t] * __expf(fminf(-Bc, 60.f))); } }
#pragma unroll
        for (int t = 0; t < 16; ++t) KH[lane * 20 + t] = f2bf(kk[t] * __expf(Bc - Bt[t]));
        { const float dsub = __expf(Bc); DC[lane] = dsub; Dtot *= dsub; }
        v2u gcur[4];
#pragma unroll
        for (int nv = 0; nv < 4; ++nv) gcur[nv] = gr[nv];
        if (sb + 1 < CH / 16) HG_LOAD(sb + 1);
        LDS_WAIT();
        v2u vt[4]; const v2u zz = (v2u){0u, 0u};
#pragma unroll
        for (int nv = 0; nv < 4; ++nv) vt[nv] = *(const LAS v2u*)(VT + (16 * nv + fr) * 20 + 4 * fq);
        if (OUT) {
            f32x4 O[4], SC = (f32x4){0.f, 0.f, 0.f, 0.f};
            v2u qf[4], kf[4];
#pragma unroll
            for (int s = 0; s < 4; ++s) { qf[s] = *(const LAS v2u*)(QT + fr * 72 + 16 * s + 4 * fq); kf[s] = *(const LAS v2u*)(KT + fr * 72 + 16 * s + 4 * fq); }
            SC = mfma_p2(kf[0], kf[1], qf[0], qf[1], SC); SC = mfma_p2(kf[2], kf[3], qf[2], qf[3], SC);
#pragma unroll
            for (int nv = 0; nv < 4; ++nv) { O[nv] = (f32x4){0.f, 0.f, 0.f, 0.f};
                O[nv] = mfma_p2(pack4(S[nv][0]), pack4(S[nv][1]), qf[0], qf[1], O[nv]); O[nv] = mfma_p2(pack4(S[nv][2]), pack4(S[nv][3]), qf[2], qf[3], O[nv]); }
#pragma unroll
            for (int r = 0; r < 4; ++r) if (4 * fq + r > fr) SC[r] = 0.f;
            const v2u scp = pack4(SC);
            float ss = 0.f;
#pragma unroll
            for (int nv = 0; nv < 4; ++nv) { O[nv] = mfma_p2(vt[nv], zz, scp, zz, O[nv]); ss += (O[nv].x * O[nv].x + O[nv].y * O[nv].y) + (O[nv].z * O[nv].z + O[nv].w * O[nv].w); }
            ss += __shfl_xor(ss, 16); ss += __shfl_xor(ss, 32);
            const float rstd = rsqrtf(ss * (1.f / 64.f) + EPS);
            const size_t row = row0 + fr;
#pragma unroll
            for (int nv = 0; nv < 4; ++nv) { f32x4 g4 = unpack4(gcur[nv]);
                g4.x = siluf(g4.x); g4.y = siluf(g4.y); g4.z = siluf(g4.z); g4.w = siluf(g4.w);
                *(GAS v2u*)(CAT + row * D + 768 + hh * 64 + 16 * nv + 4 * fq) = pack4(O[nv] * rstd * ng4[nv] * g4); }
        }
#pragma unroll
        for (int ni = 0; ni < 4; ++ni) { const f32x4 dk = *(const LAS f32x4*)(DC + 16 * ni + 4 * fq); const v2u kh = *(const LAS v2u*)(KH + (16 * ni + fr) * 20 + 4 * fq);
#pragma unroll
            for (int mi = 0; mi < 4; ++mi) S[mi][ni] = mfma_p2(kh, zz, vt[mi], zz, S[mi][ni] * dk); }
        LDS_WAIT();
    }
    if (!OUT) {
#pragma unroll
        for (int mi = 0; mi < 4; ++mi)
#pragma unroll
            for (int ni = 0; ni < 4; ++ni) *(GAS f32x4*)(stp + ((mi * 4 + ni) * 64 + lane) * 4) = S[mi][ni];
        DEC[((size_t)((b * NCH + c) * 4 + hh)) * 64 + lane] = Dtot;
    }
}
#undef HG_LOAD

DI void carry_phase(gf ST, gcf DEC, gcf AGG, gf H0, int wg, int G, int tid) {
    const int gt = wg * NTHR + tid, NT = G * NTHR;
    for (int idx = gt; idx < BATCH * 4 * 4096; idx += NT) { const int b = idx >> 14, hh = (idx >> 12) & 3, kv = idx & 4095, k = 16 * ((kv >> 8) & 3) + 4 * ((kv >> 6) & 3) + (kv & 3); float run = 0.f;
#pragma unroll 8
        for (int c = 0; c < NCH; ++c) { gf p = ST + ((size_t)((b * NCH + c) * 4 + hh)) * 4096 + kv; const float d = DEC[((size_t)((b * NCH + c) * 4 + hh)) * 64 + k], sl = *p; *p = run; run = d * run + sl; } }
    for (int idx = gt; idx < BATCH * GWD; idx += NT) { const int b = idx >> 8, ch = idx & 255; float run = 0.f;
#pragma unroll 8
        for (int c = 0; c < NCH; ++c) { const f32x2 ah = *(GAS const f32x2*)(AGG + ((size_t)(b * NCH + c) * GWD + ch) * 2); H0[(size_t)(b * NCH + c) * GWD + ch] = run; run = ah.x * run + ah.y; } }
}

struct Args { const float* in[33]; float* out; unsigned char* ws; int ph_lo, ph_hi; };
enum { I_X = 0, I_C, I_WMOD, I_BMOD, I_NMIX, I_NFFN, I_NFIN, I_WIN, I_WOUT, I_POOLW, I_POOLS, I_POOLN, I_SGUW, I_SGUB, I_SGUN, I_CONVW, I_CONVB, I_LWA, I_LBA, I_LWX, I_LBX, I_LAM, I_LN,
       I_HGAM, I_HN, I_F1, I_F3, I_F2, I_RW, I_RB, I_M1, I_M3, I_M2 };
constexpr int N_PHASES = 1 + (7 + 2) + (8 + (IS_F8(1) ? 4 : 8)) + (7 + 2) + (8 + (IS_F8(3) ? 4 : 8)) + 1;

DI gws launder(unsigned char* p) { asm volatile("" : "+s"(p)); return (gws)p; }
DI gcf inp(const Args& a, int i) { asm volatile("" : "+s"(i)); return (gcf)a.in[i]; }
#define WSP(T, off) ((GAS T*)(ws + (off)))
#define WSG(T, off) ((T*)((unsigned char*)ws + (off)))

__global__ void __launch_bounds__(NTHR, 2) mk_fwd(Args args) {
    extern __shared__ __attribute__((aligned(16))) unsigned char lds_raw[];
    LAS unsigned char* lds = (LAS unsigned char*)lds_raw;
    const int tid0 = threadIdx.x, wg0 = blockIdx.x, G0 = gridDim.x;
    for (int u = tid0; u < (LDS_BYTES - RING_BYTES) / 4; u += NTHR) ((LAS unsigned*)(lds + RING_BYTES))[u] = 0u;
    __syncthreads();
    const XcdBarrier bar = xcd_barrier_post((unsigned*)(args.ws + WS_CTL) + CW_BAR, (volatile LAS unsigned*)(lds + MISC_OFF) + 8);
    const int lo = args.ph_lo, hi = args.ph_hi;
#define XOUT ((gf)args.out)
    int pi = 0;
#define PH_IDS int tid = tid0; asm volatile("" : "+v"(tid)); const int lane = tid & 63, wave = __builtin_amdgcn_readfirstlane(tid >> 6); int wg = wg0, G = G0; asm volatile("" : "+s"(wg), "+s"(G))
#define PH_ON (pi >= lo && pi < hi)
#define PH_END do { if (pi >= lo && pi + 1 < hi) xcd_barrier(bar); ++pi; } while (0)

    if (PH_ON) { gws ws = launder(args.ws); PH_IDS;
        p0_prologue(inp(args, I_C), inp(args, I_WMOD), inp(args, I_BMOD), inp(args, I_HGAM), inp(args, I_POOLW), inp(args, I_LWA), inp(args, I_LWX), inp(args, I_SGUW), ws, lds, wg, G, tid, wave, lane); }
    PH_END;

    for (int l = 0; l < DEPTH; ++l) {
        const int moe = l & 1;
        if (PH_ON) { gws ws = launder(args.ws); PH_IDS; gcf modl = WSP(float, WS_MOD) + (size_t)l * 8 * MODW;
            convert_weights(l, inp(args, I_WIN), inp(args, I_WOUT), inp(args, I_F1), inp(args, I_F3), inp(args, I_F2), inp(args, I_M1), inp(args, I_M3), inp(args, I_M2), ws, lds, wg, G, wave, lane);
            if (l == 2) norm_phase<true, false, false, false>(nullptr, WSP(bf16, WS_XB), nullptr, inp(args, I_NMIX) + l * D, modl + 0 * D, modl + 1 * D, modl - 8 * MODW + 5 * D, WSP(bf16, WS_XN), WSP(bf16, WS_Y1), WSP(bf16, WS_XN), nullptr, nullptr, nullptr, nullptr, nullptr, nullptr, lds, wg, G, tid, wave, lane);
            else if (l == 0) norm_phase<false, false, false, true>(inp(args, I_X), WSP(bf16, WS_XB), nullptr, inp(args, I_NMIX) + l * D, modl + 0 * D, modl + 1 * D, nullptr, nullptr, nullptr, WSP(bf16, WS_XN), nullptr, nullptr, nullptr, nullptr, nullptr, nullptr, lds, wg, G, tid, wave, lane);
            else norm_phase<false, false, false, false>(nullptr, WSP(bf16, WS_XB), nullptr, inp(args, I_NMIX) + l * D, modl + 0 * D, modl + 1 * D, nullptr, nullptr, nullptr, WSP(bf16, WS_XN), nullptr, nullptr, nullptr, nullptr, nullptr, nullptr, lds, wg, G, tid, wave, lane);
        }
        PH_END;
        if (PH_ON) { gws ws = launder(args.ws); PH_IDS;
            pg8::Gemm g{WSG(bf16, WS_XN), WSG(bf16, WS_WIN), D}; pg8::TileOrder<INW / 256> S; S.init(M / 256, G, wg, 0, 0, nullptr);
            EpiProj E{WSP(bf16, WS_PROJ)};
            pg8::gemm_phase<EpiProj, pg8::TileOrder<INW / 256>, true, true>(lds, g, S, E);
        }
        PH_END;
        if (PH_ON) { gws ws = launder(args.ws); PH_IDS; gcb PROJ = WSP(bf16, WS_PROJ); gb CAT = WSP(bf16, WS_CAT);
            for (int unit = wg; unit < BATCH * NCH; unit += G) { const int b = unit >> 6, blk = unit & (NCH - 1);
                pool_unit(PROJ, CAT, WSP(bf16, WS_POOLWT) + l * 16384, inp(args, I_POOLS) + l * GWD, inp(args, I_POOLN) + l * GWD, lds, b, blk * CH, tid, wave, lane);
                sgu_unit(PROJ, CAT, WSP(bf16, WS_SGUW) + l * 65536, inp(args, I_SGUB) + l * 512, inp(args, I_SGUN) + l * GWD, lds, b, blk * CH, tid, wave, lane);
                lru_local_unit(PROJ, inp(args, I_CONVW) + l * 4 * GWD, inp(args, I_CONVB) + l * GWD, inp(args, I_LBA) + l * GWD, inp(args, I_LBX) + l * GWD, inp(args, I_LAM) + l * GWD,
                               WSP(bf16, WS_LRUWAT) + l * 16384, WSP(bf16, WS_LRUWXT) + l * 16384, WSP(float, WS_AGG), WSP(unsigned, WS_LAB), lds, b, blk, tid, wave, lane);
                __syncthreads(); }
            for (int u = wg * NWAVES + wave; u < BATCH * NCH * 4; u += G * NWAVES)
                hgrn_wave_unit<false>(PROJ, CAT, WSP(float, WS_LB) + l * GWD, inp(args, I_HN) + l * GWD, WSP(float, WS_ST), WSP(float, WS_DEC), (LAS float*)(lds + wave * 16384), u, lane);
        }
        PH_END;
        if (PH_ON) { gws ws = launder(args.ws); PH_IDS; carry_phase(WSP(float, WS_ST), WSP(float, WS_DEC), WSP(float, WS_AGG), WSP(float, WS_H0), wg, G, tid); }
        PH_END;
        if (PH_ON) { gws ws = launder(args.ws); PH_IDS; gcb PROJ = WSP(bf16, WS_PROJ); gb CAT = WSP(bf16, WS_CAT);
            for (int unit = wg; unit < BATCH * NCH; unit += G) { const int b = unit >> 6, blk = unit & (NCH - 1);
                lru_out_unit(PROJ, CAT, inp(args, I_LN) + l * GWD, WSP(float, WS_H0), WSP(unsigned, WS_LAB), lds, b, blk, tid, wave, lane); }
            __syncthreads();
            for (int u = wg * NWAVES + wave; u < BATCH * NCH * 4; u += G * NWAVES)
                hgrn_wave_unit<true>(PROJ, CAT, WSP(float, WS_LB) + l * GWD, inp(args, I_HN) + l * GWD, WSP(float, WS_ST), WSP(float, WS_DEC), (LAS float*)(lds + wave * 16384), u, lane);
        }
        PH_END;
        if (PH_ON) { gws ws = launder(args.ws); PH_IDS;
            pg8::Gemm g{WSG(bf16, WS_CAT), WSG(bf16, WS_WOUT), D}; pg8::TileOrder<D / 256> S; S.init(M / 256, G, wg, 0, 0, nullptr);
            EpiResid E{WSP(bf16, WS_XB), WSP(float, WS_MOD) + (size_t)l * 8 * MODW + 2 * D, 1.0f};
            pg8::gemm_phase<EpiResid, pg8::TileOrder<D / 256>, true, true>(lds, g, S, E);
        }
        PH_END;
        if (PH_ON) { gws ws = launder(args.ws); PH_IDS; gcf modl = WSP(float, WS_MOD) + (size_t)l * 8 * MODW;
            if (moe) norm_phase<false, true, false, false>(nullptr, WSP(bf16, WS_XB), nullptr, inp(args, I_NFFN) + l * D, modl + 3 * D, modl + 4 * D, nullptr, nullptr, nullptr, WSP(bf16, WS_XN), inp(args, I_RW) + (l >> 1) * D * NE, inp(args, I_RB) + (l >> 1) * NE,
                                                    WSP(int, WS_TOKE), WSP(float, WS_TOKW), WSP(int, WS_HISTW), WSP(v2i, WS_PAIR), lds, wg, G, tid, wave, lane);
            else if (IS_F8(l)) norm_phase<false, false, false, false, true>(nullptr, WSP(bf16, WS_XB), nullptr, inp(args, I_NFFN) + l * D, modl + 3 * D, modl + 4 * D, nullptr, nullptr, nullptr, WSP(bf16, WS_XN), nullptr, nullptr, nullptr, nullptr, nullptr, nullptr, lds, wg, G, tid, wave, lane);
            else norm_phase<false, false, false, false>(nullptr, WSP(bf16, WS_XB), nullptr, inp(args, I_NFFN) + l * D, modl + 3 * D, modl + 4 * D, nullptr, nullptr, nullptr, WSP(bf16, WS_XN), nullptr, nullptr, nullptr, nullptr, nullptr, nullptr, lds, wg, G, tid, wave, lane);
        }
        PH_END;
        if (moe) {
            if (PH_ON) { gws ws = launder(args.ws); PH_IDS;
                    route_phase(WSP(bf16, WS_XN), WSP(bf16, WS_PROJ), WSP(int, WS_TOKE), WSP(float, WS_TOKW), WSP(int, WS_HISTW), WSP(v2i, WS_PAIR), WSP(int, WS_TILEE), WSP(int, WS_NT), lds, wg, G, tid, wave, lane, IS_F8(l)); }
            PH_END;
        }
        const int nck = moe ? (IS_F8(l) ? 2 : 4) : 1;
#define FFN_RANGE int pm0 = 0, nM = M / 256; if (moe) { const int ntl = __builtin_amdgcn_readfirstlane(__hip_atomic_load(WSP(int, WS_NT), __ATOMIC_RELAXED, __HIP_MEMORY_SCOPE_AGENT)); \
            if (IS_F8(l)) { pm0 = ck * 256; nM = (ck < 1) ? 256 : ntl - 256; if (nM > 292) nM = 292; } else { pm0 = ck * 128; nM = (ck < 3) ? 128 : ntl - 384; if (nM > 146) nM = 146; } if (nM < 0) nM = 0; }
        for (int ck = 0; ck < nck; ++ck) {
            if (PH_ON && !IS_F8(l)) { gws ws = launder(args.ws); PH_IDS; FFN_RANGE;
                pg8::Gemm g{moe ? WSG(bf16, WS_PROJ) : WSG(bf16, WS_XN), WSG(bf16, WS_W13), D}; pg8::TileOrder<DFF / 128> S; S.init(nM, G, wg, pm0, 0, moe ? WSG(int, WS_TILEE) : nullptr);
                EpiSwiglu E{moe ? WSP(bf16, WS_CAT) : WSP(bf16, WS_PROJ), pm0};
                pg8::gemm_phase<EpiSwiglu, pg8::TileOrder<DFF / 128>, true, true>(lds, g, S, E);
            }
            if (PH_ON && IS_F8(l)) { gws ws = launder(args.ws); PH_IDS; FFN_RANGE;
                pg8::Gemm g{moe ? WSG(bf16, WS_PROJ) : WSG(bf16, WS_XN), WSG(bf16, WS_W13), D / 2}; pg8::TileOrder<DFF / 128> S; S.init(nM, G, wg, pm0, 0, moe ? WSG(int, WS_TILEE) : nullptr);
                EpiSwiglu8 E{moe ? WSP(unsigned char, WS_CAT) : WSP(unsigned char, WS_PROJ), pm0};
                pg8::gemm_phase<EpiSwiglu8, pg8::TileOrder<DFF / 128>, true, true, true>(lds, g, S, E);
            }
            PH_END;
            if (PH_ON && !IS_F8(l) && moe) { gws ws = launder(args.ws); PH_IDS; FFN_RANGE;
                pg8::Gemm g{WSG(bf16, WS_CAT), WSG(bf16, WS_W2), DFF}; pg8::TileOrder<D / 256> S; S.init(nM, G, wg, pm0, 1, WSG(int, WS_TILEE));
                EpiScatter E{WSP(v2i, WS_PAIR), WSP(bf16, WS_XN), WSP(bf16, WS_Y1), WSP(int, WS_TOKE), WSP(float, WS_TOKW), 1.0f};
                pg8::gemm_phase<EpiScatter, pg8::TileOrder<D / 256>, true, true>(lds, g, S, E);
            }
            if (PH_ON && !moe && !IS_F8(l)) { gws ws = launder(args.ws); PH_IDS; FFN_RANGE;
                pg8::Gemm g{WSG(bf16, WS_PROJ), WSG(bf16, WS_W2), DFF}; pg8::TileOrder<D / 256> S; S.init(nM, G, wg, pm0, 1, nullptr);
                EpiResid E{WSP(bf16, WS_XB), WSP(float, WS_MOD) + (size_t)l * 8 * MODW + 5 * D, 1.0f};
                pg8::gemm_phase<EpiResid, pg8::TileOrder<D / 256>, true, true>(lds, g, S, E);
            }
            if (PH_ON && IS_F8(l) && !moe) { gws ws = launder(args.ws); PH_IDS; FFN_RANGE;
                pg8::Gemm g{WSG(bf16, WS_PROJ), WSG(bf16, WS_W2), DFF / 2}; pg8::TileOrder<D / 256> S; S.init(nM, G, wg, pm0, 1, nullptr);
                EpiResid E{WSP(bf16, WS_XB), WSP(float, WS_MOD) + (size_t)l * 8 * MODW + 5 * D, 1.0f / F8_S2};
                pg8::gemm_phase<EpiResid, pg8::TileOrder<D / 256>, true, true, true>(lds, g, S, E);
            }
            if (PH_ON && IS_F8(l) && moe) { gws ws = launder(args.ws); PH_IDS; FFN_RANGE;
                pg8::Gemm g{WSG(bf16, WS_CAT), WSG(bf16, WS_W2), DFF / 2}; pg8::TileOrder<D / 256> S; S.init(nM, G, wg, pm0, 1, WSG(int, WS_TILEE));
                EpiScatter E{WSP(v2i, WS_PAIR), WSP(bf16, WS_XN), WSP(bf16, WS_Y1), WSP(int, WS_TOKE), WSP(float, WS_TOKW), 1.0f / F8_S2};
                pg8::gemm_phase<EpiScatter, pg8::TileOrder<D / 256>, true, true, true>(lds, g, S, E);
            }
            PH_END;
        }
#undef FFN_RANGE
    }
    if (PH_ON) { gws ws = launder(args.ws); PH_IDS;
        norm_phase<true, false, true, false>(nullptr, WSP(bf16, WS_XB), XOUT, inp(args, I_NFIN), nullptr, nullptr, WSP(float, WS_MOD) + (size_t)3 * 8 * MODW + 5 * D, WSP(bf16, WS_XN), WSP(bf16, WS_Y1), nullptr, nullptr, nullptr, nullptr, nullptr, nullptr, nullptr, lds, wg, G, tid, wave, lane); }
#undef PH_ON
#undef PH_END
}

#ifndef MK_CUTS
#define MK_CUTS 0
#endif
extern "C" void kernel_launch(void* const* d_in, gci in_sizes, int n_in, void* d_out, int out_size, void* d_ws, size_t ws_size, hipStream_t stream) {
    static int grid = 0;
    if (grid == 0) {
        if (n_in != 33 || in_sizes[0] != M * D || out_size != M * D || ws_size < WS_END) { fprintf(stderr, "kernel_launch: unexpected shapes (n_in %d, in0 %d, out %d, ws %zu); nothing launched\n", n_in, n_in > 0 ? in_sizes[0] : -1, out_size, ws_size); grid = -1; return; }
        int dev = 0, cus = 0, per_cu = 0;
        if (hipGetDevice(&dev) != hipSuccess || hipDeviceGetAttribute(&cus, hipDeviceAttributeMultiprocessorCount, dev) != hipSuccess) { grid = -1; return; }
        if (hipFuncSetAttribute((const void*)mk_fwd, hipFuncAttributeMaxDynamicSharedMemorySize, LDS_BYTES) != hipSuccess) { fprintf(stderr, "kernel_launch: hipFuncSetAttribute failed\n"); grid = -1; return; }
        if (hipOccupancyMaxActiveBlocksPerMultiprocessor(&per_cu, (const void*)mk_fwd, NTHR, LDS_BYTES) != hipSuccess || per_cu < 1) fprintf(stderr, "kernel_launch: occupancy query reports %d workgroups per CU\n", per_cu);
        (void)hipGetLastError();
        grid = cus;
    }
    if (grid < 0) return;
    if (hipMemsetAsync((char*)d_ws + WS_CTL, 0, CTL_ZERO_BYTES, stream) != hipSuccess) return;
    Args a{};
    for (int i = 0; i < 33; ++i) a.in[i] = (const float*)d_in[i];
    a.out = (float*)d_out; a.ws = (unsigned char*)d_ws;
#if MK_CUTS
    for (int p = 0; p < N_PHASES; ++p) { a.ph_lo = p; a.ph_hi = p + 1; hipLaunchKernelGGL(mk_fwd, dim3(grid), dim3(NTHR), LDS_BYTES, stream, a); }
#else
    a.ph_lo = 0; a.ph_hi = N_PHASES;
    hipLaunchKernelGGL(mk_fwd, dim3(grid), dim3(NTHR), LDS_BYTES, stream, a);
#endif
}
```

```cpp
#include <hip/hip_runtime.h>
#include <cstdio>
#include <cstdint>

namespace pg8 {
#define PG8_LAS __attribute__((address_space(3)))
typedef unsigned short bf16_t;
typedef short bf16x8 __attribute__((ext_vector_type(8)));
typedef float f32x4 __attribute__((ext_vector_type(4)));
typedef unsigned u32x4 __attribute__((ext_vector_type(4)));
constexpr int BM = 256, BK = 64, HALF = 128, HTB = HALF * BK * 2  , STAGE_BYTES = 8 * HTB, NXCD = 8, WGM = 8;

__host__ __device__ __forceinline__ int lds_byte(int r, int c) { const int st = (r >> 4) * 2 + (c >> 5), rr = r & 15, cc = c & 31, ob = rr * 64 + cc * 2; return st * 1024 + (ob ^ (((ob >> 9) & 1) << 5)); }
__host__ __device__ __forceinline__ void stage_rc(int b, int& R, int& C) { const int st = b / 1024, sb = b % 1024, swz = sb ^ (((sb >> 9) & 1) << 5); R = (st >> 1) * 16 + swz / 64; C = (st & 1) * 32 + (swz % 64) / 2; }
__host__ __device__ __forceinline__ int perm32(int rho) { const int n = rho >> 4, i = rho & 15; return 8 * (i >> 2) + 4 * n + (i & 3); }

struct Unit { int pa, pn, pm, pc; };
struct Gemm { const bf16_t* A; const bf16_t* Bt; int K; };

template <int NN>
struct TileOrder {
    int nM, nwg, G, c, pm0, a_rel; const int* tile_e;
    __device__ __forceinline__ void init(int nM_, int G_, int c_, int pm0_, int a_rel_, const int* te) { nM = nM_; nwg = nM_ * NN; G = G_; c = c_; pm0 = pm0_; a_rel = a_rel_; tile_e = te; }
    __device__ __forceinline__ bool next(int i, Unit& u) const {
        const int L = i * G + c; if (L >= nwg) return false;
        int wgid = L; { const int q = nwg >> 3, r = nwg & 7, xcd = wgid & 7, off = wgid >> 3; wgid = (xcd < r ? xcd * (q + 1) : r * (q + 1) + (xcd - r) * q) + off; }
        constexpr int nig = WGM * NN;
        const int gid = wgid / nig, x = wgid - gid * nig, fm = gid * WGM, rem = nM - fm;
        int pml, pc;
        if (rem >= WGM) { pml = fm + (x & (WGM - 1)); pc = x >> 3; } else { pml = fm + (x % rem); pc = x / rem; }
        u.pm = pm0 + pml; u.pc = pc; u.pa = a_rel ? pml : u.pm;
        int e = 0; if (tile_e) e = __builtin_amdgcn_readfirstlane(__hip_atomic_load(tile_e + u.pm, __ATOMIC_RELAXED, __HIP_MEMORY_SCOPE_AGENT));
        u.pn = e * NN + pc; return true;
    }
    __device__ __forceinline__ void a_ready(const Unit&) const {}
    __device__ __forceinline__ void done(const Unit&) const {}
};
typedef int v8i32 __attribute__((ext_vector_type(8)));
typedef int v4i32 __attribute__((ext_vector_type(4)));
__device__ __forceinline__ unsigned cvt_pk_bf16(float lo, float hi) { unsigned r; asm("v_cvt_pk_bf16_f32 %0, %1, %2" : "=v"(r) : "v"(lo), "v"(hi)); return r; }

template <class Epi, class Sched, bool ALIGN_EPI = false, bool SP2 = false, bool F8 = false>
__device__ __forceinline__ void gemm_phase(PG8_LAS unsigned char* lds, const Gemm g, const Sched& S, const Epi& E) {
    int tid = threadIdx.x; asm volatile("" : "+v"(tid));
    const int wid = __builtin_amdgcn_readfirstlane(tid >> 6), lane = tid & 63, wr = wid >> 2, wc = wid & 3, fr = lane & 15, fq = lane >> 4;
    const int K = g.K, nt = K / BK;
    unsigned voffA[2], voffB[2];
#pragma unroll
    for (int i = 0; i < 2; ++i) { int R, C; stage_rc(tid * 16 + i * 8192, R, C); const int Rb = Epi::PERM ? ((R & ~31) + perm32(R & 31)) : R;
        voffA[i] = (unsigned)(R * K + C) * 2u; voffB[i] = (unsigned)(Rb * K + C) * 2u; }
    const size_t kstep = (size_t)(BK * 2);
    const size_t hstep = (size_t)HALF * K * 2;
    const size_t tstep = 2 * hstep;
    const unsigned ldsw = (unsigned)wid * 1024u;
    const int aoff = lds_byte(wr * 64 + fr, fq * 8), boff = lds_byte(wc * 32 + fr, fq * 8);
#define PG8_SA(b, h) (((b) * 2 + (h)) * HTB)
#define PG8_SB(b, h) ((4 + (b) * 2 + (h)) * HTB)
#define PG8_STAGE(bufoff, gbase, voff) do { _Pragma("unroll") for (int _i = 0; _i < 2; ++_i) \
        __builtin_amdgcn_global_load_lds((const unsigned*)((const char*)(gbase) + (voff)[_i]), (PG8_LAS unsigned*)(lds + (bufoff) + ldsw + _i * 8192), 16, 0, 0); } while (0)
#define PG8_LD16(off_) (*(const PG8_LAS v4i32*)(lds + (off_)))
#define PG8_LDA(dst, b, h) do { _Pragma("unroll") for (int m = 0; m < 4; ++m) { if constexpr (F8) dst##8[m] = __builtin_shufflevector(PG8_LD16(PG8_SA(b, h) + aoff + m * 2048), PG8_LD16(PG8_SA(b, h) + aoff + m * 2048 + 1024), 0, 1, 2, 3, 4, 5, 6, 7); \
        else { _Pragma("unroll") for (int k = 0; k < 2; ++k) dst[m][k] = *(const PG8_LAS bf16x8*)(lds + PG8_SA(b, h) + aoff + m * 2048 + k * 1024); } } } while (0)
#define PG8_LDB(dst, b, h) do { _Pragma("unroll") for (int n = 0; n < 2; ++n) { if constexpr (F8) dst##8[n] = __builtin_shufflevector(PG8_LD16(PG8_SB(b, h) + boff + n * 2048), PG8_LD16(PG8_SB(b, h) + boff + n * 2048 + 1024), 0, 1, 2, 3, 4, 5, 6, 7); \
        else { _Pragma("unroll") for (int k = 0; k < 2; ++k) dst[n][k] = *(const PG8_LAS bf16x8*)(lds + PG8_SB(b, h) + boff + n * 2048 + k * 1024); } } } while (0)
#define PG8_MMA(ai, bj, At, Bt) do { __builtin_amdgcn_s_setprio(1); _Pragma("unroll") for (int m = 0; m < 4; ++m) _Pragma("unroll") for (int n = 0; n < 2; ++n) { \
        if constexpr (F8) asm volatile("v_mfma_scale_f32_16x16x128_f8f6f4 %0, %1, %2, %0, %3, %3 op_sel_hi:[0,0,0]" : "+v"(acc[ai][bj][m][n]) : "v"(Bt##8[n]), "v"(At##8[m]), "v"(f8scale)); \
        else { _Pragma("unroll") for (int k = 0; k < 2; ++k) acc[ai][bj][m][n] = __builtin_amdgcn_mfma_f32_16x16x32_bf16(Bt[n][k], At[m][k], acc[ai][bj][m][n], 0, 0, 0); } } __builtin_amdgcn_s_setprio(0); } while (0)
#define PG8_WAIT_V(n) asm volatile("s_waitcnt vmcnt(" #n ")" ::: "memory")
#define PG8_WAIT_L(n) asm volatile("s_waitcnt lgkmcnt(" #n ")" ::: "memory")
#define PG8_BAR __builtin_amdgcn_s_barrier()
#define PG8_SCHED __builtin_amdgcn_sched_barrier(0)
    Unit cur, nxt; int ui = 0;
    if (!S.next(0, cur)) return;
    f32x4 acc[2][2][4][2];
#pragma unroll
    for (int a = 0; a < 2; ++a)
#pragma unroll
        for (int b = 0; b < 2; ++b)
#pragma unroll
            for (int m = 0; m < 4; ++m)
#pragma unroll
                for (int n = 0; n < 2; ++n) acc[a][b][m][n] = (f32x4){0.f, 0.f, 0.f, 0.f};
    bf16x8 At[4][2], B0[2][2], B1[2][2];
    const int f8scale = 0x7f7f7f7f;
    v8i32 At8[4], B08[2], B18[2];
    const char* cA = (const char*)g.A + (size_t)cur.pa * tstep; const char* cB = (const char*)g.Bt + (size_t)cur.pn * tstep;
    S.a_ready(cur);
    if constexpr (SP2) {
        PG8_STAGE(PG8_SB(0, 0), cB, voffB); PG8_STAGE(PG8_SB(0, 1), cB + hstep, voffB); PG8_STAGE(PG8_SA(0, 0), cA, voffA); PG8_STAGE(PG8_SA(0, 1), cA + hstep, voffA);
        if (wr == 1) PG8_BAR;
        PG8_WAIT_V(2); PG8_BAR;
        PG8_STAGE(PG8_SB(1, 0), cB + kstep, voffB); PG8_STAGE(PG8_SA(1, 0), cA + kstep, voffA); PG8_STAGE(PG8_SB(1, 1), cB + hstep + kstep, voffB);
        PG8_WAIT_V(6); PG8_BAR;
    } else {
        PG8_STAGE(PG8_SB(0, 0), cB, voffB); PG8_STAGE(PG8_SA(0, 0), cA, voffA); PG8_STAGE(PG8_SB(0, 1), cB + hstep, voffB); PG8_STAGE(PG8_SA(0, 1), cA + hstep, voffA);
        if (wr == 1) PG8_BAR;
        PG8_WAIT_V(4); PG8_BAR;
        PG8_STAGE(PG8_SB(1, 0), cB + kstep, voffB); PG8_STAGE(PG8_SA(1, 0), cA + kstep, voffA); PG8_STAGE(PG8_SB(1, 1), cB + hstep + kstep, voffB);
        PG8_WAIT_V(6); PG8_BAR;
    }
    for (;;) {
        const bool has_next = S.next(ui + 1, nxt);
        const char* nA = has_next ? (const char*)g.A + (size_t)nxt.pa * tstep : cA; const char* nB = has_next ? (const char*)g.Bt + (size_t)nxt.pn * tstep : cB;
        for (int t = 0; t < nt; t += 2) {
            const bool last = (t == nt - 2);
            const char* a1 = cA + (size_t)(t + 1) * kstep;
            const char* a2 = last ? nA : cA + (size_t)(t + 2) * kstep; const char* b2 = last ? nB : cB + (size_t)(t + 2) * kstep;
            const char* a3 = a2 + kstep; const char* b3 = b2 + kstep;
            if (last && has_next) S.a_ready(nxt);
            if constexpr (SP2) {
            PG8_LDB(B0, 0, 0); PG8_LDB(B1, 0, 1); PG8_SCHED; PG8_LDA(At, 0, 0); PG8_STAGE(PG8_SA(1, 1), a1 + hstep, voffA);
            PG8_WAIT_V(8); PG8_WAIT_L(0); PG8_BAR; PG8_MMA(0, 0, At, B0); PG8_MMA(0, 1, At, B1); PG8_BAR; PG8_SCHED;
            PG8_LDA(At, 0, 1); PG8_STAGE(PG8_SB(0, 0), b2, voffB); PG8_STAGE(PG8_SB(0, 1), b2 + hstep, voffB); PG8_STAGE(PG8_SA(0, 0), a2, voffA);
            PG8_WAIT_V(8); PG8_WAIT_L(0); PG8_BAR; PG8_MMA(1, 0, At, B0); PG8_MMA(1, 1, At, B1); PG8_BAR; PG8_SCHED;
            PG8_LDB(B0, 1, 0); PG8_LDB(B1, 1, 1); PG8_SCHED; PG8_LDA(At, 1, 0); PG8_STAGE(PG8_SA(0, 1), a2 + hstep, voffA);
            PG8_WAIT_V(8); PG8_WAIT_L(0); PG8_BAR; PG8_MMA(0, 0, At, B0); PG8_MMA(0, 1, At, B1); PG8_BAR; PG8_SCHED;
            PG8_LDA(At, 1, 1); PG8_STAGE(PG8_SB(1, 0), b3, voffB); PG8_STAGE(PG8_SB(1, 1), b3 + hstep, voffB); PG8_STAGE(PG8_SA(1, 0), a3, voffA);
            PG8_WAIT_V(8); PG8_WAIT_L(0); PG8_BAR; PG8_MMA(1, 0, At, B0); PG8_MMA(1, 1, At, B1); PG8_BAR; PG8_SCHED;
            } else {
            PG8_LDB(B0, 0, 0); PG8_SCHED; PG8_LDA(At, 0, 0); PG8_STAGE(PG8_SA(1, 1), a1 + hstep, voffA);
            PG8_WAIT_L(8); PG8_BAR; PG8_WAIT_L(0); PG8_MMA(0, 0, At, B0); PG8_BAR; PG8_SCHED;
            PG8_LDB(B1, 0, 1); PG8_STAGE(PG8_SB(0, 0), b2, voffB);
            PG8_BAR; PG8_WAIT_L(0); PG8_MMA(0, 1, At, B1); PG8_BAR;
            PG8_LDA(At, 0, 1); PG8_STAGE(PG8_SA(0, 0), a2, voffA);
            PG8_BAR; PG8_WAIT_L(0); PG8_MMA(1, 0, At, B0); PG8_BAR; PG8_SCHED;
            PG8_STAGE(PG8_SB(0, 1), b2 + hstep, voffB);
            PG8_WAIT_V(6); PG8_BAR; PG8_MMA(1, 1, At, B1); PG8_BAR;
            PG8_LDB(B0, 1, 0); PG8_SCHED; PG8_LDA(At, 1, 0); PG8_STAGE(PG8_SA(0, 1), a2 + hstep, voffA);
            PG8_WAIT_L(8); PG8_BAR; PG8_WAIT_L(0); PG8_MMA(0, 0, At, B0); PG8_BAR; PG8_SCHED;
            PG8_LDB(B1, 1, 1); PG8_STAGE(PG8_SB(1, 0), b3, voffB);
            PG8_BAR; PG8_WAIT_L(0); PG8_MMA(0, 1, At, B1); PG8_BAR;
            PG8_LDA(At, 1, 1); PG8_STAGE(PG8_SA(1, 0), a3, voffA);
            PG8_BAR; PG8_WAIT_L(0); PG8_MMA(1, 0, At, B0); PG8_BAR; PG8_SCHED;
            PG8_STAGE(PG8_SB(1, 1), b3 + hstep, voffB);
            PG8_WAIT_V(6); PG8_BAR; PG8_MMA(1, 1, At, B1); PG8_BAR;
            }
        }
        if constexpr (ALIGN_EPI) { if (wr == 0) PG8_BAR; }
        if constexpr (F8) asm volatile("s_nop 15\n\ts_nop 15" ::: "memory");
        if constexpr (!Epi::AFTER_DRAIN) { E(acc, cur, wr, wc, fr, fq); S.done(cur); }
        if (!has_next) break;
#pragma unroll
        for (int a = 0; a < 2; ++a)
#pragma unroll
            for (int b = 0; b < 2; ++b)
#pragma unroll
                for (int m = 0; m < 4; ++m)
#pragma unroll
                    for (int n = 0; n < 2; ++n) acc[a][b][m][n] = (f32x4){0.f, 0.f, 0.f, 0.f};
        cur = nxt; cA = nA; cB = nB; ++ui;
        if constexpr (ALIGN_EPI) { if (wr == 1) PG8_BAR; }
    }
    PG8_WAIT_V(0);
    if constexpr (!ALIGN_EPI) { if (wr == 0) PG8_BAR; }
    PG8_BAR;
    if constexpr (Epi::AFTER_DRAIN) { E.fused(acc, cur, wr, wc, fr, fq, lds, wid, lane); S.done(cur); }
#undef PG8_SA
#undef PG8_SB
#undef PG8_STAGE
#undef PG8_LDA
#undef PG8_LD16
#undef PG8_LDB
#undef PG8_MMA
#undef PG8_WAIT_V
#undef PG8_WAIT_L
#undef PG8_BAR
#undef PG8_SCHED
}
}

constexpr int NWAVES = 8, NTHR = NWAVES * 64;
constexpr int BATCH = 8, SEQ = 8192, D = 1024, M = BATCH * SEQ, DEPTH = 4, GWD = 256, INW = 2304, DFF = 3584, NE = 8;
constexpr float EPS = 1e-6f;
constexpr int MODW = 6 * D;
constexpr int CH = 128, NCH = SEQ / CH;
#ifndef F8_MASK
#define F8_MASK 0xE
#endif
#define IS_F8(l_) (((F8_MASK) >> (l_)) & 1)
constexpr int F8_LAYER = 3;
constexpr float F8_S13 = 32.f, F8_S2 = 64.f;
constexpr int MAXPAIR = 2 * M + NE * 256;

constexpr size_t MiB = 1u << 20;
constexpr size_t WS_CTL = 0, CTL_ZERO_BYTES = 1 * MiB;
constexpr size_t WS_MOD = 1 * MiB;
constexpr size_t WS_LB = WS_MOD + 786432;
constexpr size_t WS_POOLWT = 2 * MiB;
constexpr size_t WS_LRUWAT = WS_POOLWT + 131072;
constexpr size_t WS_LRUWXT = WS_LRUWAT + 131072;
constexpr size_t WS_SGUW = 3 * MiB;
constexpr size_t WS_TOKE = 4 * MiB;
constexpr size_t WS_TOKW = WS_TOKE + 262144;
constexpr size_t WS_HISTW = 5 * MiB;
constexpr size_t WS_TILEE = WS_HISTW + 65536;
constexpr size_t WS_NT = WS_TILEE + 4096;
constexpr size_t WS_PAIR = 6 * MiB;
constexpr size_t WS_AGG = 8 * MiB;
constexpr size_t WS_H0 = 9 * MiB;
constexpr size_t WS_DEC = 10 * MiB;
constexpr size_t WS_W = 16 * MiB;
constexpr size_t WS_WIN = WS_W, WS_WOUT = WS_W + 5 * MiB, WS_W13 = WS_W + 8 * MiB, WS_W2 = WS_W + 120 * MiB;
constexpr size_t WS_XN = 192 * MiB;
constexpr size_t WS_PROJ = 320 * MiB;
constexpr size_t WS_CAT = 608 * MiB;
constexpr size_t WS_ST = 736 * MiB;
constexpr size_t WS_LAB = 768 * MiB;
constexpr size_t WS_Y1 = 864 * MiB;
constexpr size_t WS_XB = 992 * MiB;
constexpr size_t WS_END = 1120 * MiB;
constexpr int CW_BAR = 4096;
constexpr int CW_ZT = 16384;
constexpr int RING_BYTES = 131072, MISC_OFF = RING_BYTES + 320, LDS_BYTES = 147456;

#define DI __device__ __forceinline__
#define LAS __attribute__((address_space(3)))
typedef unsigned short bf16;
typedef unsigned v4u __attribute__((ext_vector_type(4)));
typedef unsigned v2u __attribute__((ext_vector_type(2)));
typedef int v4i __attribute__((ext_vector_type(4)));
typedef int v2i __attribute__((ext_vector_type(2)));
typedef float f32x4 __attribute__((ext_vector_type(4)));
typedef float f32x2 __attribute__((ext_vector_type(2)));
typedef short bf16x8 __attribute__((ext_vector_type(8)));
#define LDS_WAIT() asm volatile("s_waitcnt lgkmcnt(0)" ::: "memory")
#define GAS __attribute__((address_space(1)))
typedef GAS const float* gcf; typedef GAS float* gf; typedef GAS const bf16* gcb; typedef GAS bf16* gb; typedef GAS const int* gci; typedef GAS int* gi;
typedef GAS const v2i* gcv2i; typedef GAS v2i* gv2i; typedef GAS const unsigned* gcu; typedef GAS unsigned char* gws;

DI float bf2f(bf16 v) { return __builtin_bit_cast(float, (unsigned)v << 16); }
DI float lo_bf(unsigned w) { return __builtin_bit_cast(float, w << 16); }
DI float hi_bf(unsigned w) { return __builtin_bit_cast(float, w & 0xffff0000u); }
DI unsigned pk2(float lo, float hi) { return pg8::cvt_pk_bf16(lo, hi); }
DI bf16 f2bf(float f) { return (bf16)(pk2(f, 0.f) & 0xffffu); }
DI float sigm(float x) { return __builtin_amdgcn_rcpf(1.f + __expf(-x)); }
DI float siluf(float x) { return x * sigm(x); }
DI float gelu_t(float x) { return x * sigm(1.5957691216057308f * (x + 0.044715f * x * x * x)); }
DI float neg_expm1(float x) {
    const float p = -x * (1.f + x * (0.5f + x * (0.16666667f + x * (0.041666668f + x * (0.0083333338f + x * 0.0013888889f)))));
    return x > -0.25f ? p : 1.f - __expf(x);
}
DI float wave_sum(float v) {
#pragma unroll
    for (int o = 1; o < 64; o <<= 1) v += __shfl_xor(v, o);
    return v;
}
template <int D_> DI float row_shr0(float src) { return __builtin_bit_cast(float, __builtin_amdgcn_update_dpp(0, __builtin_bit_cast(int, src), 0x110 + D_, 0xf, 0xf, true)); }
DI float wave_sum_dpp(float v) {
    v += row_shr0<1>(v); v += row_shr0<2>(v); v += row_shr0<4>(v); v += row_shr0<8>(v);
    const int iv = __builtin_bit_cast(int, v);
    const float a = __builtin_bit_cast(float, __builtin_amdgcn_readlane(iv, 15)), b2 = __builtin_bit_cast(float, __builtin_amdgcn_readlane(iv, 31));
    const float c2 = __builtin_bit_cast(float, __builtin_amdgcn_readlane(iv, 47)), d2 = __builtin_bit_cast(float, __builtin_amdgcn_readlane(iv, 63));
    return (a + b2) + (c2 + d2);
}
DI int wave_sum_i(int v) {
#pragma unroll
    for (int o = 1; o < 64; o <<= 1) v += __shfl_xor(v, o);
    return v;
}
DI f32x4 ld4(gcf p) { return *(GAS const f32x4*)p; }
DI void unpack8(const v4u x, float (&o)[8]) { o[0] = lo_bf(x.x); o[1] = hi_bf(x.x); o[2] = lo_bf(x.y); o[3] = hi_bf(x.y); o[4] = lo_bf(x.z); o[5] = hi_bf(x.z); o[6] = lo_bf(x.w); o[7] = hi_bf(x.w); }
DI f32x4 unpack4(const v2u x) { return (f32x4){lo_bf(x.x), hi_bf(x.x), lo_bf(x.y), hi_bf(x.y)}; }
DI v2u pack4(const f32x4 v) { v2u r; r.x = pk2(v.x, v.y); r.y = pk2(v.z, v.w); return r; }
DI float clamp_f8(float v) { return __builtin_amdgcn_fmed3f(v, -448.f, 448.f); }
DI unsigned pk4_f8(float a, float b, float c, float d) { int r = __builtin_amdgcn_cvt_pk_fp8_f32(clamp_f8(a), clamp_f8(b), 0, false); r = __builtin_amdgcn_cvt_pk_fp8_f32(clamp_f8(c), clamp_f8(d), r, true); return (unsigned)r; }
DI f32x4 mfma16(const bf16x8 a, const bf16x8 b, const f32x4 c) { return __builtin_amdgcn_mfma_f32_16x16x32_bf16(a, b, c, 0, 0, 0); }

#define XB_TMO      128
#define XB_XCNT(j)  (256  + 64 * (j))
#define XB_XSUB(j)  (1280 + 64 * (j))
#define XB_XGEN(j)  (2304 + 64 * (j))
#define XB_TOP      3328
#define XB_TOPGEN   3392
#define XCD_BAR_WORDS 3456
#define XB_SPIN_CAP (1u << 18)
__device__ __forceinline__ unsigned xb_ld(unsigned* p)              { return __hip_atomic_load(p, __ATOMIC_RELAXED, __HIP_MEMORY_SCOPE_AGENT); }
__device__ __forceinline__ unsigned xb_add(unsigned* p, unsigned v) { return __hip_atomic_fetch_add(p, v, __ATOMIC_RELAXED, __HIP_MEMORY_SCOPE_AGENT); }
__device__ __forceinline__ unsigned xb_xcc_id() { return (unsigned)__builtin_amdgcn_s_getreg((3 << 11) | 20) & 0xFu; }
#define XB_SPIN(cond, bar) do { unsigned _sp = 0; while (cond) { __builtin_amdgcn_s_sleep(1); \
    if ((++_sp & 255u) == 0u) { if (xb_ld(&(bar)[XB_TMO])) break; if (_sp > XB_SPIN_CAP) { atomicAdd(&(bar)[XB_TMO], 1u); break; } } } } while (0)
struct XcdBarrier { unsigned* bar; unsigned x; volatile LAS unsigned* st; };
__device__ __forceinline__ XcdBarrier xcd_barrier_post(unsigned* bar, volatile LAS unsigned* st) {
    XcdBarrier b; b.bar = bar; b.x = xb_xcc_id(); b.st = st;
    if (threadIdx.x == 0) (void)xb_add(&bar[XB_XCNT(b.x)], 1u);
    return b;
}
__device__ __forceinline__ void xcd_barrier_complete(unsigned* bar, unsigned x, unsigned& nloc, unsigned& nx) {
    const unsigned G = gridDim.x * gridDim.y * gridDim.z;
    unsigned sum, cnt, mine, sp = 0u;
    for (;;) {
        sum = 0u; cnt = 0u; mine = 0u;
#pragma unroll
        for (unsigned j = 0; j < 16; ++j) { const unsigned c = xb_ld(&bar[XB_XCNT(j)]); sum += c; cnt += (c > 0u) ? 1u : 0u; mine = (j == x) ? c : mine; }
        if (sum == G) break;
        __builtin_amdgcn_s_sleep(1);
        if ((++sp & 255u) == 0u) { if (xb_ld(&bar[XB_TMO])) break; if (sp > XB_SPIN_CAP) { atomicAdd(&bar[XB_TMO], 1u); break; } }
    }
    nloc = mine > 0u ? mine : 1u; nx = cnt > 0u ? cnt : 1u;
}
__device__ __forceinline__ void xcd_barrier(const XcdBarrier& b) {
    asm volatile("s_waitcnt vmcnt(0)" ::: "memory");
    __syncthreads();
    if (threadIdx.x == 0) {
        unsigned* bar = b.bar;
        __builtin_amdgcn_s_waitcnt(0);
        unsigned nloc = b.st[0], nx = b.st[1];
        if (nloc == 0u) { xcd_barrier_complete(bar, b.x, nloc, nx); b.st[0] = nloc; b.st[1] = nx; }
        const unsigned old = xb_add(&bar[XB_XSUB(b.x)], 1u);
        const unsigned gen = old / nloc;
        if (old + 1u == (gen + 1u) * nloc) {
            __builtin_amdgcn_fence(__ATOMIC_RELEASE, "agent");
            asm volatile("s_waitcnt vmcnt(0)" ::: "memory");
            const unsigned og = xb_add(&bar[XB_TOP], 1u);
            const unsigned tg = og / nx;
            if (og + 1u == (tg + 1u) * nx) xb_add(&bar[XB_TOPGEN], 1u);
            else XB_SPIN(xb_ld(&bar[XB_TOPGEN]) == tg, bar);
            __builtin_amdgcn_fence(__ATOMIC_ACQUIRE, "agent");
            xb_add(&bar[XB_XGEN(b.x)], 1u);
            asm volatile("s_waitcnt vmcnt(0)" ::: "memory");
        } else {
            XB_SPIN(xb_ld(&bar[XB_XGEN(b.x)]) == gen, bar);
            __builtin_amdgcn_fence(__ATOMIC_ACQUIRE, "agent");
            asm volatile("s_waitcnt vmcnt(0)" ::: "memory");
        }
    }
    __syncthreads();
}

struct EpiProj {
    static constexpr bool PERM = true, AFTER_DRAIN = false, IDEMPOTENT = true;
    gb O;
    DI void operator()(const f32x4 (&acc)[2][2][4][2], const pg8::Unit& u, int wr, int wc, int fr, int fq) const {
        const int row0 = u.pm * 256 + wr * 64 + fr, col0 = u.pc * 256 + wc * 32 + 8 * fq;
#pragma unroll
        for (int ai = 0; ai < 2; ++ai)
#pragma unroll
            for (int m = 0; m < 4; ++m) { gb rowp = O + (size_t)(row0 + ai * 128 + m * 16) * INW + col0;
#pragma unroll
                for (int bj = 0; bj < 2; ++bj) { const f32x4 v0 = acc[ai][bj][m][0], v1 = acc[ai][bj][m][1];
                    v4u w; w.x = pk2(v0[0], v0[1]); w.y = pk2(v0[2], v0[3]); w.z = pk2(v1[0], v1[1]); w.w = pk2(v1[2], v1[3]);
                    *(GAS v4u*)(rowp + bj * 128) = w; } }
    }
};
struct EpiResid {
    static constexpr bool PERM = true, AFTER_DRAIN = false, IDEMPOTENT = false;
    gb x; gcf gate; float mul;
    DI void operator()(const f32x4 (&acc)[2][2][4][2], const pg8::Unit& u, int wr, int wc, int fr, int fq) const {
        const int b = u.pm >> 5, row0 = u.pm * 256 + wr * 64 + fr, col0 = u.pc * 256 + wc * 32 + 8 * fq;
        f32x4 gv[2][2];
#pragma unroll
        for (int bj = 0; bj < 2; ++bj)
#pragma unroll
            for (int n = 0; n < 2; ++n) gv[bj][n] = ld4(gate + (size_t)b * MODW + col0 + bj * 128 + n * 4) * mul;
#pragma unroll
        for (int ai = 0; ai < 2; ++ai) {
            v4u xr[4][2];
#pragma unroll
            for (int m = 0; m < 4; ++m)
#pragma unroll
                for (int bj = 0; bj < 2; ++bj) xr[m][bj] = *(GAS const v4u*)(x + (size_t)(row0 + ai * 128 + m * 16) * D + col0 + bj * 128);
#pragma unroll
            for (int m = 0; m < 4; ++m)
#pragma unroll
                for (int bj = 0; bj < 2; ++bj) { float xv[8]; unpack8(xr[m][bj], xv);
                    const f32x4 v0 = (f32x4){xv[0], xv[1], xv[2], xv[3]} + gv[bj][0] * acc[ai][bj][m][0], v1 = (f32x4){xv[4], xv[5], xv[6], xv[7]} + gv[bj][1] * acc[ai][bj][m][1];
                    v4u o; o.x = pk2(v0[0], v0[1]); o.y = pk2(v0[2], v0[3]); o.z = pk2(v1[0], v1[1]); o.w = pk2(v1[2], v1[3]);
                    *(GAS v4u*)(x + (size_t)(row0 + ai * 128 + m * 16) * D + col0 + bj * 128) = o; }
            asm volatile("" ::: "memory"); }
    }
};
struct EpiSwiglu {
    static constexpr bool PERM = true, AFTER_DRAIN = false, IDEMPOTENT = true;
    gb ACT; int pm0;
    DI void operator()(const f32x4 (&acc)[2][2][4][2], const pg8::Unit& u, int wr, int wc, int fr, int fq) const {
        const int row0 = (u.pm - pm0) * 256 + wr * 64 + fr, col0 = u.pc * 128 + wc * 32 + 8 * fq;
#pragma unroll
        for (int ai = 0; ai < 2; ++ai)
#pragma unroll
            for (int m = 0; m < 4; ++m) { gb rowp = ACT + (size_t)(row0 + ai * 128 + m * 16) * DFF + col0;
                const f32x4 g0 = acc[ai][0][m][0], g1 = acc[ai][0][m][1], u0 = acc[ai][1][m][0], u1 = acc[ai][1][m][1];
                v4u w; w.x = pk2(siluf(g0[0]) * u0[0], siluf(g0[1]) * u0[1]); w.y = pk2(siluf(g0[2]) * u0[2], siluf(g0[3]) * u0[3]);
                w.z = pk2(siluf(g1[0]) * u1[0], siluf(g1[1]) * u1[1]); w.w = pk2(siluf(g1[2]) * u1[2], siluf(g1[3]) * u1[3]);
                *(GAS v4u*)rowp = w; }
    }
};
struct EpiSwiglu8 {
    static constexpr bool PERM = true, AFTER_DRAIN = false, IDEMPOTENT = true;
    GAS unsigned char* ACT; int pm0;
    DI void operator()(const f32x4 (&acc)[2][2][4][2], const pg8::Unit& u, int wr, int wc, int fr, int fq) const {
        const int row0 = (u.pm - pm0) * 256 + wr * 64 + fr, col0 = u.pc * 128 + wc * 32 + 8 * fq; constexpr float is = 1.0f / F8_S13;
#pragma unroll
        for (int ai = 0; ai < 2; ++ai)
#pragma unroll
            for (int m = 0; m < 4; ++m) { GAS unsigned char* rowp = ACT + (size_t)(row0 + ai * 128 + m * 16) * DFF + col0;
                const f32x4 g0 = acc[ai][0][m][0] * is, g1 = acc[ai][0][m][1] * is, u0 = acc[ai][1][m][0] * is, u1 = acc[ai][1][m][1] * is;
                v2u w; w.x = pk4_f8(siluf(g0[0]) * u0[0], siluf(g0[1]) * u0[1], siluf(g0[2]) * u0[2], siluf(g0[3]) * u0[3]);
                w.y = pk4_f8(siluf(g1[0]) * u1[0], siluf(g1[1]) * u1[1], siluf(g1[2]) * u1[2], siluf(g1[3]) * u1[3]);
                *(GAS v2u*)rowp = w; }
    }
};
struct EpiScatter {
    static constexpr bool PERM = true, AFTER_DRAIN = false, IDEMPOTENT = true;
    gcv2i pair; gb Y0; gb Y1; gci toke; gcf tokw; float sc;
    DI void operator()(const f32x4 (&acc)[2][2][4][2], const pg8::Unit& u, int wr, int wc, int fr, int fq) const {
        const int row0 = u.pm * 256 + wr * 64 + fr, col0 = u.pc * 256 + wc * 32 + 8 * fq;
#pragma unroll
        for (int ai = 0; ai < 2; ++ai)
#pragma unroll
            for (int m = 0; m < 4; ++m) { const v2i pi = pair[row0 + ai * 128 + m * 16];
                if (pi.x >= 0) { const int tok = pi.x & 0x3fffffff; float w = tokw[2 * tok + (pi.x >> 30)] * sc;

                    gb rowp = ((pi.x >> 30) ? Y1 : Y0) + (size_t)tok * D + col0;
#pragma unroll
                    for (int bj = 0; bj < 2; ++bj) { const f32x4 v0 = acc[ai][bj][m][0] * w, v1 = acc[ai][bj][m][1] * w;
                        v4u o; o.x = pk2(v0[0], v0[1]); o.y = pk2(v0[2], v0[3]); o.z = pk2(v1[0], v1[1]); o.w = pk2(v1[2], v1[3]);
                        *(GAS v4u*)(rowp + bj * 128) = o; } } }
    }
};


DI void p0_prologue(gcf c, gcf w_mod, gcf b_mod, gcf gamma, gcf pool_w, gcf lwa, gcf lwx, gcf sgu_ws,
                    gws ws, LAS unsigned char* lds, int wg, int G, int tid, int wave, int lane) {
    LAS float* CS = (LAS float*)lds; LAS float* RED = (LAS float*)(lds + 32768);
    gf MOD = (GAS float*)(ws + WS_MOD);
    if (wg < 96) {
        for (int idx = tid; idx < 8192; idx += NTHR) { const int k = idx >> 3, b = idx & 7; const float v = c[b * D + k]; CS[idx] = siluf(v); }
        __syncthreads();
        for (int item = wg; item < 96; item += G) {
            const int l = item / 24, jb = item % 24, col = jb * 256 + lane * 4;
            f32x4 acc[8];
#pragma unroll
            for (int b = 0; b < 8; ++b) acc[b] = (f32x4){0.f, 0.f, 0.f, 0.f};
            gcf wp = w_mod + ((size_t)(l * D + wave * 128)) * MODW + col;
#pragma unroll 8
            for (int kk = 0; kk < 128; ++kk) {
                const f32x4 w = ld4(wp + (size_t)kk * MODW);
                const f32x4 c0 = *(const LAS f32x4*)(CS + (wave * 128 + kk) * 8), c1 = *(const LAS f32x4*)(CS + (wave * 128 + kk) * 8 + 4);
                acc[0] += c0.x * w; acc[1] += c0.y * w; acc[2] += c0.z * w; acc[3] += c0.w * w; acc[4] += c1.x * w; acc[5] += c1.y * w; acc[6] += c1.z * w; acc[7] += c1.w * w;
            }
#pragma unroll
            for (int b = 0; b < 8; ++b) *(LAS f32x4*)(RED + (wave * 8 + b) * 256 + lane * 4) = acc[b];
            __syncthreads();
            for (int o = tid; o < 2048; o += NTHR) { const int b = o >> 8, cc = o & 255; float s = 0.f;
#pragma unroll
                for (int w = 0; w < 8; ++w) s += RED[(w * 8 + b) * 256 + cc];
                MOD[(size_t)(l * 8 + b) * MODW + jb * 256 + cc] = s + b_mod[l * MODW + jb * 256 + cc]; }
            __syncthreads();
        }
    }
    if (wg == G - 1 && tid < GWD) {
        gf LB = (GAS float*)(ws + WS_LB);
        const float g0 = gamma[tid], g1 = gamma[GWD + tid], g2 = gamma[2 * GWD + tid], g3 = gamma[3 * GWD + tid];
        const float mx = fmaxf(fmaxf(g0, g1), fmaxf(g2, g3));
        const float e0 = expf(g0 - mx), e1 = expf(g1 - mx), e2 = expf(g2 - mx), e3 = expf(g3 - mx), inv = 1.f / (e0 + e1 + e2 + e3);
        LB[tid] = 0.f; LB[GWD + tid] = e1 * inv; LB[2 * GWD + tid] = (e1 + e2) * inv; LB[3 * GWD + tid] = (e1 + e2 + e3) * inv;
    }
    gb POOLWT = (GAS bf16*)(ws + WS_POOLWT); gb LRUWAT = (GAS bf16*)(ws + WS_LRUWAT); gb LRUWXT = (GAS bf16*)(ws + WS_LRUWXT); gb SGUW = (GAS bf16*)(ws + WS_SGUW);
    const int gt = wg * NTHR + tid, NT = G * NTHR;
    for (int idx = gt; idx < 65536; idx += NT) { const int lg = idx >> 12, j = (idx >> 6) & 63, i = idx & 63, src = (lg * 64 + i) * 64 + j;
        POOLWT[idx] = f2bf(pool_w[src]); LRUWAT[idx] = f2bf(lwa[src]); LRUWXT[idx] = f2bf(lwx[src]); }
    for (int idx = gt; idx < 262144; idx += NT) { const int t = (idx >> 7) & 127, s = idx & 127; SGUW[idx] = (s <= t) ? f2bf(sgu_ws[idx]) : (bf16)0; }
}

struct CvItem { gcf W; gb WT; int K, N, mode, idx; float f8s; };
DI void cv_load(const CvItem& I, int lane, f32x4 (&v)[8]) {
    const int nblk = I.N / 32, kb = I.idx / nblk, nb = I.idx % nblk;
    gcf p = I.W + (size_t)(64 * kb + (lane >> 3)) * I.N + 32 * nb + 4 * (lane & 7);
#pragma unroll
    for (int i = 0; i < 8; ++i) v[i] = ld4(p + (size_t)(8 * i) * I.N);
}
DI void cv_store(const CvItem& I, LAS float* scr, int lane, const f32x4 (&v)[8]) {
    const int nblk = I.N / 32, kb = I.idx / nblk, nb = I.idx % nblk, k0 = 64 * kb, n0 = 32 * nb;
#pragma unroll
    for (int i = 0; i < 8; ++i) { LAS float* d = scr + (8 * i + (lane >> 3)) * 33 + 4 * (lane & 7); d[0] = v[i].x; d[1] = v[i].y; d[2] = v[i].z; d[3] = v[i].w; }
    LDS_WAIT();
    const int c = lane & 7;
    const int drow0 = (I.mode == 0) ? n0 : ((n0 >> 7) * 256 + (n0 & 127) + (I.mode == 2 ? 128 : 0));
    if (I.f8s > 0.f) { const float sc = I.f8s; GAS unsigned char* W8 = (GAS unsigned char*)I.WT;
#pragma unroll
        for (int j = 0; j < 4; ++j) { const int n = (lane >> 3) + 8 * j; const LAS float* s = scr + (8 * c) * 33 + n;
            v2u o; o.x = pk4_f8(s[0 * 33] * sc, s[1 * 33] * sc, s[2 * 33] * sc, s[3 * 33] * sc); o.y = pk4_f8(s[4 * 33] * sc, s[5 * 33] * sc, s[6 * 33] * sc, s[7 * 33] * sc);
            *(GAS v2u*)(W8 + (size_t)(drow0 + n) * I.K + k0 + 8 * c) = o; }
    } else {
#pragma unroll
    for (int j = 0; j < 4; ++j) { const int n = (lane >> 3) + 8 * j; const LAS float* s = scr + (8 * c) * 33 + n;
        v4u o; o.x = pk2(s[0 * 33], s[1 * 33]); o.y = pk2(s[2 * 33], s[3 * 33]); o.z = pk2(s[4 * 33], s[5 * 33]); o.w = pk2(s[6 * 33], s[7 * 33]);
        *(GAS v4u*)(I.WT + (size_t)(drow0 + n) * I.K + k0 + 8 * c) = o; }
    }
    LDS_WAIT();
}
DI void convert_weights(int l, gcf w_in, gcf w_out, gcf f1, gcf f3, gcf f2, gcf m1, gcf m3, gcf m2,
                        gws ws, LAS unsigned char* lds, int wg, int G, int wave, int lane) {
    LAS float* scr = (LAS float*)(lds + wave * 16384);
    gb WIN = (GAS bf16*)(ws + WS_WIN); gb WOUT = (GAS bf16*)(ws + WS_WOUT); gb W13 = (GAS bf16*)(ws + WS_W13); gb W2 = (GAS bf16*)(ws + WS_W2);
    constexpr int n_in = 16 * 72, n_out = 16 * 32, n13 = 16 * 112, n2 = 56 * 32, per_e = 2 * n13 + n2;
    const int moe = l & 1, E = moe ? NE : 1, total = n_in + n_out + E * per_e, stride = G * NWAVES, f8 = IS_F8(l) ? 1 : 0;
#define CV_DECODE(it_, I_) do { int r = (it_); \
        if (r < n_in) { I_ = CvItem{w_in + (size_t)l * D * INW, WIN, D, INW, 0, r, 0.f}; } \
        else if (r < n_in + n_out) { I_ = CvItem{w_out + (size_t)l * D * D, WOUT, D, D, 0, r - n_in, 0.f}; } \
        else { r -= n_in + n_out; const int e = r / per_e; r -= e * per_e; \
            const size_t mo = (size_t)((l >> 1) * (moe ? NE : 1) + e) * D * DFF; \
            const size_t o13 = ((size_t)e * 2 * DFF * D) >> f8, o2 = ((size_t)e * D * DFF) >> f8;     \
            if (r < n13) I_ = CvItem{(moe ? m1 : f1) + mo, W13 + o13, D, DFF, 1, r, f8 ? F8_S13 : 0.f}; \
            else if (r < 2 * n13) I_ = CvItem{(moe ? m3 : f3) + mo, W13 + o13, D, DFF, 2, r - n13, f8 ? F8_S13 : 0.f}; \
            else I_ = CvItem{(moe ? m2 : f2) + mo, W2 + o2, DFF, D, 0, r - 2 * n13, f8 ? F8_S2 : 0.f}; } } while (0)
    int it = wg * NWAVES + wave;
    if (it >= total) return;
    CvItem Ia, Ib; f32x4 va[8], vb[8];
    CV_DECODE(it, Ia); cv_load(Ia, lane, va);
    for (;;) {
        const bool hb = it + stride < total;
        if (hb) { CV_DECODE(it + stride, Ib); cv_load(Ib, lane, vb); }
        cv_store(Ia, scr, lane, va);
        if (!hb) break;
        it += stride;
        const bool ha = it + stride < total;
        if (ha) { CV_DECODE(it + stride, Ia); cv_load(Ia, lane, va); }
        cv_store(Ib, scr, lane, vb);
        if (!ha) break;
        it += stride;
    }
#undef CV_DECODE
}

template <bool COMBINE, bool ROUTER, bool FINAL, bool XF32, bool OUT8 = false>
DI void norm_phase(gcf xf, gb xb, gf outf, gcf gain, gcf shift, gcf scale, gcf gprev, gcb Y0, gcb Y1, gb XN,
                   gcf rw, gcf rb, gi toke, gf tokw, gi histw, gv2i pair, LAS unsigned char* lds, int wg, int G, int tid, int wave, int lane) {
    LAS float* RW = (LAS float*)lds;
    if (ROUTER) {
        for (int i = tid; i < 8192; i += NTHR) RW[i] = rw[i];
        for (int i = wg * NTHR + tid; i < MAXPAIR; i += G * NTHR) pair[i] = (v2i){-1, 0};
        __syncthreads();
    }
    for (int blk = wg; blk < M / 256; blk += G) {
        const int b = blk >> 5;
        f32x4 gm[4], sh[4], gp[4];
#pragma unroll
        for (int j = 0; j < 4; ++j) { const int col = 4 * lane + 256 * j;
            if (FINAL) { gm[j] = ld4(gain + col); sh[j] = (f32x4){0.f, 0.f, 0.f, 0.f}; }
            else { gm[j] = ld4(gain + col) * (ld4(scale + (size_t)b * MODW + col) + 1.0f); sh[j] = ld4(shift + (size_t)b * MODW + col); }
            if (COMBINE) gp[j] = ld4(gprev + (size_t)b * MODW + col); else gp[j] = (f32x4){0.f, 0.f, 0.f, 0.f}; }
        int cnt[8];
#pragma unroll
        for (int e = 0; e < 8; ++e) cnt[e] = 0;
        constexpr int RG = 2;
        for (int r0 = 0; r0 < 32; r0 += RG) {
            f32x4 vv[RG][4]; v2u ya[COMBINE ? RG : 1][4], yb[COMBINE ? RG : 1][4];
#pragma unroll
            for (int q = 0; q < RG; ++q)
#pragma unroll
                for (int j = 0; j < 4; ++j) { const size_t off = (size_t)(blk * 256 + wave * 32 + r0 + q) * D + 4 * lane + 256 * j; if (XF32) vv[q][j] = ld4(xf + off); else vv[q][j] = unpack4(*(GAS const v2u*)(xb + off));
                    if (COMBINE) { ya[q][j] = *(GAS const v2u*)(Y0 + off); yb[q][j] = *(GAS const v2u*)(Y1 + off); } }
#pragma unroll
            for (int q = 0; q < RG; ++q) {
            const int row = blk * 256 + wave * 32 + r0 + q;
            f32x4 v[4]; float ss = 0.f;
#pragma unroll
            for (int j = 0; j < 4; ++j) { const size_t off = (size_t)row * D + 4 * lane + 256 * j; v[j] = vv[q][j];
                if (COMBINE) v[j] += gp[j] * (unpack4(ya[q][j]) + unpack4(yb[q][j]));
                if ((COMBINE && !FINAL) || XF32) *(GAS v2u*)(xb + off) = pack4(v[j]);
                ss += (v[j].x * v[j].x + v[j].y * v[j].y) + (v[j].z * v[j].z + v[j].w * v[j].w); }
            const float rstd = rsqrtf(wave_sum_dpp(ss) * (1.f / D) + EPS);
            f32x4 h[4];
#pragma unroll
            for (int j = 0; j < 4; ++j) { const size_t off = (size_t)row * D + 4 * lane + 256 * j; h[j] = v[j] * rstd * gm[j] + sh[j];
                if (FINAL) *(GAS f32x4*)(outf + off) = h[j]; else if (OUT8) *(GAS unsigned*)((GAS unsigned char*)XN + off) = pk4_f8(h[j].x, h[j].y, h[j].z, h[j].w); else *(GAS v2u*)(XN + off) = pack4(h[j]); }
            if (ROUTER) {
                float lg[8];
#pragma unroll
                for (int e = 0; e < 8; ++e) lg[e] = 0.f;
#pragma unroll
                for (int j = 0; j < 4; ++j)
#pragma unroll
                    for (int i = 0; i < 4; ++i) { const int cc = 4 * lane + 256 * j + i; const f32x4 w0 = *(const LAS f32x4*)(RW + cc * 8), w1 = *(const LAS f32x4*)(RW + cc * 8 + 4); const float hv = h[j][i];
                        lg[0] += hv * w0.x; lg[1] += hv * w0.y; lg[2] += hv * w0.z; lg[3] += hv * w0.w; lg[4] += hv * w1.x; lg[5] += hv * w1.y; lg[6] += hv * w1.z; lg[7] += hv * w1.w; }
#pragma unroll
                for (int e = 0; e < 8; ++e) lg[e] = wave_sum_dpp(lg[e]) + rb[e];
                int i0 = 0; float v0 = lg[0];
#pragma unroll
                for (int e = 1; e < 8; ++e) if (lg[e] > v0) { v0 = lg[e]; i0 = e; }
                int i1 = -1; float v1 = -3.0e38f;
#pragma unroll
                for (int e = 0; e < 8; ++e) if (e != i0 && lg[e] > v1) { v1 = lg[e]; i1 = e; }
                const float w0 = 1.f / (1.f + expf(v1 - v0)), w1 = 1.f - w0;
                if (lane == 0) { toke[row] = i0 | (i1 << 8); tokw[2 * row] = w0; tokw[2 * row + 1] = w1; }
#pragma unroll
                for (int e = 0; e < 8; ++e) cnt[e] += (i0 == e) + (i1 == e);
            }
            }
        }
        if (ROUTER && lane == 0) {
#pragma unroll
            for (int e = 0; e < 8; ++e) histw[(blk * 8 + wave) * 8 + e] = cnt[e]; }
    }
}

DI void route_phase(gcb XN, gb XG, gci toke, gcf tokw, gci histw, gv2i pair, gi tilee, gi ntp,
                    LAS unsigned char* lds, int wg, int G, int tid, int wave, int lane, int f8) {
    LAS int* L = (LAS int*)lds;
    for (int blk = wg; blk < M / 256; blk += G) {
        int tot[8], pre[8];
#pragma unroll
        for (int e = 0; e < 8; ++e) { tot[e] = 0; pre[e] = 0; }
        for (int q = tid; q < 2048; q += NTHR) { const v4i h0 = *(GAS const v4i*)(histw + q * 8), h1 = *(GAS const v4i*)(histw + q * 8 + 4); const int m = (q < blk * 8) ? 1 : 0;
            tot[0] += h0.x; tot[1] += h0.y; tot[2] += h0.z; tot[3] += h0.w; tot[4] += h1.x; tot[5] += h1.y; tot[6] += h1.z; tot[7] += h1.w;
            pre[0] += m * h0.x; pre[1] += m * h0.y; pre[2] += m * h0.z; pre[3] += m * h0.w; pre[4] += m * h1.x; pre[5] += m * h1.y; pre[6] += m * h1.z; pre[7] += m * h1.w; }
#pragma unroll
        for (int e = 0; e < 8; ++e) { tot[e] = wave_sum_i(tot[e]); pre[e] = wave_sum_i(pre[e]); }
        if (lane == 0) {
#pragma unroll
            for (int e = 0; e < 8; ++e) { L[wave * 16 + e] = tot[e]; L[wave * 16 + 8 + e] = pre[e]; } }
        __syncthreads();
        int start[9]; start[0] = 0;
#pragma unroll
        for (int e = 0; e < 8; ++e) { int t = 0, p = 0;
#pragma unroll
            for (int w = 0; w < 8; ++w) { t += L[w * 16 + e]; p += L[w * 16 + 8 + e]; }
            tot[e] = t; pre[e] = p; start[e + 1] = start[e] + ((t + 255) & ~255); }
        int e0 = -1, e1 = -1; const int tok = blk * 256 + tid;
        if (tid < 256) { const int te = toke[tok]; e0 = te & 255; e1 = te >> 8; }
        const unsigned long long lt = (1ull << lane) - 1ull;
        int r0 = 0, r1 = 0;
#pragma unroll
        for (int e = 0; e < 8; ++e) { const unsigned long long m0 = __ballot(e0 == e), m1 = __ballot(e1 == e);
            const int rr = __popcll(m0 & lt) + __popcll(m1 & lt);
            if (e0 == e) r0 = rr; if (e1 == e) r1 = rr;
            if (lane == 0) L[128 + wave * 8 + e] = __popcll(m0) + __popcll(m1);
            if (tid == 0) L[192 + e] = start[e] + pre[e]; }
        __syncthreads();
        if (tid < 256) {
            int p0 = L[192 + e0] + r0, p1 = L[192 + e1] + r1;
            for (int w = 0; w < wave; ++w) { p0 += L[128 + w * 8 + e0]; p1 += L[128 + w * 8 + e1]; }
            const f32x2 wv = *(GAS const f32x2*)(tokw + 2 * tok);
            pair[p0] = (v2i){tok, __builtin_bit_cast(int, wv.x)}; pair[p1] = (v2i){tok | (1 << 30), __builtin_bit_cast(int, wv.y)};
            L[256 + 2 * tid] = p0; L[256 + 2 * tid + 1] = p1;
        }
        __syncthreads();
        for (int i0 = 0; i0 < 32; i0 += 4) {
            v4u ra[4], rb2[4]; int pp0[4], pp1[4];
#pragma unroll
            for (int q = 0; q < 4; ++q) { const int tl = wave * 32 + i0 + q; pp0[q] = L[256 + 2 * tl]; pp1[q] = L[256 + 2 * tl + 1];
                gcb srcp = XN + (size_t)(blk * 256 + tl) * D + lane * 16; ra[q] = *(GAS const v4u*)srcp; rb2[q] = *(GAS const v4u*)(srcp + 8); }
            if (f8) { GAS unsigned char* X8 = (GAS unsigned char*)XG;
#pragma unroll
                for (int q = 0; q < 4; ++q) { float xa[8], xb2[8]; unpack8(ra[q], xa); unpack8(rb2[q], xb2);
                    v4u o; o.x = pk4_f8(xa[0], xa[1], xa[2], xa[3]); o.y = pk4_f8(xa[4], xa[5], xa[6], xa[7]); o.z = pk4_f8(xb2[0], xb2[1], xb2[2], xb2[3]); o.w = pk4_f8(xb2[4], xb2[5], xb2[6], xb2[7]);
                    *(GAS v4u*)(X8 + (size_t)pp0[q] * D + lane * 16) = o; *(GAS v4u*)(X8 + (size_t)pp1[q] * D + lane * 16) = o; }
            } else {
#pragma unroll
            for (int q = 0; q < 4; ++q) { gb d0 = XG + (size_t)pp0[q] * D + lane * 16; gb d1 = XG + (size_t)pp1[q] * D + lane * 16;
                *(GAS v4u*)d0 = ra[q]; *(GAS v4u*)(d0 + 8) = rb2[q]; *(GAS v4u*)d1 = ra[q]; *(GAS v4u*)(d1 + 8) = rb2[q]; } } }
        if (blk == 0) { const int ntt = start[8] >> 8;
            for (int t = tid; t < ntt; t += NTHR) { int e = 0;
#pragma unroll
                for (int q = 1; q < 8; ++q) e += (t >= (start[q] >> 8)) ? 1 : 0;
                tilee[t] = e; }
            if (tid == 0) ntp[0] = ntt; }
        __syncthreads();
    }
}

DI void pool_unit(gcb PROJ, gb CAT, gcb WT, gcf pscale, gcf pnorm, LAS unsigned char* lds, int b, int t0, int tid, int wave, int lane) {
    asm volatile("" : "+v"(tid)); lane = tid & 63;
    LAS bf16* XT = (LAS bf16*)lds;
    LAS bf16* DT = (LAS bf16*)(lds + 80 * 264 * 2);
    LAS float* SSP = (LAS float*)(lds + (80 + 64) * 264 * 2);
    const int fr = lane & 15, fq = lane >> 4, tbh = wave & 3, gp = wave >> 2;
    bf16x8 Wf[2][2][4];
#pragma unroll
    for (int gl = 0; gl < 2; ++gl)
#pragma unroll
        for (int kk = 0; kk < 2; ++kk)
#pragma unroll
            for (int nb = 0; nb < 4; ++nb) Wf[gl][kk][nb] = *(GAS const bf16x8*)(WT + (((2 * gp + gl) * 64 + nb * 16 + fr) * 64 + kk * 32 + 8 * fq));
    for (int half = 0; half < 2; ++half) {
        const int t0h = t0 + 64 * half;
        __syncthreads();
        { v4u xr[5];
#pragma unroll
            for (int i = 0; i < 5; ++i) { const int cidx = tid + NTHR * i, row = cidx >> 5, cg = cidx & 31, tt = t0h - 16 + row, ttc = tt < 0 ? 0 : tt;
                xr[i] = *(GAS const v4u*)(PROJ + ((size_t)b * SEQ + ttc) * INW + cg * 8); }
#pragma unroll
            for (int i = 0; i < 5; ++i) { const int cidx = tid + NTHR * i, row = cidx >> 5, cg = cidx & 31, tt = t0h - 16 + row;
                *(LAS v4u*)(XT + row * 264 + cg * 8) = (tt < 0) ? (v4u){0u, 0u, 0u, 0u} : xr[i]; } }
        __syncthreads();
        { const int cg = tid & 31, run = tid >> 5, ch0 = cg * 8, win = 2 << (cg >> 3), tl0 = run * 4;
            float s[8];
#pragma unroll
            for (int k = 0; k < 8; ++k) s[k] = 0.f;
            for (int r = 1; r <= win; ++r) { float xv[8]; unpack8(*(const LAS v4u*)(XT + (tl0 + 16 - r) * 264 + ch0), xv);
#pragma unroll
                for (int k = 0; k < 8; ++k) s[k] += xv[k]; }
#pragma unroll
            for (int i = 0; i < 4; ++i) { float xv[8], yv[8]; unpack8(*(const LAS v4u*)(XT + (tl0 + i + 16) * 264 + ch0), xv); unpack8(*(const LAS v4u*)(XT + (tl0 + i + 16 - win) * 264 + ch0), yv);
                const int tt = t0h + tl0 + i; const float inv = 1.f / (float)((tt + 1 < win) ? tt + 1 : win);
#pragma unroll
                for (int k = 0; k < 8; ++k) s[k] += xv[k] - yv[k];
                v4u o; o.x = pk2(s[0] * inv - xv[0], s[1] * inv - xv[1]); o.y = pk2(s[2] * inv - xv[2], s[3] * inv - xv[3]); o.z = pk2(s[4] * inv - xv[4], s[5] * inv - xv[5]); o.w = pk2(s[6] * inv - xv[6], s[7] * inv - xv[7]);
                *(LAS v4u*)(DT + (tl0 + i) * 264 + ch0) = o; } }
        __syncthreads();
        f32x4 acc[2][4];
#pragma unroll
        for (int gl = 0; gl < 2; ++gl)
#pragma unroll
            for (int nb = 0; nb < 4; ++nb) acc[gl][nb] = (f32x4){0.f, 0.f, 0.f, 0.f};
#pragma unroll
        for (int gl = 0; gl < 2; ++gl)
#pragma unroll
            for (int kk = 0; kk < 2; ++kk) { const bf16x8 X = *(const LAS bf16x8*)(DT + (16 * tbh + fr) * 264 + (2 * gp + gl) * 64 + kk * 32 + 8 * fq);
#pragma unroll
                for (int nb = 0; nb < 4; ++nb) acc[gl][nb] = mfma16(Wf[gl][kk][nb], X, acc[gl][nb]); }
        float ss = 0.f;
#pragma unroll
        for (int gl = 0; gl < 2; ++gl)
#pragma unroll
            for (int nb = 0; nb < 4; ++nb) { const f32x4 y = acc[gl][nb] * ld4(pscale + (2 * gp + gl) * 64 + nb * 16 + 4 * fq); acc[gl][nb] = y; ss += (y.x * y.x + y.y * y.y) + (y.z * y.z + y.w * y.w); }
        ss += __shfl_xor(ss, 16); ss += __shfl_xor(ss, 32);
        if (fq == 0) SSP[gp * 64 + 16 * tbh + fr] = ss;
        __syncthreads();
        const float rstd = rsqrtf((SSP[16 * tbh + fr] + SSP[64 + 16 * tbh + fr]) * (1.f / GWD) + EPS);
        const size_t row = (size_t)b * SEQ + t0h + 16 * tbh + fr;
#pragma unroll
        for (int gl = 0; gl < 2; ++gl)
#pragma unroll
            for (int nb = 0; nb < 4; ++nb) { const int ch = (2 * gp + gl) * 64 + nb * 16 + 4 * fq; *(GAS v2u*)(CAT + row * D + ch) = pack4(acc[gl][nb] * rstd * ld4(pnorm + ch)); }
    }
}

DI void sgu_unit(gcb PROJ, gb CAT, gcb SW, gcf sbias, gcf snorm, LAS unsigned char* lds, int b, int t0, int tid, int wave, int lane) {
    asm volatile("" : "+v"(tid)); lane = tid & 63;
    __syncthreads();
    LAS bf16* VT = (LAS bf16*)lds;
    const int fr = lane & 15, fq = lane >> 4, tb = wave, nk = (tb >> 1) + 1;
    { v2u vr[16];
#pragma unroll
        for (int i = 0; i < 16; ++i) vr[i] = *(GAS const v2u*)(PROJ + ((size_t)b * SEQ + t0 + 16 * wave + i) * INW + 512 + 4 * lane);
#pragma unroll
        for (int i = 0; i < 8; ++i) { const int tl = 16 * wave + 2 * i;
            f32x4 va = unpack4(vr[2 * i]), vb = unpack4(vr[2 * i + 1]);
            va.x = gelu_t(va.x); va.y = gelu_t(va.y); va.z = gelu_t(va.z); va.w = gelu_t(va.w); vb.x = gelu_t(vb.x); vb.y = gelu_t(vb.y); vb.z = gelu_t(vb.z); vb.w = gelu_t(vb.w);
            const float mua = wave_sum_dpp((va.x + va.y) + (va.z + va.w)) * (1.f / GWD), mub = wave_sum_dpp((vb.x + vb.y) + (vb.z + vb.w)) * (1.f / GWD);
            va = va - mua; vb = vb - mub;
            const float vra = wave_sum_dpp((va.x * va.x + va.y * va.y) + (va.z * va.z + va.w * va.w)) * (1.f / GWD), vrb = wave_sum_dpp((vb.x * vb.x + vb.y * vb.y) + (vb.z * vb.z + vb.w * vb.w)) * (1.f / GWD);
            va = va * rsqrtf(vra + EPS); vb = vb * rsqrtf(vrb + EPS);
            *(LAS unsigned*)(VT + (4 * lane + 0) * 136 + tl) = pk2(va.x, vb.x); *(LAS unsigned*)(VT + (4 * lane + 1) * 136 + tl) = pk2(va.y, vb.y);
            *(LAS unsigned*)(VT + (4 * lane + 2) * 136 + tl) = pk2(va.z, vb.z); *(LAS unsigned*)(VT + (4 * lane + 3) * 136 + tl) = pk2(va.w, vb.w); } }
    const int tl = 16 * tb + fr; const size_t row = (size_t)b * SEQ + t0 + tl;
    v2u ur[4][4]; float bias4[4];
#pragma unroll
    for (int h = 0; h < 4; ++h) { bias4[h] = sbias[h * 128 + tl];
#pragma unroll
        for (int db = 0; db < 4; ++db) ur[h][db] = *(GAS const v2u*)(PROJ + row * INW + 256 + h * 64 + db * 16 + 4 * fq); }
    __syncthreads();
    f32x4 acc[4][4];
#pragma unroll
    for (int h = 0; h < 4; ++h)
#pragma unroll
        for (int db = 0; db < 4; ++db) acc[h][db] = (f32x4){0.f, 0.f, 0.f, 0.f};
    for (int kk = 0; kk < nk; ++kk) {
        bf16x8 Q[4];
#pragma unroll
        for (int h = 0; h < 4; ++h) Q[h] = *(GAS const bf16x8*)(SW + ((h * 128 + 16 * tb + fr) * 128 + kk * 32 + 8 * fq));
#pragma unroll
        for (int h = 0; h < 4; ++h)
#pragma unroll
            for (int db = 0; db < 4; ++db) { const bf16x8 P = *(const LAS bf16x8*)(VT + (h * 64 + db * 16 + fr) * 136 + kk * 32 + 8 * fq); acc[h][db] = mfma16(P, Q[h], acc[h][db]); } }
    float ss = 0.f;
#pragma unroll
    for (int h = 0; h < 4; ++h)
#pragma unroll
        for (int db = 0; db < 4; ++db) { f32x4 u = unpack4(ur[h][db]);
            u.x = gelu_t(u.x); u.y = gelu_t(u.y); u.z = gelu_t(u.z); u.w = gelu_t(u.w);
            const f32x4 y = u * (acc[h][db] + bias4[h]); acc[h][db] = y; ss += (y.x * y.x + y.y * y.y) + (y.z * y.z + y.w * y.w); }
    ss += __shfl_xor(ss, 16); ss += __shfl_xor(ss, 32);
    const float rstd = rsqrtf(ss * (1.f / GWD) + EPS);
#pragma unroll
    for (int h = 0; h < 4; ++h)
#pragma unroll
        for (int db = 0; db < 4; ++db) { const int ch = h * 64 + db * 16 + 4 * fq; *(GAS v2u*)(CAT + row * D + 256 + ch) = pack4(acc[h][db] * rstd * ld4(snorm + ch)); }
}

template <int D_> DI float row_shr(float ident, float src) {
    return __builtin_bit_cast(float, __builtin_amdgcn_update_dpp(__builtin_bit_cast(int, ident), __builtin_bit_cast(int, src), 0x110 + D_, 0xf, 0xf, false));
}
DI void lru_local_unit(gcb PROJ, gcf convw, gcf convb, gcf lba, gcf lbx, gcf lam, gcb WAT, gcb WXT, gf AGG, GAS unsigned* LAB, LAS unsigned char* lds, int b, int chunk, int tid, int wave, int lane) {
    asm volatile("" : "+v"(tid)); lane = tid & 63;
    __syncthreads();
    LAS bf16* TILE = (LAS bf16*)lds;
    const int t0 = chunk * CH;
    {
        const int cg = tid & 31, ch0 = cg * 8;
        f32x4 cw[4][2], cb[2];
#pragma unroll
        for (int k = 0; k < 4; ++k) { cw[k][0] = ld4(convw + k * GWD + ch0); cw[k][1] = ld4(convw + k * GWD + ch0 + 4); }
        cb[0] = ld4(convb + ch0); cb[1] = ld4(convb + ch0 + 4);
#pragma unroll
        for (int hb2 = 0; hb2 < 2; ++hb2) {
            v4u xr[4][4];
#pragma unroll
            for (int i = 0; i < 4; ++i) { const int tl = (tid >> 5) + 16 * (hb2 * 4 + i);
#pragma unroll
                for (int k = 0; k < 4; ++k) { const int tt = t0 + tl - 3 + k, ttc = tt < 0 ? 0 : tt; xr[i][k] = *(GAS const v4u*)(PROJ + ((size_t)b * SEQ + ttc) * INW + 768 + ch0); } }
#pragma unroll
            for (int i = 0; i < 4; ++i) { const int tl = (tid >> 5) + 16 * (hb2 * 4 + i);
                f32x4 x0 = cb[0], x1 = cb[1];
#pragma unroll
                for (int k = 0; k < 4; ++k) { const float m = (t0 + tl - 3 + k >= 0) ? 1.f : 0.f; float xv[8]; unpack8(xr[i][k], xv);
                    x0 += cw[k][0] * ((f32x4){xv[0], xv[1], xv[2], xv[3]} * m); x1 += cw[k][1] * ((f32x4){xv[4], xv[5], xv[6], xv[7]} * m); }
                v4u o; o.x = pk2(x0.x, x0.y); o.y = pk2(x0.z, x0.w); o.z = pk2(x1.x, x1.y); o.w = pk2(x1.z, x1.w);
                *(LAS v4u*)(TILE + tl * 264 + ch0) = o; }
        }
    }
    const int hb = wave & 3, nh = wave >> 2, fr = lane & 15, fq = lane >> 4;
    bf16x8 WA[2][2], WX[2][2];
#pragma unroll
    for (int kk = 0; kk < 2; ++kk)
#pragma unroll
        for (int nbl = 0; nbl < 2; ++nbl) { const int o = (hb * 64 + (2 * nh + nbl) * 16 + fr) * 64 + kk * 32 + 8 * fq; WA[kk][nbl] = *(GAS const bf16x8*)(WAT + o); WX[kk][nbl] = *(GAS const bf16x8*)(WXT + o); }
    f32x4 ba4[2], bx4[2], ls4[2], hc[2], ac[2];
#pragma unroll
    for (int nbl = 0; nbl < 2; ++nbl) { const int ch = hb * 64 + (2 * nh + nbl) * 16 + 4 * fq; ba4[nbl] = ld4(lba + ch); bx4[nbl] = ld4(lbx + ch);
        const f32x4 lm = ld4(lam + ch);
#pragma unroll
        for (int j = 0; j < 4; ++j) ls4[nbl][j] = -8.0f * log1pf(expf(-lm[j]));
        hc[nbl] = (f32x4){0.f, 0.f, 0.f, 0.f}; ac[nbl] = (f32x4){1.f, 1.f, 1.f, 1.f}; }
    __syncthreads();
#pragma unroll 1
    for (int tb = 0; tb < 8; ++tb) {
        const int tl = 16 * tb + fr; const size_t row = (size_t)b * SEQ + t0 + tl;
        bf16x8 X[2];
#pragma unroll
        for (int kk = 0; kk < 2; ++kk) X[kk] = *(const LAS bf16x8*)(TILE + tl * 264 + hb * 64 + kk * 32 + 8 * fq);
#pragma unroll
        for (int nbl = 0; nbl < 2; ++nbl) {
            f32x4 ra = (f32x4){0.f, 0.f, 0.f, 0.f}, rx = (f32x4){0.f, 0.f, 0.f, 0.f};
#pragma unroll
            for (int kk = 0; kk < 2; ++kk) { ra = mfma16(WA[kk][nbl], X[kk], ra); rx = mfma16(WX[kk][nbl], X[kk], rx); }
            const int ch = hb * 64 + (2 * nh + nbl) * 16 + 4 * fq;
            const f32x4 xcv = unpack4(*(const LAS v2u*)(TILE + tl * 264 + ch));
            v4u lab;
#pragma unroll
            for (int j = 0; j < 4; ++j) {
                const float e1 = __expf(-(ra[j] + ba4[nbl][j])), e2 = __expf(-(rx[j] + bx4[nbl][j]));
                const float rp = __builtin_amdgcn_rcpf((1.f + e1) * (1.f + e2)), r = (1.f + e2) * rp, ii = (1.f + e1) * rp;
                const float la = __builtin_bit_cast(float, pk2(r * ls4[nbl][j], 0.f) << 16);
                float a = __expf(la);
                float bb = sqrtf(fmaxf((la > -0.125f) ? neg_expm1(2.0f * la) : 1.f - a * a, 0.f)) * ii * xcv[j];
                const unsigned pr = pk2(la, bb); bb = __builtin_bit_cast(float, pr & 0xffff0000u);
                lab[j] = pr;
                { const float ap = row_shr<1>(1.f, a), bp = row_shr<1>(0.f, bb); bb = a * bp + bb; a = a * ap; }
                { const float ap = row_shr<2>(1.f, a), bp = row_shr<2>(0.f, bb); bb = a * bp + bb; a = a * ap; }
                { const float ap = row_shr<4>(1.f, a), bp = row_shr<4>(0.f, bb); bb = a * bp + bb; a = a * ap; }
                { const float ap = row_shr<8>(1.f, a), bp = row_shr<8>(0.f, bb); bb = a * bp + bb; a = a * ap; }
                const float h = a * hc[nbl][j] + bb;
                hc[nbl][j] = __shfl(h, 15, 16);
                ac[nbl][j] *= __shfl(a, 15, 16);
            }
            *(GAS v4u*)(LAB + row * GWD + ch) = lab;
        }
    }
    if (fr == 0) {
#pragma unroll
        for (int nbl = 0; nbl < 2; ++nbl) { const int ch = hb * 64 + (2 * nh + nbl) * 16 + 4 * fq; gf ap = AGG + ((size_t)(b * NCH + chunk) * GWD + ch) * 2;
            *(GAS f32x4*)ap = (f32x4){ac[nbl][0], hc[nbl][0], ac[nbl][1], hc[nbl][1]}; *(GAS f32x4*)(ap + 4) = (f32x4){ac[nbl][2], hc[nbl][2], ac[nbl][3], hc[nbl][3]}; }
    }
}
DI void lru_out_unit(gcb PROJ, gb CAT, gcf lnorm, gcf H0, const GAS unsigned* LAB, LAS unsigned char* lds, int b, int chunk, int tid, int wave, int lane) {
    asm volatile("" : "+v"(tid)); lane = tid & 63;
    LAS float* SS = (LAS float*)lds;
    const int t0 = chunk * CH, hb = wave & 3, nh = wave >> 2, fr = lane & 15, fq = lane >> 4;
    v4u lab[8][2]; v2u gt[8][2];
#pragma unroll
    for (int tb = 0; tb < 8; ++tb)
#pragma unroll
        for (int nbl = 0; nbl < 2; ++nbl) { const size_t row = (size_t)b * SEQ + t0 + 16 * tb + fr; const int ch = hb * 64 + (2 * nh + nbl) * 16 + 4 * fq;
            lab[tb][nbl] = *(GAS const v4u*)(LAB + row * GWD + ch); gt[tb][nbl] = *(GAS const v2u*)(PROJ + row * INW + 1024 + ch); }
    f32x4 hc[2];
#pragma unroll
    for (int nbl = 0; nbl < 2; ++nbl) hc[nbl] = ld4(H0 + ((size_t)(b * NCH + chunk) * GWD + hb * 64 + (2 * nh + nbl) * 16 + 4 * fq));
    v2u yk[8][2];
    __syncthreads();
#pragma unroll
    for (int tb = 0; tb < 8; ++tb) {
        float ssq = 0.f;
#pragma unroll
        for (int nbl = 0; nbl < 2; ++nbl) { const f32x4 gt4 = unpack4(gt[tb][nbl]); f32x4 yv;
#pragma unroll
            for (int j = 0; j < 4; ++j) { const unsigned pr = lab[tb][nbl][j];
                float a = __expf(__builtin_bit_cast(float, pr << 16)), bb = __builtin_bit_cast(float, pr & 0xffff0000u);
                { const float ap = row_shr<1>(1.f, a), bp = row_shr<1>(0.f, bb); bb = a * bp + bb; a = a * ap; }
                { const float ap = row_shr<2>(1.f, a), bp = row_shr<2>(0.f, bb); bb = a * bp + bb; a = a * ap; }
                { const float ap = row_shr<4>(1.f, a), bp = row_shr<4>(0.f, bb); bb = a * bp + bb; a = a * ap; }
                { const float ap = row_shr<8>(1.f, a), bp = row_shr<8>(0.f, bb); bb = a * bp + bb; a = a * ap; }
                const float h = a * hc[nbl][j] + bb;
                hc[nbl][j] = __shfl(h, 15, 16);
                const float y = gelu_t(gt4[j]) * h; yv[j] = y; ssq += y * y; }
            yk[tb][nbl] = pack4(yv); }
        ssq += __shfl_xor(ssq, 16); ssq += __shfl_xor(ssq, 32); if (fq == 0) SS[wave * 128 + 16 * tb + fr] = ssq;
    }
    __syncthreads();
#pragma unroll
    for (int tb = 0; tb < 8; ++tb) { const int tl = 16 * tb + fr; const size_t row = (size_t)b * SEQ + t0 + tl; float tot = 0.f;
#pragma unroll
        for (int w = 0; w < 8; ++w) tot += SS[w * 128 + tl];
        const float rstd = rsqrtf(tot * (1.f / GWD) + EPS);
#pragma unroll
        for (int nbl = 0; nbl < 2; ++nbl) { const int ch = hb * 64 + (2 * nh + nbl) * 16 + 4 * fq; *(GAS v2u*)(CAT + row * D + 512 + ch) = pack4(unpack4(yk[tb][nbl]) * rstd * ld4(lnorm + ch)); } }
}

DI f32x4 mfma_p2(const v2u a0, const v2u a1, const v2u b0, const v2u b1, const f32x4 c) {
    v4u A, B; A.x = a0.x; A.y = a0.y; A.z = a1.x; A.w = a1.y; B.x = b0.x; B.y = b0.y; B.z = b1.x; B.w = b1.y;
    return __builtin_amdgcn_mfma_f32_16x16x32_bf16(__builtin_bit_cast(bf16x8, A), __builtin_bit_cast(bf16x8, B), c, 0, 0, 0);
}
template <bool OUT>
DI void hgrn_wave_unit(gcb PROJ, gb CAT, gcf LBl, gcf normg, gf ST, gf DEC, LAS float* wlf, int u, int lane) {
    asm volatile("" : "+v"(lane));
    const int hh = u & 3, c = (u >> 2) & (NCH - 1), b = u >> 8, fr = lane & 15, fq = lane >> 4;
    LAS bf16* QT = (LAS bf16*)wlf;
    LAS bf16* KT = QT + 16 * 72;
    LAS bf16* KH = KT + 16 * 72;
    LAS bf16* VT = KH + 64 * 20;
    LAS float* DC = (LAS float*)(VT + 64 * 20);
    const float lbv = LBl[hh * 64 + lane], oml = 1.f - lbv;
    gf stp = ST + ((size_t)((b * NCH + c) * 4 + hh)) * 4096;
    f32x4 S[4][4];
#pragma unroll
    for (int mi = 0; mi < 4; ++mi)
#pragma unroll
        for (int ni = 0; ni < 4; ++ni) S[mi][ni] = OUT ? *(GAS const f32x4*)(stp + ((mi * 4 + ni) * 64 + lane) * 4) : (f32x4){0.f, 0.f, 0.f, 0.f};
    float Dtot = 1.f;
    f32x4 ng4[4];
#pragma unroll
    for (int nv = 0; nv < 4; ++nv) ng4[nv] = OUT ? ld4(normg + hh * 64 + 16 * nv + 4 * fq) : (f32x4){0.f, 0.f, 0.f, 0.f};
    bf16 zr[16], vr[16], qr[16]; v2u gr[4];
#define HG_LOAD(sbn) do { const size_t r0_ = (size_t)b * SEQ + c * CH + (sbn) * 16; \
        _Pragma("unroll") for (int t = 0; t < 16; ++t) { gcb p = PROJ + (r0_ + t) * INW + hh * 64 + lane; zr[t] = p[1536]; vr[t] = p[1792]; if (OUT) qr[t] = p[1280]; else qr[t] = 0; } \
        _Pragma("unroll") for (int nv = 0; nv < 4; ++nv) { if (OUT) gr[nv] = *(GAS const v2u*)(PROJ + (r0_ + fr) * INW + 2048 + hh * 64 + 16 * nv + 4 * fq); else gr[nv] = (v2u){0u, 0u}; } } while (0)
    HG_LOAD(0);
    for (int sb = 0; sb < CH / 16; ++sb) {
        const size_t row0 = (size_t)b * SEQ + c * CH + sb * 16;
        float kk[16], Bt[16]; float Bc = 0.f;
#pragma unroll
        for (int t = 0; t < 16; ++t) {
            const float z = fminf(fmaxf(bf2f(zr[t]), -30.f), 30.f), ez = __expf(-z), sg = __builtin_amdgcn_rcpf(1.f + ez);
            const float f = fmaxf(lbv + oml * sg, 1e-30f);
            Bc += __logf(f); Bt[t] = Bc; kk[t] = oml * ez * sg;
            VT[lane * 20 + t] = vr[t];
            if (OUT) { const float q = siluf(bf2f(qr[t])); QT[t * 72 + lane] = f2bf(q * __expf(Bc)); KT[t * 72 + lane] = f2bf(kk[t] * __expf(fminf(-Bc, 60.f))); } }
#pragma unroll
        for (int t = 0; t < 16; ++t) KH[lane * 20 + t] = f2bf(kk[t] * __expf(Bc - Bt[t]));
        { const float dsub = __expf(Bc); DC[lane] = dsub; Dtot *= dsub; }
        v2u gcur[4];
#pragma unroll
        for (int nv = 0; nv < 4; ++nv) gcur[nv] = gr[nv];
        if (sb + 1 < CH / 16) HG_LOAD(sb + 1);
        LDS_WAIT();
        v2u vt[4]; const v2u zz = (v2u){0u, 0u};
#pragma unroll
        for (int nv = 0; nv < 4; ++nv) vt[nv] = *(const LAS v2u*)(VT + (16 * nv + fr) * 20 + 4 * fq);
        if (OUT) {
            f32x4 O[4], SC = (f32x4){0.f, 0.f, 0.f, 0.f};
            v2u qf[4], kf[4];
#pragma unroll
            for (int s = 0; s < 4; ++s) { qf[s] = *(const LAS v2u*)(QT + fr * 72 + 16 * s + 4 * fq); kf[s] = *(const LAS v2u*)(KT + fr * 72 + 16 * s + 4 * fq); }
            SC = mfma_p2(kf[0], kf[1], qf[0], qf[1], SC); SC = mfma_p2(kf[2], kf[3], qf[2], qf[3], SC);
#pragma unroll
            for (int nv = 0; nv < 4; ++nv) { O[nv] = (f32x4){0.f, 0.f, 0.f, 0.f};
                O[nv] = mfma_p2(pack4(S[nv][0]), pack4(S[nv][1]), qf[0], qf[1], O[nv]); O[nv] = mfma_p2(pack4(S[nv][2]), pack4(S[nv][3]), qf[2], qf[3], O[nv]); }
#pragma unroll
            for (int r = 0; r < 4; ++r) if (4 * fq + r > fr) SC[r] = 0.f;
            const v2u scp = pack4(SC);
            float ss = 0.f;
#pragma unroll
            for (int nv = 0; nv < 4; ++nv) { O[nv] = mfma_p2(vt[nv], zz, scp, zz, O[nv]); ss += (O[nv].x * O[nv].x + O[nv].y * O[nv].y) + (O[nv].z * O[nv].z + O[nv].w * O[nv].w); }
            ss += __shfl_xor(ss, 16); ss += __shfl_xor(ss, 32);
            const float rstd = rsqrtf(ss * (1.f / 64.f) + EPS);
            const size_t row = row0 + fr;
#pragma unroll
            for (int nv = 0; nv < 4; ++nv) { f32x4 g4 = unpack4(gcur[nv]);
                g4.x = siluf(g4.x); g4.y = siluf(g4.y); g4.z = siluf(g4.z); g4.w = siluf(g4.w);
                *(GAS v2u*)(CAT + row * D + 768 + hh * 64 + 16 * nv + 4 * fq) = pack4(O[nv] * rstd * ng4[nv] * g4); }
        }
#pragma unroll
        for (int ni = 0; ni < 4; ++ni) { const f32x4 dk = *(const LAS f32x4*)(DC + 16 * ni + 4 * fq); const v2u kh = *(const LAS v2u*)(KH + (16 * ni + fr) * 20 + 4 * fq);
#pragma unroll
            for (int mi = 0; mi < 4; ++mi) S[mi][ni] = mfma_p2(kh, zz, vt[mi], zz, S[mi][ni] * dk); }
        LDS_WAIT();
    }
    if (!OUT) {
#pragma unroll
        for (int mi = 0; mi < 4; ++mi)
#pragma unroll
            for (int ni = 0; ni < 4; ++ni) *(GAS f32x4*)(stp + ((mi * 4 + ni) * 64 + lane) * 4) = S[mi][ni];
        DEC[((size_t)((b * NCH + c) * 4 + hh)) * 64 + lane] = Dtot;
    }
}
#undef HG_LOAD

DI void carry_phase(gf ST, gcf DEC, gcf AGG, gf H0, int wg, int G, int tid) {
    const int gt = wg * NTHR + tid, NT = G * NTHR;
    for (int idx = gt; idx < BATCH * 4 * 4096; idx += NT) { const int b = idx >> 14, hh = (idx >> 12) & 3, kv = idx & 4095, k = 16 * ((kv >> 8) & 3) + 4 * ((kv >> 6) & 3) + (kv & 3); float run = 0.f;
#pragma unroll 8
        for (int c = 0; c < NCH; ++c) { gf p = ST + ((size_t)((b * NCH + c) * 4 + hh)) * 4096 + kv; const float d = DEC[((size_t)((b * NCH + c) * 4 + hh)) * 64 + k], sl = *p; *p = run; run = d * run + sl; } }
    for (int idx = gt; idx < BATCH * GWD; idx += NT) { const int b = idx >> 8, ch = idx & 255; float run = 0.f;
#pragma unroll 8
        for (int c = 0; c < NCH; ++c) { const f32x2 ah = *(GAS const f32x2*)(AGG + ((size_t)(b * NCH + c) * GWD + ch) * 2); H0[(size_t)(b * NCH + c) * GWD + ch] = run; run = ah.x * run + ah.y; } }
}

struct Args { const float* in[33]; float* out; unsigned char* ws; int ph_lo, ph_hi; };
enum { I_X = 0, I_C, I_WMOD, I_BMOD, I_NMIX, I_NFFN, I_NFIN, I_WIN, I_WOUT, I_POOLW, I_POOLS, I_POOLN, I_SGUW, I_SGUB, I_SGUN, I_CONVW, I_CONVB, I_LWA, I_LBA, I_LWX, I_LBX, I_LAM, I_LN,
       I_HGAM, I_HN, I_F1, I_F3, I_F2, I_RW, I_RB, I_M1, I_M3, I_M2 };
constexpr int N_PHASES = 1 + (7 + 2) + (8 + (IS_F8(1) ? 4 : 8)) + (7 + 2) + (8 + (IS_F8(3) ? 4 : 8)) + 1;

DI gws launder(unsigned char* p) { asm volatile("" : "+s"(p)); return (gws)p; }
DI gcf inp(const Args& a, int i) { asm volatile("" : "+s"(i)); return (gcf)a.in[i]; }
#define WSP(T, off) ((GAS T*)(ws + (off)))
#define WSG(T, off) ((T*)((unsigned char*)ws + (off)))

__global__ void __launch_bounds__(NTHR, 2) mk_fwd(Args args) {
    extern __shared__ __attribute__((aligned(16))) unsigned char lds_raw[];
    LAS unsigned char* lds = (LAS unsigned char*)lds_raw;
    const int tid0 = threadIdx.x, wg0 = blockIdx.x, G0 = gridDim.x;
    for (int u = tid0; u < (LDS_BYTES - RING_BYTES) / 4; u += NTHR) ((LAS unsigned*)(lds + RING_BYTES))[u] = 0u;
    __syncthreads();
    const XcdBarrier bar = xcd_barrier_post((unsigned*)(args.ws + WS_CTL) + CW_BAR, (volatile LAS unsigned*)(lds + MISC_OFF) + 8);
    const int lo = args.ph_lo, hi = args.ph_hi;
#define XOUT ((gf)args.out)
    int pi = 0;
#define PH_IDS int tid = tid0; asm volatile("" : "+v"(tid)); const int lane = tid & 63, wave = __builtin_amdgcn_readfirstlane(tid >> 6); int wg = wg0, G = G0; asm volatile("" : "+s"(wg), "+s"(G))
#define PH_ON (pi >= lo && pi < hi)
#define PH_END do { if (pi >= lo && pi + 1 < hi) xcd_barrier(bar); ++pi; } while (0)

    if (PH_ON) { gws ws = launder(args.ws); PH_IDS;
        p0_prologue(inp(args, I_C), inp(args, I_WMOD), inp(args, I_BMOD), inp(args, I_HGAM), inp(args, I_POOLW), inp(args, I_LWA), inp(args, I_LWX), inp(args, I_SGUW), ws, lds, wg, G, tid, wave, lane); }
    PH_END;

    for (int l = 0; l < DEPTH; ++l) {
        const int moe = l & 1;
        if (PH_ON) { gws ws = launder(args.ws); PH_IDS; gcf modl = WSP(float, WS_MOD) + (size_t)l * 8 * MODW;
            convert_weights(l, inp(args, I_WIN), inp(args, I_WOUT), inp(args, I_F1), inp(args, I_F3), inp(args, I_F2), inp(args, I_M1), inp(args, I_M3), inp(args, I_M2), ws, lds, wg, G, wave, lane);
            if (l == 2) norm_phase<true, false, false, false>(nullptr, WSP(bf16, WS_XB), nullptr, inp(args, I_NMIX) + l * D, modl + 0 * D, modl + 1 * D, modl - 8 * MODW + 5 * D, WSP(bf16, WS_XN), WSP(bf16, WS_Y1), WSP(bf16, WS_XN), nullptr, nullptr, nullptr, nullptr, nullptr, nullptr, lds, wg, G, tid, wave, lane);
            else if (l == 0) norm_phase<false, false, false, true>(inp(args, I_X), WSP(bf16, WS_XB), nullptr, inp(args, I_NMIX) + l * D, modl + 0 * D, modl + 1 * D, nullptr, nullptr, nullptr, WSP(bf16, WS_XN), nullptr, nullptr, nullptr, nullptr, nullptr, nullptr, lds, wg, G, tid, wave, lane);
            else norm_phase<false, false, false, false>(nullptr, WSP(bf16, WS_XB), nullptr, inp(args, I_NMIX) + l * D, modl + 0 * D, modl + 1 * D, nullptr, nullptr, nullptr, WSP(bf16, WS_XN), nullptr, nullptr, nullptr, nullptr, nullptr, nullptr, lds, wg, G, tid, wave, lane);
        }
        PH_END;
        if (PH_ON) { gws ws = launder(args.ws); PH_IDS;
            pg8::Gemm g{WSG(bf16, WS_XN), WSG(bf16, WS_WIN), D}; pg8::TileOrder<INW / 256> S; S.init(M / 256, G, wg, 0, 0, nullptr);
            EpiProj E{WSP(bf16, WS_PROJ)};
            pg8::gemm_phase<EpiProj, pg8::TileOrder<INW / 256>, true, true>(lds, g, S, E);
        }
        PH_END;
        if (PH_ON) { gws ws = launder(args.ws); PH_IDS; gcb PROJ = WSP(bf16, WS_PROJ); gb CAT = WSP(bf16, WS_CAT);
            for (int unit = wg; unit < BATCH * NCH; unit += G) { const int b = unit >> 6, blk = unit & (NCH - 1);
                pool_unit(PROJ, CAT, WSP(bf16, WS_POOLWT) + l * 16384, inp(args, I_POOLS) + l * GWD, inp(args, I_POOLN) + l * GWD, lds, b, blk * CH, tid, wave, lane);
                sgu_unit(PROJ, CAT, WSP(bf16, WS_SGUW) + l * 65536, inp(args, I_SGUB) + l * 512, inp(args, I_SGUN) + l * GWD, lds, b, blk * CH, tid, wave, lane);
                lru_local_unit(PROJ, inp(args, I_CONVW) + l * 4 * GWD, inp(args, I_CONVB) + l * GWD, inp(args, I_LBA) + l * GWD, inp(args, I_LBX) + l * GWD, inp(args, I_LAM) + l * GWD,
                               WSP(bf16, WS_LRUWAT) + l * 16384, WSP(bf16, WS_LRUWXT) + l * 16384, WSP(float, WS_AGG), WSP(unsigned, WS_LAB), lds, b, blk, tid, wave, lane);
                __syncthreads(); }
            for (int u = wg * NWAVES + wave; u < BATCH * NCH * 4; u += G * NWAVES)
                hgrn_wave_unit<false>(PROJ, CAT, WSP(float, WS_LB) + l * GWD, inp(args, I_HN) + l * GWD, WSP(float, WS_ST), WSP(float, WS_DEC), (LAS float*)(lds + wave * 16384), u, lane);
        }
        PH_END;
        if (PH_ON) { gws ws = launder(args.ws); PH_IDS; carry_phase(WSP(float, WS_ST), WSP(float, WS_DEC), WSP(float, WS_AGG), WSP(float, WS_H0), wg, G, tid); }
        PH_END;
        if (PH_ON) { gws ws = launder(args.ws); PH_IDS; gcb PROJ = WSP(bf16, WS_PROJ); gb CAT = WSP(bf16, WS_CAT);
            for (int unit = wg; unit < BATCH * NCH; unit += G) { const int b = unit >> 6, blk = unit & (NCH - 1);
                lru_out_unit(PROJ, CAT, inp(args, I_LN) + l * GWD, WSP(float, WS_H0), WSP(unsigned, WS_LAB), lds, b, blk, tid, wave, lane); }
            __syncthreads();
            for (int u = wg * NWAVES + wave; u < BATCH * NCH * 4; u += G * NWAVES)
                hgrn_wave_unit<true>(PROJ, CAT, WSP(float, WS_LB) + l * GWD, inp(args, I_HN) + l * GWD, WSP(float, WS_ST), WSP(float, WS_DEC), (LAS float*)(lds + wave * 16384), u, lane);
        }
        PH_END;
        if (PH_ON) { gws ws = launder(args.ws); PH_IDS;
            pg8::Gemm g{WSG(bf16, WS_CAT), WSG(bf16, WS_WOUT), D}; pg8::TileOrder<D / 256> S; S.init(M / 256, G, wg, 0, 0, nullptr);
            EpiResid E{WSP(bf16, WS_XB), WSP(float, WS_MOD) + (size_t)l * 8 * MODW + 2 * D, 1.0f};
            pg8::gemm_phase<EpiResid, pg8::TileOrder<D / 256>, true, true>(lds, g, S, E);
        }
        PH_END;
        if (PH_ON) { gws ws = launder(args.ws); PH_IDS; gcf modl = WSP(float, WS_MOD) + (size_t)l * 8 * MODW;
            if (moe) norm_phase<false, true, false, false>(nullptr, WSP(bf16, WS_XB), nullptr, inp(args, I_NFFN) + l * D, modl + 3 * D, modl + 4 * D, nullptr, nullptr, nullptr, WSP(bf16, WS_XN), inp(args, I_RW) + (l >> 1) * D * NE, inp(args, I_RB) + (l >> 1) * NE,
                                                    WSP(int, WS_TOKE), WSP(float, WS_TOKW), WSP(int, WS_HISTW), WSP(v2i, WS_PAIR), lds, wg, G, tid, wave, lane);
            else if (IS_F8(l)) norm_phase<false, false, false, false, true>(nullptr, WSP(bf16, WS_XB), nullptr, inp(args, I_NFFN) + l * D, modl + 3 * D, modl + 4 * D, nullptr, nullptr, nullptr, WSP(bf16, WS_XN), nullptr, nullptr, nullptr, nullptr, nullptr, nullptr, lds, wg, G, tid, wave, lane);
            else norm_phase<false, false, false, false>(nullptr, WSP(bf16, WS_XB), nullptr, inp(args, I_NFFN) + l * D, modl + 3 * D, modl + 4 * D, nullptr, nullptr, nullptr, WSP(bf16, WS_XN), nullptr, nullptr, nullptr, nullptr, nullptr, nullptr, lds, wg, G, tid, wave, lane);
        }
        PH_END;
        if (moe) {
            if (PH_ON) { gws ws = launder(args.ws); PH_IDS;
                    route_phase(WSP(bf16, WS_XN), WSP(bf16, WS_PROJ), WSP(int, WS_TOKE), WSP(float, WS_TOKW), WSP(int, WS_HISTW), WSP(v2i, WS_PAIR), WSP(int, WS_TILEE), WSP(int, WS_NT), lds, wg, G, tid, wave, lane, IS_F8(l)); }
            PH_END;
        }
        const int nck = moe ? (IS_F8(l) ? 2 : 4) : 1;
#define FFN_RANGE int pm0 = 0, nM = M / 256; if (moe) { const int ntl = __builtin_amdgcn_readfirstlane(__hip_atomic_load(WSP(int, WS_NT), __ATOMIC_RELAXED, __HIP_MEMORY_SCOPE_AGENT)); \
            if (IS_F8(l)) { pm0 = ck * 256; nM = (ck < 1) ? 256 : ntl - 256; if (nM > 292) nM = 292; } else { pm0 = ck * 128; nM = (ck < 3) ? 128 : ntl - 384; if (nM > 146) nM = 146; } if (nM < 0) nM = 0; }
        for (int ck = 0; ck < nck; ++ck) {
            if (PH_ON && !IS_F8(l)) { gws ws = launder(args.ws); PH_IDS; FFN_RANGE;
                pg8::Gemm g{moe ? WSG(bf16, WS_PROJ) : WSG(bf16, WS_XN), WSG(bf16, WS_W13), D}; pg8::TileOrder<DFF / 128> S; S.init(nM, G, wg, pm0, 0, moe ? WSG(int, WS_TILEE) : nullptr);
                EpiSwiglu E{moe ? WSP(bf16, WS_CAT) : WSP(bf16, WS_PROJ), pm0};
                pg8::gemm_phase<EpiSwiglu, pg8::TileOrder<DFF / 128>, true, true>(lds, g, S, E);
            }
            if (PH_ON && IS_F8(l)) { gws ws = launder(args.ws); PH_IDS; FFN_RANGE;
                pg8::Gemm g{moe ? WSG(bf16, WS_PROJ) : WSG(bf16, WS_XN), WSG(bf16, WS_W13), D / 2}; pg8::TileOrder<DFF / 128> S; S.init(nM, G, wg, pm0, 0, moe ? WSG(int, WS_TILEE) : nullptr);
                EpiSwiglu8 E{moe ? WSP(unsigned char, WS_CAT) : WSP(unsigned char, WS_PROJ), pm0};
                pg8::gemm_phase<EpiSwiglu8, pg8::TileOrder<DFF / 128>, true, true, true>(lds, g, S, E);
            }
            PH_END;
            if (PH_ON && !IS_F8(l) && moe) { gws ws = launder(args.ws); PH_IDS; FFN_RANGE;
                pg8::Gemm g{WSG(bf16, WS_CAT), WSG(bf16, WS_W2), DFF}; pg8::TileOrder<D / 256> S; S.init(nM, G, wg, pm0, 1, WSG(int, WS_TILEE));
                EpiScatter E{WSP(v2i, WS_PAIR), WSP(bf16, WS_XN), WSP(bf16, WS_Y1), WSP(int, WS_TOKE), WSP(float, WS_TOKW), 1.0f};
                pg8::gemm_phase<EpiScatter, pg8::TileOrder<D / 256>, true, true>(lds, g, S, E);
            }
            if (PH_ON && !moe && !IS_F8(l)) { gws ws = launder(args.ws); PH_IDS; FFN_RANGE;
                pg8::Gemm g{WSG(bf16, WS_PROJ), WSG(bf16, WS_W2), DFF}; pg8::TileOrder<D / 256> S; S.init(nM, G, wg, pm0, 1, nullptr);
                EpiResid E{WSP(bf16, WS_XB), WSP(float, WS_MOD) + (size_t)l * 8 * MODW + 5 * D, 1.0f};
                pg8::gemm_phase<EpiResid, pg8::TileOrder<D / 256>, true, true>(lds, g, S, E);
            }
            if (PH_ON && IS_F8(l) && !moe) { gws ws = launder(args.ws); PH_IDS; FFN_RANGE;
                pg8::Gemm g{WSG(bf16, WS_PROJ), WSG(bf16, WS_W2), DFF / 2}; pg8::TileOrder<D / 256> S; S.init(nM, G, wg, pm0, 1, nullptr);
                EpiResid E{WSP(bf16, WS_XB), WSP(float, WS_MOD) + (size_t)l * 8 * MODW + 5 * D, 1.0f / F8_S2};
                pg8::gemm_phase<EpiResid, pg8::TileOrder<D / 256>, true, true, true>(lds, g, S, E);
            }
            if (PH_ON && IS_F8(l) && moe) { gws ws = launder(args.ws); PH_IDS; FFN_RANGE;
                pg8::Gemm g{WSG(bf16, WS_CAT), WSG(bf16, WS_W2), DFF / 2}; pg8::TileOrder<D / 256> S; S.init(nM, G, wg, pm0, 1, WSG(int, WS_TILEE));
                EpiScatter E{WSP(v2i, WS_PAIR), WSP(bf16, WS_XN), WSP(bf16, WS_Y1), WSP(int, WS_TOKE), WSP(float, WS_TOKW), 1.0f / F8_S2};
                pg8::gemm_phase<EpiScatter, pg8::TileOrder<D / 256>, true, true, true>(lds, g, S, E);
            }
            PH_END;
        }
#undef FFN_RANGE
    }
    if (PH_ON) { gws ws = launder(args.ws); PH_IDS;
        norm_phase<true, false, true, false>(nullptr, WSP(bf16, WS_XB), XOUT, inp(args, I_NFIN), nullptr, nullptr, WSP(float, WS_MOD) + (size_t)3 * 8 * MODW + 5 * D, WSP(bf16, WS_XN), WSP(bf16, WS_Y1), nullptr, nullptr, nullptr, nullptr, nullptr, nullptr, nullptr, lds, wg, G, tid, wave, lane); }
#undef PH_ON
#undef PH_END
}

#ifndef MK_CUTS
#define MK_CUTS 0
#endif
extern "C" void kernel_launch(void* const* d_in, gci in_sizes, int n_in, void* d_out, int out_size, void* d_ws, size_t ws_size, hipStream_t stream) {
    static int grid = 0;
    if (grid == 0) {
        if (n_in != 33 || in_sizes[0] != M * D || out_size != M * D || ws_size < WS_END) { fprintf(stderr, "kernel_launch: unexpected shapes (n_in %d, in0 %d, out %d, ws %zu); nothing launched\n", n_in, n_in > 0 ? in_sizes[0] : -1, out_size, ws_size); grid = -1; return; }
        int dev = 0, cus = 0, per_cu = 0;
        if (hipGetDevice(&dev) != hipSuccess || hipDeviceGetAttribute(&cus, hipDeviceAttributeMultiprocessorCount, dev) != hipSuccess) { grid = -1; return; }
        if (hipFuncSetAttribute((const void*)mk_fwd, hipFuncAttributeMaxDynamicSharedMemorySize, LDS_BYTES) != hipSuccess) { fprintf(stderr, "kernel_launch: hipFuncSetAttribute failed\n"); grid = -1; return; }
        if (hipOccupancyMaxActiveBlocksPerMultiprocessor(&per_cu, (const void*)mk_fwd, NTHR, LDS_BYTES) != hipSuccess || per_cu < 1) fprintf(stderr, "kernel_launch: occupancy query reports %d workgroups per CU\n", per_cu);
        (void)hipGetLastError();
        grid = cus;
    }
    if (grid < 0) return;
    if (hipMemsetAsync((char*)d_ws + WS_CTL, 0, CTL_ZERO_BYTES, stream) != hipSuccess) return;
    Args a{};
    for (int i = 0; i < 33; ++i) a.in[i] = (const float*)d_in[i];
    a.out = (float*)d_out; a.ws = (unsigned char*)d_ws;
#if MK_CUTS
    for (int p = 0; p < N_PHASES; ++p) { a.ph_lo = p; a.ph_hi = p + 1; hipLaunchKernelGGL(mk_fwd, dim3(grid), dim3(NTHR), LDS_BYTES, stream, a); }
#else
    a.ph_lo = 0; a.ph_hi = N_PHASES;
    hipLaunchKernelGGL(mk_fwd, dim3(grid), dim3(NTHR), LDS_BYTES, stream, a);
#endif
}
```

```cpp
#include <hip/hip_runtime.h>
#include <cstdio>
#include <cstdint>

namespace pg8 {
#define PG8_LAS __attribute__((address_space(3)))
typedef unsigned short bf16_t;
typedef short bf16x8 __attribute__((ext_vector_type(8)));
typedef float f32x4 __attribute__((ext_vector_type(4)));
typedef unsigned u32x4 __attribute__((ext_vector_type(4)));
constexpr int BM = 256, BK = 64, HALF = 128, HTB = HALF * BK * 2  , STAGE_BYTES = 8 * HTB, NXCD = 8, WGM = 8;

__host__ __device__ __forceinline__ int lds_byte(int r, int c) { const int st = (r >> 4) * 2 + (c >> 5), rr = r & 15, cc = c & 31, ob = rr * 64 + cc * 2; return st * 1024 + (ob ^ (((ob >> 9) & 1) << 5)); }
__host__ __device__ __forceinline__ void stage_rc(int b, int& R, int& C) { const int st = b / 1024, sb = b % 1024, swz = sb ^ (((sb >> 9) & 1) << 5); R = (st >> 1) * 16 + swz / 64; C = (st & 1) * 32 + (swz % 64) / 2; }
__host__ __device__ __forceinline__ int perm32(int rho) { const int n = rho >> 4, i = rho & 15; return 8 * (i >> 2) + 4 * n + (i & 3); }

struct Unit { int pa, pn, pm, pc; };
struct Gemm { const bf16_t* A; const bf16_t* Bt; int K; };

template <int NN>
struct TileOrder {
    int nM, nwg, G, c, pm0, a_rel; const int* tile_e;
    __device__ __forceinline__ void init(int nM_, int G_, int c_, int pm0_, int a_rel_, const int* te) { nM = nM_; nwg = nM_ * NN; G = G_; c = c_; pm0 = pm0_; a_rel = a_rel_; tile_e = te; }
    __device__ __forceinline__ bool next(int i, Unit& u) const {
        const int L = i * G + c; if (L >= nwg) return false;
        int wgid = L; { const int q = nwg >> 3, r = nwg & 7, xcd = wgid & 7, off = wgid >> 3; wgid = (xcd < r ? xcd * (q + 1) : r * (q + 1) + (xcd - r) * q) + off; }
        constexpr int nig = WGM * NN;
        const int gid = wgid / nig, x = wgid - gid * nig, fm = gid * WGM, rem = nM - fm;
        int pml, pc;
        if (rem >= WGM) { pml = fm + (x & (WGM - 1)); pc = x >> 3; } else { pml = fm + (x % rem); pc = x / rem; }
        u.pm = pm0 + pml; u.pc = pc; u.pa = a_rel ? pml : u.pm;
        int e = 0; if (tile_e) e = __builtin_amdgcn_readfirstlane(__hip_atomic_load(tile_e + u.pm, __ATOMIC_RELAXED, __HIP_MEMORY_SCOPE_AGENT));
        u.pn = e * NN + pc; return true;
    }
    __device__ __forceinline__ void a_ready(const Unit&) const {}
    __device__ __forceinline__ void done(const Unit&) const {}
};
typedef int v8i32 __attribute__((ext_vector_type(8)));
typedef int v4i32 __attribute__((ext_vector_type(4)));
__device__ __forceinline__ unsigned cvt_pk_bf16(float lo, float hi) { unsigned r; asm("v_cvt_pk_bf16_f32 %0, %1, %2" : "=v"(r) : "v"(lo), "v"(hi)); return r; }

template <class Epi, class Sched, bool ALIGN_EPI = false, bool SP2 = false, bool F8 = false>
__device__ __forceinline__ void gemm_phase(PG8_LAS unsigned char* lds, const Gemm g, const Sched& S, const Epi& E, const int tid_in) {
    int tid = tid_in; asm volatile("" : "+v"(tid));
    const int wid = __builtin_amdgcn_readfirstlane(tid >> 6), lane = tid & 63, wr = wid >> 2, wc = wid & 3, fr = lane & 15, fq = lane >> 4;
    const int K = g.K, nt = K / BK;
    unsigned voffA[2], voffB[2];
#pragma unroll
    for (int i = 0; i < 2; ++i) { int R, C; stage_rc(tid * 16 + i * 8192, R, C); const int Rb = Epi::PERM ? ((R & ~31) + perm32(R & 31)) : R;
        voffA[i] = (unsigned)(R * K + C) * 2u; voffB[i] = (unsigned)(Rb * K + C) * 2u; }
    const size_t kstep = (size_t)(BK * 2);
    const size_t hstep = (size_t)HALF * K * 2;
    const size_t tstep = 2 * hstep;
    const unsigned ldsw = (unsigned)wid * 1024u;
    const int aoff = lds_byte(wr * 64 + fr, fq * 8), boff = lds_byte(wc * 32 + fr, fq * 8);
#define PG8_SA(b, h) (((b) * 2 + (h)) * HTB)
#define PG8_SB(b, h) ((4 + (b) * 2 + (h)) * HTB)
#define PG8_STAGE(bufoff, gbase, voff) do { _Pragma("unroll") for (int _i = 0; _i < 2; ++_i) \
        __builtin_amdgcn_global_load_lds((const unsigned*)((const char*)(gbase) + (voff)[_i]), (PG8_LAS unsigned*)(lds + (bufoff) + ldsw + _i * 8192), 16, 0, 0); } while (0)
#define PG8_LD16(off_) (*(const PG8_LAS v4i32*)(lds + (off_)))
#define PG8_LDA(dst, b, h) do { _Pragma("unroll") for (int m = 0; m < 4; ++m) { if constexpr (F8) dst##8[m] = __builtin_shufflevector(PG8_LD16(PG8_SA(b, h) + aoff + m * 2048), PG8_LD16(PG8_SA(b, h) + aoff + m * 2048 + 1024), 0, 1, 2, 3, 4, 5, 6, 7); \
        else { _Pragma("unroll") for (int k = 0; k < 2; ++k) dst[m][k] = *(const PG8_LAS bf16x8*)(lds + PG8_SA(b, h) + aoff + m * 2048 + k * 1024); } } } while (0)
#define PG8_LDB(dst, b, h) do { _Pragma("unroll") for (int n = 0; n < 2; ++n) { if constexpr (F8) dst##8[n] = __builtin_shufflevector(PG8_LD16(PG8_SB(b, h) + boff + n * 2048), PG8_LD16(PG8_SB(b, h) + boff + n * 2048 + 1024), 0, 1, 2, 3, 4, 5, 6, 7); \
        else { _Pragma("unroll") for (int k = 0; k < 2; ++k) dst[n][k] = *(const PG8_LAS bf16x8*)(lds + PG8_SB(b, h) + boff + n * 2048 + k * 1024); } } } while (0)
#define PG8_MMA(ai, bj, At, Bt, FIRST) do { __builtin_amdgcn_s_setprio(1); _Pragma("unroll") for (int m = 0; m < 4; ++m) _Pragma("unroll") for (int n = 0; n < 2; ++n) { \
        if constexpr (F8) { if constexpr (FIRST) asm volatile("v_mfma_scale_f32_16x16x128_f8f6f4 %0, %1, %2, 0, %3, %3 op_sel_hi:[0,0,0]" : "=&v"(acc[ai][bj][m][n]) : "v"(Bt##8[n]), "v"(At##8[m]), "v"(f8scale)); \
            else asm volatile("v_mfma_scale_f32_16x16x128_f8f6f4 %0, %1, %2, %0, %3, %3 op_sel_hi:[0,0,0]" : "+v"(acc[ai][bj][m][n]) : "v"(Bt##8[n]), "v"(At##8[m]), "v"(f8scale)); } \
        else { acc[ai][bj][m][n] = __builtin_amdgcn_mfma_f32_16x16x32_bf16(Bt[n][0], At[m][0], acc[ai][bj][m][n], 0, 0, 0); \
            acc[ai][bj][m][n] = __builtin_amdgcn_mfma_f32_16x16x32_bf16(Bt[n][1], At[m][1], acc[ai][bj][m][n], 0, 0, 0); } } __builtin_amdgcn_s_setprio(0); } while (0)
#define PG8_WAIT_V(n) asm volatile("s_waitcnt vmcnt(" #n ")" ::: "memory")
#define PG8_WAIT_L(n) asm volatile("s_waitcnt lgkmcnt(" #n ")" ::: "memory")
#define PG8_BAR __builtin_amdgcn_s_barrier()
#define PG8_SCHED __builtin_amdgcn_sched_barrier(0)
    Unit cur, nxt; int ui = 0;
    if (!S.next(0, cur)) return;
    f32x4 acc[2][2][4][2];
    if constexpr (!F8) {
#pragma unroll
    for (int a = 0; a < 2; ++a)
#pragma unroll
        for (int b = 0; b < 2; ++b)
#pragma unroll
            for (int m = 0; m < 4; ++m)
#pragma unroll
                for (int n = 0; n < 2; ++n) acc[a][b][m][n] = (f32x4){0.f, 0.f, 0.f, 0.f};
    }
    bf16x8 At[4][2], B0[2][2], B1[2][2];
    const int f8scale = 0x7f7f7f7f;
    v8i32 At8[4], B08[2], B18[2];
    const char* cA = (const char*)g.A + (size_t)cur.pa * tstep; const char* cB = (const char*)g.Bt + (size_t)cur.pn * tstep;
    S.a_ready(cur);
    {
        PG8_STAGE(PG8_SB(0, 0), cB, voffB); PG8_STAGE(PG8_SB(0, 1), cB + hstep, voffB); PG8_STAGE(PG8_SA(0, 0), cA, voffA); PG8_STAGE(PG8_SA(0, 1), cA + hstep, voffA);
        if (wr == 1) PG8_BAR;
        PG8_WAIT_V(2); PG8_BAR;
        PG8_STAGE(PG8_SB(1, 0), cB + kstep, voffB); PG8_STAGE(PG8_SA(1, 0), cA + kstep, voffA); PG8_STAGE(PG8_SB(1, 1), cB + hstep + kstep, voffB);
        PG8_WAIT_V(6); PG8_BAR;
    }
    for (;;) {
        const bool has_next = S.next(ui + 1, nxt);
        const char* nA = has_next ? (const char*)g.A + (size_t)nxt.pa * tstep : cA; const char* nB = has_next ? (const char*)g.Bt + (size_t)nxt.pn * tstep : cB;
#define PG8_MMA_F(ai, bj, At, Bt) do { if (F8 && t == 0) PG8_MMA(ai, bj, At, Bt, true); else PG8_MMA(ai, bj, At, Bt, false); } while (0)
#pragma nounroll
        for (int t = 0; t < nt; t += 2) {
            const bool last = (t == nt - 2);
            const char* a1 = cA + (size_t)(t + 1) * kstep;
            const char* a2 = last ? nA : cA + (size_t)(t + 2) * kstep; const char* b2 = last ? nB : cB + (size_t)(t + 2) * kstep;
            const char* a3 = a2 + kstep; const char* b3 = b2 + kstep;
            if (last && has_next) S.a_ready(nxt);
            PG8_LDB(B0, 0, 0); PG8_LDB(B1, 0, 1); PG8_SCHED; PG8_LDA(At, 0, 0); PG8_STAGE(PG8_SA(1, 1), a1 + hstep, voffA);
            PG8_WAIT_V(8); PG8_WAIT_L(0); PG8_BAR; PG8_MMA_F(0, 0, At, B0); PG8_MMA_F(0, 1, At, B1); PG8_BAR; PG8_SCHED;
            PG8_LDA(At, 0, 1); PG8_STAGE(PG8_SB(0, 0), b2, voffB); PG8_STAGE(PG8_SB(0, 1), b2 + hstep, voffB); PG8_STAGE(PG8_SA(0, 0), a2, voffA);
            PG8_WAIT_V(8); PG8_WAIT_L(0); PG8_BAR; PG8_MMA_F(1, 0, At, B0); PG8_MMA_F(1, 1, At, B1); PG8_BAR; PG8_SCHED;
            PG8_LDB(B0, 1, 0); PG8_LDB(B1, 1, 1); PG8_SCHED; PG8_LDA(At, 1, 0); PG8_STAGE(PG8_SA(0, 1), a2 + hstep, voffA);
            PG8_WAIT_V(8); PG8_WAIT_L(0); PG8_BAR; PG8_MMA(0, 0, At, B0, false); PG8_MMA(0, 1, At, B1, false); PG8_BAR; PG8_SCHED;
            PG8_LDA(At, 1, 1); PG8_STAGE(PG8_SB(1, 0), b3, voffB); PG8_STAGE(PG8_SB(1, 1), b3 + hstep, voffB); PG8_STAGE(PG8_SA(1, 0), a3, voffA);
            PG8_WAIT_V(8); PG8_WAIT_L(0); PG8_BAR; PG8_MMA(1, 0, At, B0, false); PG8_MMA(1, 1, At, B1, false); PG8_BAR; PG8_SCHED;
        }
#undef PG8_MMA_F
        if constexpr (ALIGN_EPI) { if (wr == 0) PG8_BAR; }
        if constexpr (F8) asm volatile("s_nop 15\n\ts_nop 15" ::: "memory");
        if constexpr (!Epi::AFTER_DRAIN) { E(acc, cur, wr, wc, fr, fq); S.done(cur); }
        if (!has_next) break;
        if constexpr (!F8) {
#pragma unroll
        for (int a = 0; a < 2; ++a)
#pragma unroll
            for (int b = 0; b < 2; ++b)
#pragma unroll
                for (int m = 0; m < 4; ++m)
#pragma unroll
                    for (int n = 0; n < 2; ++n) acc[a][b][m][n] = (f32x4){0.f, 0.f, 0.f, 0.f};
        }
        cur = nxt; cA = nA; cB = nB; ++ui;
        if constexpr (ALIGN_EPI) { if (wr == 1) PG8_BAR; }
    }
    PG8_WAIT_V(0);
    if constexpr (!ALIGN_EPI) { if (wr == 0) PG8_BAR; }
    PG8_BAR;
    if constexpr (Epi::AFTER_DRAIN) { E.fused(acc, cur, wr, wc, fr, fq, lds, wid, lane); S.done(cur); }
#undef PG8_SA
#undef PG8_SB
#undef PG8_STAGE
#undef PG8_LDA
#undef PG8_LD16
#undef PG8_LDB
#undef PG8_MMA
#undef PG8_WAIT_V
#undef PG8_WAIT_L
#undef PG8_BAR
#undef PG8_SCHED
}
}

constexpr int NWAVES = 8, NTHR = NWAVES * 64;
constexpr int BATCH = 8, SEQ = 8192, D = 1024, M = BATCH * SEQ, DEPTH = 4, GWD = 256, INW = 2304, DFF = 3584, NE = 8;
constexpr float EPS = 1e-6f;
constexpr int MODW = 6 * D;
constexpr int CH = 128, NCH = SEQ / CH;
#ifndef F8_MASK
#define F8_MASK 0xE
#endif
#ifndef B8_MASK
#define B8_MASK 0xC
#endif
#define IS_B8(l_) (((B8_MASK) >> (l_)) & 1)
#define IS_F8(l_) (((F8_MASK) >> (l_)) & 1)
constexpr int F8_LAYER = 3;
constexpr float F8_S13 = 32.f, F8_S2 = 64.f;
constexpr bool MOE_XN8 = ((F8_MASK >> 1) & 1) && ((F8_MASK >> 3) & 1);
constexpr int MAXPAIR = 2 * M + NE * 256;

constexpr size_t MiB = 1u << 20;
constexpr size_t WS_CTL = 0, CTL_ZERO_BYTES = 1 * MiB;
constexpr size_t WS_MOD = 1 * MiB;
constexpr size_t WS_LB = WS_MOD + 786432;
constexpr size_t WS_POOLWT = 2 * MiB;
constexpr size_t WS_LRUWAT = WS_POOLWT + 131072;
constexpr size_t WS_LRUWXT = WS_LRUWAT + 131072;
constexpr size_t WS_SGUW = 3 * MiB;
constexpr size_t WS_TOKE = 4 * MiB;
constexpr size_t WS_TOKW = WS_TOKE + 262144;
constexpr size_t WS_HISTW = 5 * MiB;
constexpr size_t WS_TILEE = WS_HISTW + 65536;
constexpr size_t WS_NT = WS_TILEE + 4096;
constexpr size_t WS_PAIR = 6 * MiB;
constexpr size_t WS_AGG = 8 * MiB;
constexpr size_t WS_H0 = 9 * MiB;
constexpr size_t WS_DEC = 10 * MiB;
constexpr size_t WS_W = 16 * MiB;
constexpr size_t WS_WIN = WS_W, WS_WOUT = WS_W + 5 * MiB, WS_W13 = WS_W + 8 * MiB, WS_W2 = WS_W + 120 * MiB;
constexpr size_t WS_XN = 192 * MiB;
constexpr size_t WS_PROJ = 320 * MiB;
constexpr size_t WS_CAT = 608 * MiB;
constexpr size_t WS_ST = 736 * MiB;
constexpr size_t WS_LAB = 768 * MiB;
constexpr size_t WS_Y1 = 864 * MiB;
constexpr size_t WS_XB = 992 * MiB;
constexpr size_t WS_END = 1120 * MiB;
constexpr int CW_BAR = 4096;
constexpr int CW_ZT = 16384;
constexpr int RING_BYTES = 131072, MISC_OFF = RING_BYTES + 320, LDS_BYTES = 147456;

#define DI __device__ __forceinline__
#define LAS __attribute__((address_space(3)))
typedef unsigned short bf16;
typedef unsigned v4u __attribute__((ext_vector_type(4)));
typedef unsigned v2u __attribute__((ext_vector_type(2)));
typedef int v4i __attribute__((ext_vector_type(4)));
typedef int v2i __attribute__((ext_vector_type(2)));
typedef float f32x4 __attribute__((ext_vector_type(4)));
typedef float f32x2 __attribute__((ext_vector_type(2)));
typedef short bf16x8 __attribute__((ext_vector_type(8)));
#define LDS_WAIT() asm volatile("s_waitcnt lgkmcnt(0)" ::: "memory")
#define GAS __attribute__((address_space(1)))
typedef GAS const float* gcf; typedef GAS float* gf; typedef GAS const bf16* gcb; typedef GAS bf16* gb; typedef GAS const int* gci; typedef GAS int* gi;
typedef GAS const v2i* gcv2i; typedef GAS v2i* gv2i; typedef GAS const unsigned* gcu; typedef GAS unsigned char* gws;

DI float bf2f(bf16 v) { return __builtin_bit_cast(float, (unsigned)v << 16); }
DI float lo_bf(unsigned w) { return __builtin_bit_cast(float, w << 16); }
DI float hi_bf(unsigned w) { return __builtin_bit_cast(float, w & 0xffff0000u); }
DI unsigned pk2(float lo, float hi) { return pg8::cvt_pk_bf16(lo, hi); }
DI bf16 f2bf(float f) { return (bf16)(pk2(f, 0.f) & 0xffffu); }
DI float sigm(float x) { return __builtin_amdgcn_rcpf(1.f + __expf(-x)); }
DI float siluf(float x) { return x * sigm(x); }
DI float gelu_t(float x) { return x * sigm(1.5957691216057308f * (x + 0.044715f * x * x * x)); }
DI float neg_expm1(float x) {
    const float p = -x * (1.f + x * (0.5f + x * (0.16666667f + x * (0.041666668f + x * (0.0083333338f + x * 0.0013888889f)))));
    return x > -0.25f ? p : 1.f - __expf(x);
}
DI float wave_sum(float v) {
#pragma unroll
    for (int o = 1; o < 64; o <<= 1) v += __shfl_xor(v, o);
    return v;
}
template <int D_> DI float row_shr0(float src) { return __builtin_bit_cast(float, __builtin_amdgcn_update_dpp(0, __builtin_bit_cast(int, src), 0x110 + D_, 0xf, 0xf, true)); }
DI float wave_sum_dpp(float v) {
    v += row_shr0<1>(v); v += row_shr0<2>(v); v += row_shr0<4>(v); v += row_shr0<8>(v);
    const int iv = __builtin_bit_cast(int, v);
    const float a = __builtin_bit_cast(float, __builtin_amdgcn_readlane(iv, 15)), b2 = __builtin_bit_cast(float, __builtin_amdgcn_readlane(iv, 31));
    const float c2 = __builtin_bit_cast(float, __builtin_amdgcn_readlane(iv, 47)), d2 = __builtin_bit_cast(float, __builtin_amdgcn_readlane(iv, 63));
    return (a + b2) + (c2 + d2);
}
DI int wave_sum_i(int v) {
#pragma unroll
    for (int o = 1; o < 64; o <<= 1) v += __shfl_xor(v, o);
    return v;
}
DI f32x4 ld4(gcf p) { return *(GAS const f32x4*)p; }
DI void unpack8(const v4u x, float (&o)[8]) { o[0] = lo_bf(x.x); o[1] = hi_bf(x.x); o[2] = lo_bf(x.y); o[3] = hi_bf(x.y); o[4] = lo_bf(x.z); o[5] = hi_bf(x.z); o[6] = lo_bf(x.w); o[7] = hi_bf(x.w); }
DI f32x4 unpack4(const v2u x) { return (f32x4){lo_bf(x.x), hi_bf(x.x), lo_bf(x.y), hi_bf(x.y)}; }
DI v2u pack4(const f32x4 v) { v2u r; r.x = pk2(v.x, v.y); r.y = pk2(v.z, v.w); return r; }
DI float clamp_f8(float v) { return __builtin_amdgcn_fmed3f(v, -448.f, 448.f); }
DI unsigned pk4_f8(float a, float b, float c, float d) { int r = __builtin_amdgcn_cvt_pk_fp8_f32(clamp_f8(a), clamp_f8(b), 0, false); r = __builtin_amdgcn_cvt_pk_fp8_f32(clamp_f8(c), clamp_f8(d), r, true); return (unsigned)r; }
DI f32x4 mfma16(const bf16x8 a, const bf16x8 b, const f32x4 c) { return __builtin_amdgcn_mfma_f32_16x16x32_bf16(a, b, c, 0, 0, 0); }

#define XB_TMO      128
#define XB_XCNT(j)  (256  + 64 * (j))
#define XB_XSUB(j)  (1280 + 64 * (j))
#define XB_XGEN(j)  (2304 + 64 * (j))
#define XB_TOP      3328
#define XB_TOPGEN   3392
#define XCD_BAR_WORDS 3456
#define XB_SPIN_CAP (1u << 18)
__device__ __forceinline__ unsigned xb_ld(unsigned* p)              { return __hip_atomic_load(p, __ATOMIC_RELAXED, __HIP_MEMORY_SCOPE_AGENT); }
__device__ __forceinline__ unsigned xb_add(unsigned* p, unsigned v) { return __hip_atomic_fetch_add(p, v, __ATOMIC_RELAXED, __HIP_MEMORY_SCOPE_AGENT); }
__device__ __forceinline__ unsigned xb_xcc_id() { return (unsigned)__builtin_amdgcn_s_getreg((3 << 11) | 20) & 0xFu; }
#define XB_SPIN(cond, bar) do { unsigned _sp = 0; while (cond) { __builtin_amdgcn_s_sleep(1); \
    if ((++_sp & 255u) == 0u) { if (xb_ld(&(bar)[XB_TMO])) break; if (_sp > XB_SPIN_CAP) { atomicAdd(&(bar)[XB_TMO], 1u); break; } } } } while (0)
DI int hw_lane() { int l; asm volatile("v_mbcnt_lo_u32_b32 %0, -1, 0\n\tv_mbcnt_hi_u32_b32 %0, -1, %0" : "=v"(l)); return l; }
struct XcdBarrier { unsigned* bar; unsigned x; volatile LAS unsigned* st; int w0; };
__device__ __forceinline__ XcdBarrier xcd_barrier_post(unsigned* bar, volatile LAS unsigned* st) {
    XcdBarrier b; b.bar = bar; b.x = xb_xcc_id(); b.st = st; b.w0 = __builtin_amdgcn_readfirstlane((int)threadIdx.x >> 6);
    if (threadIdx.x == 0) (void)xb_add(&bar[XB_XCNT(b.x)], 1u);
    return b;
}
__device__ __forceinline__ void xcd_barrier_complete(unsigned* bar, unsigned x, unsigned& nloc, unsigned& nx) {
    const unsigned G = gridDim.x * gridDim.y * gridDim.z;
    unsigned sum, cnt, mine, sp = 0u;
    for (;;) {
        sum = 0u; cnt = 0u; mine = 0u;
#pragma unroll
        for (unsigned j = 0; j < 16; ++j) { const unsigned c = xb_ld(&bar[XB_XCNT(j)]); sum += c; cnt += (c > 0u) ? 1u : 0u; mine = (j == x) ? c : mine; }
        if (sum == G) break;
        __builtin_amdgcn_s_sleep(1);
        if ((++sp & 255u) == 0u) { if (xb_ld(&bar[XB_TMO])) break; if (sp > XB_SPIN_CAP) { atomicAdd(&bar[XB_TMO], 1u); break; } }
    }
    nloc = mine > 0u ? mine : 1u; nx = cnt > 0u ? cnt : 1u;
}
__device__ __forceinline__ void xcd_barrier(const XcdBarrier& b) {
    asm volatile("s_waitcnt vmcnt(0)" ::: "memory");
    __syncthreads();
    if (b.w0 == 0 && hw_lane() == 0) {
        unsigned* bar = b.bar;
        __builtin_amdgcn_s_waitcnt(0);
        unsigned nloc = b.st[0], nx = b.st[1];
        if (nloc == 0u) { xcd_barrier_complete(bar, b.x, nloc, nx); b.st[0] = nloc; b.st[1] = nx; }
        const unsigned old = xb_add(&bar[XB_XSUB(b.x)], 1u);
        const unsigned gen = old / nloc;
        if (old + 1u == (gen + 1u) * nloc) {
            __builtin_amdgcn_fence(__ATOMIC_RELEASE, "agent");
            asm volatile("s_waitcnt vmcnt(0)" ::: "memory");
            const unsigned og = xb_add(&bar[XB_TOP], 1u);
            const unsigned tg = og / nx;
            if (og + 1u == (tg + 1u) * nx) xb_add(&bar[XB_TOPGEN], 1u);
            else XB_SPIN(xb_ld(&bar[XB_TOPGEN]) == tg, bar);
            __builtin_amdgcn_fence(__ATOMIC_ACQUIRE, "agent");
            xb_add(&bar[XB_XGEN(b.x)], 1u);
            asm volatile("s_waitcnt vmcnt(0)" ::: "memory");
        } else {
            XB_SPIN(xb_ld(&bar[XB_XGEN(b.x)]) == gen, bar);
            __builtin_amdgcn_fence(__ATOMIC_ACQUIRE, "agent");
            asm volatile("s_waitcnt vmcnt(0)" ::: "memory");
        }
    }
    __syncthreads();
}

struct EpiProj {
    static constexpr bool PERM = true, AFTER_DRAIN = false, IDEMPOTENT = true;
    gb O; float mul;
    DI void operator()(const f32x4 (&acc)[2][2][4][2], const pg8::Unit& u, int wr, int wc, int fr, int fq) const {
        const int row0 = u.pm * 256 + wr * 64 + fr, col0 = u.pc * 256 + wc * 32 + 8 * fq;
#pragma unroll
        for (int ai = 0; ai < 2; ++ai)
#pragma unroll
            for (int m = 0; m < 4; ++m) { gb rowp = O + (size_t)(row0 + ai * 128 + m * 16) * INW + col0;
#pragma unroll
                for (int bj = 0; bj < 2; ++bj) { const f32x4 v0 = acc[ai][bj][m][0] * mul, v1 = acc[ai][bj][m][1] * mul;
                    v4u w; w.x = pk2(v0[0], v0[1]); w.y = pk2(v0[2], v0[3]); w.z = pk2(v1[0], v1[1]); w.w = pk2(v1[2], v1[3]);
                    *(GAS v4u*)(rowp + bj * 128) = w; } }
    }
};
struct EpiResid {
    static constexpr bool PERM = true, AFTER_DRAIN = false, IDEMPOTENT = false;
    gb x; gcf gate; float mul;
    DI void operator()(const f32x4 (&acc)[2][2][4][2], const pg8::Unit& u, int wr, int wc, int fr, int fq) const {
        const int b = u.pm >> 5, row0 = u.pm * 256 + wr * 64 + fr, col0 = u.pc * 256 + wc * 32 + 8 * fq;
        f32x4 gv[2][2];
#pragma unroll
        for (int bj = 0; bj < 2; ++bj)
#pragma unroll
            for (int n = 0; n < 2; ++n) gv[bj][n] = ld4(gate + (size_t)b * MODW + col0 + bj * 128 + n * 4) * mul;
        constexpr int PF = 6;
        v4u xr[8][2];
#define ER_LOAD(p) _Pragma("unroll") for (int bj = 0; bj < 2; ++bj) xr[p][bj] = *(GAS const v4u*)(x + (size_t)(row0 + ((p) >> 2) * 128 + ((p) & 3) * 16) * D + col0 + bj * 128)
#pragma unroll
        for (int p = 0; p < PF; ++p) { ER_LOAD(p); }
#pragma unroll
        for (int p = 0; p < 8; ++p) { const int ai = p >> 2, m = p & 3;
#pragma unroll
            for (int bj = 0; bj < 2; ++bj) { float xv[8]; unpack8(xr[p][bj], xv);
                const f32x4 v0 = (f32x4){xv[0], xv[1], xv[2], xv[3]} + gv[bj][0] * acc[ai][bj][m][0], v1 = (f32x4){xv[4], xv[5], xv[6], xv[7]} + gv[bj][1] * acc[ai][bj][m][1];
                v4u o; o.x = pk2(v0[0], v0[1]); o.y = pk2(v0[2], v0[3]); o.z = pk2(v1[0], v1[1]); o.w = pk2(v1[2], v1[3]);
                *(GAS v4u*)(x + (size_t)(row0 + ai * 128 + m * 16) * D + col0 + bj * 128) = o; }
            if (p + PF < 8) { ER_LOAD(p + PF); }
            asm volatile("" ::: "memory"); }
#undef ER_LOAD
    }
};
struct EpiSwiglu {
    static constexpr bool PERM = true, AFTER_DRAIN = false, IDEMPOTENT = true;
    gb ACT; int pm0;
    DI void operator()(const f32x4 (&acc)[2][2][4][2], const pg8::Unit& u, int wr, int wc, int fr, int fq) const {
        const int row0 = (u.pm - pm0) * 256 + wr * 64 + fr, col0 = u.pc * 128 + wc * 32 + 8 * fq;
#pragma unroll
        for (int ai = 0; ai < 2; ++ai)
#pragma unroll
            for (int m = 0; m < 4; ++m) { gb rowp = ACT + (size_t)(row0 + ai * 128 + m * 16) * DFF + col0;
                const f32x4 g0 = acc[ai][0][m][0], g1 = acc[ai][0][m][1], u0 = acc[ai][1][m][0], u1 = acc[ai][1][m][1];
                v4u w; w.x = pk2(siluf(g0[0]) * u0[0], siluf(g0[1]) * u0[1]); w.y = pk2(siluf(g0[2]) * u0[2], siluf(g0[3]) * u0[3]);
                w.z = pk2(siluf(g1[0]) * u1[0], siluf(g1[1]) * u1[1]); w.w = pk2(siluf(g1[2]) * u1[2], siluf(g1[3]) * u1[3]);
                *(GAS v4u*)rowp = w; }
    }
};
struct EpiSwiglu8 {
    static constexpr bool PERM = true, AFTER_DRAIN = false, IDEMPOTENT = true;
    GAS unsigned char* ACT; int pm0;
    DI void operator()(const f32x4 (&acc)[2][2][4][2], const pg8::Unit& u, int wr, int wc, int fr, int fq) const {
        const int row0 = (u.pm - pm0) * 256 + wr * 64 + fr, col0 = u.pc * 128 + wc * 32 + 8 * fq;
        float c1 = -1.4426950408889634f / F8_S13, S2 = (float)F8_S13 * (float)F8_S13; asm volatile("" : "+v"(c1), "+v"(S2));
#pragma unroll
        for (int ai = 0; ai < 2; ++ai)
#pragma unroll
            for (int m = 0; m < 4; ++m) { GAS unsigned char* rowp = ACT + (size_t)(row0 + ai * 128 + m * 16) * DFF + col0;
                f32x4 o[2];
#pragma unroll
                for (int n = 0; n < 2; ++n) { const f32x4 g = acc[ai][0][m][n], uu = acc[ai][1][m][n]; f32x4 t = g * c1;
                    t.x = __builtin_amdgcn_exp2f(t.x); t.y = __builtin_amdgcn_exp2f(t.y); t.z = __builtin_amdgcn_exp2f(t.z); t.w = __builtin_amdgcn_exp2f(t.w);
                    t = t * S2 + S2;
                    t.x = __builtin_amdgcn_rcpf(t.x); t.y = __builtin_amdgcn_rcpf(t.y); t.z = __builtin_amdgcn_rcpf(t.z); t.w = __builtin_amdgcn_rcpf(t.w);
                    o[n] = (g * uu) * t; }
                v2u w; w.x = pk4_f8(o[0][0], o[0][1], o[0][2], o[0][3]); w.y = pk4_f8(o[1][0], o[1][1], o[1][2], o[1][3]);
                *(GAS v2u*)rowp = w; }
    }
};
struct EpiScatter {
    static constexpr bool PERM = true, AFTER_DRAIN = false, IDEMPOTENT = true;
    gcv2i pair; gb Y0; gb Y1; gci toke; gcf tokw; float sc;
    DI void operator()(const f32x4 (&acc)[2][2][4][2], const pg8::Unit& u, int wr, int wc, int fr, int fq) const {
        const int row0 = u.pm * 256 + wr * 64 + fr, col0 = u.pc * 256 + wc * 32 + 8 * fq;
        int px[8]; float w[8];
#pragma unroll
        for (int p = 0; p < 8; ++p) px[p] = pair[row0 + (p >> 2) * 128 + (p & 3) * 16].x;
#pragma unroll
        for (int p = 0; p < 8; ++p) w[p] = tokw[px[p] >= 0 ? 2 * (px[p] & 0x3fffffff) + (px[p] >> 30) : 0] * sc;
#pragma unroll
        for (int p = 0; p < 8; ++p) { const int ai = p >> 2, m = p & 3;
            if (px[p] >= 0) { const int tok = px[p] & 0x3fffffff;
                gb rowp = ((px[p] >> 30) ? Y1 : Y0) + (size_t)tok * D + col0;
#pragma unroll
                for (int bj = 0; bj < 2; ++bj) { const f32x4 v0 = acc[ai][bj][m][0] * w[p], v1 = acc[ai][bj][m][1] * w[p];
                    v4u o; o.x = pk2(v0[0], v0[1]); o.y = pk2(v0[2], v0[3]); o.z = pk2(v1[0], v1[1]); o.w = pk2(v1[2], v1[3]);
                    *(GAS v4u*)(rowp + bj * 128) = o; } } }
    }
};


DI void p0_prologue(gcf c, gcf w_mod, gcf b_mod, gcf gamma, gcf pool_w, gcf lwa, gcf lwx, gcf sgu_ws,
                    gws ws, LAS unsigned char* lds, int wg, int G, int tid, int wave, int lane) {
    LAS float* CS = (LAS float*)lds; LAS float* RED = (LAS float*)(lds + 32768);
    gf MOD = (GAS float*)(ws + WS_MOD);
    if (wg < 96) {
        for (int idx = tid; idx < 8192; idx += NTHR) { const int k = idx >> 3, b = idx & 7; const float v = c[b * D + k]; CS[idx] = siluf(v); }
        __syncthreads();
        for (int item = wg; item < 96; item += G) {
            const int l = item / 24, jb = item % 24, col = jb * 256 + lane * 4;
            f32x4 acc[8];
#pragma unroll
            for (int b = 0; b < 8; ++b) acc[b] = (f32x4){0.f, 0.f, 0.f, 0.f};
            gcf wp = w_mod + ((size_t)(l * D + wave * 128)) * MODW + col;
#pragma unroll 32
            for (int kk = 0; kk < 128; ++kk) {
                const f32x4 w = ld4(wp + (size_t)kk * MODW);
                const f32x4 c0 = *(const LAS f32x4*)(CS + (wave * 128 + kk) * 8), c1 = *(const LAS f32x4*)(CS + (wave * 128 + kk) * 8 + 4);
                acc[0] += c0.x * w; acc[1] += c0.y * w; acc[2] += c0.z * w; acc[3] += c0.w * w; acc[4] += c1.x * w; acc[5] += c1.y * w; acc[6] += c1.z * w; acc[7] += c1.w * w;
            }
#pragma unroll
            for (int b = 0; b < 8; ++b) *(LAS f32x4*)(RED + (wave * 8 + b) * 256 + lane * 4) = acc[b];
            __syncthreads();
            for (int o = tid; o < 2048; o += NTHR) { const int b = o >> 8, cc = o & 255; float s = 0.f;
#pragma unroll
                for (int w = 0; w < 8; ++w) s += RED[(w * 8 + b) * 256 + cc];
                MOD[(size_t)(l * 8 + b) * MODW + jb * 256 + cc] = s + b_mod[l * MODW + jb * 256 + cc]; }
            __syncthreads();
        }
    }
    if (wg == G - 1 && tid < GWD) {
        gf LB = (GAS float*)(ws + WS_LB);
        const float g0 = gamma[tid], g1 = gamma[GWD + tid], g2 = gamma[2 * GWD + tid], g3 = gamma[3 * GWD + tid];
        const float mx = fmaxf(fmaxf(g0, g1), fmaxf(g2, g3));
        const float e0 = expf(g0 - mx), e1 = expf(g1 - mx), e2 = expf(g2 - mx), e3 = expf(g3 - mx), inv = 1.f / (e0 + e1 + e2 + e3);
        LB[tid] = 0.f; LB[GWD + tid] = e1 * inv; LB[2 * GWD + tid] = (e1 + e2) * inv; LB[3 * GWD + tid] = (e1 + e2 + e3) * inv;
    }
    gb POOLWT = (GAS bf16*)(ws + WS_POOLWT); gb LRUWAT = (GAS bf16*)(ws + WS_LRUWAT); gb LRUWXT = (GAS bf16*)(ws + WS_LRUWXT); gb SGUW = (GAS bf16*)(ws + WS_SGUW);
    const int gt = wg * NTHR + tid, NT = G * NTHR;
    for (int idx = gt; idx < 65536; idx += NT) { const int lg = idx >> 12, j = (idx >> 6) & 63, i = idx & 63, src = (lg * 64 + i) * 64 + j;
        POOLWT[idx] = f2bf(pool_w[src]); LRUWAT[idx] = f2bf(lwa[src]); LRUWXT[idx] = f2bf(lwx[src]); }
    for (int idx = gt; idx < 262144; idx += NT) { const int t = (idx >> 7) & 127, s = idx & 127; SGUW[idx] = (s <= t) ? f2bf(sgu_ws[idx]) : (bf16)0; }
}

struct CvItem { gcf W; gb WT; int K, N, mode, idx; float f8s; };
DI void cv_load(const CvItem& I, int lane, f32x4 (&v)[8]) {
    const int nblk = I.N / 32, kb = I.idx / nblk, nb = I.idx % nblk;
    gcf p = I.W + (size_t)(64 * kb + (lane >> 3)) * I.N + 32 * nb + 4 * (lane & 7);
#pragma unroll
    for (int i = 0; i < 8; ++i) v[i] = ld4(p + (size_t)(8 * i) * I.N);
}
DI void cv_store(const CvItem& I, LAS float* scr, int lane, const f32x4 (&v)[8]) {
    const int nblk = I.N / 32, kb = I.idx / nblk, nb = I.idx % nblk, k0 = 64 * kb, n0 = 32 * nb;
#pragma unroll
    for (int i = 0; i < 8; ++i) { LAS float* d = scr + (8 * i + (lane >> 3)) * 33 + 4 * (lane & 7); d[0] = v[i].x; d[1] = v[i].y; d[2] = v[i].z; d[3] = v[i].w; }
    LDS_WAIT();
    const int c = lane & 7;
    const int drow0 = (I.mode == 0) ? n0 : ((n0 >> 7) * 256 + (n0 & 127) + (I.mode == 2 ? 128 : 0));
    if (I.f8s > 0.f) { const float sc = I.f8s; GAS unsigned char* W8 = (GAS unsigned char*)I.WT;
#pragma unroll
        for (int j = 0; j < 4; ++j) { const int n = (lane >> 3) + 8 * j; const LAS float* s = scr + (8 * c) * 33 + n;
            v2u o; o.x = pk4_f8(s[0 * 33] * sc, s[1 * 33] * sc, s[2 * 33] * sc, s[3 * 33] * sc); o.y = pk4_f8(s[4 * 33] * sc, s[5 * 33] * sc, s[6 * 33] * sc, s[7 * 33] * sc);
            *(GAS v2u*)(W8 + (size_t)(drow0 + n) * I.K + k0 + 8 * c) = o; }
    } else {
#pragma unroll
    for (int j = 0; j < 4; ++j) { const int n = (lane >> 3) + 8 * j; const LAS float* s = scr + (8 * c) * 33 + n;
        v4u o; o.x = pk2(s[0 * 33], s[1 * 33]); o.y = pk2(s[2 * 33], s[3 * 33]); o.z = pk2(s[4 * 33], s[5 * 33]); o.w = pk2(s[6 * 33], s[7 * 33]);
        *(GAS v4u*)(I.WT + (size_t)(drow0 + n) * I.K + k0 + 8 * c) = o; }
    }
    LDS_WAIT();
}
DI void convert_weights(int l, gcf w_in, gcf w_out, gcf f1, gcf f3, gcf f2, gcf m1, gcf m3, gcf m2,
                        gws ws, LAS unsigned char* lds, int wg, int G, int wave, int lane) {
    LAS float* scr = (LAS float*)(lds + wave * 16384);
    gb WIN = (GAS bf16*)(ws + WS_WIN); gb WOUT = (GAS bf16*)(ws + WS_WOUT); gb W13 = (GAS bf16*)(ws + WS_W13); gb W2 = (GAS bf16*)(ws + WS_W2);
    constexpr int n_in = 16 * 72, n_out = 16 * 32, n13 = 16 * 112, n2 = 56 * 32, per_e = 2 * n13 + n2;
    const int moe = l & 1, E = moe ? NE : 1, total = n_in + n_out + E * per_e, stride = G * NWAVES, f8 = IS_F8(l) ? 1 : 0;
#define CV_DECODE(it_, I_) do { int r = (it_); \
        if (r < n_in) { I_ = CvItem{w_in + (size_t)l * D * INW, WIN, D, INW, 0, r, IS_B8(l) ? F8_S13 : 0.f}; } \
        else if (r < n_in + n_out) { I_ = CvItem{w_out + (size_t)l * D * D, WOUT, D, D, 0, r - n_in, 0.f}; } \
        else { r -= n_in + n_out; const int e = r / per_e; r -= e * per_e; \
            const size_t mo = (size_t)((l >> 1) * (moe ? NE : 1) + e) * D * DFF; \
            const size_t o13 = ((size_t)e * 2 * DFF * D) >> f8, o2 = ((size_t)e * D * DFF) >> f8;     \
            if (r < n13) I_ = CvItem{(moe ? m1 : f1) + mo, W13 + o13, D, DFF, 1, r, f8 ? F8_S13 : 0.f}; \
            else if (r < 2 * n13) I_ = CvItem{(moe ? m3 : f3) + mo, W13 + o13, D, DFF, 2, r - n13, f8 ? F8_S13 : 0.f}; \
            else I_ = CvItem{(moe ? m2 : f2) + mo, W2 + o2, DFF, D, 0, r - 2 * n13, f8 ? F8_S2 : 0.f}; } } while (0)
    int it = wg * NWAVES + wave;
    if (it >= total) return;
    CvItem Ia, Ib; f32x4 va[8], vb[8];
    CV_DECODE(it, Ia); cv_load(Ia, lane, va);
    for (;;) {
        const bool hb = it + stride < total;
        if (hb) { CV_DECODE(it + stride, Ib); cv_load(Ib, lane, vb); }
        cv_store(Ia, scr, lane, va);
        if (!hb) break;
        it += stride;
        const bool ha = it + stride < total;
        if (ha) { CV_DECODE(it + stride, Ia); cv_load(Ia, lane, va); }
        cv_store(Ib, scr, lane, vb);
        if (!ha) break;
        it += stride;
    }
#undef CV_DECODE
}

template <bool COMBINE, bool ROUTER, bool FINAL, bool XF32, bool OUT8 = false>
DI void norm_phase(gcf xf, gb xb, gf outf, gcf gain, gcf shift, gcf scale, gcf gprev, gcb Y0, gcb Y1, gb XN,
                   gcf rw, gcf rb, gi toke, gf tokw, gi histw, gv2i pair, LAS unsigned char* lds, int wg, int G, int tid, int wave, int lane) {
    LAS float* RW = (LAS float*)lds;
    if (ROUTER) {
        for (int i = tid; i < 8192; i += NTHR) RW[i] = rw[i];
        { int m1 = -1, z0 = 0; asm volatile("" : "+v"(m1), "+v"(z0));
        for (int i = wg * NTHR + tid; i < MAXPAIR; i += G * NTHR) pair[i] = (v2i){m1, z0}; }
        __syncthreads();
    }
    for (int blk = wg; blk < M / 256; blk += G) {
        const int b = blk >> 5;
#define NCOL(j) (8 * lane + 512 * ((j) >> 1) + 4 * ((j) & 1))
        f32x4 gm[4], sh[4], gp[4];
#pragma unroll
        for (int j = 0; j < 4; ++j) { const int col = NCOL(j);
            if (FINAL) { gm[j] = ld4(gain + col); sh[j] = (f32x4){0.f, 0.f, 0.f, 0.f}; }
            else { gm[j] = ld4(gain + col) * (ld4(scale + (size_t)b * MODW + col) + 1.0f); sh[j] = ld4(shift + (size_t)b * MODW + col); }
            if (COMBINE) gp[j] = ld4(gprev + (size_t)b * MODW + col); else gp[j] = (f32x4){0.f, 0.f, 0.f, 0.f}; }
        int cnt[8];
#pragma unroll
        for (int e = 0; e < 8; ++e) cnt[e] = 0;
        constexpr int RG = (COMBINE || ROUTER) ? 1 : 2;
        v4u xr[2][XF32 ? 1 : RG][2]; f32x4 xfr[2][XF32 ? RG : 1][4]; v4u ya[2][COMBINE ? RG : 1][2], yb[2][COMBINE ? RG : 1][2];
#define NL_LOAD(B, R0) \
        _Pragma("unroll") for (int q = 0; q < RG; ++q) \
        _Pragma("unroll") for (int s = 0; s < 2; ++s) { const size_t off = (size_t)(blk * 256 + wave * 32 + (R0) + q) * D + 8 * lane + 512 * s; \
            if (XF32) { xfr[B][q][2 * s] = ld4(xf + off); xfr[B][q][2 * s + 1] = ld4(xf + off + 4); } else xr[B][q][s] = *(GAS const v4u*)(xb + off); \
            if (COMBINE) { ya[B][q][s] = *(GAS const v4u*)(Y0 + off); yb[B][q][s] = *(GAS const v4u*)(Y1 + off); } }
        NL_LOAD(0, 0)
#pragma unroll 1
        for (int r00 = 0; r00 < 32; r00 += 2 * RG) {
#pragma unroll
          for (int hb = 0; hb < 2; ++hb) {
            const int r0 = r00 + hb * RG;
            if (hb == 0) { NL_LOAD(1, r0 + RG) } else if (r0 + RG < 32) { NL_LOAD(0, r0 + RG) }
#pragma unroll
            for (int q = 0; q < RG; ++q) {
            const int row = blk * 256 + wave * 32 + r0 + q;
            f32x4 v[4]; float ss = 0.f;
#pragma unroll
            for (int s = 0; s < 2; ++s) { const size_t off = (size_t)row * D + 8 * lane + 512 * s;
                if (XF32) { v[2 * s] = xfr[hb][q][2 * s]; v[2 * s + 1] = xfr[hb][q][2 * s + 1]; }
                else { float t8[8]; unpack8(xr[hb][q][s], t8); v[2 * s] = (f32x4){t8[0], t8[1], t8[2], t8[3]}; v[2 * s + 1] = (f32x4){t8[4], t8[5], t8[6], t8[7]}; }
                if (COMBINE) { float a8[8], b8[8]; unpack8(ya[hb][q][s], a8); unpack8(yb[hb][q][s], b8);
                    v[2 * s] += gp[2 * s] * ((f32x4){a8[0], a8[1], a8[2], a8[3]} + (f32x4){b8[0], b8[1], b8[2], b8[3]}); v[2 * s + 1] += gp[2 * s + 1] * ((f32x4){a8[4], a8[5], a8[6], a8[7]} + (f32x4){b8[4], b8[5], b8[6], b8[7]}); }
                if ((COMBINE && !FINAL) || XF32) { v4u o; o.x = pk2(v[2 * s].x, v[2 * s].y); o.y = pk2(v[2 * s].z, v[2 * s].w); o.z = pk2(v[2 * s + 1].x, v[2 * s + 1].y); o.w = pk2(v[2 * s + 1].z, v[2 * s + 1].w); *(GAS v4u*)(xb + off) = o; }
                ss += (v[2 * s].x * v[2 * s].x + v[2 * s].y * v[2 * s].y) + (v[2 * s].z * v[2 * s].z + v[2 * s].w * v[2 * s].w) + (v[2 * s + 1].x * v[2 * s + 1].x + v[2 * s + 1].y * v[2 * s + 1].y) + (v[2 * s + 1].z * v[2 * s + 1].z + v[2 * s + 1].w * v[2 * s + 1].w); }
            const float rstd = rsqrtf(wave_sum_dpp(ss) * (1.f / D) + EPS);
            f32x4 h[4];
#pragma unroll
            for (int j = 0; j < 4; ++j) h[j] = v[j] * rstd * gm[j] + sh[j];
#pragma unroll
            for (int s = 0; s < 2; ++s) { const size_t off = (size_t)row * D + 8 * lane + 512 * s;
                if (FINAL) { *(GAS f32x4*)(outf + off) = h[2 * s]; *(GAS f32x4*)(outf + off + 4) = h[2 * s + 1]; }
                else if (OUT8) { v2u o; o.x = pk4_f8(h[2 * s].x, h[2 * s].y, h[2 * s].z, h[2 * s].w); o.y = pk4_f8(h[2 * s + 1].x, h[2 * s + 1].y, h[2 * s + 1].z, h[2 * s + 1].w); *(GAS v2u*)((GAS unsigned char*)XN + off) = o; }
                else { v4u o; o.x = pk2(h[2 * s].x, h[2 * s].y); o.y = pk2(h[2 * s].z, h[2 * s].w); o.z = pk2(h[2 * s + 1].x, h[2 * s + 1].y); o.w = pk2(h[2 * s + 1].z, h[2 * s + 1].w); *(GAS v4u*)(XN + off) = o; } }
            if (ROUTER) {
                float lg[8];
#pragma unroll
                for (int e = 0; e < 8; ++e) lg[e] = 0.f;
#pragma unroll
                for (int j = 0; j < 4; ++j)
#pragma unroll
                    for (int i = 0; i < 4; ++i) { const int cc = NCOL(j) + i; const f32x4 w0 = *(const LAS f32x4*)(RW + cc * 8), w1 = *(const LAS f32x4*)(RW + cc * 8 + 4); const float hv = h[j][i];
                        lg[0] += hv * w0.x; lg[1] += hv * w0.y; lg[2] += hv * w0.z; lg[3] += hv * w0.w; lg[4] += hv * w1.x; lg[5] += hv * w1.y; lg[6] += hv * w1.z; lg[7] += hv * w1.w; }
#pragma unroll
                for (int e = 0; e < 8; ++e) lg[e] = wave_sum_dpp(lg[e]) + rb[e];
                int i0 = 0; float v0 = lg[0];
#pragma unroll
                for (int e = 1; e < 8; ++e) if (lg[e] > v0) { v0 = lg[e]; i0 = e; }
                int i1 = -1; float v1 = -3.0e38f;
#pragma unroll
                for (int e = 0; e < 8; ++e) if (e != i0 && lg[e] > v1) { v1 = lg[e]; i1 = e; }
                const float w0 = 1.f / (1.f + expf(v1 - v0)), w1 = 1.f - w0;
                if (lane == 0) { toke[row] = i0 | (i1 << 8); tokw[2 * row] = w0; tokw[2 * row + 1] = w1; }
#pragma unroll
                for (int e = 0; e < 8; ++e) cnt[e] += (i0 == e) + (i1 == e);
            }
            }
          }
        }
#undef NL_LOAD
        if (ROUTER && lane == 0) {
#pragma unroll
            for (int e = 0; e < 8; ++e) histw[(blk * 8 + wave) * 8 + e] = cnt[e]; }
    }
#undef NCOL
}

DI void route_phase(gcb XN, gb XG, gci toke, gcf tokw, gci histw, gv2i pair, gi tilee, gi ntp,
                    LAS unsigned char* lds, int wg, int G, int tid, int wave, int lane, int f8) {
    LAS int* L = (LAS int*)lds;
    for (int blk = wg; blk < M / 256; blk += G) {
        int tot[8], pre[8];
#pragma unroll
        for (int e = 0; e < 8; ++e) { tot[e] = 0; pre[e] = 0; }
        for (int q = tid; q < 2048; q += NTHR) { const v4i h0 = *(GAS const v4i*)(histw + q * 8), h1 = *(GAS const v4i*)(histw + q * 8 + 4); const int m = (q < blk * 8) ? 1 : 0;
            tot[0] += h0.x; tot[1] += h0.y; tot[2] += h0.z; tot[3] += h0.w; tot[4] += h1.x; tot[5] += h1.y; tot[6] += h1.z; tot[7] += h1.w;
            pre[0] += m * h0.x; pre[1] += m * h0.y; pre[2] += m * h0.z; pre[3] += m * h0.w; pre[4] += m * h1.x; pre[5] += m * h1.y; pre[6] += m * h1.z; pre[7] += m * h1.w; }
#pragma unroll
        for (int e = 0; e < 8; ++e) { tot[e] = wave_sum_i(tot[e]); pre[e] = wave_sum_i(pre[e]); }
        if (lane == 0) {
#pragma unroll
            for (int e = 0; e < 8; ++e) { L[wave * 16 + e] = tot[e]; L[wave * 16 + 8 + e] = pre[e]; } }
        __syncthreads();
        int start[9]; start[0] = 0;
#pragma unroll
        for (int e = 0; e < 8; ++e) { int t = 0, p = 0;
#pragma unroll
            for (int w = 0; w < 8; ++w) { t += L[w * 16 + e]; p += L[w * 16 + 8 + e]; }
            tot[e] = t; pre[e] = p; start[e + 1] = start[e] + ((t + 255) & ~255); }
        int e0 = -1, e1 = -1; const int tok = blk * 256 + tid;
        if (tid < 256) { const int te = toke[tok]; e0 = te & 255; e1 = te >> 8; }
        const unsigned long long lt = (1ull << lane) - 1ull;
        int r0 = 0, r1 = 0;
#pragma unroll
        for (int e = 0; e < 8; ++e) { const unsigned long long m0 = __ballot(e0 == e), m1 = __ballot(e1 == e);
            const int rr = __popcll(m0 & lt) + __popcll(m1 & lt);
            if (e0 == e) r0 = rr; if (e1 == e) r1 = rr;
            if (lane == 0) L[128 + wave * 8 + e] = __popcll(m0) + __popcll(m1);
            if (tid == 0) L[192 + e] = start[e] + pre[e]; }
        __syncthreads();
        if (tid < 256) {
            int p0 = L[192 + e0] + r0, p1 = L[192 + e1] + r1;
            for (int w = 0; w < wave; ++w) { p0 += L[128 + w * 8 + e0]; p1 += L[128 + w * 8 + e1]; }
            const f32x2 wv = *(GAS const f32x2*)(tokw + 2 * tok);
            pair[p0] = (v2i){tok, __builtin_bit_cast(int, wv.x)}; pair[p1] = (v2i){tok | (1 << 30), __builtin_bit_cast(int, wv.y)};
            L[256 + 2 * tid] = p0; L[256 + 2 * tid + 1] = p1;
        }
        __syncthreads();
        if (f8 && MOE_XN8) {
            const GAS unsigned char* S8 = (const GAS unsigned char*)XN; GAS unsigned char* X8 = (GAS unsigned char*)XG;
            for (int i0 = 0; i0 < 32; i0 += 8) {
                v4u ra[8]; int pp0[8], pp1[8];
#pragma unroll
                for (int q = 0; q < 8; ++q) { const int tl = wave * 32 + i0 + q; pp0[q] = L[256 + 2 * tl]; pp1[q] = L[256 + 2 * tl + 1]; ra[q] = *(GAS const v4u*)(S8 + (size_t)(blk * 256 + tl) * D + lane * 16); }
#pragma unroll
                for (int q = 0; q < 8; ++q) { *(GAS v4u*)(X8 + (size_t)pp0[q] * D + lane * 16) = ra[q]; *(GAS v4u*)(X8 + (size_t)pp1[q] * D + lane * 16) = ra[q]; } }
        } else
        for (int i0 = 0; i0 < 32; i0 += 4) {
            v4u ra[4], rb2[4]; int pp0[4], pp1[4];
#pragma unroll
            for (int q = 0; q < 4; ++q) { const int tl = wave * 32 + i0 + q; pp0[q] = L[256 + 2 * tl]; pp1[q] = L[256 + 2 * tl + 1];
                gcb srcp = XN + (size_t)(blk * 256 + tl) * D + lane * 16; ra[q] = *(GAS const v4u*)srcp; rb2[q] = *(GAS const v4u*)(srcp + 8); }
            if (f8) { GAS unsigned char* X8 = (GAS unsigned char*)XG;
#pragma unroll
                for (int q = 0; q < 4; ++q) { float xa[8], xb2[8]; unpack8(ra[q], xa); unpack8(rb2[q], xb2);
                    v4u o; o.x = pk4_f8(xa[0], xa[1], xa[2], xa[3]); o.y = pk4_f8(xa[4], xa[5], xa[6], xa[7]); o.z = pk4_f8(xb2[0], xb2[1], xb2[2], xb2[3]); o.w = pk4_f8(xb2[4], xb2[5], xb2[6], xb2[7]);
                    *(GAS v4u*)(X8 + (size_t)pp0[q] * D + lane * 16) = o; *(GAS v4u*)(X8 + (size_t)pp1[q] * D + lane * 16) = o; }
            } else {
#pragma unroll
            for (int q = 0; q < 4; ++q) { gb d0 = XG + (size_t)pp0[q] * D + lane * 16; gb d1 = XG + (size_t)pp1[q] * D + lane * 16;
                *(GAS v4u*)d0 = ra[q]; *(GAS v4u*)(d0 + 8) = rb2[q]; *(GAS v4u*)d1 = ra[q]; *(GAS v4u*)(d1 + 8) = rb2[q]; } } }
        if (blk == 0) { const int ntt = start[8] >> 8;
            for (int t = tid; t < ntt; t += NTHR) { int e = 0;
#pragma unroll
                for (int q = 1; q < 8; ++q) e += (t >= (start[q] >> 8)) ? 1 : 0;
                tilee[t] = e; }
            if (tid == 0) ntp[0] = ntt; }
        __syncthreads();
    }
}

DI void pool_unit(gcb PROJ, gb CAT, gcb WT, gcf pscale, gcf pnorm, LAS unsigned char* lds, int b, int t0, int tid, int wave, int lane) {
    asm volatile("" : "+v"(tid)); lane = tid & 63;
    LAS bf16* XT = (LAS bf16*)lds;
    LAS bf16* DT = (LAS bf16*)(lds + 80 * 264 * 2);
    LAS float* SSP = (LAS float*)(lds + (80 + 64) * 264 * 2);
    const int fr = lane & 15, fq = lane >> 4, tbh = wave & 3, gp = wave >> 2;
    bf16x8 Wf[2][2][4];
#pragma unroll
    for (int gl = 0; gl < 2; ++gl)
#pragma unroll
        for (int kk = 0; kk < 2; ++kk)
#pragma unroll
            for (int nb = 0; nb < 4; ++nb) Wf[gl][kk][nb] = *(GAS const bf16x8*)(WT + (((2 * gp + gl) * 64 + nb * 16 + fr) * 64 + kk * 32 + 8 * fq));
    for (int half = 0; half < 2; ++half) {
        const int t0h = t0 + 64 * half;
        __syncthreads();
        { v4u xr[5];
#pragma unroll
            for (int i = 0; i < 5; ++i) { const int cidx = tid + NTHR * i, row = cidx >> 5, cg = cidx & 31, tt = t0h - 16 + row, ttc = tt < 0 ? 0 : tt;
                xr[i] = *(GAS const v4u*)(PROJ + ((size_t)b * SEQ + ttc) * INW + cg * 8); }
#pragma unroll
            for (int i = 0; i < 5; ++i) { const int cidx = tid + NTHR * i, row = cidx >> 5, cg = cidx & 31, tt = t0h - 16 + row;
                *(LAS v4u*)(XT + row * 264 + cg * 8) = (tt < 0) ? (v4u){0u, 0u, 0u, 0u} : xr[i]; } }
        __syncthreads();
        { const int cg = tid & 31, run = tid >> 5, ch0 = cg * 8, win = 2 << (cg >> 3), tl0 = run * 4;
            float s[8];
#pragma unroll
            for (int k = 0; k < 8; ++k) s[k] = 0.f;
            for (int r = 1; r <= win; ++r) { float xv[8]; unpack8(*(const LAS v4u*)(XT + (tl0 + 16 - r) * 264 + ch0), xv);
#pragma unroll
                for (int k = 0; k < 8; ++k) s[k] += xv[k]; }
#pragma unroll
            for (int i = 0; i < 4; ++i) { float xv[8], yv[8]; unpack8(*(const LAS v4u*)(XT + (tl0 + i + 16) * 264 + ch0), xv); unpack8(*(const LAS v4u*)(XT + (tl0 + i + 16 - win) * 264 + ch0), yv);
                const int tt = t0h + tl0 + i; const float inv = 1.f / (float)((tt + 1 < win) ? tt + 1 : win);
#pragma unroll
                for (int k = 0; k < 8; ++k) s[k] += xv[k] - yv[k];
                v4u o; o.x = pk2(s[0] * inv - xv[0], s[1] * inv - xv[1]); o.y = pk2(s[2] * inv - xv[2], s[3] * inv - xv[3]); o.z = pk2(s[4] * inv - xv[4], s[5] * inv - xv[5]); o.w = pk2(s[6] * inv - xv[6], s[7] * inv - xv[7]);
                *(LAS v4u*)(DT + (tl0 + i) * 264 + ch0) = o; } }
        __syncthreads();
        f32x4 acc[2][4];
#pragma unroll
        for (int gl = 0; gl < 2; ++gl)
#pragma unroll
            for (int nb = 0; nb < 4; ++nb) acc[gl][nb] = (f32x4){0.f, 0.f, 0.f, 0.f};
#pragma unroll
        for (int gl = 0; gl < 2; ++gl)
#pragma unroll
            for (int kk = 0; kk < 2; ++kk) { const bf16x8 X = *(const LAS bf16x8*)(DT + (16 * tbh + fr) * 264 + (2 * gp + gl) * 64 + kk * 32 + 8 * fq);
#pragma unroll
                for (int nb = 0; nb < 4; ++nb) acc[gl][nb] = mfma16(Wf[gl][kk][nb], X, acc[gl][nb]); }
        float ss = 0.f;
#pragma unroll
        for (int gl = 0; gl < 2; ++gl)
#pragma unroll
            for (int nb = 0; nb < 4; ++nb) { const f32x4 y = acc[gl][nb] * ld4(pscale + (2 * gp + gl) * 64 + nb * 16 + 4 * fq); acc[gl][nb] = y; ss += (y.x * y.x + y.y * y.y) + (y.z * y.z + y.w * y.w); }
        ss += __shfl_xor(ss, 16); ss += __shfl_xor(ss, 32);
        if (fq == 0) SSP[gp * 64 + 16 * tbh + fr] = ss;
        __syncthreads();
        const float rstd = rsqrtf((SSP[16 * tbh + fr] + SSP[64 + 16 * tbh + fr]) * (1.f / GWD) + EPS);
        const size_t row = (size_t)b * SEQ + t0h + 16 * tbh + fr;
#pragma unroll
        for (int gl = 0; gl < 2; ++gl)
#pragma unroll
            for (int nb = 0; nb < 4; ++nb) { const int ch = (2 * gp + gl) * 64 + nb * 16 + 4 * fq; *(GAS v2u*)(CAT + row * D + ch) = pack4(acc[gl][nb] * rstd * ld4(pnorm + ch)); }
    }
}

DI void sgu_unit(gcb PROJ, gb CAT, gcb SW, gcf sbias, gcf snorm, LAS unsigned char* lds, int b, int t0, int tid, int wave, int lane) {
    asm volatile("" : "+v"(tid)); lane = tid & 63;
    __syncthreads();
    LAS bf16* VT = (LAS bf16*)lds;
    const int fr = lane & 15, fq = lane >> 4, tb = wave, nk = (tb >> 1) + 1;
    { v2u vr[16];
#pragma unroll
        for (int i = 0; i < 16; ++i) vr[i] = *(GAS const v2u*)(PROJ + ((size_t)b * SEQ + t0 + 16 * wave + i) * INW + 512 + 4 * lane);
#pragma unroll
        for (int i = 0; i < 8; ++i) { const int tl = 16 * wave + 2 * i;
            f32x4 va = unpack4(vr[2 * i]), vb = unpack4(vr[2 * i + 1]);
            va.x = gelu_t(va.x); va.y = gelu_t(va.y); va.z = gelu_t(va.z); va.w = gelu_t(va.w); vb.x = gelu_t(vb.x); vb.y = gelu_t(vb.y); vb.z = gelu_t(vb.z); vb.w = gelu_t(vb.w);
            const float mua = wave_sum_dpp((va.x + va.y) + (va.z + va.w)) * (1.f / GWD), mub = wave_sum_dpp((vb.x + vb.y) + (vb.z + vb.w)) * (1.f / GWD);
            va = va - mua; vb = vb - mub;
            const float vra = wave_sum_dpp((va.x * va.x + va.y * va.y) + (va.z * va.z + va.w * va.w)) * (1.f / GWD), vrb = wave_sum_dpp((vb.x * vb.x + vb.y * vb.y) + (vb.z * vb.z + vb.w * vb.w)) * (1.f / GWD);
            va = va * rsqrtf(vra + EPS); vb = vb * rsqrtf(vrb + EPS);
            *(LAS unsigned*)(VT + (4 * lane + 0) * 136 + tl) = pk2(va.x, vb.x); *(LAS unsigned*)(VT + (4 * lane + 1) * 136 + tl) = pk2(va.y, vb.y);
            *(LAS unsigned*)(VT + (4 * lane + 2) * 136 + tl) = pk2(va.z, vb.z); *(LAS unsigned*)(VT + (4 * lane + 3) * 136 + tl) = pk2(va.w, vb.w); } }
    const int tl = 16 * tb + fr; const size_t row = (size_t)b * SEQ + t0 + tl;
    v2u ur[4][4]; float bias4[4];
#pragma unroll
    for (int h = 0; h < 4; ++h) { bias4[h] = sbias[h * 128 + tl];
#pragma unroll
        for (int db = 0; db < 4; ++db) ur[h][db] = *(GAS const v2u*)(PROJ + row * INW + 256 + h * 64 + db * 16 + 4 * fq); }
    __syncthreads();
    f32x4 acc[4][4];
#pragma unroll
    for (int h = 0; h < 4; ++h)
#pragma unroll
        for (int db = 0; db < 4; ++db) acc[h][db] = (f32x4){0.f, 0.f, 0.f, 0.f};
    for (int kk = 0; kk < nk; ++kk) {
        bf16x8 Q[4];
#pragma unroll
        for (int h = 0; h < 4; ++h) Q[h] = *(GAS const bf16x8*)(SW + ((h * 128 + 16 * tb + fr) * 128 + kk * 32 + 8 * fq));
#pragma unroll
        for (int h = 0; h < 4; ++h)
#pragma unroll
            for (int db = 0; db < 4; ++db) { const bf16x8 P = *(const LAS bf16x8*)(VT + (h * 64 + db * 16 + fr) * 136 + kk * 32 + 8 * fq); acc[h][db] = mfma16(P, Q[h], acc[h][db]); } }
    float ss = 0.f;
#pragma unroll
    for (int h = 0; h < 4; ++h)
#pragma unroll
        for (int db = 0; db < 4; ++db) { f32x4 u = unpack4(ur[h][db]);
            u.x = gelu_t(u.x); u.y = gelu_t(u.y); u.z = gelu_t(u.z); u.w = gelu_t(u.w);
            const f32x4 y = u * (acc[h][db] + bias4[h]); acc[h][db] = y; ss += (y.x * y.x + y.y * y.y) + (y.z * y.z + y.w * y.w); }
    ss += __shfl_xor(ss, 16); ss += __shfl_xor(ss, 32);
    const float rstd = rsqrtf(ss * (1.f / GWD) + EPS);
#pragma unroll
    for (int h = 0; h < 4; ++h)
#pragma unroll
        for (int db = 0; db < 4; ++db) { const int ch = h * 64 + db * 16 + 4 * fq; *(GAS v2u*)(CAT + row * D + 256 + ch) = pack4(acc[h][db] * rstd * ld4(snorm + ch)); }
}

template <int D_> DI float row_shr(float ident, float src) {
    return __builtin_bit_cast(float, __builtin_amdgcn_update_dpp(__builtin_bit_cast(int, ident), __builtin_bit_cast(int, src), 0x110 + D_, 0xf, 0xf, false));
}
#define LRU_STEP_(D) \
    "v_fmac_f32_dpp %0, %0, %8 row_shr:" #D " row_mask:0xf bank_mask:0xf\n\tv_fmac_f32_dpp %1, %1, %9 row_shr:" #D " row_mask:0xf bank_mask:0xf\n\t" \
    "v_fmac_f32_dpp %2, %2, %10 row_shr:" #D " row_mask:0xf bank_mask:0xf\n\tv_fmac_f32_dpp %3, %3, %11 row_shr:" #D " row_mask:0xf bank_mask:0xf\n\t" \
    "v_fmac_f32_dpp %4, %4, %12 row_shr:" #D " row_mask:0xf bank_mask:0xf\n\tv_fmac_f32_dpp %5, %5, %13 row_shr:" #D " row_mask:0xf bank_mask:0xf\n\t" \
    "v_fmac_f32_dpp %6, %6, %14 row_shr:" #D " row_mask:0xf bank_mask:0xf\n\tv_fmac_f32_dpp %7, %7, %15 row_shr:" #D " row_mask:0xf bank_mask:0xf\n\t" \
    "v_mul_f32_dpp %8, %8, %8 row_shr:" #D " row_mask:0xf bank_mask:0xf\n\tv_mul_f32_dpp %9, %9, %9 row_shr:" #D " row_mask:0xf bank_mask:0xf\n\t" \
    "v_mul_f32_dpp %10, %10, %10 row_shr:" #D " row_mask:0xf bank_mask:0xf\n\tv_mul_f32_dpp %11, %11, %11 row_shr:" #D " row_mask:0xf bank_mask:0xf\n\t" \
    "v_mul_f32_dpp %12, %12, %12 row_shr:" #D " row_mask:0xf bank_mask:0xf\n\tv_mul_f32_dpp %13, %13, %13 row_shr:" #D " row_mask:0xf bank_mask:0xf\n\t" \
    "v_mul_f32_dpp %14, %14, %14 row_shr:" #D " row_mask:0xf bank_mask:0xf\n\tv_mul_f32_dpp %15, %15, %15 row_shr:" #D " row_mask:0xf bank_mask:0xf\n\t"
#define LRU_SCAN8(bv, av) asm("s_nop 1\n\t" LRU_STEP_(1) LRU_STEP_(2) LRU_STEP_(4) LRU_STEP_(8) \
    : "+v"(bv[0][0]), "+v"(bv[0][1]), "+v"(bv[0][2]), "+v"(bv[0][3]), "+v"(bv[1][0]), "+v"(bv[1][1]), "+v"(bv[1][2]), "+v"(bv[1][3]), \
      "+v"(av[0][0]), "+v"(av[0][1]), "+v"(av[0][2]), "+v"(av[0][3]), "+v"(av[1][0]), "+v"(av[1][1]), "+v"(av[1][2]), "+v"(av[1][3]))
DI float row_bcast15(float v) { return __builtin_bit_cast(float, __builtin_amdgcn_update_dpp(0, __builtin_bit_cast(int, v), 0x15F, 0xf, 0xf, true)); }
DI void lru_local_unit(gcb PROJ, gcf convw, gcf convb, gcf lba, gcf lbx, gcf lam, gcb WAT, gcb WXT, gf AGG, GAS unsigned* LAB, LAS unsigned char* lds, int b, int chunk, int tid, int wave, int lane) {
    asm volatile("" : "+v"(tid)); lane = tid & 63;
    __syncthreads();
    LAS bf16* TILE = (LAS bf16*)lds;
    const int t0 = chunk * CH;
    {
        const int cg = tid & 31, ch0 = cg * 8;
        f32x4 cw[4][2], cb[2];
#pragma unroll
        for (int k = 0; k < 4; ++k) { cw[k][0] = ld4(convw + k * GWD + ch0); cw[k][1] = ld4(convw + k * GWD + ch0 + 4); }
        cb[0] = ld4(convb + ch0); cb[1] = ld4(convb + ch0 + 4);
#pragma unroll
        for (int hb2 = 0; hb2 < 2; ++hb2) {
            v4u xr[4][4];
#pragma unroll
            for (int i = 0; i < 4; ++i) { const int tl = (tid >> 5) + 16 * (hb2 * 4 + i);
#pragma unroll
                for (int k = 0; k < 4; ++k) { const int tt = t0 + tl - 3 + k, ttc = tt < 0 ? 0 : tt; xr[i][k] = *(GAS const v4u*)(PROJ + ((size_t)b * SEQ + ttc) * INW + 768 + ch0); } }
#pragma unroll
            for (int i = 0; i < 4; ++i) { const int tl = (tid >> 5) + 16 * (hb2 * 4 + i);
                f32x4 x0 = cb[0], x1 = cb[1];
#pragma unroll
                for (int k = 0; k < 4; ++k) { const float m = (t0 + tl - 3 + k >= 0) ? 1.f : 0.f; float xv[8]; unpack8(xr[i][k], xv);
                    x0 += cw[k][0] * ((f32x4){xv[0], xv[1], xv[2], xv[3]} * m); x1 += cw[k][1] * ((f32x4){xv[4], xv[5], xv[6], xv[7]} * m); }
                v4u o; o.x = pk2(x0.x, x0.y); o.y = pk2(x0.z, x0.w); o.z = pk2(x1.x, x1.y); o.w = pk2(x1.z, x1.w);
                *(LAS v4u*)(TILE + tl * 264 + ch0) = o; }
        }
    }
    const int hb = wave & 3, nh = wave >> 2, fr = lane & 15, fq = lane >> 4;
    bf16x8 WA[2][2], WX[2][2];
#pragma unroll
    for (int kk = 0; kk < 2; ++kk)
#pragma unroll
        for (int nbl = 0; nbl < 2; ++nbl) { const int o = (hb * 64 + (2 * nh + nbl) * 16 + fr) * 64 + kk * 32 + 8 * fq; WA[kk][nbl] = *(GAS const bf16x8*)(WAT + o); WX[kk][nbl] = *(GAS const bf16x8*)(WXT + o); }
    f32x4 ba4[2], bx4[2], ls4[2], hc[2], ac[2];
#pragma unroll
    for (int nbl = 0; nbl < 2; ++nbl) { const int ch = hb * 64 + (2 * nh + nbl) * 16 + 4 * fq; ba4[nbl] = ld4(lba + ch); bx4[nbl] = ld4(lbx + ch);
        const f32x4 lm = ld4(lam + ch);
#pragma unroll
        for (int j = 0; j < 4; ++j) ls4[nbl][j] = -8.0f * log1pf(expf(-lm[j]));
        hc[nbl] = (f32x4){0.f, 0.f, 0.f, 0.f}; ac[nbl] = (f32x4){0.f, 0.f, 0.f, 0.f}; }
    __syncthreads();
#pragma unroll 1
    for (int tb = 0; tb < 8; ++tb) {
        const int tl = 16 * tb + fr; const size_t row = (size_t)b * SEQ + t0 + tl;
        bf16x8 X[2];
#pragma unroll
        for (int kk = 0; kk < 2; ++kk) X[kk] = *(const LAS bf16x8*)(TILE + tl * 264 + hb * 64 + kk * 32 + 8 * fq);
        float av[2][4], bv[2][4];
#pragma unroll
        for (int nbl = 0; nbl < 2; ++nbl) {
            f32x4 ra = (f32x4){0.f, 0.f, 0.f, 0.f}, rx = (f32x4){0.f, 0.f, 0.f, 0.f};
#pragma unroll
            for (int kk = 0; kk < 2; ++kk) { ra = mfma16(WA[kk][nbl], X[kk], ra); rx = mfma16(WX[kk][nbl], X[kk], rx); }
            const int ch = hb * 64 + (2 * nh + nbl) * 16 + 4 * fq;
            const f32x4 xcv = unpack4(*(const LAS v2u*)(TILE + tl * 264 + ch));
            v4u lab;
#pragma unroll
            for (int j = 0; j < 4; ++j) {
                const float e1 = __expf(-(ra[j] + ba4[nbl][j])), e2 = __expf(-(rx[j] + bx4[nbl][j]));
                const float rp = __builtin_amdgcn_rcpf((1.f + e1) * (1.f + e2)), r = (1.f + e2) * rp, ii = (1.f + e1) * rp;
                const float la = __builtin_bit_cast(float, pk2(r * ls4[nbl][j], 0.f) << 16);
                const float a = __expf(la), x2 = la + la;
                const float p = -x2 * (1.f + x2 * (0.5f + x2 * (0.16666667f + x2 * (0.041666668f + x2 * 0.0083333338f))));
                const float om = fmaxf((la > -0.0625f) ? p : __builtin_fmaf(-a, a, 1.f), 0.f);
                const float bb = __builtin_amdgcn_sqrtf(om) * ii * xcv[j];
                const unsigned pr = pk2(la, bb);
                lab[j] = pr;
                av[nbl][j] = a; bv[nbl][j] = __builtin_bit_cast(float, pr & 0xffff0000u);
                ac[nbl][j] += la;
            }
            *(GAS v4u*)(LAB + row * GWD + ch) = lab;
        }
        LRU_SCAN8(bv, av);
#pragma unroll
        for (int nbl = 0; nbl < 2; ++nbl)
#pragma unroll
            for (int j = 0; j < 4; ++j) hc[nbl][j] = row_bcast15(av[nbl][j] * hc[nbl][j] + bv[nbl][j]);
    }
#pragma unroll
    for (int nbl = 0; nbl < 2; ++nbl)
#pragma unroll
        for (int j = 0; j < 4; ++j) { float t = ac[nbl][j]; t += row_shr<1>(0.f, t); t += row_shr<2>(0.f, t); t += row_shr<4>(0.f, t); t += row_shr<8>(0.f, t); ac[nbl][j] = __expf(row_bcast15(t)); }
    if (fr == 0) {
#pragma unroll
        for (int nbl = 0; nbl < 2; ++nbl) { const int ch = hb * 64 + (2 * nh + nbl) * 16 + 4 * fq; gf ap = AGG + ((size_t)(b * NCH + chunk) * GWD + ch) * 2;
            *(GAS f32x4*)ap = (f32x4){ac[nbl][0], hc[nbl][0], ac[nbl][1], hc[nbl][1]}; *(GAS f32x4*)(ap + 4) = (f32x4){ac[nbl][2], hc[nbl][2], ac[nbl][3], hc[nbl][3]}; }
    }
}
DI void lru_out_unit(gcb PROJ, gb CAT, gcf lnorm, gcf H0, const GAS unsigned* LAB, LAS unsigned char* lds, int b, int chunk, int tid, int wave, int lane) {
    asm volatile("" : "+v"(tid)); lane = tid & 63;
    LAS float* SS = (LAS float*)lds;
    const int t0 = chunk * CH, hb = wave & 3, nh = wave >> 2, fr = lane & 15, fq = lane >> 4;
    v4u lab[8][2]; v2u gt[8][2];
#pragma unroll
    for (int tb = 0; tb < 8; ++tb)
#pragma unroll
        for (int nbl = 0; nbl < 2; ++nbl) { const size_t row = (size_t)b * SEQ + t0 + 16 * tb + fr; const int ch = hb * 64 + (2 * nh + nbl) * 16 + 4 * fq;
            lab[tb][nbl] = *(GAS const v4u*)(LAB + row * GWD + ch); gt[tb][nbl] = *(GAS const v2u*)(PROJ + row * INW + 1024 + ch); }
    f32x4 hc[2];
#pragma unroll
    for (int nbl = 0; nbl < 2; ++nbl) hc[nbl] = ld4(H0 + ((size_t)(b * NCH + chunk) * GWD + hb * 64 + (2 * nh + nbl) * 16 + 4 * fq));
    v2u yk[8][2];
    __syncthreads();
#pragma unroll
    for (int tb = 0; tb < 8; ++tb) {
        float ssq = 0.f;
        float av[2][4], bv[2][4];
#pragma unroll
        for (int nbl = 0; nbl < 2; ++nbl)
#pragma unroll
            for (int j = 0; j < 4; ++j) { const unsigned pr = lab[tb][nbl][j]; av[nbl][j] = __expf(__builtin_bit_cast(float, pr << 16)); bv[nbl][j] = __builtin_bit_cast(float, pr & 0xffff0000u); }
        LRU_SCAN8(bv, av);
#pragma unroll
        for (int nbl = 0; nbl < 2; ++nbl) { const f32x4 gt4 = unpack4(gt[tb][nbl]); f32x4 yv;
#pragma unroll
            for (int j = 0; j < 4; ++j) { const float h = av[nbl][j] * hc[nbl][j] + bv[nbl][j];
                hc[nbl][j] = row_bcast15(h);
                const float y = gelu_t(gt4[j]) * h; yv[j] = y; ssq += y * y; }
            yk[tb][nbl] = pack4(yv); }
        ssq += __shfl_xor(ssq, 16); ssq += __shfl_xor(ssq, 32); if (fq == 0) SS[wave * 128 + 16 * tb + fr] = ssq;
    }
    __syncthreads();
#pragma unroll
    for (int tb = 0; tb < 8; ++tb) { const int tl = 16 * tb + fr; const size_t row = (size_t)b * SEQ + t0 + tl; float tot = 0.f;
#pragma unroll
        for (int w = 0; w < 8; ++w) tot += SS[w * 128 + tl];
        const float rstd = rsqrtf(tot * (1.f / GWD) + EPS);
#pragma unroll
        for (int nbl = 0; nbl < 2; ++nbl) { const int ch = hb * 64 + (2 * nh + nbl) * 16 + 4 * fq; *(GAS v2u*)(CAT + row * D + 512 + ch) = pack4(unpack4(yk[tb][nbl]) * rstd * ld4(lnorm + ch)); } }
}

DI f32x4 mfma_p2(const v2u a0, const v2u a1, const v2u b0, const v2u b1, const f32x4 c) {
    v4u A, B; A.x = a0.x; A.y = a0.y; A.z = a1.x; A.w = a1.y; B.x = b0.x; B.y = b0.y; B.z = b1.x; B.w = b1.y;
    return __builtin_amdgcn_mfma_f32_16x16x32_bf16(__builtin_bit_cast(bf16x8, A), __builtin_bit_cast(bf16x8, B), c, 0, 0, 0);
}
template <bool OUT>
DI void hgrn_wave_unit(gcb PROJ, gb CAT, gcf LBl, gcf normg, gf ST, gf DEC, LAS float* wlf, int u, int lane) {
    asm volatile("" : "+v"(lane));
    const int hh = u & 3, c = (u >> 2) & (NCH - 1), b = u >> 8, fr = lane & 15, fq = lane >> 4;
    LAS bf16* QT = (LAS bf16*)wlf;
    LAS bf16* KT = QT + 16 * 72;
    LAS bf16* KH = KT + 16 * 72;
    LAS bf16* VT = KH + 64 * 20;
    LAS float* DC = (LAS float*)(VT + 64 * 20);
    const float lbv = LBl[hh * 64 + lane], oml = 1.f - lbv;
    gf stp = ST + ((size_t)((b * NCH + c) * 4 + hh)) * 4096;
    f32x4 S[4][4];
#pragma unroll
    for (int mi = 0; mi < 4; ++mi)
#pragma unroll
        for (int ni = 0; ni < 4; ++ni) S[mi][ni] = OUT ? *(GAS const f32x4*)(stp + ((mi * 4 + ni) * 64 + lane) * 4) : (f32x4){0.f, 0.f, 0.f, 0.f};
    float Dtot = 1.f;
    f32x4 ng4[4];
#pragma unroll
    for (int nv = 0; nv < 4; ++nv) ng4[nv] = OUT ? ld4(normg + hh * 64 + 16 * nv + 4 * fq) : (f32x4){0.f, 0.f, 0.f, 0.f};
    bf16 zr[16], vr[16], qr[16]; v2u gr[4];
#define HG_LOAD(sbn) do { const size_t r0_ = (size_t)b * SEQ + c * CH + (sbn) * 16; \
        _Pragma("unroll") for (int t = 0; t < 16; ++t) { gcb p = PROJ + (r0_ + t) * INW + hh * 64 + lane; zr[t] = p[1536]; vr[t] = p[1792]; if (OUT) qr[t] = p[1280]; else qr[t] = 0; } \
        _Pragma("unroll") for (int nv = 0; nv < 4; ++nv) { if (OUT) gr[nv] = *(GAS const v2u*)(PROJ + (r0_ + fr) * INW + 2048 + hh * 64 + 16 * nv + 4 * fq); else gr[nv] = (v2u){0u, 0u}; } } while (0)
    HG_LOAD(0);
    for (int sb = 0; sb < CH / 16; ++sb) {
        const size_t row0 = (size_t)b * SEQ + c * CH + sb * 16;
        float kk[16], Bt[16]; float Bc = 0.f;
#pragma unroll
        for (int t = 0; t < 16; ++t) {
            const float z = fminf(fmaxf(bf2f(zr[t]), -30.f), 30.f), ez = __expf(-z), sg = __builtin_amdgcn_rcpf(1.f + ez);
            const float f = fmaxf(lbv + oml * sg, 1e-30f);
            Bc += __logf(f); Bt[t] = Bc; kk[t] = oml * ez * sg;
            VT[lane * 20 + t] = vr[t];
            if (OUT) { const float q = siluf(bf2f(qr[t])); QT[t * 72 + lane] = f2bf(q * __expf(Bc)); KT[t * 72 + lane] = f2bf(kk[t] * __expf(fminf(-Bc, 60.f))); } }
#pragma unroll
        for (int t = 0; t < 16; ++t) KH[lane * 20 + t] = f2bf(kk[t] * __expf(Bc - Bt[t]));
        { const float dsub = __expf(Bc); DC[lane] = dsub; Dtot *= dsub; }
        v2u gcur[4];
#pragma unroll
        for (int nv = 0; nv < 4; ++nv) gcur[nv] = gr[nv];
        if (sb + 1 < CH / 16) HG_LOAD(sb + 1);
        LDS_WAIT();
        v2u vt[4]; const v2u zz = (v2u){0u, 0u};
#pragma unroll
        for (int nv = 0; nv < 4; ++nv) vt[nv] = *(const LAS v2u*)(VT + (16 * nv + fr) * 20 + 4 * fq);
        if (OUT) {
            f32x4 O[4], SC = (f32x4){0.f, 0.f, 0.f, 0.f};
            v2u qf[4], kf[4];
#pragma unroll
            for (int s = 0; s < 4; ++s) { qf[s] = *(const LAS v2u*)(QT + fr * 72 + 16 * s + 4 * fq); kf[s] = *(const LAS v2u*)(KT + fr * 72 + 16 * s + 4 * fq); }
            SC = mfma_p2(kf[0], kf[1], qf[0], qf[1], SC); SC = mfma_p2(kf[2], kf[3], qf[2], qf[3], SC);
#pragma unroll
            for (int nv = 0; nv < 4; ++nv) { O[nv] = (f32x4){0.f, 0.f, 0.f, 0.f};
                O[nv] = mfma_p2(pack4(S[nv][0]), pack4(S[nv][1]), qf[0], qf[1], O[nv]); O[nv] = mfma_p2(pack4(S[nv][2]), pack4(S[nv][3]), qf[2], qf[3], O[nv]); }
#pragma unroll
            for (int r = 0; r < 4; ++r) if (4 * fq + r > fr) SC[r] = 0.f;
            const v2u scp = pack4(SC);
            float ss = 0.f;
#pragma unroll
            for (int nv = 0; nv < 4; ++nv) { O[nv] = mfma_p2(vt[nv], zz, scp, zz, O[nv]); ss += (O[nv].x * O[nv].x + O[nv].y * O[nv].y) + (O[nv].z * O[nv].z + O[nv].w * O[nv].w); }
            ss += __shfl_xor(ss, 16); ss += __shfl_xor(ss, 32);
            const float rstd = rsqrtf(ss * (1.f / 64.f) + EPS);
            const size_t row = row0 + fr;
#pragma unroll
            for (int nv = 0; nv < 4; ++nv) { f32x4 g4 = unpack4(gcur[nv]);
                g4.x = siluf(g4.x); g4.y = siluf(g4.y); g4.z = siluf(g4.z); g4.w = siluf(g4.w);
                *(GAS v2u*)(CAT + row * D + 768 + hh * 64 + 16 * nv + 4 * fq) = pack4(O[nv] * rstd * ng4[nv] * g4); }
        }
#pragma unroll
        for (int ni = 0; ni < 4; ++ni) { const f32x4 dk = *(const LAS f32x4*)(DC + 16 * ni + 4 * fq); const v2u kh = *(const LAS v2u*)(KH + (16 * ni + fr) * 20 + 4 * fq);
#pragma unroll
            for (int mi = 0; mi < 4; ++mi) S[mi][ni] = mfma_p2(kh, zz, vt[mi], zz, S[mi][ni] * dk); }
        LDS_WAIT();
    }
    if (!OUT) {
#pragma unroll
        for (int mi = 0; mi < 4; ++mi)
#pragma unroll
            for (int ni = 0; ni < 4; ++ni) *(GAS f32x4*)(stp + ((mi * 4 + ni) * 64 + lane) * 4) = S[mi][ni];
        DEC[((size_t)((b * NCH + c) * 4 + hh)) * 64 + lane] = Dtot;
    }
}
#undef HG_LOAD

DI void carry_phase(gf ST, gcf DEC, gcf AGG, gf H0, int wg, int G, int tid) {
    const int gt = wg * NTHR + tid, NT = G * NTHR, lane = tid & 63, wv = gt >> 6;
    for (int idx = wv; idx < BATCH * GWD; idx += NT >> 6) { const int b = idx >> 8, ch = idx & 255;
        const f32x2 ah = *(GAS const f32x2*)(AGG + ((size_t)(b * NCH + lane) * GWD + ch) * 2); float a = ah.x, h = ah.y;
#pragma unroll
        for (int d = 1; d < 64; d <<= 1) { const float ap = __shfl_up(a, d), hp = __shfl_up(h, d); if (lane >= d) { h = a * hp + h; a = a * ap; } }
        const float hprev = __shfl_up(h, 1);
        H0[(size_t)(b * NCH + lane) * GWD + ch] = lane ? hprev : 0.f; }
    for (int idx = gt; idx < BATCH * 4 * 4096; idx += NT) { const int b = idx >> 14, hh = (idx >> 12) & 3, kv = idx & 4095, k = 16 * ((kv >> 8) & 3) + 4 * ((kv >> 6) & 3) + (kv & 3); float run = 0.f;
#pragma unroll 1
        for (int c0 = 0; c0 < NCH; c0 += 32) { float sl[32], d[32];
#pragma unroll
            for (int c = 0; c < 32; ++c) { sl[c] = ST[((size_t)((b * NCH + c0 + c) * 4 + hh)) * 4096 + kv]; d[c] = DEC[((size_t)((b * NCH + c0 + c) * 4 + hh)) * 64 + k]; }
#pragma unroll
            for (int c = 0; c < 32; ++c) { ST[((size_t)((b * NCH + c0 + c) * 4 + hh)) * 4096 + kv] = run; run = d[c] * run + sl[c]; } } }
}
struct Args { const float* in[33]; float* out; unsigned char* ws; int ph_lo, ph_hi; };
enum { I_X = 0, I_C, I_WMOD, I_BMOD, I_NMIX, I_NFFN, I_NFIN, I_WIN, I_WOUT, I_POOLW, I_POOLS, I_POOLN, I_SGUW, I_SGUB, I_SGUN, I_CONVW, I_CONVB, I_LWA, I_LBA, I_LWX, I_LBX, I_LAM, I_LN,
       I_HGAM, I_HN, I_F1, I_F3, I_F2, I_RW, I_RB, I_M1, I_M3, I_M2 };
constexpr int N_PHASES = 1 + (7 + 2) + (8 + (IS_F8(1) ? 4 : 8)) + (7 + 2) + (8 + (IS_F8(3) ? 4 : 8)) + 1;

DI gws launder(unsigned char* p) { asm volatile("" : "+s"(p)); return (gws)p; }
DI gcf inp(const Args& a, int i) { asm volatile("" : "+s"(i)); return (gcf)a.in[i]; }
#define WSP(T, off) ((GAS T*)(ws + (off)))
#define WSG(T, off) ((T*)((unsigned char*)ws + (off)))

__global__ void __launch_bounds__(NTHR, 2) mk_fwd(Args args) {
    extern __shared__ __attribute__((aligned(16))) unsigned char lds_raw[];
    LAS unsigned char* lds = (LAS unsigned char*)lds_raw;
    const int tid0 = threadIdx.x, wg0 = blockIdx.x, G0 = gridDim.x;
    for (int u = tid0; u < (LDS_BYTES - RING_BYTES) / 4; u += NTHR) ((LAS unsigned*)(lds + RING_BYTES))[u] = 0u;
    __syncthreads();
    const XcdBarrier bar = xcd_barrier_post((unsigned*)(args.ws + WS_CTL) + CW_BAR, (volatile LAS unsigned*)(lds + MISC_OFF) + 8);
    const int lo = args.ph_lo, hi = args.ph_hi;
#define XOUT ((gf)args.out)
    int pi = 0;
#define PH_IDS int tid = (bar.w0 << 6) | hw_lane(); asm volatile("" : "+v"(tid)); const int lane = tid & 63, wave = __builtin_amdgcn_readfirstlane(tid >> 6); int wg = wg0, G = G0; asm volatile("" : "+s"(wg), "+s"(G))
#define PH_ON (pi >= lo && pi < hi)
#define PH_END do { if (pi >= lo && pi + 1 < hi) xcd_barrier(bar); ++pi; } while (0)

    if (PH_ON) { gws ws = launder(args.ws); PH_IDS;
        p0_prologue(inp(args, I_C), inp(args, I_WMOD), inp(args, I_BMOD), inp(args, I_HGAM), inp(args, I_POOLW), inp(args, I_LWA), inp(args, I_LWX), inp(args, I_SGUW), ws, lds, wg, G, tid, wave, lane); }
    PH_END;

    for (int l = 0; l < DEPTH; ++l) {
        const int moe = l & 1;
        if (PH_ON) { gws ws = launder(args.ws); PH_IDS; gcf modl = WSP(float, WS_MOD) + (size_t)l * 8 * MODW;
            convert_weights(l, inp(args, I_WIN), inp(args, I_WOUT), inp(args, I_F1), inp(args, I_F3), inp(args, I_F2), inp(args, I_M1), inp(args, I_M3), inp(args, I_M2), ws, lds, wg, G, wave, lane);
            if (l == 2) norm_phase<true, false, false, false, (bool)IS_B8(2)>(nullptr, WSP(bf16, WS_XB), nullptr, inp(args, I_NMIX) + l * D, modl + 0 * D, modl + 1 * D, modl - 8 * MODW + 5 * D, WSP(bf16, WS_XN), WSP(bf16, WS_Y1), IS_B8(2) ? WSP(bf16, WS_CAT) : WSP(bf16, WS_XN), nullptr, nullptr, nullptr, nullptr, nullptr, nullptr, lds, wg, G, tid, wave, lane);
            else if (l == 0) norm_phase<false, false, false, true>(inp(args, I_X), WSP(bf16, WS_XB), nullptr, inp(args, I_NMIX) + l * D, modl + 0 * D, modl + 1 * D, nullptr, nullptr, nullptr, WSP(bf16, WS_XN), nullptr, nullptr, nullptr, nullptr, nullptr, nullptr, lds, wg, G, tid, wave, lane);
            else if (IS_B8(l)) norm_phase<false, false, false, false, true>(nullptr, WSP(bf16, WS_XB), nullptr, inp(args, I_NMIX) + l * D, modl + 0 * D, modl + 1 * D, nullptr, nullptr, nullptr, WSP(bf16, WS_XN), nullptr, nullptr, nullptr, nullptr, nullptr, nullptr, lds, wg, G, tid, wave, lane);
            else norm_phase<false, false, false, false>(nullptr, WSP(bf16, WS_XB), nullptr, inp(args, I_NMIX) + l * D, modl + 0 * D, modl + 1 * D, nullptr, nullptr, nullptr, WSP(bf16, WS_XN), nullptr, nullptr, nullptr, nullptr, nullptr, nullptr, lds, wg, G, tid, wave, lane);
        }
        PH_END;
        if (PH_ON && !IS_B8(l)) { gws ws = launder(args.ws); PH_IDS;
            pg8::Gemm g{WSG(bf16, WS_XN), WSG(bf16, WS_WIN), D}; pg8::TileOrder<INW / 256> S; S.init(M / 256, G, wg, 0, 0, nullptr);
            EpiProj E{WSP(bf16, WS_PROJ), 1.0f};
            pg8::gemm_phase<EpiProj, pg8::TileOrder<INW / 256>, true, true>(lds, g, S, E, tid);
        }
        if (PH_ON && IS_B8(l)) { gws ws = launder(args.ws); PH_IDS;
            pg8::Gemm g{l == 2 ? WSG(bf16, WS_CAT) : WSG(bf16, WS_XN), WSG(bf16, WS_WIN), D / 2}; pg8::TileOrder<INW / 256> S; S.init(M / 256, G, wg, 0, 0, nullptr);
            EpiProj E{WSP(bf16, WS_PROJ), 1.0f / F8_S13};
            pg8::gemm_phase<EpiProj, pg8::TileOrder<INW / 256>, true, true, true>(lds, g, S, E, tid);
        }
        PH_END;
        if (PH_ON) { gws ws = launder(args.ws); PH_IDS; gcb PROJ = WSP(bf16, WS_PROJ); gb CAT = WSP(bf16, WS_CAT);
            for (int unit = wg; unit < BATCH * NCH; unit += G) { const int b = unit >> 6, blk = unit & (NCH - 1);
                pool_unit(PROJ, CAT, WSP(bf16, WS_POOLWT) + l * 16384, inp(args, I_POOLS) + l * GWD, inp(args, I_POOLN) + l * GWD, lds, b, blk * CH, tid, wave, lane);
                sgu_unit(PROJ, CAT, WSP(bf16, WS_SGUW) + l * 65536, inp(args, I_SGUB) + l * 512, inp(args, I_SGUN) + l * GWD, lds, b, blk * CH, tid, wave, lane);
                lru_local_unit(PROJ, inp(args, I_CONVW) + l * 4 * GWD, inp(args, I_CONVB) + l * GWD, inp(args, I_LBA) + l * GWD, inp(args, I_LBX) + l * GWD, inp(args, I_LAM) + l * GWD,
                               WSP(bf16, WS_LRUWAT) + l * 16384, WSP(bf16, WS_LRUWXT) + l * 16384, WSP(float, WS_AGG), WSP(unsigned, WS_LAB), lds, b, blk, tid, wave, lane);
                __syncthreads(); }
            for (int u = wg * NWAVES + wave; u < BATCH * NCH * 4; u += G * NWAVES)
                hgrn_wave_unit<false>(PROJ, CAT, WSP(float, WS_LB) + l * GWD, inp(args, I_HN) + l * GWD, WSP(float, WS_ST), WSP(float, WS_DEC), (LAS float*)(lds + wave * 16384), u, lane);
        }
        PH_END;
        if (PH_ON) { gws ws = launder(args.ws); PH_IDS; carry_phase(WSP(float, WS_ST), WSP(float, WS_DEC), WSP(float, WS_AGG), WSP(float, WS_H0), wg, G, tid); }
        PH_END;
        if (PH_ON) { gws ws = launder(args.ws); PH_IDS; gcb PROJ = WSP(bf16, WS_PROJ); gb CAT = WSP(bf16, WS_CAT);
            for (int unit = wg; unit < BATCH * NCH; unit += G) { const int b = unit >> 6, blk = unit & (NCH - 1);
                lru_out_unit(PROJ, CAT, inp(args, I_LN) + l * GWD, WSP(float, WS_H0), WSP(unsigned, WS_LAB), lds, b, blk, tid, wave, lane); }
            __syncthreads();
            for (int u = wg * NWAVES + wave; u < BATCH * NCH * 4; u += G * NWAVES)
                hgrn_wave_unit<true>(PROJ, CAT, WSP(float, WS_LB) + l * GWD, inp(args, I_HN) + l * GWD, WSP(float, WS_ST), WSP(float, WS_DEC), (LAS float*)(lds + wave * 16384), u, lane);
        }
        PH_END;
        if (PH_ON) { gws ws = launder(args.ws); PH_IDS;
            pg8::Gemm g{WSG(bf16, WS_CAT), WSG(bf16, WS_WOUT), D}; pg8::TileOrder<D / 256> S; S.init(M / 256, G, wg, 0, 0, nullptr);
            EpiResid E{WSP(bf16, WS_XB), WSP(float, WS_MOD) + (size_t)l * 8 * MODW + 2 * D, 1.0f};
            pg8::gemm_phase<EpiResid, pg8::TileOrder<D / 256>, true, true>(lds, g, S, E, tid);
        }
        PH_END;
        if (PH_ON) { gws ws = launder(args.ws); PH_IDS; gcf modl = WSP(float, WS_MOD) + (size_t)l * 8 * MODW;
            if (moe) norm_phase<false, true, false, false, MOE_XN8>(nullptr, WSP(bf16, WS_XB), nullptr, inp(args, I_NFFN) + l * D, modl + 3 * D, modl + 4 * D, nullptr, nullptr, nullptr, WSP(bf16, WS_XN), inp(args, I_RW) + (l >> 1) * D * NE, inp(args, I_RB) + (l >> 1) * NE,
                                                    WSP(int, WS_TOKE), WSP(float, WS_TOKW), WSP(int, WS_HISTW), WSP(v2i, WS_PAIR), lds, wg, G, tid, wave, lane);
            else if (IS_F8(l)) norm_phase<false, false, false, false, true>(nullptr, WSP(bf16, WS_XB), nullptr, inp(args, I_NFFN) + l * D, modl + 3 * D, modl + 4 * D, nullptr, nullptr, nullptr, WSP(bf16, WS_XN), nullptr, nullptr, nullptr, nullptr, nullptr, nullptr, lds, wg, G, tid, wave, lane);
            else norm_phase<false, false, false, false>(nullptr, WSP(bf16, WS_XB), nullptr, inp(args, I_NFFN) + l * D, modl + 3 * D, modl + 4 * D, nullptr, nullptr, nullptr, WSP(bf16, WS_XN), nullptr, nullptr, nullptr, nullptr, nullptr, nullptr, lds, wg, G, tid, wave, lane);
        }
        PH_END;
        if (moe) {
            if (PH_ON) { gws ws = launder(args.ws); PH_IDS;
                    route_phase(WSP(bf16, WS_XN), WSP(bf16, WS_PROJ), WSP(int, WS_TOKE), WSP(float, WS_TOKW), WSP(int, WS_HISTW), WSP(v2i, WS_PAIR), WSP(int, WS_TILEE), WSP(int, WS_NT), lds, wg, G, tid, wave, lane, IS_F8(l)); }
            PH_END;
        }
        const int nck = moe ? (IS_F8(l) ? 2 : 4) : 1;
#define FFN_RANGE int pm0 = 0, nM = M / 256; if (moe) { const int ntl = __builtin_amdgcn_readfirstlane(__hip_atomic_load(WSP(int, WS_NT), __ATOMIC_RELAXED, __HIP_MEMORY_SCOPE_AGENT)); \
            if (IS_F8(l)) { pm0 = ck * 256; nM = (ck < 1) ? 256 : ntl - 256; if (nM > 292) nM = 292; } else { pm0 = ck * 128; nM = (ck < 3) ? 128 : ntl - 384; if (nM > 146) nM = 146; } if (nM < 0) nM = 0; }
        for (int ck = 0; ck < nck; ++ck) {
            if (PH_ON && !IS_F8(l)) { gws ws = launder(args.ws); PH_IDS; FFN_RANGE;
                pg8::Gemm g{moe ? WSG(bf16, WS_PROJ) : WSG(bf16, WS_XN), WSG(bf16, WS_W13), D}; pg8::TileOrder<DFF / 128> S; S.init(nM, G, wg, pm0, 0, moe ? WSG(int, WS_TILEE) : nullptr);
                EpiSwiglu E{moe ? WSP(bf16, WS_CAT) : WSP(bf16, WS_PROJ), pm0};
                pg8::gemm_phase<EpiSwiglu, pg8::TileOrder<DFF / 128>, true, true>(lds, g, S, E, tid);
            }
            if (PH_ON && IS_F8(l)) { gws ws = launder(args.ws); PH_IDS; FFN_RANGE;
                pg8::Gemm g{moe ? WSG(bf16, WS_PROJ) : WSG(bf16, WS_XN), WSG(bf16, WS_W13), D / 2}; pg8::TileOrder<DFF / 128> S; S.init(nM, G, wg, pm0, 0, moe ? WSG(int, WS_TILEE) : nullptr);
                EpiSwiglu8 E{moe ? WSP(unsigned char, WS_CAT) : WSP(unsigned char, WS_PROJ), pm0};
                pg8::gemm_phase<EpiSwiglu8, pg8::TileOrder<DFF / 128>, true, true, true>(lds, g, S, E, tid);
            }
            PH_END;
            if (PH_ON && !IS_F8(l) && moe) { gws ws = launder(args.ws); PH_IDS; FFN_RANGE;
                pg8::Gemm g{WSG(bf16, WS_CAT), WSG(bf16, WS_W2), DFF}; pg8::TileOrder<D / 256> S; S.init(nM, G, wg, pm0, 1, WSG(int, WS_TILEE));
                EpiScatter E{WSP(v2i, WS_PAIR), WSP(bf16, WS_XN), WSP(bf16, WS_Y1), WSP(int, WS_TOKE), WSP(float, WS_TOKW), 1.0f};
                pg8::gemm_phase<EpiScatter, pg8::TileOrder<D / 256>, true, true>(lds, g, S, E, tid);
            }
            if (PH_ON && !moe && !IS_F8(l)) { gws ws = launder(args.ws); PH_IDS; FFN_RANGE;
                pg8::Gemm g{WSG(bf16, WS_PROJ), WSG(bf16, WS_W2), DFF}; pg8::TileOrder<D / 256> S; S.init(nM, G, wg, pm0, 1, nullptr);
                EpiResid E{WSP(bf16, WS_XB), WSP(float, WS_MOD) + (size_t)l * 8 * MODW + 5 * D, 1.0f};
                pg8::gemm_phase<EpiResid, pg8::TileOrder<D / 256>, true, true>(lds, g, S, E, tid);
            }
            if (PH_ON && IS_F8(l) && !moe) { gws ws = launder(args.ws); PH_IDS; FFN_RANGE;
                pg8::Gemm g{WSG(bf16, WS_PROJ), WSG(bf16, WS_W2), DFF / 2}; pg8::TileOrder<D / 256> S; S.init(nM, G, wg, pm0, 1, nullptr);
                EpiResid E{WSP(bf16, WS_XB), WSP(float, WS_MOD) + (size_t)l * 8 * MODW + 5 * D, 1.0f / F8_S2};
                pg8::gemm_phase<EpiResid, pg8::TileOrder<D / 256>, true, true, true>(lds, g, S, E, tid);
            }
            if (PH_ON && IS_F8(l) && moe) { gws ws = launder(args.ws); PH_IDS; FFN_RANGE;
                pg8::Gemm g{WSG(bf16, WS_CAT), WSG(bf16, WS_W2), DFF / 2}; pg8::TileOrder<D / 256> S; S.init(nM, G, wg, pm0, 1, WSG(int, WS_TILEE));
                EpiScatter E{WSP(v2i, WS_PAIR), WSP(bf16, WS_XN), WSP(bf16, WS_Y1), WSP(int, WS_TOKE), WSP(float, WS_TOKW), 1.0f / F8_S2};
                pg8::gemm_phase<EpiScatter, pg8::TileOrder<D / 256>, true, true, true>(lds, g, S, E, tid);
            }
            PH_END;
        }
#undef FFN_RANGE
    }
    if (PH_ON) { gws ws = launder(args.ws); PH_IDS;
        norm_phase<true, false, true, false>(nullptr, WSP(bf16, WS_XB), XOUT, inp(args, I_NFIN), nullptr, nullptr, WSP(float, WS_MOD) + (size_t)3 * 8 * MODW + 5 * D, WSP(bf16, WS_XN), WSP(bf16, WS_Y1), nullptr, nullptr, nullptr, nullptr, nullptr, nullptr, nullptr, lds, wg, G, tid, wave, lane); }
#undef PH_ON
#undef PH_END
}

#ifndef MK_CUTS
#define MK_CUTS 0
#endif
extern "C" void kernel_launch(void* const* d_in, gci in_sizes, int n_in, void* d_out, int out_size, void* d_ws, size_t ws_size, hipStream_t stream) {
    static int grid = 0;
    if (grid == 0) {
        if (n_in != 33 || in_sizes[0] != M * D || out_size != M * D || ws_size < WS_END) { fprintf(stderr, "kernel_launch: unexpected shapes (n_in %d, in0 %d, out %d, ws %zu); nothing launched\n", n_in, n_in > 0 ? in_sizes[0] : -1, out_size, ws_size); grid = -1; return; }
        int dev = 0, cus = 0, per_cu = 0;
        if (hipGetDevice(&dev) != hipSuccess || hipDeviceGetAttribute(&cus, hipDeviceAttributeMultiprocessorCount, dev) != hipSuccess) { grid = -1; return; }
        if (hipFuncSetAttribute((const void*)mk_fwd, hipFuncAttributeMaxDynamicSharedMemorySize, LDS_BYTES) != hipSuccess) { fprintf(stderr, "kernel_launch: hipFuncSetAttribute failed\n"); grid = -1; return; }
        if (hipOccupancyMaxActiveBlocksPerMultiprocessor(&per_cu, (const void*)mk_fwd, NTHR, LDS_BYTES) != hipSuccess || per_cu < 1) fprintf(stderr, "kernel_launch: occupancy query reports %d workgroups per CU\n", per_cu);
        (void)hipGetLastError();
        grid = cus;
    }
    if (grid < 0) return;
    if (hipMemsetAsync((char*)d_ws + WS_CTL, 0, CTL_ZERO_BYTES, stream) != hipSuccess) return;
    Args a{};
    for (int i = 0; i < 33; ++i) a.in[i] = (const float*)d_in[i];
    a.out = (float*)d_out; a.ws = (unsigned char*)d_ws;
#if MK_CUTS
    for (int p = 0; p < N_PHASES; ++p) { a.ph_lo = p; a.ph_hi = p + 1; hipLaunchKernelGGL(mk_fwd, dim3(grid), dim3(NTHR), LDS_BYTES, stream, a); }
#else
    a.ph_lo = 0; a.ph_hi = N_PHASES;
    hipLaunchKernelGGL(mk_fwd, dim3(grid), dim3(NTHR), LDS_BYTES, stream, a);
#endif
}
```

```cpp
#include <hip/hip_runtime.h>
#include <cstdio>
#include <cstdint>

namespace pg8 {
#define PG8_LAS __attribute__((address_space(3)))
typedef unsigned short bf16_t;
typedef short bf16x8 __attribute__((ext_vector_type(8)));
typedef float f32x4 __attribute__((ext_vector_type(4)));
typedef unsigned u32x4 __attribute__((ext_vector_type(4)));
constexpr int BM = 256, BK = 64, HALF = 128, HTB = HALF * BK * 2  , STAGE_BYTES = 8 * HTB, NXCD = 8, WGM = 8;

__host__ __device__ __forceinline__ int lds_byte(int r, int c) { const int st = (r >> 4) * 2 + (c >> 5), rr = r & 15, cc = c & 31, ob = rr * 64 + cc * 2; return st * 1024 + (ob ^ (((ob >> 9) & 1) << 5)); }
__host__ __device__ __forceinline__ void stage_rc(int b, int& R, int& C) { const int st = b / 1024, sb = b % 1024, swz = sb ^ (((sb >> 9) & 1) << 5); R = (st >> 1) * 16 + swz / 64; C = (st & 1) * 32 + (swz % 64) / 2; }
__host__ __device__ __forceinline__ int perm32(int rho) { const int n = rho >> 4, i = rho & 15; return 8 * (i >> 2) + 4 * n + (i & 3); }

struct Unit { int pa, pn, pm, pc; };
struct Gemm { const bf16_t* A; const bf16_t* Bt; int K; };

template <int NN>
struct TileOrder {
    int nM, nwg, G, c, pm0, a_rel; const int* tile_e;
    __device__ __forceinline__ void init(int nM_, int G_, int c_, int pm0_, int a_rel_, const int* te) { nM = nM_; nwg = nM_ * NN; G = G_; c = c_; pm0 = pm0_; a_rel = a_rel_; tile_e = te; }
    __device__ __forceinline__ bool next(int i, Unit& u) const {
        const int L = i * G + c; if (L >= nwg) return false;
        int wgid = L; { const int q = nwg >> 3, r = nwg & 7, xcd = wgid & 7, off = wgid >> 3; wgid = (xcd < r ? xcd * (q + 1) : r * (q + 1) + (xcd - r) * q) + off; }
        constexpr int nig = WGM * NN;
        const int gid = wgid / nig, x = wgid - gid * nig, fm = gid * WGM, rem = nM - fm;
        int pml, pc;
        if (rem >= WGM) { pml = fm + (x & (WGM - 1)); pc = x >> 3; } else { pml = fm + (x % rem); pc = x / rem; }
        u.pm = pm0 + pml; u.pc = pc; u.pa = a_rel ? pml : u.pm;
        int e = 0; if (tile_e) e = __builtin_amdgcn_readfirstlane(__hip_atomic_load(tile_e + u.pm, __ATOMIC_RELAXED, __HIP_MEMORY_SCOPE_AGENT));
        u.pn = e * NN + pc; return true;
    }
    __device__ __forceinline__ void a_ready(const Unit&) const {}
    __device__ __forceinline__ void done(const Unit&) const {}
};
typedef int v8i32 __attribute__((ext_vector_type(8)));
typedef int v4i32 __attribute__((ext_vector_type(4)));
__device__ __forceinline__ unsigned cvt_pk_bf16(float lo, float hi) { unsigned r; asm("v_cvt_pk_bf16_f32 %0, %1, %2" : "=v"(r) : "v"(lo), "v"(hi)); return r; }

template <class Epi, class Sched, bool ALIGN_EPI = false, bool SP2 = false, bool F8 = false>
__device__ __forceinline__ void gemm_phase(PG8_LAS unsigned char* lds, const Gemm g, const Sched& S, const Epi& E, const int tid_in) {
    int tid = tid_in; asm volatile("" : "+v"(tid));
    const int wid = __builtin_amdgcn_readfirstlane(tid >> 6), lane = tid & 63, wr = wid >> 2, wc = wid & 3, fr = lane & 15, fq = lane >> 4;
    const int K = g.K, nt = K / BK;
    unsigned voffA[2], voffB[2];
#pragma unroll
    for (int i = 0; i < 2; ++i) { int R, C; stage_rc(tid * 16 + i * 8192, R, C); const int Rb = Epi::PERM ? ((R & ~31) + perm32(R & 31)) : R;
        voffA[i] = (unsigned)(R * K + C) * 2u; voffB[i] = (unsigned)(Rb * K + C) * 2u; }
    const size_t kstep = (size_t)(BK * 2);
    const size_t hstep = (size_t)HALF * K * 2;
    const size_t tstep = 2 * hstep;
    const unsigned ldsw = (unsigned)wid * 1024u;
    const int aoff = lds_byte(wr * 64 + fr, fq * 8), boff = lds_byte(wc * 32 + fr, fq * 8);
#define PG8_SA(b, h) (((b) * 2 + (h)) * HTB)
#define PG8_SB(b, h) ((4 + (b) * 2 + (h)) * HTB)
#define PG8_STAGE(bufoff, gbase, voff) do { _Pragma("unroll") for (int _i = 0; _i < 2; ++_i) \
        __builtin_amdgcn_global_load_lds((const unsigned*)((const char*)(gbase) + (voff)[_i]), (PG8_LAS unsigned*)(lds + (bufoff) + ldsw + _i * 8192), 16, 0, 0); } while (0)
#define PG8_LD16(off_) (*(const PG8_LAS v4i32*)(lds + (off_)))
#define PG8_LDA(dst, b, h) do { _Pragma("unroll") for (int m = 0; m < 4; ++m) { if constexpr (F8) dst##8[m] = __builtin_shufflevector(PG8_LD16(PG8_SA(b, h) + aoff + m * 2048), PG8_LD16(PG8_SA(b, h) + aoff + m * 2048 + 1024), 0, 1, 2, 3, 4, 5, 6, 7); \
        else { _Pragma("unroll") for (int k = 0; k < 2; ++k) dst[m][k] = *(const PG8_LAS bf16x8*)(lds + PG8_SA(b, h) + aoff + m * 2048 + k * 1024); } } } while (0)
#define PG8_LDB(dst, b, h) do { _Pragma("unroll") for (int n = 0; n < 2; ++n) { if constexpr (F8) dst##8[n] = __builtin_shufflevector(PG8_LD16(PG8_SB(b, h) + boff + n * 2048), PG8_LD16(PG8_SB(b, h) + boff + n * 2048 + 1024), 0, 1, 2, 3, 4, 5, 6, 7); \
        else { _Pragma("unroll") for (int k = 0; k < 2; ++k) dst[n][k] = *(const PG8_LAS bf16x8*)(lds + PG8_SB(b, h) + boff + n * 2048 + k * 1024); } } } while (0)
#define PG8_MMA(ai, bj, At, Bt, FIRST) do { __builtin_amdgcn_s_setprio(1); _Pragma("unroll") for (int m = 0; m < 4; ++m) _Pragma("unroll") for (int n = 0; n < 2; ++n) { \
        if constexpr (F8) { if constexpr (FIRST) asm volatile("v_mfma_scale_f32_16x16x128_f8f6f4 %0, %1, %2, 0, %3, %3 op_sel_hi:[0,0,0]" : "=&v"(acc[ai][bj][m][n]) : "v"(Bt##8[n]), "v"(At##8[m]), "v"(f8scale)); \
            else asm volatile("v_mfma_scale_f32_16x16x128_f8f6f4 %0, %1, %2, %0, %3, %3 op_sel_hi:[0,0,0]" : "+v"(acc[ai][bj][m][n]) : "v"(Bt##8[n]), "v"(At##8[m]), "v"(f8scale)); } \
        else { acc[ai][bj][m][n] = __builtin_amdgcn_mfma_f32_16x16x32_bf16(Bt[n][0], At[m][0], acc[ai][bj][m][n], 0, 0, 0); \
            acc[ai][bj][m][n] = __builtin_amdgcn_mfma_f32_16x16x32_bf16(Bt[n][1], At[m][1], acc[ai][bj][m][n], 0, 0, 0); } } __builtin_amdgcn_s_setprio(0); } while (0)
#define PG8_WAIT_V(n) asm volatile("s_waitcnt vmcnt(" #n ")" ::: "memory")
#define PG8_WAIT_L(n) asm volatile("s_waitcnt lgkmcnt(" #n ")" ::: "memory")
#define PG8_BAR __builtin_amdgcn_s_barrier()
#define PG8_SCHED __builtin_amdgcn_sched_barrier(0)
    Unit cur, nxt; int ui = 0;
    if (!S.next(0, cur)) return;
    f32x4 acc[2][2][4][2];
    if constexpr (!F8) {
#pragma unroll
    for (int a = 0; a < 2; ++a)
#pragma unroll
        for (int b = 0; b < 2; ++b)
#pragma unroll
            for (int m = 0; m < 4; ++m)
#pragma unroll
                for (int n = 0; n < 2; ++n) acc[a][b][m][n] = (f32x4){0.f, 0.f, 0.f, 0.f};
    }
    bf16x8 At[4][2], B0[2][2], B1[2][2];
    const int f8scale = 0x7f7f7f7f;
    v8i32 At8[4], B08[2], B18[2];
    const char* cA = (const char*)g.A + (size_t)cur.pa * tstep; const char* cB = (const char*)g.Bt + (size_t)cur.pn * tstep;
    S.a_ready(cur);
    {
        PG8_STAGE(PG8_SB(0, 0), cB, voffB); PG8_STAGE(PG8_SB(0, 1), cB + hstep, voffB); PG8_STAGE(PG8_SA(0, 0), cA, voffA); PG8_STAGE(PG8_SA(0, 1), cA + hstep, voffA);
        if (wr == 1) PG8_BAR;
        PG8_WAIT_V(2); PG8_BAR;
        PG8_STAGE(PG8_SB(1, 0), cB + kstep, voffB); PG8_STAGE(PG8_SA(1, 0), cA + kstep, voffA); PG8_STAGE(PG8_SB(1, 1), cB + hstep + kstep, voffB);
        PG8_WAIT_V(6); PG8_BAR;
    }
    for (;;) {
        const bool has_next = S.next(ui + 1, nxt);
        const char* nA = has_next ? (const char*)g.A + (size_t)nxt.pa * tstep : cA; const char* nB = has_next ? (const char*)g.Bt + (size_t)nxt.pn * tstep : cB;
#define PG8_MMA_F(ai, bj, At, Bt) do { if (F8 && t == 0) PG8_MMA(ai, bj, At, Bt, true); else PG8_MMA(ai, bj, At, Bt, false); } while (0)
#pragma nounroll
        for (int t = 0; t < nt; t += 2) {
            const bool last = (t == nt - 2);
            const char* a1 = cA + (size_t)(t + 1) * kstep;
            const char* a2 = last ? nA : cA + (size_t)(t + 2) * kstep; const char* b2 = last ? nB : cB + (size_t)(t + 2) * kstep;
            const char* a3 = a2 + kstep; const char* b3 = b2 + kstep;
            if (last && has_next) S.a_ready(nxt);
            PG8_LDB(B0, 0, 0); PG8_LDB(B1, 0, 1); PG8_SCHED; PG8_LDA(At, 0, 0); PG8_STAGE(PG8_SA(1, 1), a1 + hstep, voffA);
            PG8_WAIT_V(8); PG8_WAIT_L(0); PG8_BAR; PG8_MMA_F(0, 0, At, B0); PG8_MMA_F(0, 1, At, B1); PG8_BAR; PG8_SCHED;
            PG8_LDA(At, 0, 1); PG8_STAGE(PG8_SB(0, 0), b2, voffB); PG8_STAGE(PG8_SB(0, 1), b2 + hstep, voffB); PG8_STAGE(PG8_SA(0, 0), a2, voffA);
            PG8_WAIT_V(8); PG8_WAIT_L(0); PG8_BAR; PG8_MMA_F(1, 0, At, B0); PG8_MMA_F(1, 1, At, B1); PG8_BAR; PG8_SCHED;
            PG8_LDB(B0, 1, 0); PG8_LDB(B1, 1, 1); PG8_SCHED; PG8_LDA(At, 1, 0); PG8_STAGE(PG8_SA(0, 1), a2 + hstep, voffA);
            PG8_WAIT_V(8); PG8_WAIT_L(0); PG8_BAR; PG8_MMA(0, 0, At, B0, false); PG8_MMA(0, 1, At, B1, false); PG8_BAR; PG8_SCHED;
            PG8_LDA(At, 1, 1); PG8_STAGE(PG8_SB(1, 0), b3, voffB); PG8_STAGE(PG8_SB(1, 1), b3 + hstep, voffB); PG8_STAGE(PG8_SA(1, 0), a3, voffA);
            PG8_WAIT_V(8); PG8_WAIT_L(0); PG8_BAR; PG8_MMA(1, 0, At, B0, false); PG8_MMA(1, 1, At, B1, false); PG8_BAR; PG8_SCHED;
        }
#undef PG8_MMA_F
        if constexpr (ALIGN_EPI) { if (wr == 0) PG8_BAR; }
        if constexpr (F8) asm volatile("s_nop 15\n\ts_nop 15" ::: "memory");
        if constexpr (!Epi::AFTER_DRAIN) { E(acc, cur, wr, wc, fr, fq); S.done(cur); }
        if (!has_next) break;
        if constexpr (!F8) {
#pragma unroll
        for (int a = 0; a < 2; ++a)
#pragma unroll
            for (int b = 0; b < 2; ++b)
#pragma unroll
                for (int m = 0; m < 4; ++m)
#pragma unroll
                    for (int n = 0; n < 2; ++n) acc[a][b][m][n] = (f32x4){0.f, 0.f, 0.f, 0.f};
        }
        cur = nxt; cA = nA; cB = nB; ++ui;
        if constexpr (ALIGN_EPI) { if (wr == 1) PG8_BAR; }
    }
    PG8_WAIT_V(0);
    if constexpr (!ALIGN_EPI) { if (wr == 0) PG8_BAR; }
    PG8_BAR;
    if constexpr (Epi::AFTER_DRAIN) { E.fused(acc, cur, wr, wc, fr, fq, lds, wid, lane); S.done(cur); }
#undef PG8_SA
#undef PG8_SB
#undef PG8_STAGE
#undef PG8_LDA
#undef PG8_LD16
#undef PG8_LDB
#undef PG8_MMA
#undef PG8_WAIT_V
#undef PG8_WAIT_L
#undef PG8_BAR
#undef PG8_SCHED
}
}

constexpr int NWAVES = 8, NTHR = NWAVES * 64;
constexpr int BATCH = 8, SEQ = 8192, D = 1024, M = BATCH * SEQ, DEPTH = 4, GWD = 256, INW = 2304, DFF = 3584, NE = 8;
constexpr float EPS = 1e-6f;
constexpr int MODW = 6 * D;
constexpr int CH = 128, NCH = SEQ / CH;
#ifndef F8_MASK
#define F8_MASK 0xE
#endif
#ifndef B8_MASK
#define B8_MASK 0xC
#endif
#define IS_B8(l_) (((B8_MASK) >> (l_)) & 1)
#define IS_F8(l_) (((F8_MASK) >> (l_)) & 1)
constexpr int F8_LAYER = 3;
constexpr float F8_S13 = 32.f, F8_S2 = 64.f;
constexpr bool MOE_XN8 = ((F8_MASK >> 1) & 1) && ((F8_MASK >> 3) & 1);
constexpr int MAXPAIR = 2 * M + NE * 256;

constexpr size_t MiB = 1u << 20;
constexpr size_t WS_CTL = 0, CTL_ZERO_BYTES = 1 * MiB;
constexpr size_t WS_MOD = 1 * MiB;
constexpr size_t WS_LB = WS_MOD + 786432;
constexpr size_t WS_POOLWT = 2 * MiB;
constexpr size_t WS_LRUWAT = WS_POOLWT + 131072;
constexpr size_t WS_LRUWXT = WS_LRUWAT + 131072;
constexpr size_t WS_SGUW = 3 * MiB;
constexpr size_t WS_TOKE = 4 * MiB;
constexpr size_t WS_TOKW = WS_TOKE + 262144;
constexpr size_t WS_HISTW = 5 * MiB;
constexpr size_t WS_TILEE = WS_HISTW + 65536;
constexpr size_t WS_NT = WS_TILEE + 4096;
constexpr size_t WS_PAIR = 6 * MiB;
constexpr size_t WS_AGG = 8 * MiB;
constexpr size_t WS_H0 = 9 * MiB;
constexpr size_t WS_DEC = 10 * MiB;
constexpr size_t WS_W = 16 * MiB;
constexpr size_t WS_WIN = WS_W, WS_WOUT = WS_W + 5 * MiB, WS_W13 = WS_W + 8 * MiB, WS_W2 = WS_W + 120 * MiB;
constexpr size_t WS_XN = 192 * MiB;
constexpr size_t WS_PROJ = 320 * MiB;
constexpr size_t WS_CAT = 608 * MiB;
constexpr size_t WS_ST = 736 * MiB;
constexpr size_t WS_LAB = 768 * MiB;
constexpr size_t WS_Y1 = 864 * MiB;
constexpr size_t WS_XB = 992 * MiB;
constexpr size_t WS_END = 1120 * MiB;
constexpr int CW_BAR = 4096;
constexpr int CW_ZT = 16384;
constexpr int RING_BYTES = 131072, MISC_OFF = RING_BYTES + 320, LDS_BYTES = 147456;

#define DI __device__ __forceinline__
#define LAS __attribute__((address_space(3)))
typedef unsigned short bf16;
typedef unsigned v4u __attribute__((ext_vector_type(4)));
typedef unsigned v2u __attribute__((ext_vector_type(2)));
typedef int v4i __attribute__((ext_vector_type(4)));
typedef int v2i __attribute__((ext_vector_type(2)));
typedef float f32x4 __attribute__((ext_vector_type(4)));
typedef float f32x2 __attribute__((ext_vector_type(2)));
typedef short bf16x8 __attribute__((ext_vector_type(8)));
#define LDS_WAIT() asm volatile("s_waitcnt lgkmcnt(0)" ::: "memory")
#define GAS __attribute__((address_space(1)))
typedef GAS const float* gcf; typedef GAS float* gf; typedef GAS const bf16* gcb; typedef GAS bf16* gb; typedef GAS const int* gci; typedef GAS int* gi;
typedef GAS const v2i* gcv2i; typedef GAS v2i* gv2i; typedef GAS const unsigned* gcu; typedef GAS unsigned char* gws;

DI float bf2f(bf16 v) { return __builtin_bit_cast(float, (unsigned)v << 16); }
DI float lo_bf(unsigned w) { return __builtin_bit_cast(float, w << 16); }
DI float hi_bf(unsigned w) { return __builtin_bit_cast(float, w & 0xffff0000u); }
DI unsigned pk2(float lo, float hi) { return pg8::cvt_pk_bf16(lo, hi); }
DI bf16 f2bf(float f) { return (bf16)(pk2(f, 0.f) & 0xffffu); }
DI float sigm(float x) { return __builtin_amdgcn_rcpf(1.f + __expf(-x)); }
DI float siluf(float x) { return x * sigm(x); }
DI float gelu_t(float x) { return x * sigm(1.5957691216057308f * (x + 0.044715f * x * x * x)); }
DI float neg_expm1(float x) {
    const float p = -x * (1.f + x * (0.5f + x * (0.16666667f + x * (0.041666668f + x * (0.0083333338f + x * 0.0013888889f)))));
    return x > -0.25f ? p : 1.f - __expf(x);
}
DI float wave_sum(float v) {
#pragma unroll
    for (int o = 1; o < 64; o <<= 1) v += __shfl_xor(v, o);
    return v;
}
template <int D_> DI float row_shr0(float src) { return __builtin_bit_cast(float, __builtin_amdgcn_update_dpp(0, __builtin_bit_cast(int, src), 0x110 + D_, 0xf, 0xf, true)); }
DI float wave_sum_dpp(float v) {
    v += row_shr0<1>(v); v += row_shr0<2>(v); v += row_shr0<4>(v); v += row_shr0<8>(v);
    const int iv = __builtin_bit_cast(int, v);
    const float a = __builtin_bit_cast(float, __builtin_amdgcn_readlane(iv, 15)), b2 = __builtin_bit_cast(float, __builtin_amdgcn_readlane(iv, 31));
    const float c2 = __builtin_bit_cast(float, __builtin_amdgcn_readlane(iv, 47)), d2 = __builtin_bit_cast(float, __builtin_amdgcn_readlane(iv, 63));
    return (a + b2) + (c2 + d2);
}
DI int wave_sum_i(int v) {
#pragma unroll
    for (int o = 1; o < 64; o <<= 1) v += __shfl_xor(v, o);
    return v;
}
DI f32x4 ld4(gcf p) { return *(GAS const f32x4*)p; }
DI void unpack8(const v4u x, float (&o)[8]) { o[0] = lo_bf(x.x); o[1] = hi_bf(x.x); o[2] = lo_bf(x.y); o[3] = hi_bf(x.y); o[4] = lo_bf(x.z); o[5] = hi_bf(x.z); o[6] = lo_bf(x.w); o[7] = hi_bf(x.w); }
DI f32x4 unpack4(const v2u x) { return (f32x4){lo_bf(x.x), hi_bf(x.x), lo_bf(x.y), hi_bf(x.y)}; }
DI v2u pack4(const f32x4 v) { v2u r; r.x = pk2(v.x, v.y); r.y = pk2(v.z, v.w); return r; }
DI float clamp_f8(float v) { return __builtin_amdgcn_fmed3f(v, -448.f, 448.f); }
DI unsigned pk4_f8(float a, float b, float c, float d) { int r = __builtin_amdgcn_cvt_pk_fp8_f32(clamp_f8(a), clamp_f8(b), 0, false); r = __builtin_amdgcn_cvt_pk_fp8_f32(clamp_f8(c), clamp_f8(d), r, true); return (unsigned)r; }
DI f32x4 mfma16(const bf16x8 a, const bf16x8 b, const f32x4 c) { return __builtin_amdgcn_mfma_f32_16x16x32_bf16(a, b, c, 0, 0, 0); }

#define XB_TMO      128
#define XB_XCNT(j)  (256  + 64 * (j))
#define XB_XSUB(j)  (1280 + 64 * (j))
#define XB_XGEN(j)  (2304 + 64 * (j))
#define XB_TOP      3328
#define XB_TOPGEN   3392
#define XCD_BAR_WORDS 3456
#define XB_SPIN_CAP (1u << 18)
__device__ __forceinline__ unsigned xb_ld(unsigned* p)              { return __hip_atomic_load(p, __ATOMIC_RELAXED, __HIP_MEMORY_SCOPE_AGENT); }
__device__ __forceinline__ unsigned xb_add(unsigned* p, unsigned v) { return __hip_atomic_fetch_add(p, v, __ATOMIC_RELAXED, __HIP_MEMORY_SCOPE_AGENT); }
__device__ __forceinline__ unsigned xb_xcc_id() { return (unsigned)__builtin_amdgcn_s_getreg((3 << 11) | 20) & 0xFu; }
#define XB_SPIN(cond, bar) do { unsigned _sp = 0; while (cond) { __builtin_amdgcn_s_sleep(1); \
    if ((++_sp & 255u) == 0u) { if (xb_ld(&(bar)[XB_TMO])) break; if (_sp > XB_SPIN_CAP) { atomicAdd(&(bar)[XB_TMO], 1u); break; } } } } while (0)
DI int hw_lane() { int l; asm volatile("v_mbcnt_lo_u32_b32 %0, -1, 0\n\tv_mbcnt_hi_u32_b32 %0, -1, %0" : "=v"(l)); return l; }
struct XcdBarrier { unsigned* bar; unsigned x; volatile LAS unsigned* st; int w0; };
__device__ __forceinline__ XcdBarrier xcd_barrier_post(unsigned* bar, volatile LAS unsigned* st) {
    XcdBarrier b; b.bar = bar; b.x = xb_xcc_id(); b.st = st; b.w0 = __builtin_amdgcn_readfirstlane((int)threadIdx.x >> 6);
    if (threadIdx.x == 0) (void)xb_add(&bar[XB_XCNT(b.x)], 1u);
    return b;
}
__device__ __forceinline__ void xcd_barrier_complete(unsigned* bar, unsigned x, unsigned& nloc, unsigned& nx) {
    const unsigned G = gridDim.x * gridDim.y * gridDim.z;
    unsigned sum, cnt, mine, sp = 0u;
    for (;;) {
        sum = 0u; cnt = 0u; mine = 0u;
#pragma unroll
        for (unsigned j = 0; j < 16; ++j) { const unsigned c = xb_ld(&bar[XB_XCNT(j)]); sum += c; cnt += (c > 0u) ? 1u : 0u; mine = (j == x) ? c : mine; }
        if (sum == G) break;
        __builtin_amdgcn_s_sleep(1);
        if ((++sp & 255u) == 0u) { if (xb_ld(&bar[XB_TMO])) break; if (sp > XB_SPIN_CAP) { atomicAdd(&bar[XB_TMO], 1u); break; } }
    }
    nloc = mine > 0u ? mine : 1u; nx = cnt > 0u ? cnt : 1u;
}
__device__ __forceinline__ void xcd_barrier(const XcdBarrier& b) {
    asm volatile("s_waitcnt vmcnt(0)" ::: "memory");
    __syncthreads();
    if (b.w0 == 0 && hw_lane() == 0) {
        unsigned* bar = b.bar;
        __builtin_amdgcn_s_waitcnt(0);
        unsigned nloc = b.st[0], nx = b.st[1];
        if (nloc == 0u) { xcd_barrier_complete(bar, b.x, nloc, nx); b.st[0] = nloc; b.st[1] = nx; }
        const unsigned old = xb_add(&bar[XB_XSUB(b.x)], 1u);
        const unsigned gen = old / nloc;
        if (old + 1u == (gen + 1u) * nloc) {
            __builtin_amdgcn_fence(__ATOMIC_RELEASE, "agent");
            asm volatile("s_waitcnt vmcnt(0)" ::: "memory");
            const unsigned og = xb_add(&bar[XB_TOP], 1u);
            const unsigned tg = og / nx;
            if (og + 1u == (tg + 1u) * nx) xb_add(&bar[XB_TOPGEN], 1u);
            else XB_SPIN(xb_ld(&bar[XB_TOPGEN]) == tg, bar);
            __builtin_amdgcn_fence(__ATOMIC_ACQUIRE, "agent");
            xb_add(&bar[XB_XGEN(b.x)], 1u);
            asm volatile("s_waitcnt vmcnt(0)" ::: "memory");
        } else {
            XB_SPIN(xb_ld(&bar[XB_XGEN(b.x)]) == gen, bar);
            __builtin_amdgcn_fence(__ATOMIC_ACQUIRE, "agent");
            asm volatile("s_waitcnt vmcnt(0)" ::: "memory");
        }
    }
    __syncthreads();
}

struct EpiProj {
    static constexpr bool PERM = true, AFTER_DRAIN = false, IDEMPOTENT = true;
    gb O; float mul;
    DI void operator()(const f32x4 (&acc)[2][2][4][2], const pg8::Unit& u, int wr, int wc, int fr, int fq) const {
        const int row0 = u.pm * 256 + wr * 64 + fr, col0 = u.pc * 256 + wc * 32 + 8 * fq;
#pragma unroll
        for (int ai = 0; ai < 2; ++ai)
#pragma unroll
            for (int m = 0; m < 4; ++m) { gb rowp = O + (size_t)(row0 + ai * 128 + m * 16) * INW + col0;
#pragma unroll
                for (int bj = 0; bj < 2; ++bj) { const f32x4 v0 = acc[ai][bj][m][0] * mul, v1 = acc[ai][bj][m][1] * mul;
                    v4u w; w.x = pk2(v0[0], v0[1]); w.y = pk2(v0[2], v0[3]); w.z = pk2(v1[0], v1[1]); w.w = pk2(v1[2], v1[3]);
                    *(GAS v4u*)(rowp + bj * 128) = w; } }
    }
};
struct EpiResid {
    static constexpr bool PERM = true, AFTER_DRAIN = false, IDEMPOTENT = false;
    gb x; gcf gate; float mul;
    DI void operator()(const f32x4 (&acc)[2][2][4][2], const pg8::Unit& u, int wr, int wc, int fr, int fq) const {
        const int b = u.pm >> 5, row0 = u.pm * 256 + wr * 64 + fr, col0 = u.pc * 256 + wc * 32 + 8 * fq;
        f32x4 gv[2][2];
#pragma unroll
        for (int bj = 0; bj < 2; ++bj)
#pragma unroll
            for (int n = 0; n < 2; ++n) gv[bj][n] = ld4(gate + (size_t)b * MODW + col0 + bj * 128 + n * 4) * mul;
        constexpr int PF = 6;
        v4u xr[8][2];
#define ER_LOAD(p) _Pragma("unroll") for (int bj = 0; bj < 2; ++bj) xr[p][bj] = *(GAS const v4u*)(x + (size_t)(row0 + ((p) >> 2) * 128 + ((p) & 3) * 16) * D + col0 + bj * 128)
#pragma unroll
        for (int p = 0; p < PF; ++p) { ER_LOAD(p); }
#pragma unroll
        for (int p = 0; p < 8; ++p) { const int ai = p >> 2, m = p & 3;
#pragma unroll
            for (int bj = 0; bj < 2; ++bj) { float xv[8]; unpack8(xr[p][bj], xv);
                const f32x4 v0 = (f32x4){xv[0], xv[1], xv[2], xv[3]} + gv[bj][0] * acc[ai][bj][m][0], v1 = (f32x4){xv[4], xv[5], xv[6], xv[7]} + gv[bj][1] * acc[ai][bj][m][1];
                v4u o; o.x = pk2(v0[0], v0[1]); o.y = pk2(v0[2], v0[3]); o.z = pk2(v1[0], v1[1]); o.w = pk2(v1[2], v1[3]);
                *(GAS v4u*)(x + (size_t)(row0 + ai * 128 + m * 16) * D + col0 + bj * 128) = o; }
            if (p + PF < 8) { ER_LOAD(p + PF); }
            asm volatile("" ::: "memory"); }
#undef ER_LOAD
    }
};
struct EpiSwiglu {
    static constexpr bool PERM = true, AFTER_DRAIN = false, IDEMPOTENT = true;
    gb ACT; int pm0;
    DI void operator()(const f32x4 (&acc)[2][2][4][2], const pg8::Unit& u, int wr, int wc, int fr, int fq) const {
        const int row0 = (u.pm - pm0) * 256 + wr * 64 + fr, col0 = u.pc * 128 + wc * 32 + 8 * fq;
#pragma unroll
        for (int ai = 0; ai < 2; ++ai)
#pragma unroll
            for (int m = 0; m < 4; ++m) { gb rowp = ACT + (size_t)(row0 + ai * 128 + m * 16) * DFF + col0;
                const f32x4 g0 = acc[ai][0][m][0], g1 = acc[ai][0][m][1], u0 = acc[ai][1][m][0], u1 = acc[ai][1][m][1];
                v4u w; w.x = pk2(siluf(g0[0]) * u0[0], siluf(g0[1]) * u0[1]); w.y = pk2(siluf(g0[2]) * u0[2], siluf(g0[3]) * u0[3]);
                w.z = pk2(siluf(g1[0]) * u1[0], siluf(g1[1]) * u1[1]); w.w = pk2(siluf(g1[2]) * u1[2], siluf(g1[3]) * u1[3]);
                *(GAS v4u*)rowp = w; }
    }
};
struct EpiSwiglu8 {
    static constexpr bool PERM = true, AFTER_DRAIN = false, IDEMPOTENT = true;
    GAS unsigned char* ACT; int pm0;
    DI void operator()(const f32x4 (&acc)[2][2][4][2], const pg8::Unit& u, int wr, int wc, int fr, int fq) const {
        const int row0 = (u.pm - pm0) * 256 + wr * 64 + fr, col0 = u.pc * 128 + wc * 32 + 8 * fq;
        float c1 = -1.4426950408889634f / F8_S13, S2 = (float)F8_S13 * (float)F8_S13; asm volatile("" : "+v"(c1), "+v"(S2));
#pragma unroll
        for (int ai = 0; ai < 2; ++ai)
#pragma unroll
            for (int m = 0; m < 4; ++m) { GAS unsigned char* rowp = ACT + (size_t)(row0 + ai * 128 + m * 16) * DFF + col0;
                f32x4 o[2];
#pragma unroll
                for (int n = 0; n < 2; ++n) { const f32x4 g = acc[ai][0][m][n], uu = acc[ai][1][m][n]; f32x4 t = g * c1;
                    t.x = __builtin_amdgcn_exp2f(t.x); t.y = __builtin_amdgcn_exp2f(t.y); t.z = __builtin_amdgcn_exp2f(t.z); t.w = __builtin_amdgcn_exp2f(t.w);
                    t = t * S2 + S2;
                    t.x = __builtin_amdgcn_rcpf(t.x); t.y = __builtin_amdgcn_rcpf(t.y); t.z = __builtin_amdgcn_rcpf(t.z); t.w = __builtin_amdgcn_rcpf(t.w);
                    o[n] = (g * uu) * t; }
                v2u w; w.x = pk4_f8(o[0][0], o[0][1], o[0][2], o[0][3]); w.y = pk4_f8(o[1][0], o[1][1], o[1][2], o[1][3]);
                *(GAS v2u*)rowp = w; }
    }
};
struct EpiScatter {
    static constexpr bool PERM = true, AFTER_DRAIN = false, IDEMPOTENT = true;
    gcv2i pair; gb Y0; gb Y1; gci toke; gcf tokw; float sc;
    DI void operator()(const f32x4 (&acc)[2][2][4][2], const pg8::Unit& u, int wr, int wc, int fr, int fq) const {
        const int row0 = u.pm * 256 + wr * 64 + fr, col0 = u.pc * 256 + wc * 32 + 8 * fq;
        int px[8]; float w[8];
#pragma unroll
        for (int p = 0; p < 8; ++p) px[p] = pair[row0 + (p >> 2) * 128 + (p & 3) * 16].x;
#pragma unroll
        for (int p = 0; p < 8; ++p) w[p] = tokw[px[p] >= 0 ? 2 * (px[p] & 0x3fffffff) + (px[p] >> 30) : 0] * sc;
#pragma unroll
        for (int p = 0; p < 8; ++p) { const int ai = p >> 2, m = p & 3;
            if (px[p] >= 0) { const int tok = px[p] & 0x3fffffff;
                gb rowp = ((px[p] >> 30) ? Y1 : Y0) + (size_t)tok * D + col0;
#pragma unroll
                for (int bj = 0; bj < 2; ++bj) { const f32x4 v0 = acc[ai][bj][m][0] * w[p], v1 = acc[ai][bj][m][1] * w[p];
                    v4u o; o.x = pk2(v0[0], v0[1]); o.y = pk2(v0[2], v0[3]); o.z = pk2(v1[0], v1[1]); o.w = pk2(v1[2], v1[3]);
                    *(GAS v4u*)(rowp + bj * 128) = o; } } }
    }
};


DI void p0_prologue(gcf c, gcf w_mod, gcf b_mod, gcf gamma, gcf pool_w, gcf lwa, gcf lwx, gcf sgu_ws,
                    gws ws, LAS unsigned char* lds, int wg, int G, int tid, int wave, int lane) {
    LAS float* CS = (LAS float*)lds; LAS float* RED = (LAS float*)(lds + 32768);
    gf MOD = (GAS float*)(ws + WS_MOD);
    if (wg < 96) {
        for (int idx = tid; idx < 8192; idx += NTHR) { const int k = idx >> 3, b = idx & 7; const float v = c[b * D + k]; CS[idx] = siluf(v); }
        __syncthreads();
        for (int item = wg; item < 96; item += G) {
            const int l = item / 24, jb = item % 24, col = jb * 256 + lane * 4;
            f32x4 acc[8];
#pragma unroll
            for (int b = 0; b < 8; ++b) acc[b] = (f32x4){0.f, 0.f, 0.f, 0.f};
            gcf wp = w_mod + ((size_t)(l * D + wave * 128)) * MODW + col;
#pragma unroll 32
            for (int kk = 0; kk < 128; ++kk) {
                const f32x4 w = ld4(wp + (size_t)kk * MODW);
                const f32x4 c0 = *(const LAS f32x4*)(CS + (wave * 128 + kk) * 8), c1 = *(const LAS f32x4*)(CS + (wave * 128 + kk) * 8 + 4);
                acc[0] += c0.x * w; acc[1] += c0.y * w; acc[2] += c0.z * w; acc[3] += c0.w * w; acc[4] += c1.x * w; acc[5] += c1.y * w; acc[6] += c1.z * w; acc[7] += c1.w * w;
            }
#pragma unroll
            for (int b = 0; b < 8; ++b) *(LAS f32x4*)(RED + (wave * 8 + b) * 256 + lane * 4) = acc[b];
            __syncthreads();
            for (int o = tid; o < 2048; o += NTHR) { const int b = o >> 8, cc = o & 255; float s = 0.f;
#pragma unroll
                for (int w = 0; w < 8; ++w) s += RED[(w * 8 + b) * 256 + cc];
                MOD[(size_t)(l * 8 + b) * MODW + jb * 256 + cc] = s + b_mod[l * MODW + jb * 256 + cc]; }
            __syncthreads();
        }
    }
    if (wg == G - 1 && tid < GWD) {
        gf LB = (GAS float*)(ws + WS_LB);
        const float g0 = gamma[tid], g1 = gamma[GWD + tid], g2 = gamma[2 * GWD + tid], g3 = gamma[3 * GWD + tid];
        const float mx = fmaxf(fmaxf(g0, g1), fmaxf(g2, g3));
        const float e0 = expf(g0 - mx), e1 = expf(g1 - mx), e2 = expf(g2 - mx), e3 = expf(g3 - mx), inv = 1.f / (e0 + e1 + e2 + e3);
        LB[tid] = 0.f; LB[GWD + tid] = e1 * inv; LB[2 * GWD + tid] = (e1 + e2) * inv; LB[3 * GWD + tid] = (e1 + e2 + e3) * inv;
    }
    gb POOLWT = (GAS bf16*)(ws + WS_POOLWT); gb LRUWAT = (GAS bf16*)(ws + WS_LRUWAT); gb LRUWXT = (GAS bf16*)(ws + WS_LRUWXT); gb SGUW = (GAS bf16*)(ws + WS_SGUW);
    const int gt = wg * NTHR + tid, NT = G * NTHR;
    for (int idx = gt; idx < 65536; idx += NT) { const int lg = idx >> 12, j = (idx >> 6) & 63, i = idx & 63, src = (lg * 64 + i) * 64 + j;
        POOLWT[idx] = f2bf(pool_w[src]); LRUWAT[idx] = f2bf(lwa[src]); LRUWXT[idx] = f2bf(lwx[src]); }
    for (int idx = gt; idx < 262144; idx += NT) { const int t = (idx >> 7) & 127, s = idx & 127; SGUW[idx] = (s <= t) ? f2bf(sgu_ws[idx]) : (bf16)0; }
}

struct CvItem { gcf W; gb WT; int K, N, mode, idx; float f8s; };
DI void cv_load(const CvItem& I, int lane, f32x4 (&v)[8]) {
    const int nblk = I.N / 32, kb = I.idx / nblk, nb = I.idx % nblk;
    gcf p = I.W + (size_t)(64 * kb + (lane >> 3)) * I.N + 32 * nb + 4 * (lane & 7);
#pragma unroll
    for (int i = 0; i < 8; ++i) v[i] = ld4(p + (size_t)(8 * i) * I.N);
}
DI void cv_store(const CvItem& I, LAS float* scr, int lane, const f32x4 (&v)[8]) {
    const int nblk = I.N / 32, kb = I.idx / nblk, nb = I.idx % nblk, k0 = 64 * kb, n0 = 32 * nb;
#pragma unroll
    for (int i = 0; i < 8; ++i) { LAS float* d = scr + (8 * i + (lane >> 3)) * 33 + 4 * (lane & 7); d[0] = v[i].x; d[1] = v[i].y; d[2] = v[i].z; d[3] = v[i].w; }
    LDS_WAIT();
    const int c = lane & 7;
    const int drow0 = (I.mode == 0) ? n0 : ((n0 >> 7) * 256 + (n0 & 127) + (I.mode == 2 ? 128 : 0));
    if (I.f8s > 0.f) { const float sc = I.f8s; GAS unsigned char* W8 = (GAS unsigned char*)I.WT; const int c4 = lane & 3;
#pragma unroll
        for (int j = 0; j < 2; ++j) { const int n = (lane >> 2) + 16 * j; const LAS float* s = scr + (16 * c4) * 33 + n;
            v4u o; o.x = pk4_f8(s[0 * 33] * sc, s[1 * 33] * sc, s[2 * 33] * sc, s[3 * 33] * sc); o.y = pk4_f8(s[4 * 33] * sc, s[5 * 33] * sc, s[6 * 33] * sc, s[7 * 33] * sc);
            o.z = pk4_f8(s[8 * 33] * sc, s[9 * 33] * sc, s[10 * 33] * sc, s[11 * 33] * sc); o.w = pk4_f8(s[12 * 33] * sc, s[13 * 33] * sc, s[14 * 33] * sc, s[15 * 33] * sc);
            *(GAS v4u*)(W8 + (size_t)(drow0 + n) * I.K + k0 + 16 * c4) = o; }
    } else {
#pragma unroll
    for (int j = 0; j < 4; ++j) { const int n = (lane >> 3) + 8 * j; const LAS float* s = scr + (8 * c) * 33 + n;
        v4u o; o.x = pk2(s[0 * 33], s[1 * 33]); o.y = pk2(s[2 * 33], s[3 * 33]); o.z = pk2(s[4 * 33], s[5 * 33]); o.w = pk2(s[6 * 33], s[7 * 33]);
        *(GAS v4u*)(I.WT + (size_t)(drow0 + n) * I.K + k0 + 8 * c) = o; }
    }
    LDS_WAIT();
}
DI void convert_weights(int l, gcf w_in, gcf w_out, gcf f1, gcf f3, gcf f2, gcf m1, gcf m3, gcf m2,
                        gws ws, LAS unsigned char* lds, int wg, int G, int wave, int lane) {
    LAS float* scr = (LAS float*)(lds + wave * 16384);
    gb WIN = (GAS bf16*)(ws + WS_WIN); gb WOUT = (GAS bf16*)(ws + WS_WOUT); gb W13 = (GAS bf16*)(ws + WS_W13); gb W2 = (GAS bf16*)(ws + WS_W2);
    constexpr int n_in = 16 * 72, n_out = 16 * 32, n13 = 16 * 112, n2 = 56 * 32, per_e = 2 * n13 + n2;
    const int moe = l & 1, E = moe ? NE : 1, total = n_in + n_out + E * per_e, stride = G * NWAVES, f8 = IS_F8(l) ? 1 : 0;
#define CV_DECODE(it_, I_) do { int r = (it_); \
        if (r < n_in) { I_ = CvItem{w_in + (size_t)l * D * INW, WIN, D, INW, 0, r, IS_B8(l) ? F8_S13 : 0.f}; } \
        else if (r < n_in + n_out) { I_ = CvItem{w_out + (size_t)l * D * D, WOUT, D, D, 0, r - n_in, 0.f}; } \
        else { r -= n_in + n_out; const int e = r / per_e; r -= e * per_e; \
            const size_t mo = (size_t)((l >> 1) * (moe ? NE : 1) + e) * D * DFF; \
            const size_t o13 = ((size_t)e * 2 * DFF * D) >> f8, o2 = ((size_t)e * D * DFF) >> f8;     \
            if (r < n13) I_ = CvItem{(moe ? m1 : f1) + mo, W13 + o13, D, DFF, 1, r, f8 ? F8_S13 : 0.f}; \
            else if (r < 2 * n13) I_ = CvItem{(moe ? m3 : f3) + mo, W13 + o13, D, DFF, 2, r - n13, f8 ? F8_S13 : 0.f}; \
            else I_ = CvItem{(moe ? m2 : f2) + mo, W2 + o2, DFF, D, 0, r - 2 * n13, f8 ? F8_S2 : 0.f}; } } while (0)
    int it = wg * NWAVES + wave;
    if (it >= total) return;
    CvItem Ia, Ib; f32x4 va[8], vb[8];
    CV_DECODE(it, Ia); cv_load(Ia, lane, va);
    for (;;) {
        const bool hb = it + stride < total;
        if (hb) { CV_DECODE(it + stride, Ib); cv_load(Ib, lane, vb); }
        cv_store(Ia, scr, lane, va);
        if (!hb) break;
        it += stride;
        const bool ha = it + stride < total;
        if (ha) { CV_DECODE(it + stride, Ia); cv_load(Ia, lane, va); }
        cv_store(Ib, scr, lane, vb);
        if (!ha) break;
        it += stride;
    }
#undef CV_DECODE
}

template <bool COMBINE, bool ROUTER, bool FINAL, bool XF32, bool OUT8 = false>
DI void norm_phase(gcf xf, gb xb, gf outf, gcf gain, gcf shift, gcf scale, gcf gprev, gcb Y0, gcb Y1, gb XN,
                   gcf rw, gcf rb, gi toke, gf tokw, gi histw, gv2i pair, LAS unsigned char* lds, int wg, int G, int tid, int wave, int lane) {
    LAS float* RW = (LAS float*)lds;
    if (ROUTER) {
        for (int i = tid; i < 8192; i += NTHR) RW[i] = rw[i];
        { int m1 = -1, z0 = 0; asm volatile("" : "+v"(m1), "+v"(z0));
        for (int i = wg * NTHR + tid; i < MAXPAIR; i += G * NTHR) pair[i] = (v2i){m1, z0}; }
        __syncthreads();
    }
    for (int blk = wg; blk < M / 256; blk += G) {
        const int b = blk >> 5;
#define NCOL(j) (8 * lane + 512 * ((j) >> 1) + 4 * ((j) & 1))
        f32x4 gm[4], sh[4], gp[4];
#pragma unroll
        for (int j = 0; j < 4; ++j) { const int col = NCOL(j);
            if (FINAL) { gm[j] = ld4(gain + col); sh[j] = (f32x4){0.f, 0.f, 0.f, 0.f}; }
            else { gm[j] = ld4(gain + col) * (ld4(scale + (size_t)b * MODW + col) + 1.0f); sh[j] = ld4(shift + (size_t)b * MODW + col); }
            if (COMBINE) gp[j] = ld4(gprev + (size_t)b * MODW + col); else gp[j] = (f32x4){0.f, 0.f, 0.f, 0.f}; }
        int cnt[8];
#pragma unroll
        for (int e = 0; e < 8; ++e) cnt[e] = 0;
        constexpr int RG = (COMBINE || ROUTER) ? 1 : 2;
        v4u xr[2][XF32 ? 1 : RG][2]; f32x4 xfr[2][XF32 ? RG : 1][4]; v4u ya[2][COMBINE ? RG : 1][2], yb[2][COMBINE ? RG : 1][2];
#define NL_LOAD(B, R0) \
        _Pragma("unroll") for (int q = 0; q < RG; ++q) \
        _Pragma("unroll") for (int s = 0; s < 2; ++s) { const size_t off = (size_t)(blk * 256 + wave * 32 + (R0) + q) * D + 8 * lane + 512 * s; \
            if (XF32) { xfr[B][q][2 * s] = ld4(xf + off); xfr[B][q][2 * s + 1] = ld4(xf + off + 4); } else xr[B][q][s] = *(GAS const v4u*)(xb + off); \
            if (COMBINE) { ya[B][q][s] = *(GAS const v4u*)(Y0 + off); yb[B][q][s] = *(GAS const v4u*)(Y1 + off); } }
        NL_LOAD(0, 0)
#pragma unroll 1
        for (int r00 = 0; r00 < 32; r00 += 2 * RG) {
#pragma unroll
          for (int hb = 0; hb < 2; ++hb) {
            const int r0 = r00 + hb * RG;
            if (hb == 0) { NL_LOAD(1, r0 + RG) } else if (r0 + RG < 32) { NL_LOAD(0, r0 + RG) }
#pragma unroll
            for (int q = 0; q < RG; ++q) {
            const int row = blk * 256 + wave * 32 + r0 + q;
            f32x4 v[4]; float ss = 0.f;
#pragma unroll
            for (int s = 0; s < 2; ++s) { const size_t off = (size_t)row * D + 8 * lane + 512 * s;
                if (XF32) { v[2 * s] = xfr[hb][q][2 * s]; v[2 * s + 1] = xfr[hb][q][2 * s + 1]; }
                else { float t8[8]; unpack8(xr[hb][q][s], t8); v[2 * s] = (f32x4){t8[0], t8[1], t8[2], t8[3]}; v[2 * s + 1] = (f32x4){t8[4], t8[5], t8[6], t8[7]}; }
                if (COMBINE) { float a8[8], b8[8]; unpack8(ya[hb][q][s], a8); unpack8(yb[hb][q][s], b8);
                    v[2 * s] += gp[2 * s] * ((f32x4){a8[0], a8[1], a8[2], a8[3]} + (f32x4){b8[0], b8[1], b8[2], b8[3]}); v[2 * s + 1] += gp[2 * s + 1] * ((f32x4){a8[4], a8[5], a8[6], a8[7]} + (f32x4){b8[4], b8[5], b8[6], b8[7]}); }
                if ((COMBINE && !FINAL) || XF32) { v4u o; o.x = pk2(v[2 * s].x, v[2 * s].y); o.y = pk2(v[2 * s].z, v[2 * s].w); o.z = pk2(v[2 * s + 1].x, v[2 * s + 1].y); o.w = pk2(v[2 * s + 1].z, v[2 * s + 1].w); *(GAS v4u*)(xb + off) = o; }
                ss += (v[2 * s].x * v[2 * s].x + v[2 * s].y * v[2 * s].y) + (v[2 * s].z * v[2 * s].z + v[2 * s].w * v[2 * s].w) + (v[2 * s + 1].x * v[2 * s + 1].x + v[2 * s + 1].y * v[2 * s + 1].y) + (v[2 * s + 1].z * v[2 * s + 1].z + v[2 * s + 1].w * v[2 * s + 1].w); }
            const float rstd = rsqrtf(wave_sum_dpp(ss) * (1.f / D) + EPS);
            f32x4 h[4];
#pragma unroll
            for (int j = 0; j < 4; ++j) h[j] = v[j] * rstd * gm[j] + sh[j];
#pragma unroll
            for (int s = 0; s < 2; ++s) { const size_t off = (size_t)row * D + 8 * lane + 512 * s;
                if (FINAL) { *(GAS f32x4*)(outf + off) = h[2 * s]; *(GAS f32x4*)(outf + off + 4) = h[2 * s + 1]; }
                else if (OUT8) {
                    if (s == 1) { v2u o0, o1; o0.x = pk4_f8(h[0].x, h[0].y, h[0].z, h[0].w); o0.y = pk4_f8(h[1].x, h[1].y, h[1].z, h[1].w); o1.x = pk4_f8(h[2].x, h[2].y, h[2].z, h[2].w); o1.y = pk4_f8(h[3].x, h[3].y, h[3].z, h[3].w);
                        const bool odd = lane & 1; const unsigned sx = odd ? o0.x : o1.x, sy = odd ? o0.y : o1.y;
                        const unsigned tx = (unsigned)__builtin_amdgcn_update_dpp(0, (int)sx, 0xB1, 0xf, 0xf, true), ty = (unsigned)__builtin_amdgcn_update_dpp(0, (int)sy, 0xB1, 0xf, 0xf, true);
                        v4u w; if (odd) { w.x = tx; w.y = ty; w.z = o1.x; w.w = o1.y; } else { w.x = o0.x; w.y = o0.y; w.z = tx; w.w = ty; }
                        *(GAS v4u*)((GAS unsigned char*)XN + (size_t)row * D + (odd ? 512 + 8 * (lane - 1) : 8 * lane)) = w; } }
                else { v4u o; o.x = pk2(h[2 * s].x, h[2 * s].y); o.y = pk2(h[2 * s].z, h[2 * s].w); o.z = pk2(h[2 * s + 1].x, h[2 * s + 1].y); o.w = pk2(h[2 * s + 1].z, h[2 * s + 1].w); *(GAS v4u*)(XN + off) = o; } }
            if (ROUTER) {
                float lg[8];
#pragma unroll
                for (int e = 0; e < 8; ++e) lg[e] = 0.f;
#pragma unroll
                for (int j = 0; j < 4; ++j)
#pragma unroll
                    for (int i = 0; i < 4; ++i) { const int cc = NCOL(j) + i; const f32x4 w0 = *(const LAS f32x4*)(RW + cc * 8), w1 = *(const LAS f32x4*)(RW + cc * 8 + 4); const float hv = h[j][i];
                        lg[0] += hv * w0.x; lg[1] += hv * w0.y; lg[2] += hv * w0.z; lg[3] += hv * w0.w; lg[4] += hv * w1.x; lg[5] += hv * w1.y; lg[6] += hv * w1.z; lg[7] += hv * w1.w; }
#pragma unroll
                for (int e = 0; e < 8; ++e) lg[e] = wave_sum_dpp(lg[e]) + rb[e];
                int i0 = 0; float v0 = lg[0];
#pragma unroll
                for (int e = 1; e < 8; ++e) if (lg[e] > v0) { v0 = lg[e]; i0 = e; }
                int i1 = -1; float v1 = -3.0e38f;
#pragma unroll
                for (int e = 0; e < 8; ++e) if (e != i0 && lg[e] > v1) { v1 = lg[e]; i1 = e; }
                const float w0 = 1.f / (1.f + expf(v1 - v0)), w1 = 1.f - w0;
                if (lane == 0) { toke[row] = i0 | (i1 << 8); tokw[2 * row] = w0; tokw[2 * row + 1] = w1; }
#pragma unroll
                for (int e = 0; e < 8; ++e) cnt[e] += (i0 == e) + (i1 == e);
            }
            }
          }
        }
#undef NL_LOAD
        if (ROUTER && lane == 0) {
#pragma unroll
            for (int e = 0; e < 8; ++e) histw[(blk * 8 + wave) * 8 + e] = cnt[e]; }
    }
#undef NCOL
}

DI void route_phase(gcb XN, gb XG, gci toke, gcf tokw, gci histw, gv2i pair, gi tilee, gi ntp,
                    LAS unsigned char* lds, int wg, int G, int tid, int wave, int lane, int f8) {
    LAS int* L = (LAS int*)lds;
    for (int blk = wg; blk < M / 256; blk += G) {
        int tot[8], pre[8];
#pragma unroll
        for (int e = 0; e < 8; ++e) { tot[e] = 0; pre[e] = 0; }
        for (int q = tid; q < 2048; q += NTHR) { const v4i h0 = *(GAS const v4i*)(histw + q * 8), h1 = *(GAS const v4i*)(histw + q * 8 + 4); const int m = (q < blk * 8) ? 1 : 0;
            tot[0] += h0.x; tot[1] += h0.y; tot[2] += h0.z; tot[3] += h0.w; tot[4] += h1.x; tot[5] += h1.y; tot[6] += h1.z; tot[7] += h1.w;
            pre[0] += m * h0.x; pre[1] += m * h0.y; pre[2] += m * h0.z; pre[3] += m * h0.w; pre[4] += m * h1.x; pre[5] += m * h1.y; pre[6] += m * h1.z; pre[7] += m * h1.w; }
#pragma unroll
        for (int e = 0; e < 8; ++e) { tot[e] = wave_sum_i(tot[e]); pre[e] = wave_sum_i(pre[e]); }
        if (lane == 0) {
#pragma unroll
            for (int e = 0; e < 8; ++e) { L[wave * 16 + e] = tot[e]; L[wave * 16 + 8 + e] = pre[e]; } }
        __syncthreads();
        int start[9]; start[0] = 0;
#pragma unroll
        for (int e = 0; e < 8; ++e) { int t = 0, p = 0;
#pragma unroll
            for (int w = 0; w < 8; ++w) { t += L[w * 16 + e]; p += L[w * 16 + 8 + e]; }
            tot[e] = t; pre[e] = p; start[e + 1] = start[e] + ((t + 255) & ~255); }
        int e0 = -1, e1 = -1; const int tok = blk * 256 + tid;
        if (tid < 256) { const int te = toke[tok]; e0 = te & 255; e1 = te >> 8; }
        const unsigned long long lt = (1ull << lane) - 1ull;
        int r0 = 0, r1 = 0;
#pragma unroll
        for (int e = 0; e < 8; ++e) { const unsigned long long m0 = __ballot(e0 == e), m1 = __ballot(e1 == e);
            const int rr = __popcll(m0 & lt) + __popcll(m1 & lt);
            if (e0 == e) r0 = rr; if (e1 == e) r1 = rr;
            if (lane == 0) L[128 + wave * 8 + e] = __popcll(m0) + __popcll(m1);
            if (tid == 0) L[192 + e] = start[e] + pre[e]; }
        __syncthreads();
        if (tid < 256) {
            int p0 = L[192 + e0] + r0, p1 = L[192 + e1] + r1;
            for (int w = 0; w < wave; ++w) { p0 += L[128 + w * 8 + e0]; p1 += L[128 + w * 8 + e1]; }
            const f32x2 wv = *(GAS const f32x2*)(tokw + 2 * tok);
            pair[p0] = (v2i){tok, __builtin_bit_cast(int, wv.x)}; pair[p1] = (v2i){tok | (1 << 30), __builtin_bit_cast(int, wv.y)};
            L[256 + 2 * tid] = p0; L[256 + 2 * tid + 1] = p1;
        }
        __syncthreads();
        if (f8 && MOE_XN8) {
            const GAS unsigned char* S8 = (const GAS unsigned char*)XN; GAS unsigned char* X8 = (GAS unsigned char*)XG;
            for (int i0 = 0; i0 < 32; i0 += 8) {
                v4u ra[8]; int pp0[8], pp1[8];
#pragma unroll
                for (int q = 0; q < 8; ++q) { const int tl = wave * 32 + i0 + q; pp0[q] = L[256 + 2 * tl]; pp1[q] = L[256 + 2 * tl + 1]; ra[q] = *(GAS const v4u*)(S8 + (size_t)(blk * 256 + tl) * D + lane * 16); }
#pragma unroll
                for (int q = 0; q < 8; ++q) { *(GAS v4u*)(X8 + (size_t)pp0[q] * D + lane * 16) = ra[q]; *(GAS v4u*)(X8 + (size_t)pp1[q] * D + lane * 16) = ra[q]; } }
        } else
        for (int i0 = 0; i0 < 32; i0 += 4) {
            v4u ra[4], rb2[4]; int pp0[4], pp1[4];
#pragma unroll
            for (int q = 0; q < 4; ++q) { const int tl = wave * 32 + i0 + q; pp0[q] = L[256 + 2 * tl]; pp1[q] = L[256 + 2 * tl + 1];
                gcb srcp = XN + (size_t)(blk * 256 + tl) * D + lane * 16; ra[q] = *(GAS const v4u*)srcp; rb2[q] = *(GAS const v4u*)(srcp + 8); }
            if (f8) { GAS unsigned char* X8 = (GAS unsigned char*)XG;
#pragma unroll
                for (int q = 0; q < 4; ++q) { float xa[8], xb2[8]; unpack8(ra[q], xa); unpack8(rb2[q], xb2);
                    v4u o; o.x = pk4_f8(xa[0], xa[1], xa[2], xa[3]); o.y = pk4_f8(xa[4], xa[5], xa[6], xa[7]); o.z = pk4_f8(xb2[0], xb2[1], xb2[2], xb2[3]); o.w = pk4_f8(xb2[4], xb2[5], xb2[6], xb2[7]);
                    *(GAS v4u*)(X8 + (size_t)pp0[q] * D + lane * 16) = o; *(GAS v4u*)(X8 + (size_t)pp1[q] * D + lane * 16) = o; }
            } else {
#pragma unroll
            for (int q = 0; q < 4; ++q) { gb d0 = XG + (size_t)pp0[q] * D + lane * 16; gb d1 = XG + (size_t)pp1[q] * D + lane * 16;
                *(GAS v4u*)d0 = ra[q]; *(GAS v4u*)(d0 + 8) = rb2[q]; *(GAS v4u*)d1 = ra[q]; *(GAS v4u*)(d1 + 8) = rb2[q]; } } }
        if (blk == 0) { const int ntt = start[8] >> 8;
            for (int t = tid; t < ntt; t += NTHR) { int e = 0;
#pragma unroll
                for (int q = 1; q < 8; ++q) e += (t >= (start[q] >> 8)) ? 1 : 0;
                tilee[t] = e; }
            if (tid == 0) ntp[0] = ntt; }
        __syncthreads();
    }
}

DI void pool_unit(gcb PROJ, gb CAT, gcb WT, gcf pscale, gcf pnorm, LAS unsigned char* lds, int b, int t0, int tid, int wave, int lane) {
    asm volatile("" : "+v"(tid)); lane = tid & 63;
    LAS bf16* XT = (LAS bf16*)lds;
    LAS bf16* DT = (LAS bf16*)(lds + 80 * 264 * 2);
    LAS float* SSP = (LAS float*)(lds + (80 + 64) * 264 * 2);
    const int fr = lane & 15, fq = lane >> 4, tbh = wave & 3, gp = wave >> 2;
    bf16x8 Wf[2][2][4];
#pragma unroll
    for (int gl = 0; gl < 2; ++gl)
#pragma unroll
        for (int kk = 0; kk < 2; ++kk)
#pragma unroll
            for (int nb = 0; nb < 4; ++nb) Wf[gl][kk][nb] = *(GAS const bf16x8*)(WT + (((2 * gp + gl) * 64 + nb * 16 + fr) * 64 + kk * 32 + 8 * fq));
    for (int half = 0; half < 2; ++half) {
        const int t0h = t0 + 64 * half;
        __syncthreads();
        { v4u xr[5];
#pragma unroll
            for (int i = 0; i < 5; ++i) { const int cidx = tid + NTHR * i, row = cidx >> 5, cg = cidx & 31, tt = t0h - 16 + row, ttc = tt < 0 ? 0 : tt;
                xr[i] = *(GAS const v4u*)(PROJ + ((size_t)b * SEQ + ttc) * INW + cg * 8); }
#pragma unroll
            for (int i = 0; i < 5; ++i) { const int cidx = tid + NTHR * i, row = cidx >> 5, cg = cidx & 31, tt = t0h - 16 + row;
                *(LAS v4u*)(XT + row * 264 + cg * 8) = (tt < 0) ? (v4u){0u, 0u, 0u, 0u} : xr[i]; } }
        __syncthreads();
        { const int cg = tid & 31, run = tid >> 5, ch0 = cg * 8, win = 2 << (cg >> 3), tl0 = run * 4;
            float s[8];
#pragma unroll
            for (int k = 0; k < 8; ++k) s[k] = 0.f;
            for (int r = 1; r <= win; ++r) { float xv[8]; unpack8(*(const LAS v4u*)(XT + (tl0 + 16 - r) * 264 + ch0), xv);
#pragma unroll
                for (int k = 0; k < 8; ++k) s[k] += xv[k]; }
#pragma unroll
            for (int i = 0; i < 4; ++i) { float xv[8], yv[8]; unpack8(*(const LAS v4u*)(XT + (tl0 + i + 16) * 264 + ch0), xv); unpack8(*(const LAS v4u*)(XT + (tl0 + i + 16 - win) * 264 + ch0), yv);
                const int tt = t0h + tl0 + i; const float inv = 1.f / (float)((tt + 1 < win) ? tt + 1 : win);
#pragma unroll
                for (int k = 0; k < 8; ++k) s[k] += xv[k] - yv[k];
                v4u o; o.x = pk2(s[0] * inv - xv[0], s[1] * inv - xv[1]); o.y = pk2(s[2] * inv - xv[2], s[3] * inv - xv[3]); o.z = pk2(s[4] * inv - xv[4], s[5] * inv - xv[5]); o.w = pk2(s[6] * inv - xv[6], s[7] * inv - xv[7]);
                *(LAS v4u*)(DT + (tl0 + i) * 264 + ch0) = o; } }
        __syncthreads();
        f32x4 acc[2][4];
#pragma unroll
        for (int gl = 0; gl < 2; ++gl)
#pragma unroll
            for (int nb = 0; nb < 4; ++nb) acc[gl][nb] = (f32x4){0.f, 0.f, 0.f, 0.f};
#pragma unroll
        for (int gl = 0; gl < 2; ++gl)
#pragma unroll
            for (int kk = 0; kk < 2; ++kk) { const bf16x8 X = *(const LAS bf16x8*)(DT + (16 * tbh + fr) * 264 + (2 * gp + gl) * 64 + kk * 32 + 8 * fq);
#pragma unroll
                for (int nb = 0; nb < 4; ++nb) acc[gl][nb] = mfma16(Wf[gl][kk][nb], X, acc[gl][nb]); }
        float ss = 0.f;
#pragma unroll
        for (int gl = 0; gl < 2; ++gl)
#pragma unroll
            for (int nb = 0; nb < 4; ++nb) { const f32x4 y = acc[gl][nb] * ld4(pscale + (2 * gp + gl) * 64 + nb * 16 + 4 * fq); acc[gl][nb] = y; ss += (y.x * y.x + y.y * y.y) + (y.z * y.z + y.w * y.w); }
        ss += __shfl_xor(ss, 16); ss += __shfl_xor(ss, 32);
        if (fq == 0) SSP[gp * 64 + 16 * tbh + fr] = ss;
        __syncthreads();
        const float rstd = rsqrtf((SSP[16 * tbh + fr] + SSP[64 + 16 * tbh + fr]) * (1.f / GWD) + EPS);
        const size_t row = (size_t)b * SEQ + t0h + 16 * tbh + fr;
#pragma unroll
        for (int gl = 0; gl < 2; ++gl)
#pragma unroll
            for (int nb = 0; nb < 4; ++nb) { const int ch = (2 * gp + gl) * 64 + nb * 16 + 4 * fq; *(GAS v2u*)(CAT + row * D + ch) = pack4(acc[gl][nb] * rstd * ld4(pnorm + ch)); }
    }
}

DI void sgu_unit(gcb PROJ, gb CAT, gcb SW, gcf sbias, gcf snorm, LAS unsigned char* lds, int b, int t0, int tid, int wave, int lane) {
    asm volatile("" : "+v"(tid)); lane = tid & 63;
    __syncthreads();
    LAS bf16* VT = (LAS bf16*)lds;
    const int fr = lane & 15, fq = lane >> 4, tb = wave, nk = (tb >> 1) + 1;
    { v2u vr[16];
#pragma unroll
        for (int i = 0; i < 16; ++i) vr[i] = *(GAS const v2u*)(PROJ + ((size_t)b * SEQ + t0 + 16 * wave + i) * INW + 512 + 4 * lane);
#pragma unroll
        for (int i = 0; i < 8; ++i) { const int tl = 16 * wave + 2 * i;
            f32x4 va = unpack4(vr[2 * i]), vb = unpack4(vr[2 * i + 1]);
            va.x = gelu_t(va.x); va.y = gelu_t(va.y); va.z = gelu_t(va.z); va.w = gelu_t(va.w); vb.x = gelu_t(vb.x); vb.y = gelu_t(vb.y); vb.z = gelu_t(vb.z); vb.w = gelu_t(vb.w);
            const float mua = wave_sum_dpp((va.x + va.y) + (va.z + va.w)) * (1.f / GWD), mub = wave_sum_dpp((vb.x + vb.y) + (vb.z + vb.w)) * (1.f / GWD);
            va = va - mua; vb = vb - mub;
            const float vra = wave_sum_dpp((va.x * va.x + va.y * va.y) + (va.z * va.z + va.w * va.w)) * (1.f / GWD), vrb = wave_sum_dpp((vb.x * vb.x + vb.y * vb.y) + (vb.z * vb.z + vb.w * vb.w)) * (1.f / GWD);
            va = va * rsqrtf(vra + EPS); vb = vb * rsqrtf(vrb + EPS);
            *(LAS unsigned*)(VT + (4 * lane + 0) * 136 + tl) = pk2(va.x, vb.x); *(LAS unsigned*)(VT + (4 * lane + 1) * 136 + tl) = pk2(va.y, vb.y);
            *(LAS unsigned*)(VT + (4 * lane + 2) * 136 + tl) = pk2(va.z, vb.z); *(LAS unsigned*)(VT + (4 * lane + 3) * 136 + tl) = pk2(va.w, vb.w); } }
    const int tl = 16 * tb + fr; const size_t row = (size_t)b * SEQ + t0 + tl;
    v2u ur[4][4]; float bias4[4];
#pragma unroll
    for (int h = 0; h < 4; ++h) { bias4[h] = sbias[h * 128 + tl];
#pragma unroll
        for (int db = 0; db < 4; ++db) ur[h][db] = *(GAS const v2u*)(PROJ + row * INW + 256 + h * 64 + db * 16 + 4 * fq); }
    __syncthreads();
    f32x4 acc[4][4];
#pragma unroll
    for (int h = 0; h < 4; ++h)
#pragma unroll
        for (int db = 0; db < 4; ++db) acc[h][db] = (f32x4){0.f, 0.f, 0.f, 0.f};
    for (int kk = 0; kk < nk; ++kk) {
        bf16x8 Q[4];
#pragma unroll
        for (int h = 0; h < 4; ++h) Q[h] = *(GAS const bf16x8*)(SW + ((h * 128 + 16 * tb + fr) * 128 + kk * 32 + 8 * fq));
#pragma unroll
        for (int h = 0; h < 4; ++h)
#pragma unroll
            for (int db = 0; db < 4; ++db) { const bf16x8 P = *(const LAS bf16x8*)(VT + (h * 64 + db * 16 + fr) * 136 + kk * 32 + 8 * fq); acc[h][db] = mfma16(P, Q[h], acc[h][db]); } }
    float ss = 0.f;
#pragma unroll
    for (int h = 0; h < 4; ++h)
#pragma unroll
        for (int db = 0; db < 4; ++db) { f32x4 u = unpack4(ur[h][db]);
            u.x = gelu_t(u.x); u.y = gelu_t(u.y); u.z = gelu_t(u.z); u.w = gelu_t(u.w);
            const f32x4 y = u * (acc[h][db] + bias4[h]); acc[h][db] = y; ss += (y.x * y.x + y.y * y.y) + (y.z * y.z + y.w * y.w); }
    ss += __shfl_xor(ss, 16); ss += __shfl_xor(ss, 32);
    const float rstd = rsqrtf(ss * (1.f / GWD) + EPS);
#pragma unroll
    for (int h = 0; h < 4; ++h)
#pragma unroll
        for (int db = 0; db < 4; ++db) { const int ch = h * 64 + db * 16 + 4 * fq; *(GAS v2u*)(CAT + row * D + 256 + ch) = pack4(acc[h][db] * rstd * ld4(snorm + ch)); }
}

template <int D_> DI float row_shr(float ident, float src) {
    return __builtin_bit_cast(float, __builtin_amdgcn_update_dpp(__builtin_bit_cast(int, ident), __builtin_bit_cast(int, src), 0x110 + D_, 0xf, 0xf, false));
}
#define LRU_STEP_(D) \
    "v_fmac_f32_dpp %0, %0, %8 row_shr:" #D " row_mask:0xf bank_mask:0xf\n\tv_fmac_f32_dpp %1, %1, %9 row_shr:" #D " row_mask:0xf bank_mask:0xf\n\t" \
    "v_fmac_f32_dpp %2, %2, %10 row_shr:" #D " row_mask:0xf bank_mask:0xf\n\tv_fmac_f32_dpp %3, %3, %11 row_shr:" #D " row_mask:0xf bank_mask:0xf\n\t" \
    "v_fmac_f32_dpp %4, %4, %12 row_shr:" #D " row_mask:0xf bank_mask:0xf\n\tv_fmac_f32_dpp %5, %5, %13 row_shr:" #D " row_mask:0xf bank_mask:0xf\n\t" \
    "v_fmac_f32_dpp %6, %6, %14 row_shr:" #D " row_mask:0xf bank_mask:0xf\n\tv_fmac_f32_dpp %7, %7, %15 row_shr:" #D " row_mask:0xf bank_mask:0xf\n\t" \
    "v_mul_f32_dpp %8, %8, %8 row_shr:" #D " row_mask:0xf bank_mask:0xf\n\tv_mul_f32_dpp %9, %9, %9 row_shr:" #D " row_mask:0xf bank_mask:0xf\n\t" \
    "v_mul_f32_dpp %10, %10, %10 row_shr:" #D " row_mask:0xf bank_mask:0xf\n\tv_mul_f32_dpp %11, %11, %11 row_shr:" #D " row_mask:0xf bank_mask:0xf\n\t" \
    "v_mul_f32_dpp %12, %12, %12 row_shr:" #D " row_mask:0xf bank_mask:0xf\n\tv_mul_f32_dpp %13, %13, %13 row_shr:" #D " row_mask:0xf bank_mask:0xf\n\t" \
    "v_mul_f32_dpp %14, %14, %14 row_shr:" #D " row_mask:0xf bank_mask:0xf\n\tv_mul_f32_dpp %15, %15, %15 row_shr:" #D " row_mask:0xf bank_mask:0xf\n\t"
#define LRU_SCAN8(bv, av) asm("s_nop 1\n\t" LRU_STEP_(1) LRU_STEP_(2) LRU_STEP_(4) LRU_STEP_(8) \
    : "+v"(bv[0][0]), "+v"(bv[0][1]), "+v"(bv[0][2]), "+v"(bv[0][3]), "+v"(bv[1][0]), "+v"(bv[1][1]), "+v"(bv[1][2]), "+v"(bv[1][3]), \
      "+v"(av[0][0]), "+v"(av[0][1]), "+v"(av[0][2]), "+v"(av[0][3]), "+v"(av[1][0]), "+v"(av[1][1]), "+v"(av[1][2]), "+v"(av[1][3]))
DI float row_bcast15(float v) { return __builtin_bit_cast(float, __builtin_amdgcn_update_dpp(0, __builtin_bit_cast(int, v), 0x15F, 0xf, 0xf, true)); }
DI void lru_local_unit(gcb PROJ, gcf convw, gcf convb, gcf lba, gcf lbx, gcf lam, gcb WAT, gcb WXT, gf AGG, GAS unsigned* LAB, LAS unsigned char* lds, int b, int chunk, int tid, int wave, int lane) {
    asm volatile("" : "+v"(tid)); lane = tid & 63;
    __syncthreads();
    LAS bf16* TILE = (LAS bf16*)lds;
    const int t0 = chunk * CH;
    {
        const int cg = tid & 31, ch0 = cg * 8;
        f32x4 cw[4][2], cb[2];
#pragma unroll
        for (int k = 0; k < 4; ++k) { cw[k][0] = ld4(convw + k * GWD + ch0); cw[k][1] = ld4(convw + k * GWD + ch0 + 4); }
        cb[0] = ld4(convb + ch0); cb[1] = ld4(convb + ch0 + 4);
#pragma unroll
        for (int hb2 = 0; hb2 < 2; ++hb2) {
            v4u xr[4][4];
#pragma unroll
            for (int i = 0; i < 4; ++i) { const int tl = (tid >> 5) + 16 * (hb2 * 4 + i);
#pragma unroll
                for (int k = 0; k < 4; ++k) { const int tt = t0 + tl - 3 + k, ttc = tt < 0 ? 0 : tt; xr[i][k] = *(GAS const v4u*)(PROJ + ((size_t)b * SEQ + ttc) * INW + 768 + ch0); } }
#pragma unroll
            for (int i = 0; i < 4; ++i) { const int tl = (tid >> 5) + 16 * (hb2 * 4 + i);
                f32x4 x0 = cb[0], x1 = cb[1];
#pragma unroll
                for (int k = 0; k < 4; ++k) { const float m = (t0 + tl - 3 + k >= 0) ? 1.f : 0.f; float xv[8]; unpack8(xr[i][k], xv);
                    x0 += cw[k][0] * ((f32x4){xv[0], xv[1], xv[2], xv[3]} * m); x1 += cw[k][1] * ((f32x4){xv[4], xv[5], xv[6], xv[7]} * m); }
                v4u o; o.x = pk2(x0.x, x0.y); o.y = pk2(x0.z, x0.w); o.z = pk2(x1.x, x1.y); o.w = pk2(x1.z, x1.w);
                *(LAS v4u*)(TILE + tl * 264 + ch0) = o; }
        }
    }
    const int hb = wave & 3, nh = wave >> 2, fr = lane & 15, fq = lane >> 4;
    bf16x8 WA[2][2], WX[2][2];
#pragma unroll
    for (int kk = 0; kk < 2; ++kk)
#pragma unroll
        for (int nbl = 0; nbl < 2; ++nbl) { const int o = (hb * 64 + (2 * nh + nbl) * 16 + fr) * 64 + kk * 32 + 8 * fq; WA[kk][nbl] = *(GAS const bf16x8*)(WAT + o); WX[kk][nbl] = *(GAS const bf16x8*)(WXT + o); }
    f32x4 ba4[2], bx4[2], ls4[2], hc[2], ac[2];
#pragma unroll
    for (int nbl = 0; nbl < 2; ++nbl) { const int ch = hb * 64 + (2 * nh + nbl) * 16 + 4 * fq; ba4[nbl] = ld4(lba + ch); bx4[nbl] = ld4(lbx + ch);
        const f32x4 lm = ld4(lam + ch);
#pragma unroll
        for (int j = 0; j < 4; ++j) ls4[nbl][j] = -8.0f * log1pf(expf(-lm[j]));
        hc[nbl] = (f32x4){0.f, 0.f, 0.f, 0.f}; ac[nbl] = (f32x4){0.f, 0.f, 0.f, 0.f}; }
    __syncthreads();
#pragma unroll 1
    for (int tb = 0; tb < 8; ++tb) {
        const int tl = 16 * tb + fr; const size_t row = (size_t)b * SEQ + t0 + tl;
        bf16x8 X[2];
#pragma unroll
        for (int kk = 0; kk < 2; ++kk) X[kk] = *(const LAS bf16x8*)(TILE + tl * 264 + hb * 64 + kk * 32 + 8 * fq);
        float av[2][4], bv[2][4];
#pragma unroll
        for (int nbl = 0; nbl < 2; ++nbl) {
            f32x4 ra = (f32x4){0.f, 0.f, 0.f, 0.f}, rx = (f32x4){0.f, 0.f, 0.f, 0.f};
#pragma unroll
            for (int kk = 0; kk < 2; ++kk) { ra = mfma16(WA[kk][nbl], X[kk], ra); rx = mfma16(WX[kk][nbl], X[kk], rx); }
            const int ch = hb * 64 + (2 * nh + nbl) * 16 + 4 * fq;
            const f32x4 xcv = unpack4(*(const LAS v2u*)(TILE + tl * 264 + ch));
            v4u lab;
#pragma unroll
            for (int j = 0; j < 4; ++j) {
                const float e1 = __expf(-(ra[j] + ba4[nbl][j])), e2 = __expf(-(rx[j] + bx4[nbl][j]));
                const float rp = __builtin_amdgcn_rcpf((1.f + e1) * (1.f + e2)), r = (1.f + e2) * rp, ii = (1.f + e1) * rp;
                const float la = __builtin_bit_cast(float, pk2(r * ls4[nbl][j], 0.f) << 16);
                const float a = __expf(la), x2 = la + la;
                const float p = -x2 * (1.f + x2 * (0.5f + x2 * (0.16666667f + x2 * (0.041666668f + x2 * 0.0083333338f))));
                const float om = fmaxf((la > -0.0625f) ? p : __builtin_fmaf(-a, a, 1.f), 0.f);
                const float bb = __builtin_amdgcn_sqrtf(om) * ii * xcv[j];
                const unsigned pr = pk2(la, bb);
                lab[j] = pr;
                av[nbl][j] = a; bv[nbl][j] = __builtin_bit_cast(float, pr & 0xffff0000u);
                ac[nbl][j] += la;
            }
            *(GAS v4u*)(LAB + row * GWD + ch) = lab;
        }
        LRU_SCAN8(bv, av);
#pragma unroll
        for (int nbl = 0; nbl < 2; ++nbl)
#pragma unroll
            for (int j = 0; j < 4; ++j) hc[nbl][j] = row_bcast15(av[nbl][j] * hc[nbl][j] + bv[nbl][j]);
    }
#pragma unroll
    for (int nbl = 0; nbl < 2; ++nbl)
#pragma unroll
        for (int j = 0; j < 4; ++j) { float t = ac[nbl][j]; t += row_shr<1>(0.f, t); t += row_shr<2>(0.f, t); t += row_shr<4>(0.f, t); t += row_shr<8>(0.f, t); ac[nbl][j] = __expf(row_bcast15(t)); }
    if (fr == 0) {
#pragma unroll
        for (int nbl = 0; nbl < 2; ++nbl) { const int ch = hb * 64 + (2 * nh + nbl) * 16 + 4 * fq; gf ap = AGG + ((size_t)(b * NCH + chunk) * GWD + ch) * 2;
            *(GAS f32x4*)ap = (f32x4){ac[nbl][0], hc[nbl][0], ac[nbl][1], hc[nbl][1]}; *(GAS f32x4*)(ap + 4) = (f32x4){ac[nbl][2], hc[nbl][2], ac[nbl][3], hc[nbl][3]}; }
    }
}
DI void lru_out_unit(gcb PROJ, gb CAT, gcf lnorm, gcf H0, const GAS unsigned* LAB, LAS unsigned char* lds, int b, int chunk, int tid, int wave, int lane) {
    asm volatile("" : "+v"(tid)); lane = tid & 63;
    LAS float* SS = (LAS float*)lds;
    const int t0 = chunk * CH, hb = wave & 3, nh = wave >> 2, fr = lane & 15, fq = lane >> 4;
    v4u lab[8][2]; v2u gt[8][2];
#pragma unroll
    for (int tb = 0; tb < 8; ++tb)
#pragma unroll
        for (int nbl = 0; nbl < 2; ++nbl) { const size_t row = (size_t)b * SEQ + t0 + 16 * tb + fr; const int ch = hb * 64 + (2 * nh + nbl) * 16 + 4 * fq;
            lab[tb][nbl] = *(GAS const v4u*)(LAB + row * GWD + ch); gt[tb][nbl] = *(GAS const v2u*)(PROJ + row * INW + 1024 + ch); }
    f32x4 hc[2];
#pragma unroll
    for (int nbl = 0; nbl < 2; ++nbl) hc[nbl] = ld4(H0 + ((size_t)(b * NCH + chunk) * GWD + hb * 64 + (2 * nh + nbl) * 16 + 4 * fq));
    v2u yk[8][2];
    __syncthreads();
#pragma unroll
    for (int tb = 0; tb < 8; ++tb) {
        float ssq = 0.f;
        float av[2][4], bv[2][4];
#pragma unroll
        for (int nbl = 0; nbl < 2; ++nbl)
#pragma unroll
            for (int j = 0; j < 4; ++j) { const unsigned pr = lab[tb][nbl][j]; av[nbl][j] = __expf(__builtin_bit_cast(float, pr << 16)); bv[nbl][j] = __builtin_bit_cast(float, pr & 0xffff0000u); }
        LRU_SCAN8(bv, av);
#pragma unroll
        for (int nbl = 0; nbl < 2; ++nbl) { const f32x4 gt4 = unpack4(gt[tb][nbl]); f32x4 yv;
#pragma unroll
            for (int j = 0; j < 4; ++j) { const float h = av[nbl][j] * hc[nbl][j] + bv[nbl][j];
                hc[nbl][j] = row_bcast15(h);
                const float y = gelu_t(gt4[j]) * h; yv[j] = y; ssq += y * y; }
            yk[tb][nbl] = pack4(yv); }
        ssq += __shfl_xor(ssq, 16); ssq += __shfl_xor(ssq, 32); if (fq == 0) SS[wave * 128 + 16 * tb + fr] = ssq;
    }
    __syncthreads();
#pragma unroll
    for (int tb = 0; tb < 8; ++tb) { const int tl = 16 * tb + fr; const size_t row = (size_t)b * SEQ + t0 + tl; float tot = 0.f;
#pragma unroll
        for (int w = 0; w < 8; ++w) tot += SS[w * 128 + tl];
        const float rstd = rsqrtf(tot * (1.f / GWD) + EPS);
#pragma unroll
        for (int nbl = 0; nbl < 2; ++nbl) { const int ch = hb * 64 + (2 * nh + nbl) * 16 + 4 * fq; *(GAS v2u*)(CAT + row * D + 512 + ch) = pack4(unpack4(yk[tb][nbl]) * rstd * ld4(lnorm + ch)); } }
}

DI f32x4 mfma_p2(const v2u a0, const v2u a1, const v2u b0, const v2u b1, const f32x4 c) {
    v4u A, B; A.x = a0.x; A.y = a0.y; A.z = a1.x; A.w = a1.y; B.x = b0.x; B.y = b0.y; B.z = b1.x; B.w = b1.y;
    return __builtin_amdgcn_mfma_f32_16x16x32_bf16(__builtin_bit_cast(bf16x8, A), __builtin_bit_cast(bf16x8, B), c, 0, 0, 0);
}
template <bool OUT>
DI void hgrn_wave_unit(gcb PROJ, gb CAT, gcf LBl, gcf normg, gf ST, gf DEC, LAS float* wlf, int u, int lane) {
    asm volatile("" : "+v"(lane));
    const int hh = u & 3, c = (u >> 2) & (NCH - 1), b = u >> 8, fr = lane & 15, fq = lane >> 4;
    LAS bf16* QT = (LAS bf16*)wlf;
    LAS bf16* KT = QT + 16 * 72;
    LAS bf16* KH = KT + 16 * 72;
    LAS bf16* VT = KH + 64 * 20;
    LAS float* DC = (LAS float*)(VT + 64 * 20);
    const float lbv = LBl[hh * 64 + lane], oml = 1.f - lbv;
    gf stp = ST + ((size_t)((b * NCH + c) * 4 + hh)) * 4096;
    f32x4 S[4][4];
#pragma unroll
    for (int mi = 0; mi < 4; ++mi)
#pragma unroll
        for (int ni = 0; ni < 4; ++ni) S[mi][ni] = OUT ? *(GAS const f32x4*)(stp + ((mi * 4 + ni) * 64 + lane) * 4) : (f32x4){0.f, 0.f, 0.f, 0.f};
    float Dtot = 1.f;
    f32x4 ng4[4];
#pragma unroll
    for (int nv = 0; nv < 4; ++nv) ng4[nv] = OUT ? ld4(normg + hh * 64 + 16 * nv + 4 * fq) : (f32x4){0.f, 0.f, 0.f, 0.f};
    bf16 zr[16], vr[16], qr[16]; v2u gr[4];
#define HG_LOAD(sbn) do { const size_t r0_ = (size_t)b * SEQ + c * CH + (sbn) * 16; \
        _Pragma("unroll") for (int t = 0; t < 16; ++t) { gcb p = PROJ + (r0_ + t) * INW + hh * 64 + lane; zr[t] = p[1536]; vr[t] = p[1792]; if (OUT) qr[t] = p[1280]; else qr[t] = 0; } \
        _Pragma("unroll") for (int nv = 0; nv < 4; ++nv) { if (OUT) gr[nv] = *(GAS const v2u*)(PROJ + (r0_ + fr) * INW + 2048 + hh * 64 + 16 * nv + 4 * fq); else gr[nv] = (v2u){0u, 0u}; } } while (0)
    HG_LOAD(0);
    for (int sb = 0; sb < CH / 16; ++sb) {
        const size_t row0 = (size_t)b * SEQ + c * CH + sb * 16;
        float kk[16], Bt[16]; float Bc = 0.f;
#pragma unroll
        for (int t = 0; t < 16; ++t) {
            const float z = fminf(fmaxf(bf2f(zr[t]), -30.f), 30.f), ez = __expf(-z), sg = __builtin_amdgcn_rcpf(1.f + ez);
            const float f = fmaxf(lbv + oml * sg, 1e-30f);
            Bc += __logf(f); Bt[t] = Bc; kk[t] = oml * ez * sg;
            VT[lane * 20 + t] = vr[t];
            if (OUT) { const float q = siluf(bf2f(qr[t])); QT[t * 72 + lane] = f2bf(q * __expf(Bc)); KT[t * 72 + lane] = f2bf(kk[t] * __expf(fminf(-Bc, 60.f))); } }
#pragma unroll
        for (int t = 0; t < 16; ++t) KH[lane * 20 + t] = f2bf(kk[t] * __expf(Bc - Bt[t]));
        { const float dsub = __expf(Bc); DC[lane] = dsub; Dtot *= dsub; }
        v2u gcur[4];
#pragma unroll
        for (int nv = 0; nv < 4; ++nv) gcur[nv] = gr[nv];
        if (sb + 1 < CH / 16) HG_LOAD(sb + 1);
        LDS_WAIT();
        v2u vt[4]; const v2u zz = (v2u){0u, 0u};
#pragma unroll
        for (int nv = 0; nv < 4; ++nv) vt[nv] = *(const LAS v2u*)(VT + (16 * nv + fr) * 20 + 4 * fq);
        if (OUT) {
            f32x4 O[4], SC = (f32x4){0.f, 0.f, 0.f, 0.f};
            v2u qf[4], kf[4];
#pragma unroll
            for (int s = 0; s < 4; ++s) { qf[s] = *(const LAS v2u*)(QT + fr * 72 + 16 * s + 4 * fq); kf[s] = *(const LAS v2u*)(KT + fr * 72 + 16 * s + 4 * fq); }
            SC = mfma_p2(kf[0], kf[1], qf[0], qf[1], SC); SC = mfma_p2(kf[2], kf[3], qf[2], qf[3], SC);
#pragma unroll
            for (int nv = 0; nv < 4; ++nv) { O[nv] = (f32x4){0.f, 0.f, 0.f, 0.f};
                O[nv] = mfma_p2(pack4(S[nv][0]), pack4(S[nv][1]), qf[0], qf[1], O[nv]); O[nv] = mfma_p2(pack4(S[nv][2]), pack4(S[nv][3]), qf[2], qf[3], O[nv]); }
#pragma unroll
            for (int r = 0; r < 4; ++r) if (4 * fq + r > fr) SC[r] = 0.f;
            const v2u scp = pack4(SC);
            float ss = 0.f;
#pragma unroll
            for (int nv = 0; nv < 4; ++nv) { O[nv] = mfma_p2(vt[nv], zz, scp, zz, O[nv]); ss += (O[nv].x * O[nv].x + O[nv].y * O[nv].y) + (O[nv].z * O[nv].z + O[nv].w * O[nv].w); }
            ss += __shfl_xor(ss, 16); ss += __shfl_xor(ss, 32);
            const float rstd = rsqrtf(ss * (1.f / 64.f) + EPS);
            const size_t row = row0 + fr;
#pragma unroll
            for (int nv = 0; nv < 4; ++nv) { f32x4 g4 = unpack4(gcur[nv]);
                g4.x = siluf(g4.x); g4.y = siluf(g4.y); g4.z = siluf(g4.z); g4.w = siluf(g4.w);
                *(GAS v2u*)(CAT + row * D + 768 + hh * 64 + 16 * nv + 4 * fq) = pack4(O[nv] * rstd * ng4[nv] * g4); }
        }
#pragma unroll
        for (int ni = 0; ni < 4; ++ni) { const f32x4 dk = *(const LAS f32x4*)(DC + 16 * ni + 4 * fq); const v2u kh = *(const LAS v2u*)(KH + (16 * ni + fr) * 20 + 4 * fq);
#pragma unroll
            for (int mi = 0; mi < 4; ++mi) S[mi][ni] = mfma_p2(kh, zz, vt[mi], zz, S[mi][ni] * dk); }
        LDS_WAIT();
    }
    if (!OUT) {
#pragma unroll
        for (int mi = 0; mi < 4; ++mi)
#pragma unroll
            for (int ni = 0; ni < 4; ++ni) *(GAS f32x4*)(stp + ((mi * 4 + ni) * 64 + lane) * 4) = S[mi][ni];
        DEC[((size_t)((b * NCH + c) * 4 + hh)) * 64 + lane] = Dtot;
    }
}
#undef HG_LOAD

DI void carry_phase(gf ST, gcf DEC, gcf AGG, gf H0, int wg, int G, int tid) {
    const int gt = wg * NTHR + tid, NT = G * NTHR, lane = tid & 63, wv = gt >> 6;
    for (int idx = wv; idx < BATCH * GWD; idx += NT >> 6) { const int b = idx >> 8, ch = idx & 255;
        const f32x2 ah = *(GAS const f32x2*)(AGG + ((size_t)(b * NCH + lane) * GWD + ch) * 2); float a = ah.x, h = ah.y;
#pragma unroll
        for (int d = 1; d < 64; d <<= 1) { const float ap = __shfl_up(a, d), hp = __shfl_up(h, d); if (lane >= d) { h = a * hp + h; a = a * ap; } }
        const float hprev = __shfl_up(h, 1);
        H0[(size_t)(b * NCH + lane) * GWD + ch] = lane ? hprev : 0.f; }
    for (int idx = gt; idx < BATCH * 4 * 4096; idx += NT) { const int b = idx >> 14, hh = (idx >> 12) & 3, kv = idx & 4095, k = 16 * ((kv >> 8) & 3) + 4 * ((kv >> 6) & 3) + (kv & 3); float run = 0.f;
#pragma unroll 1
        for (int c0 = 0; c0 < NCH; c0 += 32) { float sl[32], d[32];
#pragma unroll
            for (int c = 0; c < 32; ++c) { sl[c] = ST[((size_t)((b * NCH + c0 + c) * 4 + hh)) * 4096 + kv]; d[c] = DEC[((size_t)((b * NCH + c0 + c) * 4 + hh)) * 64 + k]; }
#pragma unroll
            for (int c = 0; c < 32; ++c) { ST[((size_t)((b * NCH + c0 + c) * 4 + hh)) * 4096 + kv] = run; run = d[c] * run + sl[c]; } } }
}
struct Args { const float* in[33]; float* out; unsigned char* ws; int ph_lo, ph_hi; };
enum { I_X = 0, I_C, I_WMOD, I_BMOD, I_NMIX, I_NFFN, I_NFIN, I_WIN, I_WOUT, I_POOLW, I_POOLS, I_POOLN, I_SGUW, I_SGUB, I_SGUN, I_CONVW, I_CONVB, I_LWA, I_LBA, I_LWX, I_LBX, I_LAM, I_LN,
       I_HGAM, I_HN, I_F1, I_F3, I_F2, I_RW, I_RB, I_M1, I_M3, I_M2 };
constexpr int N_PHASES = 1 + (7 + 2) + (8 + (IS_F8(1) ? 4 : 8)) + (7 + 2) + (8 + (IS_F8(3) ? 4 : 8)) + 1;

DI gws launder(unsigned char* p) { asm volatile("" : "+s"(p)); return (gws)p; }
DI gcf inp(const Args& a, int i) { asm volatile("" : "+s"(i)); return (gcf)a.in[i]; }
#define WSP(T, off) ((GAS T*)(ws + (off)))
#define WSG(T, off) ((T*)((unsigned char*)ws + (off)))

__global__ void __launch_bounds__(NTHR, 2) mk_fwd(Args args) {
    extern __shared__ __attribute__((aligned(16))) unsigned char lds_raw[];
    LAS unsigned char* lds = (LAS unsigned char*)lds_raw;
    const int tid0 = threadIdx.x, wg0 = blockIdx.x, G0 = gridDim.x;
    for (int u = tid0; u < (LDS_BYTES - RING_BYTES) / 4; u += NTHR) ((LAS unsigned*)(lds + RING_BYTES))[u] = 0u;
    __syncthreads();
    const XcdBarrier bar = xcd_barrier_post((unsigned*)(args.ws + WS_CTL) + CW_BAR, (volatile LAS unsigned*)(lds + MISC_OFF) + 8);
    const int lo = args.ph_lo, hi = args.ph_hi;
#define XOUT ((gf)args.out)
    int pi = 0;
#define PH_IDS int tid = (bar.w0 << 6) | hw_lane(); asm volatile("" : "+v"(tid)); const int lane = tid & 63, wave = __builtin_amdgcn_readfirstlane(tid >> 6); int wg = wg0, G = G0; asm volatile("" : "+s"(wg), "+s"(G))
#define PH_ON (pi >= lo && pi < hi)
#define PH_END do { if (pi >= lo && pi + 1 < hi) xcd_barrier(bar); ++pi; } while (0)

    if (PH_ON) { gws ws = launder(args.ws); PH_IDS;
        p0_prologue(inp(args, I_C), inp(args, I_WMOD), inp(args, I_BMOD), inp(args, I_HGAM), inp(args, I_POOLW), inp(args, I_LWA), inp(args, I_LWX), inp(args, I_SGUW), ws, lds, wg, G, tid, wave, lane); }
    PH_END;

    for (int l = 0; l < DEPTH; ++l) {
        const int moe = l & 1;
        if (PH_ON) { gws ws = launder(args.ws); PH_IDS; gcf modl = WSP(float, WS_MOD) + (size_t)l * 8 * MODW;
            convert_weights(l, inp(args, I_WIN), inp(args, I_WOUT), inp(args, I_F1), inp(args, I_F3), inp(args, I_F2), inp(args, I_M1), inp(args, I_M3), inp(args, I_M2), ws, lds, wg, G, wave, lane);
            if (l == 2) norm_phase<true, false, false, false, (bool)IS_B8(2)>(nullptr, WSP(bf16, WS_XB), nullptr, inp(args, I_NMIX) + l * D, modl + 0 * D, modl + 1 * D, modl - 8 * MODW + 5 * D, WSP(bf16, WS_XN), WSP(bf16, WS_Y1), IS_B8(2) ? WSP(bf16, WS_CAT) : WSP(bf16, WS_XN), nullptr, nullptr, nullptr, nullptr, nullptr, nullptr, lds, wg, G, tid, wave, lane);
            else if (l == 0) norm_phase<false, false, false, true>(inp(args, I_X), WSP(bf16, WS_XB), nullptr, inp(args, I_NMIX) + l * D, modl + 0 * D, modl + 1 * D, nullptr, nullptr, nullptr, WSP(bf16, WS_XN), nullptr, nullptr, nullptr, nullptr, nullptr, nullptr, lds, wg, G, tid, wave, lane);
            else if (IS_B8(l)) norm_phase<false, false, false, false, true>(nullptr, WSP(bf16, WS_XB), nullptr, inp(args, I_NMIX) + l * D, modl + 0 * D, modl + 1 * D, nullptr, nullptr, nullptr, WSP(bf16, WS_XN), nullptr, nullptr, nullptr, nullptr, nullptr, nullptr, lds, wg, G, tid, wave, lane);
            else norm_phase<false, false, false, false>(nullptr, WSP(bf16, WS_XB), nullptr, inp(args, I_NMIX) + l * D, modl + 0 * D, modl + 1 * D, nullptr, nullptr, nullptr, WSP(bf16, WS_XN), nullptr, nullptr, nullptr, nullptr, nullptr, nullptr, lds, wg, G, tid, wave, lane);
        }
        PH_END;
        if (PH_ON && !IS_B8(l)) { gws ws = launder(args.ws); PH_IDS;
            pg8::Gemm g{WSG(bf16, WS_XN), WSG(bf16, WS_WIN), D}; pg8::TileOrder<INW / 256> S; S.init(M / 256, G, wg, 0, 0, nullptr);
            EpiProj E{WSP(bf16, WS_PROJ), 1.0f};
            pg8::gemm_phase<EpiProj, pg8::TileOrder<INW / 256>, true, true>(lds, g, S, E, tid);
        }
        if (PH_ON && IS_B8(l)) { gws ws = launder(args.ws); PH_IDS;
            pg8::Gemm g{l == 2 ? WSG(bf16, WS_CAT) : WSG(bf16, WS_XN), WSG(bf16, WS_WIN), D / 2}; pg8::TileOrder<INW / 256> S; S.init(M / 256, G, wg, 0, 0, nullptr);
            EpiProj E{WSP(bf16, WS_PROJ), 1.0f / F8_S13};
            pg8::gemm_phase<EpiProj, pg8::TileOrder<INW / 256>, true, true, true>(lds, g, S, E, tid);
        }
        PH_END;
        if (PH_ON) { gws ws = launder(args.ws); PH_IDS; gcb PROJ = WSP(bf16, WS_PROJ); gb CAT = WSP(bf16, WS_CAT);
            for (int unit = wg; unit < BATCH * NCH; unit += G) { const int b = unit >> 6, blk = unit & (NCH - 1);
                pool_unit(PROJ, CAT, WSP(bf16, WS_POOLWT) + l * 16384, inp(args, I_POOLS) + l * GWD, inp(args, I_POOLN) + l * GWD, lds, b, blk * CH, tid, wave, lane);
                sgu_unit(PROJ, CAT, WSP(bf16, WS_SGUW) + l * 65536, inp(args, I_SGUB) + l * 512, inp(args, I_SGUN) + l * GWD, lds, b, blk * CH, tid, wave, lane);
                lru_local_unit(PROJ, inp(args, I_CONVW) + l * 4 * GWD, inp(args, I_CONVB) + l * GWD, inp(args, I_LBA) + l * GWD, inp(args, I_LBX) + l * GWD, inp(args, I_LAM) + l * GWD,
                               WSP(bf16, WS_LRUWAT) + l * 16384, WSP(bf16, WS_LRUWXT) + l * 16384, WSP(float, WS_AGG), WSP(unsigned, WS_LAB), lds, b, blk, tid, wave, lane);
                __syncthreads(); }
            for (int u = wg * NWAVES + wave; u < BATCH * NCH * 4; u += G * NWAVES)
                hgrn_wave_unit<false>(PROJ, CAT, WSP(float, WS_LB) + l * GWD, inp(args, I_HN) + l * GWD, WSP(float, WS_ST), WSP(float, WS_DEC), (LAS float*)(lds + wave * 16384), u, lane);
        }
        PH_END;
        if (PH_ON) { gws ws = launder(args.ws); PH_IDS; carry_phase(WSP(float, WS_ST), WSP(float, WS_DEC), WSP(float, WS_AGG), WSP(float, WS_H0), wg, G, tid); }
        PH_END;
        if (PH_ON) { gws ws = launder(args.ws); PH_IDS; gcb PROJ = WSP(bf16, WS_PROJ); gb CAT = WSP(bf16, WS_CAT);
            for (int unit = wg; unit < BATCH * NCH; unit += G) { const int b = unit >> 6, blk = unit & (NCH - 1);
                lru_out_unit(PROJ, CAT, inp(args, I_LN) + l * GWD, WSP(float, WS_H0), WSP(unsigned, WS_LAB), lds, b, blk, tid, wave, lane); }
            __syncthreads();
            for (int u = wg * NWAVES + wave; u < BATCH * NCH * 4; u += G * NWAVES)
                hgrn_wave_unit<true>(PROJ, CAT, WSP(float, WS_LB) + l * GWD, inp(args, I_HN) + l * GWD, WSP(float, WS_ST), WSP(float, WS_DEC), (LAS float*)(lds + wave * 16384), u, lane);
        }
        PH_END;
        if (PH_ON) { gws ws = launder(args.ws); PH_IDS;
            pg8::Gemm g{WSG(bf16, WS_CAT), WSG(bf16, WS_WOUT), D}; pg8::TileOrder<D / 256> S; S.init(M / 256, G, wg, 0, 0, nullptr);
            EpiResid E{WSP(bf16, WS_XB), WSP(float, WS_MOD) + (size_t)l * 8 * MODW + 2 * D, 1.0f};
            pg8::gemm_phase<EpiResid, pg8::TileOrder<D / 256>, true, true>(lds, g, S, E, tid);
        }
        PH_END;
        if (PH_ON) { gws ws = launder(args.ws); PH_IDS; gcf modl = WSP(float, WS_MOD) + (size_t)l * 8 * MODW;
            if (moe) norm_phase<false, true, false, false, MOE_XN8>(nullptr, WSP(bf16, WS_XB), nullptr, inp(args, I_NFFN) + l * D, modl + 3 * D, modl + 4 * D, nullptr, nullptr, nullptr, WSP(bf16, WS_XN), inp(args, I_RW) + (l >> 1) * D * NE, inp(args, I_RB) + (l >> 1) * NE,
                                                    WSP(int, WS_TOKE), WSP(float, WS_TOKW), WSP(int, WS_HISTW), WSP(v2i, WS_PAIR), lds, wg, G, tid, wave, lane);
            else if (IS_F8(l)) norm_phase<false, false, false, false, true>(nullptr, WSP(bf16, WS_XB), nullptr, inp(args, I_NFFN) + l * D, modl + 3 * D, modl + 4 * D, nullptr, nullptr, nullptr, WSP(bf16, WS_XN), nullptr, nullptr, nullptr, nullptr, nullptr, nullptr, lds, wg, G, tid, wave, lane);
            else norm_phase<false, false, false, false>(nullptr, WSP(bf16, WS_XB), nullptr, inp(args, I_NFFN) + l * D, modl + 3 * D, modl + 4 * D, nullptr, nullptr, nullptr, WSP(bf16, WS_XN), nullptr, nullptr, nullptr, nullptr, nullptr, nullptr, lds, wg, G, tid, wave, lane);
        }
        PH_END;
        if (moe) {
            if (PH_ON) { gws ws = launder(args.ws); PH_IDS;
                    route_phase(WSP(bf16, WS_XN), WSP(bf16, WS_PROJ), WSP(int, WS_TOKE), WSP(float, WS_TOKW), WSP(int, WS_HISTW), WSP(v2i, WS_PAIR), WSP(int, WS_TILEE), WSP(int, WS_NT), lds, wg, G, tid, wave, lane, IS_F8(l)); }
            PH_END;
        }
        const int nck = moe ? (IS_F8(l) ? 2 : 4) : 1;
#define FFN_RANGE int pm0 = 0, nM = M / 256; if (moe) { const int ntl = __builtin_amdgcn_readfirstlane(__hip_atomic_load(WSP(int, WS_NT), __ATOMIC_RELAXED, __HIP_MEMORY_SCOPE_AGENT)); \
            if (IS_F8(l)) { pm0 = ck * 256; nM = (ck < 1) ? 256 : ntl - 256; if (nM > 292) nM = 292; } else { pm0 = ck * 128; nM = (ck < 3) ? 128 : ntl - 384; if (nM > 146) nM = 146; } if (nM < 0) nM = 0; }
        for (int ck = 0; ck < nck; ++ck) {
            if (PH_ON && !IS_F8(l)) { gws ws = launder(args.ws); PH_IDS; FFN_RANGE;
                pg8::Gemm g{moe ? WSG(bf16, WS_PROJ) : WSG(bf16, WS_XN), WSG(bf16, WS_W13), D}; pg8::TileOrder<DFF / 128> S; S.init(nM, G, wg, pm0, 0, moe ? WSG(int, WS_TILEE) : nullptr);
                EpiSwiglu E{moe ? WSP(bf16, WS_CAT) : WSP(bf16, WS_PROJ), pm0};
                pg8::gemm_phase<EpiSwiglu, pg8::TileOrder<DFF / 128>, true, true>(lds, g, S, E, tid);
            }
            if (PH_ON && IS_F8(l)) { gws ws = launder(args.ws); PH_IDS; FFN_RANGE;
                pg8::Gemm g{moe ? WSG(bf16, WS_PROJ) : WSG(bf16, WS_XN), WSG(bf16, WS_W13), D / 2}; pg8::TileOrder<DFF / 128> S; S.init(nM, G, wg, pm0, 0, moe ? WSG(int, WS_TILEE) : nullptr);
                EpiSwiglu8 E{moe ? WSP(unsigned char, WS_CAT) : WSP(unsigned char, WS_PROJ), pm0};
                pg8::gemm_phase<EpiSwiglu8, pg8::TileOrder<DFF / 128>, true, true, true>(lds, g, S, E, tid);
            }
            PH_END;
            if (PH_ON && !IS_F8(l) && moe) { gws ws = launder(args.ws); PH_IDS; FFN_RANGE;
                pg8::Gemm g{WSG(bf16, WS_CAT), WSG(bf16, WS_W2), DFF}; pg8::TileOrder<D / 256> S; S.init(nM, G, wg, pm0, 1, WSG(int, WS_TILEE));
                EpiScatter E{WSP(v2i, WS_PAIR), WSP(bf16, WS_XN), WSP(bf16, WS_Y1), WSP(int, WS_TOKE), WSP(float, WS_TOKW), 1.0f};
                pg8::gemm_phase<EpiScatter, pg8::TileOrder<D / 256>, true, true>(lds, g, S, E, tid);
            }
            if (PH_ON && !moe && !IS_F8(l)) { gws ws = launder(args.ws); PH_IDS; FFN_RANGE;
                pg8::Gemm g{WSG(bf16, WS_PROJ), WSG(bf16, WS_W2), DFF}; pg8::TileOrder<D / 256> S; S.init(nM, G, wg, pm0, 1, nullptr);
                EpiResid E{WSP(bf16, WS_XB), WSP(float, WS_MOD) + (size_t)l * 8 * MODW + 5 * D, 1.0f};
                pg8::gemm_phase<EpiResid, pg8::TileOrder<D / 256>, true, true>(lds, g, S, E, tid);
            }
            if (PH_ON && IS_F8(l) && !moe) { gws ws = launder(args.ws); PH_IDS; FFN_RANGE;
                pg8::Gemm g{WSG(bf16, WS_PROJ), WSG(bf16, WS_W2), DFF / 2}; pg8::TileOrder<D / 256> S; S.init(nM, G, wg, pm0, 1, nullptr);
                EpiResid E{WSP(bf16, WS_XB), WSP(float, WS_MOD) + (size_t)l * 8 * MODW + 5 * D, 1.0f / F8_S2};
                pg8::gemm_phase<EpiResid, pg8::TileOrder<D / 256>, true, true, true>(lds, g, S, E, tid);
            }
            if (PH_ON && IS_F8(l) && moe) { gws ws = launder(args.ws); PH_IDS; FFN_RANGE;
                pg8::Gemm g{WSG(bf16, WS_CAT), WSG(bf16, WS_W2), DFF / 2}; pg8::TileOrder<D / 256> S; S.init(nM, G, wg, pm0, 1, WSG(int, WS_TILEE));
                EpiScatter E{WSP(v2i, WS_PAIR), WSP(bf16, WS_XN), WSP(bf16, WS_Y1), WSP(int, WS_TOKE), WSP(float, WS_TOKW), 1.0f / F8_S2};
                pg8::gemm_phase<EpiScatter, pg8::TileOrder<D / 256>, true, true, true>(lds, g, S, E, tid);
            }
            PH_END;
        }
#undef FFN_RANGE
    }
    if (PH_ON) { gws ws = launder(args.ws); PH_IDS;
        norm_phase<true, false, true, false>(nullptr, WSP(bf16, WS_XB), XOUT, inp(args, I_NFIN), nullptr, nullptr, WSP(float, WS_MOD) + (size_t)3 * 8 * MODW + 5 * D, WSP(bf16, WS_XN), WSP(bf16, WS_Y1), nullptr, nullptr, nullptr, nullptr, nullptr, nullptr, nullptr, lds, wg, G, tid, wave, lane); }
#undef PH_ON
#undef PH_END
}

#ifndef MK_CUTS
#define MK_CUTS 0
#endif
extern "C" void kernel_launch(void* const* d_in, gci in_sizes, int n_in, void* d_out, int out_size, void* d_ws, size_t ws_size, hipStream_t stream) {
    static int grid = 0;
    if (grid == 0) {
        if (n_in != 33 || in_sizes[0] != M * D || out_size != M * D || ws_size < WS_END) { fprintf(stderr, "kernel_launch: unexpected shapes (n_in %d, in0 %d, out %d, ws %zu); nothing launched\n", n_in, n_in > 0 ? in_sizes[0] : -1, out_size, ws_size); grid = -1; return; }
        int dev = 0, cus = 0, per_cu = 0;
        if (hipGetDevice(&dev) != hipSuccess || hipDeviceGetAttribute(&cus, hipDeviceAttributeMultiprocessorCount, dev) != hipSuccess) { grid = -1; return; }
        if (hipFuncSetAttribute((const void*)mk_fwd, hipFuncAttributeMaxDynamicSharedMemorySize, LDS_BYTES) != hipSuccess) { fprintf(stderr, "kernel_launch: hipFuncSetAttribute failed\n"); grid = -1; return; }
        if (hipOccupancyMaxActiveBlocksPerMultiprocessor(&per_cu, (const void*)mk_fwd, NTHR, LDS_BYTES) != hipSuccess || per_cu < 1) fprintf(stderr, "kernel_launch: occupancy query reports %d workgroups per CU\n", per_cu);
        (void)hipGetLastError();
        grid = cus;
    }
    if (grid < 0) return;
    if (hipMemsetAsync((char*)d_ws + WS_CTL, 0, CTL_ZERO_BYTES, stream) != hipSuccess) return;
    Args a{};
    for (int i = 0; i < 33; ++i) a.in[i] = (const float*)d_in[i];
    a.out = (float*)d_out; a.ws = (unsigned char*)d_ws;
#if MK_CUTS
    for (int p = 0; p < N_PHASES; ++p) { a.ph_lo = p; a.ph_hi = p + 1; hipLaunchKernelGGL(mk_fwd, dim3(grid), dim3(NTHR), LDS_BYTES, stream, a); }
#else
    a.ph_lo = 0; a.ph_hi = N_PHASES;
    hipLaunchKernelGGL(mk_fwd, dim3(grid), dim3(NTHR), LDS_BYTES, stream, a);
#endif
}
```

```cpp
#include <hip/hip_runtime.h>
#include <cstdio>
#include <cstdint>

namespace pg8 {
#define PG8_LAS __attribute__((address_space(3)))
typedef unsigned short bf16_t;
typedef short bf16x8 __attribute__((ext_vector_type(8)));
typedef float f32x4 __attribute__((ext_vector_type(4)));
typedef unsigned u32x4 __attribute__((ext_vector_type(4)));
constexpr int BM = 256, BK = 64, HALF = 128, HTB = HALF * BK * 2  , STAGE_BYTES = 8 * HTB, NXCD = 8, WGM = 8;

__host__ __device__ __forceinline__ int lds_byte(int r, int c) { const int st = (r >> 4) * 2 + (c >> 5), rr = r & 15, cc = c & 31, ob = rr * 64 + cc * 2; return st * 1024 + (ob ^ (((ob >> 9) & 1) << 5)); }
__host__ __device__ __forceinline__ void stage_rc(int b, int& R, int& C) { const int st = b / 1024, sb = b % 1024, swz = sb ^ (((sb >> 9) & 1) << 5); R = (st >> 1) * 16 + swz / 64; C = (st & 1) * 32 + (swz % 64) / 2; }
__host__ __device__ __forceinline__ int perm32(int rho) { const int n = rho >> 4, i = rho & 15; return 8 * (i >> 2) + 4 * n + (i & 3); }

struct Unit { int pa, pn, pm, pc; };
struct Gemm { const bf16_t* A; const bf16_t* Bt; int K; };

template <int NN>
struct TileOrder {
    int nM, nwg, G, c, pm0, a_rel; const int* tile_e;
    __device__ __forceinline__ void init(int nM_, int G_, int c_, int pm0_, int a_rel_, const int* te) { nM = nM_; nwg = nM_ * NN; G = G_; c = c_; pm0 = pm0_; a_rel = a_rel_; tile_e = te; }
    __device__ __forceinline__ bool next(int i, Unit& u) const {
        const int L = i * G + c; if (L >= nwg) return false;
        int wgid = L; { const int q = nwg >> 3, r = nwg & 7, xcd = wgid & 7, off = wgid >> 3; wgid = (xcd < r ? xcd * (q + 1) : r * (q + 1) + (xcd - r) * q) + off; }
        constexpr int nig = WGM * NN;
        const int gid = wgid / nig, x = wgid - gid * nig, fm = gid * WGM, rem = nM - fm;
        int pml, pc;
        if (rem >= WGM) { pml = fm + (x & (WGM - 1)); pc = x >> 3; } else { pml = fm + (x % rem); pc = x / rem; }
        u.pm = pm0 + pml; u.pc = pc; u.pa = a_rel ? pml : u.pm;
        int e = 0; if (tile_e) e = __builtin_amdgcn_readfirstlane(__hip_atomic_load(tile_e + u.pm, __ATOMIC_RELAXED, __HIP_MEMORY_SCOPE_AGENT));
        u.pn = e * NN + pc; return true;
    }
    __device__ __forceinline__ void a_ready(const Unit&) const {}
    __device__ __forceinline__ void done(const Unit&) const {}
};
typedef int v8i32 __attribute__((ext_vector_type(8)));
typedef int v4i32 __attribute__((ext_vector_type(4)));
__device__ __forceinline__ unsigned cvt_pk_bf16(float lo, float hi) { unsigned r; asm("v_cvt_pk_bf16_f32 %0, %1, %2" : "=v"(r) : "v"(lo), "v"(hi)); return r; }

template <class Epi, class Sched, bool ALIGN_EPI = false, bool SP2 = false, bool F8 = false>
__device__ __forceinline__ void gemm_phase(PG8_LAS unsigned char* lds, const Gemm g, const Sched& S, const Epi& E, const int tid_in) {
    int tid = tid_in; asm volatile("" : "+v"(tid));
    const int wid = __builtin_amdgcn_readfirstlane(tid >> 6), lane = tid & 63, wr = wid >> 2, wc = wid & 3, fr = lane & 15, fq = lane >> 4;
    const int K = g.K, nt = K / BK;
    unsigned voffA[2], voffB[2];
#pragma unroll
    for (int i = 0; i < 2; ++i) { int R, C; stage_rc(tid * 16 + i * 8192, R, C); const int Rb = Epi::PERM ? ((R & ~31) + perm32(R & 31)) : R;
        voffA[i] = (unsigned)(R * K + C) * 2u; voffB[i] = (unsigned)(Rb * K + C) * 2u; }
    const size_t kstep = (size_t)(BK * 2);
    const size_t hstep = (size_t)HALF * K * 2;
    const size_t tstep = 2 * hstep;
    const unsigned ldsw = (unsigned)wid * 1024u;
    const int aoff = lds_byte(wr * 64 + fr, fq * 8), boff = lds_byte(wc * 32 + fr, fq * 8);
#define PG8_SA(b, h) (((b) * 2 + (h)) * HTB)
#define PG8_SB(b, h) ((4 + (b) * 2 + (h)) * HTB)
#define PG8_STAGE(bufoff, gbase, voff) do { _Pragma("unroll") for (int _i = 0; _i < 2; ++_i) \
        __builtin_amdgcn_global_load_lds((const unsigned*)((const char*)(gbase) + (voff)[_i]), (PG8_LAS unsigned*)(lds + (bufoff) + ldsw + _i * 8192), 16, 0, 0); } while (0)
#define PG8_LD16(off_) (*(const PG8_LAS v4i32*)(lds + (off_)))
#define PG8_LDA(dst, b, h) do { _Pragma("unroll") for (int m = 0; m < 4; ++m) { if constexpr (F8) dst##8[m] = __builtin_shufflevector(PG8_LD16(PG8_SA(b, h) + aoff + m * 2048), PG8_LD16(PG8_SA(b, h) + aoff + m * 2048 + 1024), 0, 1, 2, 3, 4, 5, 6, 7); \
        else { _Pragma("unroll") for (int k = 0; k < 2; ++k) dst[m][k] = *(const PG8_LAS bf16x8*)(lds + PG8_SA(b, h) + aoff + m * 2048 + k * 1024); } } } while (0)
#define PG8_LDB(dst, b, h) do { _Pragma("unroll") for (int n = 0; n < 2; ++n) { if constexpr (F8) dst##8[n] = __builtin_shufflevector(PG8_LD16(PG8_SB(b, h) + boff + n * 2048), PG8_LD16(PG8_SB(b, h) + boff + n * 2048 + 1024), 0, 1, 2, 3, 4, 5, 6, 7); \
        else { _Pragma("unroll") for (int k = 0; k < 2; ++k) dst[n][k] = *(const PG8_LAS bf16x8*)(lds + PG8_SB(b, h) + boff + n * 2048 + k * 1024); } } } while (0)
#define PG8_MMA(ai, bj, At, Bt, FIRST) do { __builtin_amdgcn_s_setprio(1); _Pragma("unroll") for (int m = 0; m < 4; ++m) _Pragma("unroll") for (int n = 0; n < 2; ++n) { \
        if constexpr (F8) { if constexpr (FIRST) asm volatile("v_mfma_scale_f32_16x16x128_f8f6f4 %0, %1, %2, 0, %3, %3 op_sel_hi:[0,0,0]" : "=&v"(acc[ai][bj][m][n]) : "v"(Bt##8[n]), "v"(At##8[m]), "v"(f8scale)); \
            else asm volatile("v_mfma_scale_f32_16x16x128_f8f6f4 %0, %1, %2, %0, %3, %3 op_sel_hi:[0,0,0]" : "+v"(acc[ai][bj][m][n]) : "v"(Bt##8[n]), "v"(At##8[m]), "v"(f8scale)); } \
        else { acc[ai][bj][m][n] = __builtin_amdgcn_mfma_f32_16x16x32_bf16(Bt[n][0], At[m][0], acc[ai][bj][m][n], 0, 0, 0); \
            acc[ai][bj][m][n] = __builtin_amdgcn_mfma_f32_16x16x32_bf16(Bt[n][1], At[m][1], acc[ai][bj][m][n], 0, 0, 0); } } __builtin_amdgcn_s_setprio(0); } while (0)
#define PG8_WAIT_V(n) asm volatile("s_waitcnt vmcnt(" #n ")" ::: "memory")
#define PG8_WAIT_L(n) asm volatile("s_waitcnt lgkmcnt(" #n ")" ::: "memory")
#define PG8_BAR __builtin_amdgcn_s_barrier()
#define PG8_SCHED __builtin_amdgcn_sched_barrier(0)
    Unit cur, nxt; int ui = 0;
    if (!S.next(0, cur)) return;
    f32x4 acc[2][2][4][2];
    if constexpr (!F8) {
#pragma unroll
    for (int a = 0; a < 2; ++a)
#pragma unroll
        for (int b = 0; b < 2; ++b)
#pragma unroll
            for (int m = 0; m < 4; ++m)
#pragma unroll
                for (int n = 0; n < 2; ++n) acc[a][b][m][n] = (f32x4){0.f, 0.f, 0.f, 0.f};
    }
    bf16x8 At[4][2], B0[2][2], B1[2][2];
    const int f8scale = 0x7f7f7f7f;
    v8i32 At8[4], B08[2], B18[2];
    const char* cA = (const char*)g.A + (size_t)cur.pa * tstep; const char* cB = (const char*)g.Bt + (size_t)cur.pn * tstep;
    S.a_ready(cur);
    {
        PG8_STAGE(PG8_SB(0, 0), cB, voffB); PG8_STAGE(PG8_SB(0, 1), cB + hstep, voffB); PG8_STAGE(PG8_SA(0, 0), cA, voffA); PG8_STAGE(PG8_SA(0, 1), cA + hstep, voffA);
        if (wr == 1) PG8_BAR;
        PG8_WAIT_V(2); PG8_BAR;
        PG8_STAGE(PG8_SB(1, 0), cB + kstep, voffB); PG8_STAGE(PG8_SA(1, 0), cA + kstep, voffA); PG8_STAGE(PG8_SB(1, 1), cB + hstep + kstep, voffB);
        PG8_WAIT_V(6); PG8_BAR;
    }
    for (;;) {
        const bool has_next = S.next(ui + 1, nxt);
        const char* nA = has_next ? (const char*)g.A + (size_t)nxt.pa * tstep : cA; const char* nB = has_next ? (const char*)g.Bt + (size_t)nxt.pn * tstep : cB;
#define PG8_MMA_F(ai, bj, At, Bt) do { if (F8 && t == 0) PG8_MMA(ai, bj, At, Bt, true); else PG8_MMA(ai, bj, At, Bt, false); } while (0)
#pragma nounroll
        for (int t = 0; t < nt; t += 2) {
            const bool last = (t == nt - 2);
            const char* a1 = cA + (size_t)(t + 1) * kstep;
            const char* a2 = last ? nA : cA + (size_t)(t + 2) * kstep; const char* b2 = last ? nB : cB + (size_t)(t + 2) * kstep;
            const char* a3 = a2 + kstep; const char* b3 = b2 + kstep;
            if (last && has_next) S.a_ready(nxt);
            PG8_LDB(B0, 0, 0); PG8_LDB(B1, 0, 1); PG8_SCHED; PG8_LDA(At, 0, 0); PG8_STAGE(PG8_SA(1, 1), a1 + hstep, voffA);
            PG8_WAIT_V(8); PG8_WAIT_L(0); PG8_BAR; PG8_MMA_F(0, 0, At, B0); PG8_MMA_F(0, 1, At, B1); PG8_BAR; PG8_SCHED;
            PG8_LDA(At, 0, 1); PG8_STAGE(PG8_SB(0, 0), b2, voffB); PG8_STAGE(PG8_SB(0, 1), b2 + hstep, voffB); PG8_STAGE(PG8_SA(0, 0), a2, voffA);
            PG8_WAIT_V(8); PG8_WAIT_L(0); PG8_BAR; PG8_MMA_F(1, 0, At, B0); PG8_MMA_F(1, 1, At, B1); PG8_BAR; PG8_SCHED;
            PG8_LDB(B0, 1, 0); PG8_LDB(B1, 1, 1); PG8_SCHED; PG8_LDA(At, 1, 0); PG8_STAGE(PG8_SA(0, 1), a2 + hstep, voffA);
            PG8_WAIT_V(8); PG8_WAIT_L(0); PG8_BAR; PG8_MMA(0, 0, At, B0, false); PG8_MMA(0, 1, At, B1, false); PG8_BAR; PG8_SCHED;
            PG8_LDA(At, 1, 1); PG8_STAGE(PG8_SB(1, 0), b3, voffB); PG8_STAGE(PG8_SB(1, 1), b3 + hstep, voffB); PG8_STAGE(PG8_SA(1, 0), a3, voffA);
            PG8_WAIT_V(8); PG8_WAIT_L(0); PG8_BAR; PG8_MMA(1, 0, At, B0, false); PG8_MMA(1, 1, At, B1, false); PG8_BAR; PG8_SCHED;
        }
#undef PG8_MMA_F
        if constexpr (ALIGN_EPI) { if (wr == 0) PG8_BAR; }
        if constexpr (F8) asm volatile("s_nop 15\n\ts_nop 15" ::: "memory");
        if constexpr (!Epi::AFTER_DRAIN) { E(acc, cur, wr, wc, fr, fq); S.done(cur); }
        if (!has_next) break;
        if constexpr (!F8) {
#pragma unroll
        for (int a = 0; a < 2; ++a)
#pragma unroll
            for (int b = 0; b < 2; ++b)
#pragma unroll
                for (int m = 0; m < 4; ++m)
#pragma unroll
                    for (int n = 0; n < 2; ++n) acc[a][b][m][n] = (f32x4){0.f, 0.f, 0.f, 0.f};
        }
        cur = nxt; cA = nA; cB = nB; ++ui;
        if constexpr (ALIGN_EPI) { if (wr == 1) PG8_BAR; }
    }
    PG8_WAIT_V(0);
    if constexpr (!ALIGN_EPI) { if (wr == 0) PG8_BAR; }
    PG8_BAR;
    if constexpr (Epi::AFTER_DRAIN) { E.fused(acc, cur, wr, wc, fr, fq, lds, wid, lane); S.done(cur); }
#undef PG8_SA
#undef PG8_SB
#undef PG8_STAGE
#undef PG8_LDA
#undef PG8_LD16
#undef PG8_LDB
#undef PG8_MMA
#undef PG8_WAIT_V
#undef PG8_WAIT_L
#undef PG8_BAR
#undef PG8_SCHED
}
}

constexpr int NWAVES = 8, NTHR = NWAVES * 64;
constexpr int BATCH = 8, SEQ = 8192, D = 1024, M = BATCH * SEQ, DEPTH = 4, GWD = 256, INW = 2304, DFF = 3584, NE = 8;
constexpr float EPS = 1e-6f;
constexpr int MODW = 6 * D;
constexpr int CH = 128, NCH = SEQ / CH;
#ifndef F8_MASK
#define F8_MASK 0xE
#endif
#ifndef B8_MASK
#define B8_MASK 0xC
#endif
#define IS_B8(l_) (((B8_MASK) >> (l_)) & 1)
#define IS_F8(l_) (((F8_MASK) >> (l_)) & 1)
constexpr int F8_LAYER = 3;
constexpr float F8_S13 = 32.f, F8_S2 = 64.f;
constexpr bool MOE_XN8 = ((F8_MASK >> 1) & 1) && ((F8_MASK >> 3) & 1);
constexpr int MAXPAIR = 2 * M + NE * 256;

constexpr size_t MiB = 1u << 20;
constexpr size_t WS_CTL = 0, CTL_ZERO_BYTES = 1 * MiB;
constexpr size_t WS_MOD = 1 * MiB;
constexpr size_t WS_LB = WS_MOD + 786432;
constexpr size_t WS_POOLWT = 2 * MiB;
constexpr size_t WS_LRUWAT = WS_POOLWT + 131072;
constexpr size_t WS_LRUWXT = WS_LRUWAT + 131072;
constexpr size_t WS_SGUW = 3 * MiB;
constexpr size_t WS_TOKE = 4 * MiB;
constexpr size_t WS_TOKW = WS_TOKE + 262144;
constexpr size_t WS_HISTW = 5 * MiB;
constexpr size_t WS_TILEE = WS_HISTW + 65536;
constexpr size_t WS_NT = WS_TILEE + 4096;
constexpr size_t WS_PAIR = 6 * MiB;
constexpr size_t WS_AGG = 8 * MiB;
constexpr size_t WS_H0 = 9 * MiB;
constexpr size_t WS_DEC = 10 * MiB;
constexpr size_t WS_W = 16 * MiB;
constexpr size_t WS_WIN = WS_W, WS_WOUT = WS_W + 5 * MiB, WS_W13 = WS_W + 8 * MiB, WS_W2 = WS_W + 120 * MiB;
constexpr size_t WS_XN = 192 * MiB;
constexpr size_t WS_PROJ = 320 * MiB;
constexpr size_t WS_CAT = 608 * MiB;
constexpr size_t WS_ST = 736 * MiB;
constexpr size_t WS_LAB = 768 * MiB;
constexpr size_t WS_Y1 = 864 * MiB;
constexpr size_t WS_XB = 992 * MiB;
constexpr size_t WS_END = 1120 * MiB;
constexpr int CW_BAR = 4096;
constexpr int CW_ZT = 16384;
constexpr int RING_BYTES = 131072, MISC_OFF = RING_BYTES + 320, LDS_BYTES = 147456;

#define DI __device__ __forceinline__
#define LAS __attribute__((address_space(3)))
typedef unsigned short bf16;
typedef unsigned v4u __attribute__((ext_vector_type(4)));
typedef unsigned v2u __attribute__((ext_vector_type(2)));
typedef int v4i __attribute__((ext_vector_type(4)));
typedef int v2i __attribute__((ext_vector_type(2)));
typedef float f32x4 __attribute__((ext_vector_type(4)));
typedef float f32x2 __attribute__((ext_vector_type(2)));
typedef short bf16x8 __attribute__((ext_vector_type(8)));
#define LDS_WAIT() asm volatile("s_waitcnt lgkmcnt(0)" ::: "memory")
#define GAS __attribute__((address_space(1)))
typedef GAS const float* gcf; typedef GAS float* gf; typedef GAS const bf16* gcb; typedef GAS bf16* gb; typedef GAS const int* gci; typedef GAS int* gi;
typedef GAS const v2i* gcv2i; typedef GAS v2i* gv2i; typedef GAS const unsigned* gcu; typedef GAS unsigned char* gws;

DI float bf2f(bf16 v) { return __builtin_bit_cast(float, (unsigned)v << 16); }
DI float lo_bf(unsigned w) { return __builtin_bit_cast(float, w << 16); }
DI float hi_bf(unsigned w) { return __builtin_bit_cast(float, w & 0xffff0000u); }
DI unsigned pk2(float lo, float hi) { return pg8::cvt_pk_bf16(lo, hi); }
DI bf16 f2bf(float f) { return (bf16)(pk2(f, 0.f) & 0xffffu); }
DI float sigm(float x) { return __builtin_amdgcn_rcpf(1.f + __expf(-x)); }
DI float siluf(float x) { return x * sigm(x); }
DI float gelu_t(float x) { return x * sigm(1.5957691216057308f * (x + 0.044715f * x * x * x)); }
DI float neg_expm1(float x) {
    const float p = -x * (1.f + x * (0.5f + x * (0.16666667f + x * (0.041666668f + x * (0.0083333338f + x * 0.0013888889f)))));
    return x > -0.25f ? p : 1.f - __expf(x);
}
DI float wave_sum(float v) {
#pragma unroll
    for (int o = 1; o < 64; o <<= 1) v += __shfl_xor(v, o);
    return v;
}
template <int D_> DI float row_shr0(float src) { return __builtin_bit_cast(float, __builtin_amdgcn_update_dpp(0, __builtin_bit_cast(int, src), 0x110 + D_, 0xf, 0xf, true)); }
DI float wave_sum_dpp(float v) {
    v += row_shr0<1>(v); v += row_shr0<2>(v); v += row_shr0<4>(v); v += row_shr0<8>(v);
    const int iv = __builtin_bit_cast(int, v);
    const float a = __builtin_bit_cast(float, __builtin_amdgcn_readlane(iv, 15)), b2 = __builtin_bit_cast(float, __builtin_amdgcn_readlane(iv, 31));
    const float c2 = __builtin_bit_cast(float, __builtin_amdgcn_readlane(iv, 47)), d2 = __builtin_bit_cast(float, __builtin_amdgcn_readlane(iv, 63));
    return (a + b2) + (c2 + d2);
}
DI int wave_sum_i(int v) {
#pragma unroll
    for (int o = 1; o < 64; o <<= 1) v += __shfl_xor(v, o);
    return v;
}
DI f32x4 ld4(gcf p) { return *(GAS const f32x4*)p; }
DI f32x4 ld4_nt(gcf p) { return __builtin_nontemporal_load((GAS const f32x4*)p); }
DI void unpack8(const v4u x, float (&o)[8]) { o[0] = lo_bf(x.x); o[1] = hi_bf(x.x); o[2] = lo_bf(x.y); o[3] = hi_bf(x.y); o[4] = lo_bf(x.z); o[5] = hi_bf(x.z); o[6] = lo_bf(x.w); o[7] = hi_bf(x.w); }
DI f32x4 unpack4(const v2u x) { return (f32x4){lo_bf(x.x), hi_bf(x.x), lo_bf(x.y), hi_bf(x.y)}; }
DI v2u pack4(const f32x4 v) { v2u r; r.x = pk2(v.x, v.y); r.y = pk2(v.z, v.w); return r; }
DI float clamp_f8(float v) { return __builtin_amdgcn_fmed3f(v, -448.f, 448.f); }
DI unsigned pk4_f8(float a, float b, float c, float d) { int r = __builtin_amdgcn_cvt_pk_fp8_f32(clamp_f8(a), clamp_f8(b), 0, false); r = __builtin_amdgcn_cvt_pk_fp8_f32(clamp_f8(c), clamp_f8(d), r, true); return (unsigned)r; }
DI f32x4 mfma16(const bf16x8 a, const bf16x8 b, const f32x4 c) { return __builtin_amdgcn_mfma_f32_16x16x32_bf16(a, b, c, 0, 0, 0); }

#define XB_TMO      128
#define XB_XCNT(j)  (256  + 64 * (j))
#define XB_XSUB(j)  (1280 + 64 * (j))
#define XB_XGEN(j)  (2304 + 64 * (j))
#define XB_TOP      3328
#define XB_TOPGEN   3392
#define XCD_BAR_WORDS 3456
#define XB_SPIN_CAP (1u << 18)
__device__ __forceinline__ unsigned xb_ld(unsigned* p)              { return __hip_atomic_load(p, __ATOMIC_RELAXED, __HIP_MEMORY_SCOPE_AGENT); }
__device__ __forceinline__ unsigned xb_add(unsigned* p, unsigned v) { return __hip_atomic_fetch_add(p, v, __ATOMIC_RELAXED, __HIP_MEMORY_SCOPE_AGENT); }
__device__ __forceinline__ unsigned xb_xcc_id() { return (unsigned)__builtin_amdgcn_s_getreg((3 << 11) | 20) & 0xFu; }
#define XB_SPIN(cond, bar) do { unsigned _sp = 0; while (cond) { __builtin_amdgcn_s_sleep(1); \
    if ((++_sp & 255u) == 0u) { if (xb_ld(&(bar)[XB_TMO])) break; if (_sp > XB_SPIN_CAP) { atomicAdd(&(bar)[XB_TMO], 1u); break; } } } } while (0)
DI int hw_lane() { int l; asm volatile("v_mbcnt_lo_u32_b32 %0, -1, 0\n\tv_mbcnt_hi_u32_b32 %0, -1, %0" : "=v"(l)); return l; }
struct XcdBarrier { unsigned* bar; unsigned x; volatile LAS unsigned* st; int w0; };
__device__ __forceinline__ XcdBarrier xcd_barrier_post(unsigned* bar, volatile LAS unsigned* st) {
    XcdBarrier b; b.bar = bar; b.x = xb_xcc_id(); b.st = st; b.w0 = __builtin_amdgcn_readfirstlane((int)threadIdx.x >> 6);
    if (threadIdx.x == 0) (void)xb_add(&bar[XB_XCNT(b.x)], 1u);
    return b;
}
__device__ __forceinline__ void xcd_barrier_complete(unsigned* bar, unsigned x, unsigned& nloc, unsigned& nx) {
    const unsigned G = gridDim.x * gridDim.y * gridDim.z;
    unsigned sum, cnt, mine, sp = 0u;
    for (;;) {
        sum = 0u; cnt = 0u; mine = 0u;
#pragma unroll
        for (unsigned j = 0; j < 16; ++j) { const unsigned c = xb_ld(&bar[XB_XCNT(j)]); sum += c; cnt += (c > 0u) ? 1u : 0u; mine = (j == x) ? c : mine; }
        if (sum == G) break;
        __builtin_amdgcn_s_sleep(1);
        if ((++sp & 255u) == 0u) { if (xb_ld(&bar[XB_TMO])) break; if (sp > XB_SPIN_CAP) { atomicAdd(&bar[XB_TMO], 1u); break; } }
    }
    nloc = mine > 0u ? mine : 1u; nx = cnt > 0u ? cnt : 1u;
}
__device__ __forceinline__ void xcd_barrier(const XcdBarrier& b) {
    asm volatile("s_waitcnt vmcnt(0)" ::: "memory");
    __syncthreads();
    if (b.w0 == 0 && hw_lane() == 0) {
        unsigned* bar = b.bar;
        __builtin_amdgcn_s_waitcnt(0);
        unsigned nloc = b.st[0], nx = b.st[1];
        if (nloc == 0u) { xcd_barrier_complete(bar, b.x, nloc, nx); b.st[0] = nloc; b.st[1] = nx; }
        const unsigned old = xb_add(&bar[XB_XSUB(b.x)], 1u);
        const unsigned gen = old / nloc;
        if (old + 1u == (gen + 1u) * nloc) {
            __builtin_amdgcn_fence(__ATOMIC_RELEASE, "agent");
            asm volatile("s_waitcnt vmcnt(0)" ::: "memory");
            const unsigned og = xb_add(&bar[XB_TOP], 1u);
            const unsigned tg = og / nx;
            if (og + 1u == (tg + 1u) * nx) xb_add(&bar[XB_TOPGEN], 1u);
            else XB_SPIN(xb_ld(&bar[XB_TOPGEN]) == tg, bar);
            __builtin_amdgcn_fence(__ATOMIC_ACQUIRE, "agent");
            xb_add(&bar[XB_XGEN(b.x)], 1u);
            asm volatile("s_waitcnt vmcnt(0)" ::: "memory");
        } else {
            XB_SPIN(xb_ld(&bar[XB_XGEN(b.x)]) == gen, bar);
            __builtin_amdgcn_fence(__ATOMIC_ACQUIRE, "agent");
            asm volatile("s_waitcnt vmcnt(0)" ::: "memory");
        }
    }
    __syncthreads();
}

struct EpiProj {
    static constexpr bool PERM = true, AFTER_DRAIN = false, IDEMPOTENT = true;
    gb O; float mul;
    DI void operator()(const f32x4 (&acc)[2][2][4][2], const pg8::Unit& u, int wr, int wc, int fr, int fq) const {
        const int row0 = u.pm * 256 + wr * 64 + fr, col0 = u.pc * 256 + wc * 32 + 8 * fq;
#pragma unroll
        for (int ai = 0; ai < 2; ++ai)
#pragma unroll
            for (int m = 0; m < 4; ++m) { gb rowp = O + (size_t)(row0 + ai * 128 + m * 16) * INW + col0;
#pragma unroll
                for (int bj = 0; bj < 2; ++bj) { const f32x4 v0 = acc[ai][bj][m][0] * mul, v1 = acc[ai][bj][m][1] * mul;
                    v4u w; w.x = pk2(v0[0], v0[1]); w.y = pk2(v0[2], v0[3]); w.z = pk2(v1[0], v1[1]); w.w = pk2(v1[2], v1[3]);
                    *(GAS v4u*)(rowp + bj * 128) = w; } }
    }
};
struct EpiResid {
    static constexpr bool PERM = true, AFTER_DRAIN = false, IDEMPOTENT = false;
    gb x; gcf gate; float mul;
    DI void operator()(const f32x4 (&acc)[2][2][4][2], const pg8::Unit& u, int wr, int wc, int fr, int fq) const {
        const int b = u.pm >> 5, row0 = u.pm * 256 + wr * 64 + fr, col0 = u.pc * 256 + wc * 32 + 8 * fq;
        f32x4 gv[2][2];
#pragma unroll
        for (int bj = 0; bj < 2; ++bj)
#pragma unroll
            for (int n = 0; n < 2; ++n) gv[bj][n] = ld4(gate + (size_t)b * MODW + col0 + bj * 128 + n * 4) * mul;
        constexpr int PF = 6;
        v4u xr[8][2];
#define ER_LOAD(p) _Pragma("unroll") for (int bj = 0; bj < 2; ++bj) xr[p][bj] = *(GAS const v4u*)(x + (size_t)(row0 + ((p) >> 2) * 128 + ((p) & 3) * 16) * D + col0 + bj * 128)
#pragma unroll
        for (int p = 0; p < PF; ++p) { ER_LOAD(p); }
#pragma unroll
        for (int p = 0; p < 8; ++p) { const int ai = p >> 2, m = p & 3;
#pragma unroll
            for (int bj = 0; bj < 2; ++bj) { float xv[8]; unpack8(xr[p][bj], xv);
                const f32x4 v0 = (f32x4){xv[0], xv[1], xv[2], xv[3]} + gv[bj][0] * acc[ai][bj][m][0], v1 = (f32x4){xv[4], xv[5], xv[6], xv[7]} + gv[bj][1] * acc[ai][bj][m][1];
                v4u o; o.x = pk2(v0[0], v0[1]); o.y = pk2(v0[2], v0[3]); o.z = pk2(v1[0], v1[1]); o.w = pk2(v1[2], v1[3]);
                *(GAS v4u*)(x + (size_t)(row0 + ai * 128 + m * 16) * D + col0 + bj * 128) = o; }
            if (p + PF < 8) { ER_LOAD(p + PF); }
            asm volatile("" ::: "memory"); }
#undef ER_LOAD
    }
};
struct EpiSwiglu {
    static constexpr bool PERM = true, AFTER_DRAIN = false, IDEMPOTENT = true;
    gb ACT; int pm0;
    DI void operator()(const f32x4 (&acc)[2][2][4][2], const pg8::Unit& u, int wr, int wc, int fr, int fq) const {
        const int row0 = (u.pm - pm0) * 256 + wr * 64 + fr, col0 = u.pc * 128 + wc * 32 + 8 * fq;
#pragma unroll
        for (int ai = 0; ai < 2; ++ai)
#pragma unroll
            for (int m = 0; m < 4; ++m) { gb rowp = ACT + (size_t)(row0 + ai * 128 + m * 16) * DFF + col0;
                const f32x4 g0 = acc[ai][0][m][0], g1 = acc[ai][0][m][1], u0 = acc[ai][1][m][0], u1 = acc[ai][1][m][1];
                v4u w; w.x = pk2(siluf(g0[0]) * u0[0], siluf(g0[1]) * u0[1]); w.y = pk2(siluf(g0[2]) * u0[2], siluf(g0[3]) * u0[3]);
                w.z = pk2(siluf(g1[0]) * u1[0], siluf(g1[1]) * u1[1]); w.w = pk2(siluf(g1[2]) * u1[2], siluf(g1[3]) * u1[3]);
                *(GAS v4u*)rowp = w; }
    }
};
struct EpiSwiglu8 {
    static constexpr bool PERM = true, AFTER_DRAIN = false, IDEMPOTENT = true;
    GAS unsigned char* ACT; int pm0;
    DI void operator()(const f32x4 (&acc)[2][2][4][2], const pg8::Unit& u, int wr, int wc, int fr, int fq) const {
        const int row0 = (u.pm - pm0) * 256 + wr * 64 + fr, col0 = u.pc * 128 + wc * 32 + 8 * fq;
        float c1 = -1.4426950408889634f / F8_S13, S2 = (float)F8_S13 * (float)F8_S13; asm volatile("" : "+v"(c1), "+v"(S2));
#pragma unroll
        for (int ai = 0; ai < 2; ++ai)
#pragma unroll
            for (int m = 0; m < 4; ++m) { GAS unsigned char* rowp = ACT + (size_t)(row0 + ai * 128 + m * 16) * DFF + col0;
                f32x4 o[2];
#pragma unroll
                for (int n = 0; n < 2; ++n) { const f32x4 g = acc[ai][0][m][n], uu = acc[ai][1][m][n]; f32x4 t = g * c1;
                    t.x = __builtin_amdgcn_exp2f(t.x); t.y = __builtin_amdgcn_exp2f(t.y); t.z = __builtin_amdgcn_exp2f(t.z); t.w = __builtin_amdgcn_exp2f(t.w);
                    t = t * S2 + S2;
                    t.x = __builtin_amdgcn_rcpf(t.x); t.y = __builtin_amdgcn_rcpf(t.y); t.z = __builtin_amdgcn_rcpf(t.z); t.w = __builtin_amdgcn_rcpf(t.w);
                    o[n] = (g * uu) * t; }
                v2u w; w.x = pk4_f8(o[0][0], o[0][1], o[0][2], o[0][3]); w.y = pk4_f8(o[1][0], o[1][1], o[1][2], o[1][3]);
                *(GAS v2u*)rowp = w; }
    }
};
struct EpiScatter {
    static constexpr bool PERM = true, AFTER_DRAIN = false, IDEMPOTENT = true;
    gcv2i pair; gb Y0; gb Y1; gci toke; gcf tokw; float sc;
    DI void operator()(const f32x4 (&acc)[2][2][4][2], const pg8::Unit& u, int wr, int wc, int fr, int fq) const {
        const int row0 = u.pm * 256 + wr * 64 + fr, col0 = u.pc * 256 + wc * 32 + 8 * fq;
        int px[8]; float w[8];
#pragma unroll
        for (int p = 0; p < 8; ++p) px[p] = pair[row0 + (p >> 2) * 128 + (p & 3) * 16].x;
#pragma unroll
        for (int p = 0; p < 8; ++p) w[p] = tokw[px[p] >= 0 ? 2 * (px[p] & 0x3fffffff) + (px[p] >> 30) : 0] * sc;
#pragma unroll
        for (int p = 0; p < 8; ++p) { const int ai = p >> 2, m = p & 3;
            if (px[p] >= 0) { const int tok = px[p] & 0x3fffffff;
                gb rowp = ((px[p] >> 30) ? Y1 : Y0) + (size_t)tok * D + col0;
#pragma unroll
                for (int bj = 0; bj < 2; ++bj) { const f32x4 v0 = acc[ai][bj][m][0] * w[p], v1 = acc[ai][bj][m][1] * w[p];
                    v4u o; o.x = pk2(v0[0], v0[1]); o.y = pk2(v0[2], v0[3]); o.z = pk2(v1[0], v1[1]); o.w = pk2(v1[2], v1[3]);
                    *(GAS v4u*)(rowp + bj * 128) = o; } } }
    }
};


DI void p0_prologue(gcf c, gcf w_mod, gcf b_mod, gcf gamma, gcf pool_w, gcf lwa, gcf lwx, gcf sgu_ws,
                    gws ws, LAS unsigned char* lds, int wg, int G, int tid, int wave, int lane) {
    LAS float* CS = (LAS float*)lds; LAS float* RED = (LAS float*)(lds + 32768);
    gf MOD = (GAS float*)(ws + WS_MOD);
    if (wg < 96) {
        for (int idx = tid; idx < 8192; idx += NTHR) { const int k = idx >> 3, b = idx & 7; const float v = c[b * D + k]; CS[idx] = siluf(v); }
        __syncthreads();
        for (int item = wg; item < 96; item += G) {
            const int l = item / 24, jb = item % 24, col = jb * 256 + lane * 4;
            f32x4 acc[8];
#pragma unroll
            for (int b = 0; b < 8; ++b) acc[b] = (f32x4){0.f, 0.f, 0.f, 0.f};
            gcf wp = w_mod + ((size_t)(l * D + wave * 128)) * MODW + col;
#pragma unroll 32
            for (int kk = 0; kk < 128; ++kk) {
                const f32x4 w = ld4(wp + (size_t)kk * MODW);
                const f32x4 c0 = *(const LAS f32x4*)(CS + (wave * 128 + kk) * 8), c1 = *(const LAS f32x4*)(CS + (wave * 128 + kk) * 8 + 4);
                acc[0] += c0.x * w; acc[1] += c0.y * w; acc[2] += c0.z * w; acc[3] += c0.w * w; acc[4] += c1.x * w; acc[5] += c1.y * w; acc[6] += c1.z * w; acc[7] += c1.w * w;
            }
#pragma unroll
            for (int b = 0; b < 8; ++b) *(LAS f32x4*)(RED + (wave * 8 + b) * 256 + lane * 4) = acc[b];
            __syncthreads();
            for (int o = tid; o < 2048; o += NTHR) { const int b = o >> 8, cc = o & 255; float s = 0.f;
#pragma unroll
                for (int w = 0; w < 8; ++w) s += RED[(w * 8 + b) * 256 + cc];
                MOD[(size_t)(l * 8 + b) * MODW + jb * 256 + cc] = s + b_mod[l * MODW + jb * 256 + cc]; }
            __syncthreads();
        }
    }
    if (wg == G - 1 && tid < GWD) {
        gf LB = (GAS float*)(ws + WS_LB);
        const float g0 = gamma[tid], g1 = gamma[GWD + tid], g2 = gamma[2 * GWD + tid], g3 = gamma[3 * GWD + tid];
        const float mx = fmaxf(fmaxf(g0, g1), fmaxf(g2, g3));
        const float e0 = expf(g0 - mx), e1 = expf(g1 - mx), e2 = expf(g2 - mx), e3 = expf(g3 - mx), inv = 1.f / (e0 + e1 + e2 + e3);
        LB[tid] = 0.f; LB[GWD + tid] = e1 * inv; LB[2 * GWD + tid] = (e1 + e2) * inv; LB[3 * GWD + tid] = (e1 + e2 + e3) * inv;
    }
    gb POOLWT = (GAS bf16*)(ws + WS_POOLWT); gb LRUWAT = (GAS bf16*)(ws + WS_LRUWAT); gb LRUWXT = (GAS bf16*)(ws + WS_LRUWXT); gb SGUW = (GAS bf16*)(ws + WS_SGUW);
    const int gt = wg * NTHR + tid, NT = G * NTHR;
    for (int idx = gt; idx < 65536; idx += NT) { const int lg = idx >> 12, j = (idx >> 6) & 63, i = idx & 63, src = (lg * 64 + i) * 64 + j;
        POOLWT[idx] = f2bf(pool_w[src]); LRUWAT[idx] = f2bf(lwa[src]); LRUWXT[idx] = f2bf(lwx[src]); }
    for (int idx = gt; idx < 262144; idx += NT) { const int t = (idx >> 7) & 127, s = idx & 127; SGUW[idx] = (s <= t) ? f2bf(sgu_ws[idx]) : (bf16)0; }
}

struct CvItem { gcf W; gb WT; int K, N, mode, idx; float f8s; };
DI void cv_load(const CvItem& I, int lane, f32x4 (&v)[8]) {
    const int nblk = I.N / 32, kb = I.idx / nblk, nb = I.idx % nblk;
    gcf p = I.W + (size_t)(64 * kb + (lane >> 3)) * I.N + 32 * nb + 4 * (lane & 7);
#pragma unroll
    for (int i = 0; i < 8; ++i) v[i] = ld4_nt(p + (size_t)(8 * i) * I.N);
}
DI void cv_store(const CvItem& I, LAS float* scr, int lane, const f32x4 (&v)[8]) {
    const int nblk = I.N / 32, kb = I.idx / nblk, nb = I.idx % nblk, k0 = 64 * kb, n0 = 32 * nb;
#pragma unroll
    for (int i = 0; i < 8; ++i) { LAS float* d = scr + (8 * i + (lane >> 3)) * 33 + 4 * (lane & 7); d[0] = v[i].x; d[1] = v[i].y; d[2] = v[i].z; d[3] = v[i].w; }
    LDS_WAIT();
    const int c = lane & 7;
    const int drow0 = (I.mode == 0) ? n0 : ((n0 >> 7) * 256 + (n0 & 127) + (I.mode == 2 ? 128 : 0));
    if (I.f8s > 0.f) { const float sc = I.f8s; GAS unsigned char* W8 = (GAS unsigned char*)I.WT; const int c4 = lane & 3;
#pragma unroll
        for (int j = 0; j < 2; ++j) { const int n = (lane >> 2) + 16 * j; const LAS float* s = scr + (16 * c4) * 33 + n;
            v4u o; o.x = pk4_f8(s[0 * 33] * sc, s[1 * 33] * sc, s[2 * 33] * sc, s[3 * 33] * sc); o.y = pk4_f8(s[4 * 33] * sc, s[5 * 33] * sc, s[6 * 33] * sc, s[7 * 33] * sc);
            o.z = pk4_f8(s[8 * 33] * sc, s[9 * 33] * sc, s[10 * 33] * sc, s[11 * 33] * sc); o.w = pk4_f8(s[12 * 33] * sc, s[13 * 33] * sc, s[14 * 33] * sc, s[15 * 33] * sc);
            *(GAS v4u*)(W8 + (size_t)(drow0 + n) * I.K + k0 + 16 * c4) = o; }
    } else {
#pragma unroll
    for (int j = 0; j < 4; ++j) { const int n = (lane >> 3) + 8 * j; const LAS float* s = scr + (8 * c) * 33 + n;
        v4u o; o.x = pk2(s[0 * 33], s[1 * 33]); o.y = pk2(s[2 * 33], s[3 * 33]); o.z = pk2(s[4 * 33], s[5 * 33]); o.w = pk2(s[6 * 33], s[7 * 33]);
        *(GAS v4u*)(I.WT + (size_t)(drow0 + n) * I.K + k0 + 8 * c) = o; }
    }
    LDS_WAIT();
}
DI void convert_weights(int l, gcf w_in, gcf w_out, gcf f1, gcf f3, gcf f2, gcf m1, gcf m3, gcf m2,
                        gws ws, LAS unsigned char* lds, int wg, int G, int wave, int lane) {
    LAS float* scr = (LAS float*)(lds + wave * 16384);
    gb WIN = (GAS bf16*)(ws + WS_WIN); gb WOUT = (GAS bf16*)(ws + WS_WOUT); gb W13 = (GAS bf16*)(ws + WS_W13); gb W2 = (GAS bf16*)(ws + WS_W2);
    constexpr int n_in = 16 * 72, n_out = 16 * 32, n13 = 16 * 112, n2 = 56 * 32, per_e = 2 * n13 + n2;
    const int moe = l & 1, E = moe ? NE : 1, total = n_in + n_out + E * per_e, stride = G * NWAVES, f8 = IS_F8(l) ? 1 : 0;
#define CV_DECODE(it_, I_) do { int r = (it_); \
        if (r < n_in) { I_ = CvItem{w_in + (size_t)l * D * INW, WIN, D, INW, 0, r, IS_B8(l) ? F8_S13 : 0.f}; } \
        else if (r < n_in + n_out) { I_ = CvItem{w_out + (size_t)l * D * D, WOUT, D, D, 0, r - n_in, 0.f}; } \
        else { r -= n_in + n_out; const int e = r / per_e; r -= e * per_e; \
            const size_t mo = (size_t)((l >> 1) * (moe ? NE : 1) + e) * D * DFF; \
            const size_t o13 = ((size_t)e * 2 * DFF * D) >> f8, o2 = ((size_t)e * D * DFF) >> f8;     \
            if (r < n13) I_ = CvItem{(moe ? m1 : f1) + mo, W13 + o13, D, DFF, 1, r, f8 ? F8_S13 : 0.f}; \
            else if (r < 2 * n13) I_ = CvItem{(moe ? m3 : f3) + mo, W13 + o13, D, DFF, 2, r - n13, f8 ? F8_S13 : 0.f}; \
            else I_ = CvItem{(moe ? m2 : f2) + mo, W2 + o2, DFF, D, 0, r - 2 * n13, f8 ? F8_S2 : 0.f}; } } while (0)
    int it = wg * NWAVES + wave;
    if (it >= total) return;
    CvItem Ia, Ib; f32x4 va[8], vb[8];
    CV_DECODE(it, Ia); cv_load(Ia, lane, va);
    for (;;) {
        const bool hb = it + stride < total;
        if (hb) { CV_DECODE(it + stride, Ib); cv_load(Ib, lane, vb); }
        cv_store(Ia, scr, lane, va);
        if (!hb) break;
        it += stride;
        const bool ha = it + stride < total;
        if (ha) { CV_DECODE(it + stride, Ia); cv_load(Ia, lane, va); }
        cv_store(Ib, scr, lane, vb);
        if (!ha) break;
        it += stride;
    }
#undef CV_DECODE
}

template <bool COMBINE, bool ROUTER, bool FINAL, bool XF32, bool OUT8 = false>
DI void norm_phase(gcf xf, gb xb, gf outf, gcf gain, gcf shift, gcf scale, gcf gprev, gcb Y0, gcb Y1, gb XN,
                   gcf rw, gcf rb, gi toke, gf tokw, gi histw, gv2i pair, LAS unsigned char* lds, int wg, int G, int tid, int wave, int lane) {
    LAS float* RW = (LAS float*)lds;
    if (ROUTER) {
        for (int i = tid; i < 8192; i += NTHR) RW[i] = rw[i];
        { int m1 = -1, z0 = 0; asm volatile("" : "+v"(m1), "+v"(z0));
        for (int i = wg * NTHR + tid; i < MAXPAIR; i += G * NTHR) pair[i] = (v2i){m1, z0}; }
        __syncthreads();
    }
    for (int blk = wg; blk < M / 256; blk += G) {
        const int b = blk >> 5;
#define NCOL(j) (8 * lane + 512 * ((j) >> 1) + 4 * ((j) & 1))
        f32x4 gm[4], sh[4], gp[4];
#pragma unroll
        for (int j = 0; j < 4; ++j) { const int col = NCOL(j);
            if (FINAL) { gm[j] = ld4(gain + col); sh[j] = (f32x4){0.f, 0.f, 0.f, 0.f}; }
            else { gm[j] = ld4(gain + col) * (ld4(scale + (size_t)b * MODW + col) + 1.0f); sh[j] = ld4(shift + (size_t)b * MODW + col); }
            if (COMBINE) gp[j] = ld4(gprev + (size_t)b * MODW + col); else gp[j] = (f32x4){0.f, 0.f, 0.f, 0.f}; }
        int cnt[8];
#pragma unroll
        for (int e = 0; e < 8; ++e) cnt[e] = 0;
        constexpr int RG = (COMBINE || ROUTER) ? 1 : 2;
        v4u xr[2][XF32 ? 1 : RG][2]; f32x4 xfr[2][XF32 ? RG : 1][4]; v4u ya[2][COMBINE ? RG : 1][2], yb[2][COMBINE ? RG : 1][2];
#define NL_LOAD(B, R0) \
        _Pragma("unroll") for (int q = 0; q < RG; ++q) \
        _Pragma("unroll") for (int s = 0; s < 2; ++s) { const size_t off = (size_t)(blk * 256 + wave * 32 + (R0) + q) * D + 8 * lane + 512 * s; \
            if (XF32) { xfr[B][q][2 * s] = ld4_nt(xf + off); xfr[B][q][2 * s + 1] = ld4_nt(xf + off + 4); } else xr[B][q][s] = *(GAS const v4u*)(xb + off); \
            if (COMBINE) { ya[B][q][s] = *(GAS const v4u*)(Y0 + off); yb[B][q][s] = *(GAS const v4u*)(Y1 + off); } }
        NL_LOAD(0, 0)
#pragma unroll 1
        for (int r00 = 0; r00 < 32; r00 += 2 * RG) {
#pragma unroll
          for (int hb = 0; hb < 2; ++hb) {
            const int r0 = r00 + hb * RG;
            if (hb == 0) { NL_LOAD(1, r0 + RG) } else if (r0 + RG < 32) { NL_LOAD(0, r0 + RG) }
#pragma unroll
            for (int q = 0; q < RG; ++q) {
            const int row = blk * 256 + wave * 32 + r0 + q;
            f32x4 v[4]; float ss = 0.f;
#pragma unroll
            for (int s = 0; s < 2; ++s) { const size_t off = (size_t)row * D + 8 * lane + 512 * s;
                if (XF32) { v[2 * s] = xfr[hb][q][2 * s]; v[2 * s + 1] = xfr[hb][q][2 * s + 1]; }
                else { float t8[8]; unpack8(xr[hb][q][s], t8); v[2 * s] = (f32x4){t8[0], t8[1], t8[2], t8[3]}; v[2 * s + 1] = (f32x4){t8[4], t8[5], t8[6], t8[7]}; }
                if (COMBINE) { float a8[8], b8[8]; unpack8(ya[hb][q][s], a8); unpack8(yb[hb][q][s], b8);
                    v[2 * s] += gp[2 * s] * ((f32x4){a8[0], a8[1], a8[2], a8[3]} + (f32x4){b8[0], b8[1], b8[2], b8[3]}); v[2 * s + 1] += gp[2 * s + 1] * ((f32x4){a8[4], a8[5], a8[6], a8[7]} + (f32x4){b8[4], b8[5], b8[6], b8[7]}); }
                if ((COMBINE && !FINAL) || XF32) { v4u o; o.x = pk2(v[2 * s].x, v[2 * s].y); o.y = pk2(v[2 * s].z, v[2 * s].w); o.z = pk2(v[2 * s + 1].x, v[2 * s + 1].y); o.w = pk2(v[2 * s + 1].z, v[2 * s + 1].w); *(GAS v4u*)(xb + off) = o; }
                ss += (v[2 * s].x * v[2 * s].x + v[2 * s].y * v[2 * s].y) + (v[2 * s].z * v[2 * s].z + v[2 * s].w * v[2 * s].w) + (v[2 * s + 1].x * v[2 * s + 1].x + v[2 * s + 1].y * v[2 * s + 1].y) + (v[2 * s + 1].z * v[2 * s + 1].z + v[2 * s + 1].w * v[2 * s + 1].w); }
            const float rstd = rsqrtf(wave_sum_dpp(ss) * (1.f / D) + EPS);
            f32x4 h[4];
#pragma unroll
            for (int j = 0; j < 4; ++j) h[j] = v[j] * rstd * gm[j] + sh[j];
#pragma unroll
            for (int s = 0; s < 2; ++s) { const size_t off = (size_t)row * D + 8 * lane + 512 * s;
                if (FINAL) { __builtin_nontemporal_store(h[2 * s], (GAS f32x4*)(outf + off)); __builtin_nontemporal_store(h[2 * s + 1], (GAS f32x4*)(outf + off + 4)); }
                else if (OUT8) {
                    if (s == 1) { v2u o0, o1; o0.x = pk4_f8(h[0].x, h[0].y, h[0].z, h[0].w); o0.y = pk4_f8(h[1].x, h[1].y, h[1].z, h[1].w); o1.x = pk4_f8(h[2].x, h[2].y, h[2].z, h[2].w); o1.y = pk4_f8(h[3].x, h[3].y, h[3].z, h[3].w);
                        const bool odd = lane & 1; const unsigned sx = odd ? o0.x : o1.x, sy = odd ? o0.y : o1.y;
                        const unsigned tx = (unsigned)__builtin_amdgcn_update_dpp(0, (int)sx, 0xB1, 0xf, 0xf, true), ty = (unsigned)__builtin_amdgcn_update_dpp(0, (int)sy, 0xB1, 0xf, 0xf, true);
                        v4u w; if (odd) { w.x = tx; w.y = ty; w.z = o1.x; w.w = o1.y; } else { w.x = o0.x; w.y = o0.y; w.z = tx; w.w = ty; }
                        *(GAS v4u*)((GAS unsigned char*)XN + (size_t)row * D + (odd ? 512 + 8 * (lane - 1) : 8 * lane)) = w; } }
                else { v4u o; o.x = pk2(h[2 * s].x, h[2 * s].y); o.y = pk2(h[2 * s].z, h[2 * s].w); o.z = pk2(h[2 * s + 1].x, h[2 * s + 1].y); o.w = pk2(h[2 * s + 1].z, h[2 * s + 1].w); *(GAS v4u*)(XN + off) = o; } }
            if (ROUTER) {
                float lg[8];
#pragma unroll
                for (int e = 0; e < 8; ++e) lg[e] = 0.f;
#pragma unroll
                for (int j = 0; j < 4; ++j)
#pragma unroll
                    for (int i = 0; i < 4; ++i) { const int cc = NCOL(j) + i; const f32x4 w0 = *(const LAS f32x4*)(RW + cc * 8), w1 = *(const LAS f32x4*)(RW + cc * 8 + 4); const float hv = h[j][i];
                        lg[0] += hv * w0.x; lg[1] += hv * w0.y; lg[2] += hv * w0.z; lg[3] += hv * w0.w; lg[4] += hv * w1.x; lg[5] += hv * w1.y; lg[6] += hv * w1.z; lg[7] += hv * w1.w; }
#pragma unroll
                for (int e = 0; e < 8; ++e) lg[e] = wave_sum_dpp(lg[e]) + rb[e];
                int i0 = 0; float v0 = lg[0];
#pragma unroll
                for (int e = 1; e < 8; ++e) if (lg[e] > v0) { v0 = lg[e]; i0 = e; }
                int i1 = -1; float v1 = -3.0e38f;
#pragma unroll
                for (int e = 0; e < 8; ++e) if (e != i0 && lg[e] > v1) { v1 = lg[e]; i1 = e; }
                const float w0 = 1.f / (1.f + expf(v1 - v0)), w1 = 1.f - w0;
                if (lane == 0) { toke[row] = i0 | (i1 << 8); tokw[2 * row] = w0; tokw[2 * row + 1] = w1; }
#pragma unroll
                for (int e = 0; e < 8; ++e) cnt[e] += (i0 == e) + (i1 == e);
            }
            }
          }
        }
#undef NL_LOAD
        if (ROUTER && lane == 0) {
#pragma unroll
            for (int e = 0; e < 8; ++e) histw[(blk * 8 + wave) * 8 + e] = cnt[e]; }
    }
#undef NCOL
}

DI void route_phase(gcb XN, gb XG, gci toke, gcf tokw, gci histw, gv2i pair, gi tilee, gi ntp,
                    LAS unsigned char* lds, int wg, int G, int tid, int wave, int lane, int f8) {
    LAS int* L = (LAS int*)lds;
    for (int blk = wg; blk < M / 256; blk += G) {
        int tot[8], pre[8];
#pragma unroll
        for (int e = 0; e < 8; ++e) { tot[e] = 0; pre[e] = 0; }
        for (int q = tid; q < 2048; q += NTHR) { const v4i h0 = *(GAS const v4i*)(histw + q * 8), h1 = *(GAS const v4i*)(histw + q * 8 + 4); const int m = (q < blk * 8) ? 1 : 0;
            tot[0] += h0.x; tot[1] += h0.y; tot[2] += h0.z; tot[3] += h0.w; tot[4] += h1.x; tot[5] += h1.y; tot[6] += h1.z; tot[7] += h1.w;
            pre[0] += m * h0.x; pre[1] += m * h0.y; pre[2] += m * h0.z; pre[3] += m * h0.w; pre[4] += m * h1.x; pre[5] += m * h1.y; pre[6] += m * h1.z; pre[7] += m * h1.w; }
#pragma unroll
        for (int e = 0; e < 8; ++e) { tot[e] = wave_sum_i(tot[e]); pre[e] = wave_sum_i(pre[e]); }
        if (lane == 0) {
#pragma unroll
            for (int e = 0; e < 8; ++e) { L[wave * 16 + e] = tot[e]; L[wave * 16 + 8 + e] = pre[e]; } }
        __syncthreads();
        int start[9]; start[0] = 0;
#pragma unroll
        for (int e = 0; e < 8; ++e) { int t = 0, p = 0;
#pragma unroll
            for (int w = 0; w < 8; ++w) { t += L[w * 16 + e]; p += L[w * 16 + 8 + e]; }
            tot[e] = t; pre[e] = p; start[e + 1] = start[e] + ((t + 255) & ~255); }
        int e0 = -1, e1 = -1; const int tok = blk * 256 + tid;
        if (tid < 256) { const int te = toke[tok]; e0 = te & 255; e1 = te >> 8; }
        const unsigned long long lt = (1ull << lane) - 1ull;
        int r0 = 0, r1 = 0;
#pragma unroll
        for (int e = 0; e < 8; ++e) { const unsigned long long m0 = __ballot(e0 == e), m1 = __ballot(e1 == e);
            const int rr = __popcll(m0 & lt) + __popcll(m1 & lt);
            if (e0 == e) r0 = rr; if (e1 == e) r1 = rr;
            if (lane == 0) L[128 + wave * 8 + e] = __popcll(m0) + __popcll(m1);
            if (tid == 0) L[192 + e] = start[e] + pre[e]; }
        __syncthreads();
        if (tid < 256) {
            int p0 = L[192 + e0] + r0, p1 = L[192 + e1] + r1;
            for (int w = 0; w < wave; ++w) { p0 += L[128 + w * 8 + e0]; p1 += L[128 + w * 8 + e1]; }
            const f32x2 wv = *(GAS const f32x2*)(tokw + 2 * tok);
            pair[p0] = (v2i){tok, __builtin_bit_cast(int, wv.x)}; pair[p1] = (v2i){tok | (1 << 30), __builtin_bit_cast(int, wv.y)};
            L[256 + 2 * tid] = p0; L[256 + 2 * tid + 1] = p1;
        }
        __syncthreads();
        if (f8 && MOE_XN8) {
            const GAS unsigned char* S8 = (const GAS unsigned char*)XN; GAS unsigned char* X8 = (GAS unsigned char*)XG;
            for (int i0 = 0; i0 < 32; i0 += 8) {
                v4u ra[8]; int pp0[8], pp1[8];
#pragma unroll
                for (int q = 0; q < 8; ++q) { const int tl = wave * 32 + i0 + q; pp0[q] = L[256 + 2 * tl]; pp1[q] = L[256 + 2 * tl + 1]; ra[q] = *(GAS const v4u*)(S8 + (size_t)(blk * 256 + tl) * D + lane * 16); }
#pragma unroll
                for (int q = 0; q < 8; ++q) { *(GAS v4u*)(X8 + (size_t)pp0[q] * D + lane * 16) = ra[q]; *(GAS v4u*)(X8 + (size_t)pp1[q] * D + lane * 16) = ra[q]; } }
        } else
        for (int i0 = 0; i0 < 32; i0 += 4) {
            v4u ra[4], rb2[4]; int pp0[4], pp1[4];
#pragma unroll
            for (int q = 0; q < 4; ++q) { const int tl = wave * 32 + i0 + q; pp0[q] = L[256 + 2 * tl]; pp1[q] = L[256 + 2 * tl + 1];
                gcb srcp = XN + (size_t)(blk * 256 + tl) * D + lane * 16; ra[q] = *(GAS const v4u*)srcp; rb2[q] = *(GAS const v4u*)(srcp + 8); }
            if (f8) { GAS unsigned char* X8 = (GAS unsigned char*)XG;
#pragma unroll
                for (int q = 0; q < 4; ++q) { float xa[8], xb2[8]; unpack8(ra[q], xa); unpack8(rb2[q], xb2);
                    v4u o; o.x = pk4_f8(xa[0], xa[1], xa[2], xa[3]); o.y = pk4_f8(xa[4], xa[5], xa[6], xa[7]); o.z = pk4_f8(xb2[0], xb2[1], xb2[2], xb2[3]); o.w = pk4_f8(xb2[4], xb2[5], xb2[6], xb2[7]);
                    *(GAS v4u*)(X8 + (size_t)pp0[q] * D + lane * 16) = o; *(GAS v4u*)(X8 + (size_t)pp1[q] * D + lane * 16) = o; }
            } else {
#pragma unroll
            for (int q = 0; q < 4; ++q) { gb d0 = XG + (size_t)pp0[q] * D + lane * 16; gb d1 = XG + (size_t)pp1[q] * D + lane * 16;
                *(GAS v4u*)d0 = ra[q]; *(GAS v4u*)(d0 + 8) = rb2[q]; *(GAS v4u*)d1 = ra[q]; *(GAS v4u*)(d1 + 8) = rb2[q]; } } }
        if (blk == 0) { const int ntt = start[8] >> 8;
            for (int t = tid; t < ntt; t += NTHR) { int e = 0;
#pragma unroll
                for (int q = 1; q < 8; ++q) e += (t >= (start[q] >> 8)) ? 1 : 0;
                tilee[t] = e; }
            if (tid == 0) ntp[0] = ntt; }
        __syncthreads();
    }
}

DI void pool_unit(gcb PROJ, gb CAT, gcb WT, gcf pscale, gcf pnorm, LAS unsigned char* lds, int b, int t0, int tid, int wave, int lane) {
    asm volatile("" : "+v"(tid)); lane = tid & 63;
    LAS bf16* XT = (LAS bf16*)lds;
    LAS bf16* DT = (LAS bf16*)(lds + 80 * 264 * 2);
    LAS float* SSP = (LAS float*)(lds + (80 + 64) * 264 * 2);
    const int fr = lane & 15, fq = lane >> 4, tbh = wave & 3, gp = wave >> 2;
    bf16x8 Wf[2][2][4];
#pragma unroll
    for (int gl = 0; gl < 2; ++gl)
#pragma unroll
        for (int kk = 0; kk < 2; ++kk)
#pragma unroll
            for (int nb = 0; nb < 4; ++nb) Wf[gl][kk][nb] = *(GAS const bf16x8*)(WT + (((2 * gp + gl) * 64 + nb * 16 + fr) * 64 + kk * 32 + 8 * fq));
    for (int half = 0; half < 2; ++half) {
        const int t0h = t0 + 64 * half;
        __syncthreads();
        { v4u xr[5];
#pragma unroll
            for (int i = 0; i < 5; ++i) { const int cidx = tid + NTHR * i, row = cidx >> 5, cg = cidx & 31, tt = t0h - 16 + row, ttc = tt < 0 ? 0 : tt;
                xr[i] = *(GAS const v4u*)(PROJ + ((size_t)b * SEQ + ttc) * INW + cg * 8); }
#pragma unroll
            for (int i = 0; i < 5; ++i) { const int cidx = tid + NTHR * i, row = cidx >> 5, cg = cidx & 31, tt = t0h - 16 + row;
                *(LAS v4u*)(XT + row * 264 + cg * 8) = (tt < 0) ? (v4u){0u, 0u, 0u, 0u} : xr[i]; } }
        __syncthreads();
        { const int cg = tid & 31, run = tid >> 5, ch0 = cg * 8, win = 2 << (cg >> 3), tl0 = run * 4;
            float s[8];
#pragma unroll
            for (int k = 0; k < 8; ++k) s[k] = 0.f;
            for (int r = 1; r <= win; ++r) { float xv[8]; unpack8(*(const LAS v4u*)(XT + (tl0 + 16 - r) * 264 + ch0), xv);
#pragma unroll
                for (int k = 0; k < 8; ++k) s[k] += xv[k]; }
#pragma unroll
            for (int i = 0; i < 4; ++i) { float xv[8], yv[8]; unpack8(*(const LAS v4u*)(XT + (tl0 + i + 16) * 264 + ch0), xv); unpack8(*(const LAS v4u*)(XT + (tl0 + i + 16 - win) * 264 + ch0), yv);
                const int tt = t0h + tl0 + i; const float inv = 1.f / (float)((tt + 1 < win) ? tt + 1 : win);
#pragma unroll
                for (int k = 0; k < 8; ++k) s[k] += xv[k] - yv[k];
                v4u o; o.x = pk2(s[0] * inv - xv[0], s[1] * inv - xv[1]); o.y = pk2(s[2] * inv - xv[2], s[3] * inv - xv[3]); o.z = pk2(s[4] * inv - xv[4], s[5] * inv - xv[5]); o.w = pk2(s[6] * inv - xv[6], s[7] * inv - xv[7]);
                *(LAS v4u*)(DT + (tl0 + i) * 264 + ch0) = o; } }
        __syncthreads();
        f32x4 acc[2][4];
#pragma unroll
        for (int gl = 0; gl < 2; ++gl)
#pragma unroll
            for (int nb = 0; nb < 4; ++nb) acc[gl][nb] = (f32x4){0.f, 0.f, 0.f, 0.f};
#pragma unroll
        for (int gl = 0; gl < 2; ++gl)
#pragma unroll
            for (int kk = 0; kk < 2; ++kk) { const bf16x8 X = *(const LAS bf16x8*)(DT + (16 * tbh + fr) * 264 + (2 * gp + gl) * 64 + kk * 32 + 8 * fq);
#pragma unroll
                for (int nb = 0; nb < 4; ++nb) acc[gl][nb] = mfma16(Wf[gl][kk][nb], X, acc[gl][nb]); }
        float ss = 0.f;
#pragma unroll
        for (int gl = 0; gl < 2; ++gl)
#pragma unroll
            for (int nb = 0; nb < 4; ++nb) { const f32x4 y = acc[gl][nb] * ld4(pscale + (2 * gp + gl) * 64 + nb * 16 + 4 * fq); acc[gl][nb] = y; ss += (y.x * y.x + y.y * y.y) + (y.z * y.z + y.w * y.w); }
        ss += __shfl_xor(ss, 16); ss += __shfl_xor(ss, 32);
        if (fq == 0) SSP[gp * 64 + 16 * tbh + fr] = ss;
        __syncthreads();
        const float rstd = rsqrtf((SSP[16 * tbh + fr] + SSP[64 + 16 * tbh + fr]) * (1.f / GWD) + EPS);
        const size_t row = (size_t)b * SEQ + t0h + 16 * tbh + fr;
#pragma unroll
        for (int gl = 0; gl < 2; ++gl)
#pragma unroll
            for (int nb = 0; nb < 4; ++nb) { const int ch = (2 * gp + gl) * 64 + nb * 16 + 4 * fq; *(GAS v2u*)(CAT + row * D + ch) = pack4(acc[gl][nb] * rstd * ld4(pnorm + ch)); }
    }
}

DI void sgu_unit(gcb PROJ, gb CAT, gcb SW, gcf sbias, gcf snorm, LAS unsigned char* lds, int b, int t0, int tid, int wave, int lane) {
    asm volatile("" : "+v"(tid)); lane = tid & 63;
    __syncthreads();
    LAS bf16* VT = (LAS bf16*)lds;
    const int fr = lane & 15, fq = lane >> 4, tb = wave, nk = (tb >> 1) + 1;
    { v2u vr[16];
#pragma unroll
        for (int i = 0; i < 16; ++i) vr[i] = *(GAS const v2u*)(PROJ + ((size_t)b * SEQ + t0 + 16 * wave + i) * INW + 512 + 4 * lane);
#pragma unroll
        for (int i = 0; i < 8; ++i) { const int tl = 16 * wave + 2 * i;
            f32x4 va = unpack4(vr[2 * i]), vb = unpack4(vr[2 * i + 1]);
            va.x = gelu_t(va.x); va.y = gelu_t(va.y); va.z = gelu_t(va.z); va.w = gelu_t(va.w); vb.x = gelu_t(vb.x); vb.y = gelu_t(vb.y); vb.z = gelu_t(vb.z); vb.w = gelu_t(vb.w);
            const float mua = wave_sum_dpp((va.x + va.y) + (va.z + va.w)) * (1.f / GWD), mub = wave_sum_dpp((vb.x + vb.y) + (vb.z + vb.w)) * (1.f / GWD);
            va = va - mua; vb = vb - mub;
            const float vra = wave_sum_dpp((va.x * va.x + va.y * va.y) + (va.z * va.z + va.w * va.w)) * (1.f / GWD), vrb = wave_sum_dpp((vb.x * vb.x + vb.y * vb.y) + (vb.z * vb.z + vb.w * vb.w)) * (1.f / GWD);
            va = va * rsqrtf(vra + EPS); vb = vb * rsqrtf(vrb + EPS);
            *(LAS unsigned*)(VT + (4 * lane + 0) * 136 + tl) = pk2(va.x, vb.x); *(LAS unsigned*)(VT + (4 * lane + 1) * 136 + tl) = pk2(va.y, vb.y);
            *(LAS unsigned*)(VT + (4 * lane + 2) * 136 + tl) = pk2(va.z, vb.z); *(LAS unsigned*)(VT + (4 * lane + 3) * 136 + tl) = pk2(va.w, vb.w); } }
    const int tl = 16 * tb + fr; const size_t row = (size_t)b * SEQ + t0 + tl;
    v2u ur[4][4]; float bias4[4];
#pragma unroll
    for (int h = 0; h < 4; ++h) { bias4[h] = sbias[h * 128 + tl];
#pragma unroll
        for (int db = 0; db < 4; ++db) ur[h][db] = *(GAS const v2u*)(PROJ + row * INW + 256 + h * 64 + db * 16 + 4 * fq); }
    __syncthreads();
    f32x4 acc[4][4];
#pragma unroll
    for (int h = 0; h < 4; ++h)
#pragma unroll
        for (int db = 0; db < 4; ++db) acc[h][db] = (f32x4){0.f, 0.f, 0.f, 0.f};
    for (int kk = 0; kk < nk; ++kk) {
        bf16x8 Q[4];
#pragma unroll
        for (int h = 0; h < 4; ++h) Q[h] = *(GAS const bf16x8*)(SW + ((h * 128 + 16 * tb + fr) * 128 + kk * 32 + 8 * fq));
#pragma unroll
        for (int h = 0; h < 4; ++h)
#pragma unroll
            for (int db = 0; db < 4; ++db) { const bf16x8 P = *(const LAS bf16x8*)(VT + (h * 64 + db * 16 + fr) * 136 + kk * 32 + 8 * fq); acc[h][db] = mfma16(P, Q[h], acc[h][db]); } }
    float ss = 0.f;
#pragma unroll
    for (int h = 0; h < 4; ++h)
#pragma unroll
        for (int db = 0; db < 4; ++db) { f32x4 u = unpack4(ur[h][db]);
            u.x = gelu_t(u.x); u.y = gelu_t(u.y); u.z = gelu_t(u.z); u.w = gelu_t(u.w);
            const f32x4 y = u * (acc[h][db] + bias4[h]); acc[h][db] = y; ss += (y.x * y.x + y.y * y.y) + (y.z * y.z + y.w * y.w); }
    ss += __shfl_xor(ss, 16); ss += __shfl_xor(ss, 32);
    const float rstd = rsqrtf(ss * (1.f / GWD) + EPS);
#pragma unroll
    for (int h = 0; h < 4; ++h)
#pragma unroll
        for (int db = 0; db < 4; ++db) { const int ch = h * 64 + db * 16 + 4 * fq; *(GAS v2u*)(CAT + row * D + 256 + ch) = pack4(acc[h][db] * rstd * ld4(snorm + ch)); }
}

template <int D_> DI float row_shr(float ident, float src) {
    return __builtin_bit_cast(float, __builtin_amdgcn_update_dpp(__builtin_bit_cast(int, ident), __builtin_bit_cast(int, src), 0x110 + D_, 0xf, 0xf, false));
}
#define LRU_STEP_(D) \
    "v_fmac_f32_dpp %0, %0, %8 row_shr:" #D " row_mask:0xf bank_mask:0xf\n\tv_fmac_f32_dpp %1, %1, %9 row_shr:" #D " row_mask:0xf bank_mask:0xf\n\t" \
    "v_fmac_f32_dpp %2, %2, %10 row_shr:" #D " row_mask:0xf bank_mask:0xf\n\tv_fmac_f32_dpp %3, %3, %11 row_shr:" #D " row_mask:0xf bank_mask:0xf\n\t" \
    "v_fmac_f32_dpp %4, %4, %12 row_shr:" #D " row_mask:0xf bank_mask:0xf\n\tv_fmac_f32_dpp %5, %5, %13 row_shr:" #D " row_mask:0xf bank_mask:0xf\n\t" \
    "v_fmac_f32_dpp %6, %6, %14 row_shr:" #D " row_mask:0xf bank_mask:0xf\n\tv_fmac_f32_dpp %7, %7, %15 row_shr:" #D " row_mask:0xf bank_mask:0xf\n\t" \
    "v_mul_f32_dpp %8, %8, %8 row_shr:" #D " row_mask:0xf bank_mask:0xf\n\tv_mul_f32_dpp %9, %9, %9 row_shr:" #D " row_mask:0xf bank_mask:0xf\n\t" \
    "v_mul_f32_dpp %10, %10, %10 row_shr:" #D " row_mask:0xf bank_mask:0xf\n\tv_mul_f32_dpp %11, %11, %11 row_shr:" #D " row_mask:0xf bank_mask:0xf\n\t" \
    "v_mul_f32_dpp %12, %12, %12 row_shr:" #D " row_mask:0xf bank_mask:0xf\n\tv_mul_f32_dpp %13, %13, %13 row_shr:" #D " row_mask:0xf bank_mask:0xf\n\t" \
    "v_mul_f32_dpp %14, %14, %14 row_shr:" #D " row_mask:0xf bank_mask:0xf\n\tv_mul_f32_dpp %15, %15, %15 row_shr:" #D " row_mask:0xf bank_mask:0xf\n\t"
#define LRU_SCAN8(bv, av) asm("s_nop 1\n\t" LRU_STEP_(1) LRU_STEP_(2) LRU_STEP_(4) LRU_STEP_(8) \
    : "+v"(bv[0][0]), "+v"(bv[0][1]), "+v"(bv[0][2]), "+v"(bv[0][3]), "+v"(bv[1][0]), "+v"(bv[1][1]), "+v"(bv[1][2]), "+v"(bv[1][3]), \
      "+v"(av[0][0]), "+v"(av[0][1]), "+v"(av[0][2]), "+v"(av[0][3]), "+v"(av[1][0]), "+v"(av[1][1]), "+v"(av[1][2]), "+v"(av[1][3]))
DI float row_bcast15(float v) { return __builtin_bit_cast(float, __builtin_amdgcn_update_dpp(0, __builtin_bit_cast(int, v), 0x15F, 0xf, 0xf, true)); }
DI void lru_local_unit(gcb PROJ, gcf convw, gcf convb, gcf lba, gcf lbx, gcf lam, gcb WAT, gcb WXT, gf AGG, GAS unsigned* LAB, LAS unsigned char* lds, int b, int chunk, int tid, int wave, int lane) {
    asm volatile("" : "+v"(tid)); lane = tid & 63;
    __syncthreads();
    LAS bf16* TILE = (LAS bf16*)lds;
    const int t0 = chunk * CH;
    {
        const int cg = tid & 31, ch0 = cg * 8;
        f32x4 cw[4][2], cb[2];
#pragma unroll
        for (int k = 0; k < 4; ++k) { cw[k][0] = ld4(convw + k * GWD + ch0); cw[k][1] = ld4(convw + k * GWD + ch0 + 4); }
        cb[0] = ld4(convb + ch0); cb[1] = ld4(convb + ch0 + 4);
#pragma unroll
        for (int hb2 = 0; hb2 < 2; ++hb2) {
            v4u xr[4][4];
#pragma unroll
            for (int i = 0; i < 4; ++i) { const int tl = (tid >> 5) + 16 * (hb2 * 4 + i);
#pragma unroll
                for (int k = 0; k < 4; ++k) { const int tt = t0 + tl - 3 + k, ttc = tt < 0 ? 0 : tt; xr[i][k] = *(GAS const v4u*)(PROJ + ((size_t)b * SEQ + ttc) * INW + 768 + ch0); } }
#pragma unroll
            for (int i = 0; i < 4; ++i) { const int tl = (tid >> 5) + 16 * (hb2 * 4 + i);
                f32x4 x0 = cb[0], x1 = cb[1];
#pragma unroll
                for (int k = 0; k < 4; ++k) { const float m = (t0 + tl - 3 + k >= 0) ? 1.f : 0.f; float xv[8]; unpack8(xr[i][k], xv);
                    x0 += cw[k][0] * ((f32x4){xv[0], xv[1], xv[2], xv[3]} * m); x1 += cw[k][1] * ((f32x4){xv[4], xv[5], xv[6], xv[7]} * m); }
                v4u o; o.x = pk2(x0.x, x0.y); o.y = pk2(x0.z, x0.w); o.z = pk2(x1.x, x1.y); o.w = pk2(x1.z, x1.w);
                *(LAS v4u*)(TILE + tl * 264 + ch0) = o; }
        }
    }
    const int hb = wave & 3, nh = wave >> 2, fr = lane & 15, fq = lane >> 4;
    bf16x8 WA[2][2], WX[2][2];
#pragma unroll
    for (int kk = 0; kk < 2; ++kk)
#pragma unroll
        for (int nbl = 0; nbl < 2; ++nbl) { const int o = (hb * 64 + (2 * nh + nbl) * 16 + fr) * 64 + kk * 32 + 8 * fq; WA[kk][nbl] = *(GAS const bf16x8*)(WAT + o); WX[kk][nbl] = *(GAS const bf16x8*)(WXT + o); }
    f32x4 ba4[2], bx4[2], ls4[2], hc[2], ac[2];
#pragma unroll
    for (int nbl = 0; nbl < 2; ++nbl) { const int ch = hb * 64 + (2 * nh + nbl) * 16 + 4 * fq; ba4[nbl] = ld4(lba + ch); bx4[nbl] = ld4(lbx + ch);
        const f32x4 lm = ld4(lam + ch);
#pragma unroll
        for (int j = 0; j < 4; ++j) ls4[nbl][j] = -8.0f * log1pf(expf(-lm[j]));
        hc[nbl] = (f32x4){0.f, 0.f, 0.f, 0.f}; ac[nbl] = (f32x4){0.f, 0.f, 0.f, 0.f}; }
    __syncthreads();
#pragma unroll 1
    for (int tb = 0; tb < 8; ++tb) {
        const int tl = 16 * tb + fr; const size_t row = (size_t)b * SEQ + t0 + tl;
        bf16x8 X[2];
#pragma unroll
        for (int kk = 0; kk < 2; ++kk) X[kk] = *(const LAS bf16x8*)(TILE + tl * 264 + hb * 64 + kk * 32 + 8 * fq);
        float av[2][4], bv[2][4];
#pragma unroll
        for (int nbl = 0; nbl < 2; ++nbl) {
            f32x4 ra = (f32x4){0.f, 0.f, 0.f, 0.f}, rx = (f32x4){0.f, 0.f, 0.f, 0.f};
#pragma unroll
            for (int kk = 0; kk < 2; ++kk) { ra = mfma16(WA[kk][nbl], X[kk], ra); rx = mfma16(WX[kk][nbl], X[kk], rx); }
            const int ch = hb * 64 + (2 * nh + nbl) * 16 + 4 * fq;
            const f32x4 xcv = unpack4(*(const LAS v2u*)(TILE + tl * 264 + ch));
            v4u lab;
#pragma unroll
            for (int j = 0; j < 4; ++j) {
                const float e1 = __expf(-(ra[j] + ba4[nbl][j])), e2 = __expf(-(rx[j] + bx4[nbl][j]));
                const float rp = __builtin_amdgcn_rcpf((1.f + e1) * (1.f + e2)), r = (1.f + e2) * rp, ii = (1.f + e1) * rp;
                const float la = __builtin_bit_cast(float, pk2(r * ls4[nbl][j], 0.f) << 16);
                const float a = __expf(la), x2 = la + la;
                const float p = -x2 * (1.f + x2 * (0.5f + x2 * (0.16666667f + x2 * (0.041666668f + x2 * 0.0083333338f))));
                const float om = fmaxf((la > -0.0625f) ? p : __builtin_fmaf(-a, a, 1.f), 0.f);
                const float bb = __builtin_amdgcn_sqrtf(om) * ii * xcv[j];
                const unsigned pr = pk2(la, bb);
                lab[j] = pr;
                av[nbl][j] = a; bv[nbl][j] = __builtin_bit_cast(float, pr & 0xffff0000u);
                ac[nbl][j] += la;
            }
            *(GAS v4u*)(LAB + row * GWD + ch) = lab;
        }
        LRU_SCAN8(bv, av);
#pragma unroll
        for (int nbl = 0; nbl < 2; ++nbl)
#pragma unroll
            for (int j = 0; j < 4; ++j) hc[nbl][j] = row_bcast15(av[nbl][j] * hc[nbl][j] + bv[nbl][j]);
    }
#pragma unroll
    for (int nbl = 0; nbl < 2; ++nbl)
#pragma unroll
        for (int j = 0; j < 4; ++j) { float t = ac[nbl][j]; t += row_shr<1>(0.f, t); t += row_shr<2>(0.f, t); t += row_shr<4>(0.f, t); t += row_shr<8>(0.f, t); ac[nbl][j] = __expf(row_bcast15(t)); }
    if (fr == 0) {
#pragma unroll
        for (int nbl = 0; nbl < 2; ++nbl) { const int ch = hb * 64 + (2 * nh + nbl) * 16 + 4 * fq; gf ap = AGG + ((size_t)(b * NCH + chunk) * GWD + ch) * 2;
            *(GAS f32x4*)ap = (f32x4){ac[nbl][0], hc[nbl][0], ac[nbl][1], hc[nbl][1]}; *(GAS f32x4*)(ap + 4) = (f32x4){ac[nbl][2], hc[nbl][2], ac[nbl][3], hc[nbl][3]}; }
    }
}
DI void lru_out_unit(gcb PROJ, gb CAT, gcf lnorm, gcf H0, const GAS unsigned* LAB, LAS unsigned char* lds, int b, int chunk, int tid, int wave, int lane) {
    asm volatile("" : "+v"(tid)); lane = tid & 63;
    LAS float* SS = (LAS float*)lds;
    const int t0 = chunk * CH, hb = wave & 3, nh = wave >> 2, fr = lane & 15, fq = lane >> 4;
    v4u lab[8][2]; v2u gt[8][2];
#pragma unroll
    for (int tb = 0; tb < 8; ++tb)
#pragma unroll
        for (int nbl = 0; nbl < 2; ++nbl) { const size_t row = (size_t)b * SEQ + t0 + 16 * tb + fr; const int ch = hb * 64 + (2 * nh + nbl) * 16 + 4 * fq;
            lab[tb][nbl] = *(GAS const v4u*)(LAB + row * GWD + ch); gt[tb][nbl] = *(GAS const v2u*)(PROJ + row * INW + 1024 + ch); }
    f32x4 hc[2];
#pragma unroll
    for (int nbl = 0; nbl < 2; ++nbl) hc[nbl] = ld4(H0 + ((size_t)(b * NCH + chunk) * GWD + hb * 64 + (2 * nh + nbl) * 16 + 4 * fq));
    v2u yk[8][2];
    __syncthreads();
#pragma unroll
    for (int tb = 0; tb < 8; ++tb) {
        float ssq = 0.f;
        float av[2][4], bv[2][4];
#pragma unroll
        for (int nbl = 0; nbl < 2; ++nbl)
#pragma unroll
            for (int j = 0; j < 4; ++j) { const unsigned pr = lab[tb][nbl][j]; av[nbl][j] = __expf(__builtin_bit_cast(float, pr << 16)); bv[nbl][j] = __builtin_bit_cast(float, pr & 0xffff0000u); }
        LRU_SCAN8(bv, av);
#pragma unroll
        for (int nbl = 0; nbl < 2; ++nbl) { const f32x4 gt4 = unpack4(gt[tb][nbl]); f32x4 yv;
#pragma unroll
            for (int j = 0; j < 4; ++j) { const float h = av[nbl][j] * hc[nbl][j] + bv[nbl][j];
                hc[nbl][j] = row_bcast15(h);
                const float y = gelu_t(gt4[j]) * h; yv[j] = y; ssq += y * y; }
            yk[tb][nbl] = pack4(yv); }
        ssq += __shfl_xor(ssq, 16); ssq += __shfl_xor(ssq, 32); if (fq == 0) SS[wave * 128 + 16 * tb + fr] = ssq;
    }
    __syncthreads();
#pragma unroll
    for (int tb = 0; tb < 8; ++tb) { const int tl = 16 * tb + fr; const size_t row = (size_t)b * SEQ + t0 + tl; float tot = 0.f;
#pragma unroll
        for (int w = 0; w < 8; ++w) tot += SS[w * 128 + tl];
        const float rstd = rsqrtf(tot * (1.f / GWD) + EPS);
#pragma unroll
        for (int nbl = 0; nbl < 2; ++nbl) { const int ch = hb * 64 + (2 * nh + nbl) * 16 + 4 * fq; *(GAS v2u*)(CAT + row * D + 512 + ch) = pack4(unpack4(yk[tb][nbl]) * rstd * ld4(lnorm + ch)); } }
}

DI f32x4 mfma_p2(const v2u a0, const v2u a1, const v2u b0, const v2u b1, const f32x4 c) {
    v4u A, B; A.x = a0.x; A.y = a0.y; A.z = a1.x; A.w = a1.y; B.x = b0.x; B.y = b0.y; B.z = b1.x; B.w = b1.y;
    return __builtin_amdgcn_mfma_f32_16x16x32_bf16(__builtin_bit_cast(bf16x8, A), __builtin_bit_cast(bf16x8, B), c, 0, 0, 0);
}
template <bool OUT>
DI void hgrn_wave_unit(gcb PROJ, gb CAT, gcf LBl, gcf normg, gf ST, gf DEC, LAS float* wlf, int u, int lane) {
    asm volatile("" : "+v"(lane));
    const int hh = u & 3, c = (u >> 2) & (NCH - 1), b = u >> 8, fr = lane & 15, fq = lane >> 4;
    LAS bf16* QT = (LAS bf16*)wlf;
    LAS bf16* KT = QT + 16 * 72;
    LAS bf16* KH = KT + 16 * 72;
    LAS bf16* VT = KH + 64 * 20;
    LAS float* DC = (LAS float*)(VT + 64 * 20);
    const float lbv = LBl[hh * 64 + lane], oml = 1.f - lbv;
    gf stp = ST + ((size_t)((b * NCH + c) * 4 + hh)) * 4096;
    f32x4 S[4][4];
#pragma unroll
    for (int mi = 0; mi < 4; ++mi)
#pragma unroll
        for (int ni = 0; ni < 4; ++ni) S[mi][ni] = OUT ? *(GAS const f32x4*)(stp + ((mi * 4 + ni) * 64 + lane) * 4) : (f32x4){0.f, 0.f, 0.f, 0.f};
    float Dtot = 1.f;
    f32x4 ng4[4];
#pragma unroll
    for (int nv = 0; nv < 4; ++nv) ng4[nv] = OUT ? ld4(normg + hh * 64 + 16 * nv + 4 * fq) : (f32x4){0.f, 0.f, 0.f, 0.f};
    bf16 zr[16], vr[16], qr[16]; v2u gr[4];
#define HG_LOAD(sbn) do { const size_t r0_ = (size_t)b * SEQ + c * CH + (sbn) * 16; \
        _Pragma("unroll") for (int t = 0; t < 16; ++t) { gcb p = PROJ + (r0_ + t) * INW + hh * 64 + lane; zr[t] = p[1536]; vr[t] = p[1792]; if (OUT) qr[t] = p[1280]; else qr[t] = 0; } \
        _Pragma("unroll") for (int nv = 0; nv < 4; ++nv) { if (OUT) gr[nv] = *(GAS const v2u*)(PROJ + (r0_ + fr) * INW + 2048 + hh * 64 + 16 * nv + 4 * fq); else gr[nv] = (v2u){0u, 0u}; } } while (0)
    HG_LOAD(0);
    for (int sb = 0; sb < CH / 16; ++sb) {
        const size_t row0 = (size_t)b * SEQ + c * CH + sb * 16;
        float kk[16], Bt[16]; float Bc = 0.f;
#pragma unroll
        for (int t = 0; t < 16; ++t) {
            const float z = fminf(fmaxf(bf2f(zr[t]), -30.f), 30.f), ez = __expf(-z), sg = __builtin_amdgcn_rcpf(1.f + ez);
            const float f = fmaxf(lbv + oml * sg, 1e-30f);
            Bc += __logf(f); Bt[t] = Bc; kk[t] = oml * ez * sg;
            VT[lane * 20 + t] = vr[t];
            if (OUT) { const float q = siluf(bf2f(qr[t])); QT[t * 72 + lane] = f2bf(q * __expf(Bc)); KT[t * 72 + lane] = f2bf(kk[t] * __expf(fminf(-Bc, 60.f))); } }
#pragma unroll
        for (int t = 0; t < 16; ++t) KH[lane * 20 + t] = f2bf(kk[t] * __expf(Bc - Bt[t]));
        { const float dsub = __expf(Bc); DC[lane] = dsub; Dtot *= dsub; }
        v2u gcur[4];
#pragma unroll
        for (int nv = 0; nv < 4; ++nv) gcur[nv] = gr[nv];
        if (sb + 1 < CH / 16) HG_LOAD(sb + 1);
        LDS_WAIT();
        v2u vt[4]; const v2u zz = (v2u){0u, 0u};
#pragma unroll
        for (int nv = 0; nv < 4; ++nv) vt[nv] = *(const LAS v2u*)(VT + (16 * nv + fr) * 20 + 4 * fq);
        if (OUT) {
            f32x4 O[4], SC = (f32x4){0.f, 0.f, 0.f, 0.f};
            v2u qf[4], kf[4];
#pragma unroll
            for (int s = 0; s < 4; ++s) { qf[s] = *(const LAS v2u*)(QT + fr * 72 + 16 * s + 4 * fq); kf[s] = *(const LAS v2u*)(KT + fr * 72 + 16 * s + 4 * fq); }
            SC = mfma_p2(kf[0], kf[1], qf[0], qf[1], SC); SC = mfma_p2(kf[2], kf[3], qf[2], qf[3], SC);
#pragma unroll
            for (int nv = 0; nv < 4; ++nv) { O[nv] = (f32x4){0.f, 0.f, 0.f, 0.f};
                O[nv] = mfma_p2(pack4(S[nv][0]), pack4(S[nv][1]), qf[0], qf[1], O[nv]); O[nv] = mfma_p2(pack4(S[nv][2]), pack4(S[nv][3]), qf[2], qf[3], O[nv]); }
#pragma unroll
            for (int r = 0; r < 4; ++r) if (4 * fq + r > fr) SC[r] = 0.f;
            const v2u scp = pack4(SC);
            float ss = 0.f;
#pragma unroll
            for (int nv = 0; nv < 4; ++nv) { O[nv] = mfma_p2(vt[nv], zz, scp, zz, O[nv]); ss += (O[nv].x * O[nv].x + O[nv].y * O[nv].y) + (O[nv].z * O[nv].z + O[nv].w * O[nv].w); }
            ss += __shfl_xor(ss, 16); ss += __shfl_xor(ss, 32);
            const float rstd = rsqrtf(ss * (1.f / 64.f) + EPS);
            const size_t row = row0 + fr;
#pragma unroll
            for (int nv = 0; nv < 4; ++nv) { f32x4 g4 = unpack4(gcur[nv]);
                g4.x = siluf(g4.x); g4.y = siluf(g4.y); g4.z = siluf(g4.z); g4.w = siluf(g4.w);
                *(GAS v2u*)(CAT + row * D + 768 + hh * 64 + 16 * nv + 4 * fq) = pack4(O[nv] * rstd * ng4[nv] * g4); }
        }
#pragma unroll
        for (int ni = 0; ni < 4; ++ni) { const f32x4 dk = *(const LAS f32x4*)(DC + 16 * ni + 4 * fq); const v2u kh = *(const LAS v2u*)(KH + (16 * ni + fr) * 20 + 4 * fq);
#pragma unroll
            for (int mi = 0; mi < 4; ++mi) S[mi][ni] = mfma_p2(kh, zz, vt[mi], zz, S[mi][ni] * dk); }
        LDS_WAIT();
    }
    if (!OUT) {
#pragma unroll
        for (int mi = 0; mi < 4; ++mi)
#pragma unroll
            for (int ni = 0; ni < 4; ++ni) *(GAS f32x4*)(stp + ((mi * 4 + ni) * 64 + lane) * 4) = S[mi][ni];
        DEC[((size_t)((b * NCH + c) * 4 + hh)) * 64 + lane] = Dtot;
    }
}
#undef HG_LOAD

DI void carry_phase(gf ST, gcf DEC, gcf AGG, gf H0, int wg, int G, int tid) {
    const int gt = wg * NTHR + tid, NT = G * NTHR, lane = tid & 63, wv = gt >> 6;
    for (int idx = wv; idx < BATCH * GWD; idx += NT >> 6) { const int b = idx >> 8, ch = idx & 255;
        const f32x2 ah = *(GAS const f32x2*)(AGG + ((size_t)(b * NCH + lane) * GWD + ch) * 2); float a = ah.x, h = ah.y;
#pragma unroll
        for (int d = 1; d < 64; d <<= 1) { const float ap = __shfl_up(a, d), hp = __shfl_up(h, d); if (lane >= d) { h = a * hp + h; a = a * ap; } }
        const float hprev = __shfl_up(h, 1);
        H0[(size_t)(b * NCH + lane) * GWD + ch] = lane ? hprev : 0.f; }
    for (int idx = gt; idx < BATCH * 4 * 4096; idx += NT) { const int b = idx >> 14, hh = (idx >> 12) & 3, kv = idx & 4095, k = 16 * ((kv >> 8) & 3) + 4 * ((kv >> 6) & 3) + (kv & 3); float run = 0.f;
#pragma unroll 1
        for (int c0 = 0; c0 < NCH; c0 += 32) { float sl[32], d[32];
#pragma unroll
            for (int c = 0; c < 32; ++c) { sl[c] = ST[((size_t)((b * NCH + c0 + c) * 4 + hh)) * 4096 + kv]; d[c] = DEC[((size_t)((b * NCH + c0 + c) * 4 + hh)) * 64 + k]; }
#pragma unroll
            for (int c = 0; c < 32; ++c) { ST[((size_t)((b * NCH + c0 + c) * 4 + hh)) * 4096 + kv] = run; run = d[c] * run + sl[c]; } } }
}
struct Args { const float* in[33]; float* out; unsigned char* ws; int ph_lo, ph_hi; };
enum { I_X = 0, I_C, I_WMOD, I_BMOD, I_NMIX, I_NFFN, I_NFIN, I_WIN, I_WOUT, I_POOLW, I_POOLS, I_POOLN, I_SGUW, I_SGUB, I_SGUN, I_CONVW, I_CONVB, I_LWA, I_LBA, I_LWX, I_LBX, I_LAM, I_LN,
       I_HGAM, I_HN, I_F1, I_F3, I_F2, I_RW, I_RB, I_M1, I_M3, I_M2 };
constexpr int N_PHASES = 1 + (7 + 2) + (8 + (IS_F8(1) ? 4 : 8)) + (7 + 2) + (8 + (IS_F8(3) ? 4 : 8)) + 1;

DI gws launder(unsigned char* p) { asm volatile("" : "+s"(p)); return (gws)p; }
DI gcf inp(const Args& a, int i) { asm volatile("" : "+s"(i)); return (gcf)a.in[i]; }
#define WSP(T, off) ((GAS T*)(ws + (off)))
#define WSG(T, off) ((T*)((unsigned char*)ws + (off)))

__global__ void __launch_bounds__(NTHR, 2) mk_fwd(Args args) {
    extern __shared__ __attribute__((aligned(16))) unsigned char lds_raw[];
    LAS unsigned char* lds = (LAS unsigned char*)lds_raw;
    const int tid0 = threadIdx.x, wg0 = blockIdx.x, G0 = gridDim.x;
    for (int u = tid0; u < (LDS_BYTES - RING_BYTES) / 4; u += NTHR) ((LAS unsigned*)(lds + RING_BYTES))[u] = 0u;
    __syncthreads();
    const XcdBarrier bar = xcd_barrier_post((unsigned*)(args.ws + WS_CTL) + CW_BAR, (volatile LAS unsigned*)(lds + MISC_OFF) + 8);
    const int lo = args.ph_lo, hi = args.ph_hi;
#define XOUT ((gf)args.out)
    int pi = 0;
#define PH_IDS int tid = (bar.w0 << 6) | hw_lane(); asm volatile("" : "+v"(tid)); const int lane = tid & 63, wave = __builtin_amdgcn_readfirstlane(tid >> 6); int wg = wg0, G = G0; asm volatile("" : "+s"(wg), "+s"(G))
#define PH_ON (pi >= lo && pi < hi)
#define PH_END do { if (pi >= lo && pi + 1 < hi) xcd_barrier(bar); ++pi; } while (0)

    if (PH_ON) { gws ws = launder(args.ws); PH_IDS;
        p0_prologue(inp(args, I_C), inp(args, I_WMOD), inp(args, I_BMOD), inp(args, I_HGAM), inp(args, I_POOLW), inp(args, I_LWA), inp(args, I_LWX), inp(args, I_SGUW), ws, lds, wg, G, tid, wave, lane); }
    PH_END;

    for (int l = 0; l < DEPTH; ++l) {
        const int moe = l & 1;
        if (PH_ON) { gws ws = launder(args.ws); PH_IDS; gcf modl = WSP(float, WS_MOD) + (size_t)l * 8 * MODW;
            convert_weights(l, inp(args, I_WIN), inp(args, I_WOUT), inp(args, I_F1), inp(args, I_F3), inp(args, I_F2), inp(args, I_M1), inp(args, I_M3), inp(args, I_M2), ws, lds, wg, G, wave, lane);
            if (l == 2) norm_phase<true, false, false, false, (bool)IS_B8(2)>(nullptr, WSP(bf16, WS_XB), nullptr, inp(args, I_NMIX) + l * D, modl + 0 * D, modl + 1 * D, modl - 8 * MODW + 5 * D, WSP(bf16, WS_XN), WSP(bf16, WS_Y1), IS_B8(2) ? WSP(bf16, WS_CAT) : WSP(bf16, WS_XN), nullptr, nullptr, nullptr, nullptr, nullptr, nullptr, lds, wg, G, tid, wave, lane);
            else if (l == 0) norm_phase<false, false, false, true>(inp(args, I_X), WSP(bf16, WS_XB), nullptr, inp(args, I_NMIX) + l * D, modl + 0 * D, modl + 1 * D, nullptr, nullptr, nullptr, WSP(bf16, WS_XN), nullptr, nullptr, nullptr, nullptr, nullptr, nullptr, lds, wg, G, tid, wave, lane);
            else if (IS_B8(l)) norm_phase<false, false, false, false, true>(nullptr, WSP(bf16, WS_XB), nullptr, inp(args, I_NMIX) + l * D, modl + 0 * D, modl + 1 * D, nullptr, nullptr, nullptr, WSP(bf16, WS_XN), nullptr, nullptr, nullptr, nullptr, nullptr, nullptr, lds, wg, G, tid, wave, lane);
            else norm_phase<false, false, false, false>(nullptr, WSP(bf16, WS_XB), nullptr, inp(args, I_NMIX) + l * D, modl + 0 * D, modl + 1 * D, nullptr, nullptr, nullptr, WSP(bf16, WS_XN), nullptr, nullptr, nullptr, nullptr, nullptr, nullptr, lds, wg, G, tid, wave, lane);
        }
        PH_END;
        if (PH_ON && !IS_B8(l)) { gws ws = launder(args.ws); PH_IDS;
            pg8::Gemm g{WSG(bf16, WS_XN), WSG(bf16, WS_WIN), D}; pg8::TileOrder<INW / 256> S; S.init(M / 256, G, wg, 0, 0, nullptr);
            EpiProj E{WSP(bf16, WS_PROJ), 1.0f};
            pg8::gemm_phase<EpiProj, pg8::TileOrder<INW / 256>, true, true>(lds, g, S, E, tid);
        }
        if (PH_ON && IS_B8(l)) { gws ws = launder(args.ws); PH_IDS;
            pg8::Gemm g{l == 2 ? WSG(bf16, WS_CAT) : WSG(bf16, WS_XN), WSG(bf16, WS_WIN), D / 2}; pg8::TileOrder<INW / 256> S; S.init(M / 256, G, wg, 0, 0, nullptr);
            EpiProj E{WSP(bf16, WS_PROJ), 1.0f / F8_S13};
            pg8::gemm_phase<EpiProj, pg8::TileOrder<INW / 256>, true, true, true>(lds, g, S, E, tid);
        }
        PH_END;
        if (PH_ON) { gws ws = launder(args.ws); PH_IDS; gcb PROJ = WSP(bf16, WS_PROJ); gb CAT = WSP(bf16, WS_CAT);
            for (int unit = wg; unit < BATCH * NCH; unit += G) { const int b = unit >> 6, blk = unit & (NCH - 1);
                pool_unit(PROJ, CAT, WSP(bf16, WS_POOLWT) + l * 16384, inp(args, I_POOLS) + l * GWD, inp(args, I_POOLN) + l * GWD, lds, b, blk * CH, tid, wave, lane);
                sgu_unit(PROJ, CAT, WSP(bf16, WS_SGUW) + l * 65536, inp(args, I_SGUB) + l * 512, inp(args, I_SGUN) + l * GWD, lds, b, blk * CH, tid, wave, lane);
                lru_local_unit(PROJ, inp(args, I_CONVW) + l * 4 * GWD, inp(args, I_CONVB) + l * GWD, inp(args, I_LBA) + l * GWD, inp(args, I_LBX) + l * GWD, inp(args, I_LAM) + l * GWD,
                               WSP(bf16, WS_LRUWAT) + l * 16384, WSP(bf16, WS_LRUWXT) + l * 16384, WSP(float, WS_AGG), WSP(unsigned, WS_LAB), lds, b, blk, tid, wave, lane);
                __syncthreads(); }
            for (int u = wg * NWAVES + wave; u < BATCH * NCH * 4; u += G * NWAVES)
                hgrn_wave_unit<false>(PROJ, CAT, WSP(float, WS_LB) + l * GWD, inp(args, I_HN) + l * GWD, WSP(float, WS_ST), WSP(float, WS_DEC), (LAS float*)(lds + wave * 16384), u, lane);
        }
        PH_END;
        if (PH_ON) { gws ws = launder(args.ws); PH_IDS; carry_phase(WSP(float, WS_ST), WSP(float, WS_DEC), WSP(float, WS_AGG), WSP(float, WS_H0), wg, G, tid); }
        PH_END;
        if (PH_ON) { gws ws = launder(args.ws); PH_IDS; gcb PROJ = WSP(bf16, WS_PROJ); gb CAT = WSP(bf16, WS_CAT);
            for (int unit = wg; unit < BATCH * NCH; unit += G) { const int b = unit >> 6, blk = unit & (NCH - 1);
                lru_out_unit(PROJ, CAT, inp(args, I_LN) + l * GWD, WSP(float, WS_H0), WSP(unsigned, WS_LAB), lds, b, blk, tid, wave, lane); }
            __syncthreads();
            for (int u = wg * NWAVES + wave; u < BATCH * NCH * 4; u += G * NWAVES)
                hgrn_wave_unit<true>(PROJ, CAT, WSP(float, WS_LB) + l * GWD, inp(args, I_HN) + l * GWD, WSP(float, WS_ST), WSP(float, WS_DEC), (LAS float*)(lds + wave * 16384), u, lane);
        }
        PH_END;
        if (PH_ON) { gws ws = launder(args.ws); PH_IDS;
            pg8::Gemm g{WSG(bf16, WS_CAT), WSG(bf16, WS_WOUT), D}; pg8::TileOrder<D / 256> S; S.init(M / 256, G, wg, 0, 0, nullptr);
            EpiResid E{WSP(bf16, WS_XB), WSP(float, WS_MOD) + (size_t)l * 8 * MODW + 2 * D, 1.0f};
            pg8::gemm_phase<EpiResid, pg8::TileOrder<D / 256>, true, true>(lds, g, S, E, tid);
        }
        PH_END;
        if (PH_ON) { gws ws = launder(args.ws); PH_IDS; gcf modl = WSP(float, WS_MOD) + (size_t)l * 8 * MODW;
            if (moe) norm_phase<false, true, false, false, MOE_XN8>(nullptr, WSP(bf16, WS_XB), nullptr, inp(args, I_NFFN) + l * D, modl + 3 * D, modl + 4 * D, nullptr, nullptr, nullptr, WSP(bf16, WS_XN), inp(args, I_RW) + (l >> 1) * D * NE, inp(args, I_RB) + (l >> 1) * NE,
                                                    WSP(int, WS_TOKE), WSP(float, WS_TOKW), WSP(int, WS_HISTW), WSP(v2i, WS_PAIR), lds, wg, G, tid, wave, lane);
            else if (IS_F8(l)) norm_phase<false, false, false, false, true>(nullptr, WSP(bf16, WS_XB), nullptr, inp(args, I_NFFN) + l * D, modl + 3 * D, modl + 4 * D, nullptr, nullptr, nullptr, WSP(bf16, WS_XN), nullptr, nullptr, nullptr, nullptr, nullptr, nullptr, lds, wg, G, tid, wave, lane);
            else norm_phase<false, false, false, false>(nullptr, WSP(bf16, WS_XB), nullptr, inp(args, I_NFFN) + l * D, modl + 3 * D, modl + 4 * D, nullptr, nullptr, nullptr, WSP(bf16, WS_XN), nullptr, nullptr, nullptr, nullptr, nullptr, nullptr, lds, wg, G, tid, wave, lane);
        }
        PH_END;
        if (moe) {
            if (PH_ON) { gws ws = launder(args.ws); PH_IDS;
                    route_phase(WSP(bf16, WS_XN), WSP(bf16, WS_PROJ), WSP(int, WS_TOKE), WSP(float, WS_TOKW), WSP(int, WS_HISTW), WSP(v2i, WS_PAIR), WSP(int, WS_TILEE), WSP(int, WS_NT), lds, wg, G, tid, wave, lane, IS_F8(l)); }
            PH_END;
        }
        const int nck = moe ? (IS_F8(l) ? 2 : 4) : 1;
#define FFN_RANGE int pm0 = 0, nM = M / 256; if (moe) { const int ntl = __builtin_amdgcn_readfirstlane(__hip_atomic_load(WSP(int, WS_NT), __ATOMIC_RELAXED, __HIP_MEMORY_SCOPE_AGENT)); \
            if (IS_F8(l)) { pm0 = ck * 256; nM = (ck < 1) ? 256 : ntl - 256; if (nM > 292) nM = 292; } else { pm0 = ck * 128; nM = (ck < 3) ? 128 : ntl - 384; if (nM > 146) nM = 146; } if (nM < 0) nM = 0; }
        for (int ck = 0; ck < nck; ++ck) {
            if (PH_ON && !IS_F8(l)) { gws ws = launder(args.ws); PH_IDS; FFN_RANGE;
                pg8::Gemm g{moe ? WSG(bf16, WS_PROJ) : WSG(bf16, WS_XN), WSG(bf16, WS_W13), D}; pg8::TileOrder<DFF / 128> S; S.init(nM, G, wg, pm0, 0, moe ? WSG(int, WS_TILEE) : nullptr);
                EpiSwiglu E{moe ? WSP(bf16, WS_CAT) : WSP(bf16, WS_PROJ), pm0};
                pg8::gemm_phase<EpiSwiglu, pg8::TileOrder<DFF / 128>, true, true>(lds, g, S, E, tid);
            }
            if (PH_ON && IS_F8(l)) { gws ws = launder(args.ws); PH_IDS; FFN_RANGE;
                pg8::Gemm g{moe ? WSG(bf16, WS_PROJ) : WSG(bf16, WS_XN), WSG(bf16, WS_W13), D / 2}; pg8::TileOrder<DFF / 128> S; S.init(nM, G, wg, pm0, 0, moe ? WSG(int, WS_TILEE) : nullptr);
                EpiSwiglu8 E{moe ? WSP(unsigned char, WS_CAT) : WSP(unsigned char, WS_PROJ), pm0};
                pg8::gemm_phase<EpiSwiglu8, pg8::TileOrder<DFF / 128>, true, true, true>(lds, g, S, E, tid);
            }
            PH_END;
            if (PH_ON && !IS_F8(l) && moe) { gws ws = launder(args.ws); PH_IDS; FFN_RANGE;
                pg8::Gemm g{WSG(bf16, WS_CAT), WSG(bf16, WS_W2), DFF}; pg8::TileOrder<D / 256> S; S.init(nM, G, wg, pm0, 1, WSG(int, WS_TILEE));
                EpiScatter E{WSP(v2i, WS_PAIR), WSP(bf16, WS_XN), WSP(bf16, WS_Y1), WSP(int, WS_TOKE), WSP(float, WS_TOKW), 1.0f};
                pg8::gemm_phase<EpiScatter, pg8::TileOrder<D / 256>, true, true>(lds, g, S, E, tid);
            }
            if (PH_ON && !moe && !IS_F8(l)) { gws ws = launder(args.ws); PH_IDS; FFN_RANGE;
                pg8::Gemm g{WSG(bf16, WS_PROJ), WSG(bf16, WS_W2), DFF}; pg8::TileOrder<D / 256> S; S.init(nM, G, wg, pm0, 1, nullptr);
                EpiResid E{WSP(bf16, WS_XB), WSP(float, WS_MOD) + (size_t)l * 8 * MODW + 5 * D, 1.0f};
                pg8::gemm_phase<EpiResid, pg8::TileOrder<D / 256>, true, true>(lds, g, S, E, tid);
            }
            if (PH_ON && IS_F8(l) && !moe) { gws ws = launder(args.ws); PH_IDS; FFN_RANGE;
                pg8::Gemm g{WSG(bf16, WS_PROJ), WSG(bf16, WS_W2), DFF / 2}; pg8::TileOrder<D / 256> S; S.init(nM, G, wg, pm0, 1, nullptr);
                EpiResid E{WSP(bf16, WS_XB), WSP(float, WS_MOD) + (size_t)l * 8 * MODW + 5 * D, 1.0f / F8_S2};
                pg8::gemm_phase<EpiResid, pg8::TileOrder<D / 256>, true, true, true>(lds, g, S, E, tid);
            }
            if (PH_ON && IS_F8(l) && moe) { gws ws = launder(args.ws); PH_IDS; FFN_RANGE;
                pg8::Gemm g{WSG(bf16, WS_CAT), WSG(bf16, WS_W2), DFF / 2}; pg8::TileOrder<D / 256> S; S.init(nM, G, wg, pm0, 1, WSG(int, WS_TILEE));
                EpiScatter E{WSP(v2i, WS_PAIR), WSP(bf16, WS_XN), WSP(bf16, WS_Y1), WSP(int, WS_TOKE), WSP(float, WS_TOKW), 1.0f / F8_S2};
                pg8::gemm_phase<EpiScatter, pg8::TileOrder<D / 256>, true, true, true>(lds, g, S, E, tid);
            }
            PH_END;
        }
#undef FFN_RANGE
    }
    if (PH_ON) { gws ws = launder(args.ws); PH_IDS;
        norm_phase<true, false, true, false>(nullptr, WSP(bf16, WS_XB), XOUT, inp(args, I_NFIN), nullptr, nullptr, WSP(float, WS_MOD) + (size_t)3 * 8 * MODW + 5 * D, WSP(bf16, WS_XN), WSP(bf16, WS_Y1), nullptr, nullptr, nullptr, nullptr, nullptr, nullptr, nullptr, lds, wg, G, tid, wave, lane); }
#undef PH_ON
#undef PH_END
}

#ifndef MK_CUTS
#define MK_CUTS 0
#endif
extern "C" void kernel_launch(void* const* d_in, gci in_sizes, int n_in, void* d_out, int out_size, void* d_ws, size_t ws_size, hipStream_t stream) {
    static int grid = 0;
    if (grid == 0) {
        if (n_in != 33 || in_sizes[0] != M * D || out_size != M * D || ws_size < WS_END) { fprintf(stderr, "kernel_launch: unexpected shapes (n_in %d, in0 %d, out %d, ws %zu); nothing launched\n", n_in, n_in > 0 ? in_sizes[0] : -1, out_size, ws_size); grid = -1; return; }
        int dev = 0, cus = 0, per_cu = 0;
        if (hipGetDevice(&dev) != hipSuccess || hipDeviceGetAttribute(&cus, hipDeviceAttributeMultiprocessorCount, dev) != hipSuccess) { grid = -1; return; }
        if (hipFuncSetAttribute((const void*)mk_fwd, hipFuncAttributeMaxDynamicSharedMemorySize, LDS_BYTES) != hipSuccess) { fprintf(stderr, "kernel_launch: hipFuncSetAttribute failed\n"); grid = -1; return; }
        if (hipOccupancyMaxActiveBlocksPerMultiprocessor(&per_cu, (const void*)mk_fwd, NTHR, LDS_BYTES) != hipSuccess || per_cu < 1) fprintf(stderr, "kernel_launch: occupancy query reports %d workgroups per CU\n", per_cu);
        (void)hipGetLastError();
        grid = cus;
    }
    if (grid < 0) return;
    if (hipMemsetAsync((char*)d_ws + WS_CTL, 0, CTL_ZERO_BYTES, stream) != hipSuccess) return;
    Args a{};
    for (int i = 0; i < 33; ++i) a.in[i] = (const float*)d_in[i];
    a.out = (float*)d_out; a.ws = (unsigned char*)d_ws;
#if MK_CUTS
    for (int p = 0; p < N_PHASES; ++p) { a.ph_lo = p; a.ph_hi = p + 1; hipLaunchKernelGGL(mk_fwd, dim3(grid), dim3(NTHR), LDS_BYTES, stream, a); }
#else
    a.ph_lo = 0; a.ph_hi = N_PHASES;
    hipLaunchKernelGGL(mk_fwd, dim3(grid), dim3(NTHR), LDS_BYTES, stream, a);
#endif
}
```

```cpp
#include <hip/hip_runtime.h>
#include <cstdio>
#include <cstdint>

namespace pg8 {
#define PG8_LAS __attribute__((address_space(3)))
typedef unsigned short bf16_t;
typedef short bf16x8 __attribute__((ext_vector_type(8)));
typedef float f32x4 __attribute__((ext_vector_type(4)));
typedef unsigned u32x4 __attribute__((ext_vector_type(4)));
constexpr int BM = 256, BK = 64, HALF = 128, HTB = HALF * BK * 2  , STAGE_BYTES = 8 * HTB, NXCD = 8, WGM = 8;

__host__ __device__ __forceinline__ int lds_byte(int r, int c) { const int st = (r >> 4) * 2 + (c >> 5), rr = r & 15, cc = c & 31, ob = rr * 64 + cc * 2; return st * 1024 + (ob ^ (((ob >> 9) & 1) << 5)); }
__host__ __device__ __forceinline__ void stage_rc(int b, int& R, int& C) { const int st = b / 1024, sb = b % 1024, swz = sb ^ (((sb >> 9) & 1) << 5); R = (st >> 1) * 16 + swz / 64; C = (st & 1) * 32 + (swz % 64) / 2; }
__host__ __device__ __forceinline__ int perm32(int rho) { const int n = rho >> 4, i = rho & 15; return 8 * (i >> 2) + 4 * n + (i & 3); }

struct Unit { int pa, pn, pm, pc; };
struct Gemm { const bf16_t* A; const bf16_t* Bt; int K; };

template <int NN>
struct TileOrder {
    int nM, nwg, G, c, pm0, a_rel; const int* tile_e;
    __device__ __forceinline__ void init(int nM_, int G_, int c_, int pm0_, int a_rel_, const int* te) { nM = nM_; nwg = nM_ * NN; G = G_; c = c_; pm0 = pm0_; a_rel = a_rel_; tile_e = te; }
    __device__ __forceinline__ bool next(int i, Unit& u) const {
        const int L = i * G + c; if (L >= nwg) return false;
        int wgid = L; { const int q = nwg >> 3, r = nwg & 7, xcd = wgid & 7, off = wgid >> 3; wgid = (xcd < r ? xcd * (q + 1) : r * (q + 1) + (xcd - r) * q) + off; }
        constexpr int nig = WGM * NN;
        const int gid = wgid / nig, x = wgid - gid * nig, fm = gid * WGM, rem = nM - fm;
        int pml, pc;
        if (rem >= WGM) { pml = fm + (x & (WGM - 1)); pc = x >> 3; } else { pml = fm + (x % rem); pc = x / rem; }
        u.pm = pm0 + pml; u.pc = pc; u.pa = a_rel ? pml : u.pm;
        int e = 0; if (tile_e) e = __builtin_amdgcn_readfirstlane(__hip_atomic_load(tile_e + u.pm, __ATOMIC_RELAXED, __HIP_MEMORY_SCOPE_AGENT));
        u.pn = e * NN + pc; return true;
    }
    __device__ __forceinline__ void a_ready(const Unit&) const {}
    __device__ __forceinline__ void done(const Unit&) const {}
};
typedef int v8i32 __attribute__((ext_vector_type(8)));
typedef int v4i32 __attribute__((ext_vector_type(4)));
__device__ __forceinline__ unsigned cvt_pk_bf16(float lo, float hi) { unsigned r; asm("v_cvt_pk_bf16_f32 %0, %1, %2" : "=v"(r) : "v"(lo), "v"(hi)); return r; }

template <class Epi, class Sched, bool ALIGN_EPI = false, bool SP2 = false, bool F8 = false>
__device__ __forceinline__ void gemm_phase(PG8_LAS unsigned char* lds, const Gemm g, const Sched& S, const Epi& E, const int tid_in) {
    int tid = tid_in; asm volatile("" : "+v"(tid));
    const int wid = __builtin_amdgcn_readfirstlane(tid >> 6), lane = tid & 63, wr = wid >> 2, wc = wid & 3, fr = lane & 15, fq = lane >> 4;
    const int K = g.K, nt = K / BK;
    unsigned voffA[2], voffB[2];
#pragma unroll
    for (int i = 0; i < 2; ++i) { int R, C; stage_rc(tid * 16 + i * 8192, R, C); const int Rb = Epi::PERM ? ((R & ~31) + perm32(R & 31)) : R;
        voffA[i] = (unsigned)(R * K + C) * 2u; voffB[i] = (unsigned)(Rb * K + C) * 2u; }
    const size_t kstep = (size_t)(BK * 2);
    const size_t hstep = (size_t)HALF * K * 2;
    const size_t tstep = 2 * hstep;
    const unsigned ldsw = (unsigned)wid * 1024u;
    const int aoff = lds_byte(wr * 64 + fr, fq * 8), boff = lds_byte(wc * 32 + fr, fq * 8);
#define PG8_SA(b, h) (((b) * 2 + (h)) * HTB)
#define PG8_SB(b, h) ((4 + (b) * 2 + (h)) * HTB)
#define PG8_STAGE(bufoff, gbase, voff) do { _Pragma("unroll") for (int _i = 0; _i < 2; ++_i) \
        __builtin_amdgcn_global_load_lds((const unsigned*)((const char*)(gbase) + (voff)[_i]), (PG8_LAS unsigned*)(lds + (bufoff) + ldsw + _i * 8192), 16, 0, 0); } while (0)
#define PG8_LD16(off_) (*(const PG8_LAS v4i32*)(lds + (off_)))
#define PG8_LDA(dst, b, h) do { _Pragma("unroll") for (int m = 0; m < 4; ++m) { if constexpr (F8) dst##8[m] = __builtin_shufflevector(PG8_LD16(PG8_SA(b, h) + aoff + m * 2048), PG8_LD16(PG8_SA(b, h) + aoff + m * 2048 + 1024), 0, 1, 2, 3, 4, 5, 6, 7); \
        else { _Pragma("unroll") for (int k = 0; k < 2; ++k) dst[m][k] = *(const PG8_LAS bf16x8*)(lds + PG8_SA(b, h) + aoff + m * 2048 + k * 1024); } } } while (0)
#define PG8_LDB(dst, b, h) do { _Pragma("unroll") for (int n = 0; n < 2; ++n) { if constexpr (F8) dst##8[n] = __builtin_shufflevector(PG8_LD16(PG8_SB(b, h) + boff + n * 2048), PG8_LD16(PG8_SB(b, h) + boff + n * 2048 + 1024), 0, 1, 2, 3, 4, 5, 6, 7); \
        else { _Pragma("unroll") for (int k = 0; k < 2; ++k) dst[n][k] = *(const PG8_LAS bf16x8*)(lds + PG8_SB(b, h) + boff + n * 2048 + k * 1024); } } } while (0)
#define PG8_MMA(ai, bj, At, Bt, FIRST) do { __builtin_amdgcn_s_setprio(1); _Pragma("unroll") for (int m = 0; m < 4; ++m) _Pragma("unroll") for (int n = 0; n < 2; ++n) { \
        if constexpr (F8) { if constexpr (FIRST) asm volatile("v_mfma_scale_f32_16x16x128_f8f6f4 %0, %1, %2, 0, %3, %3 op_sel_hi:[0,0,0]" : "=&v"(acc[ai][bj][m][n]) : "v"(Bt##8[n]), "v"(At##8[m]), "v"(f8scale)); \
            else asm volatile("v_mfma_scale_f32_16x16x128_f8f6f4 %0, %1, %2, %0, %3, %3 op_sel_hi:[0,0,0]" : "+v"(acc[ai][bj][m][n]) : "v"(Bt##8[n]), "v"(At##8[m]), "v"(f8scale)); } \
        else { acc[ai][bj][m][n] = __builtin_amdgcn_mfma_f32_16x16x32_bf16(Bt[n][0], At[m][0], acc[ai][bj][m][n], 0, 0, 0); \
            acc[ai][bj][m][n] = __builtin_amdgcn_mfma_f32_16x16x32_bf16(Bt[n][1], At[m][1], acc[ai][bj][m][n], 0, 0, 0); } } __builtin_amdgcn_s_setprio(0); } while (0)
#define PG8_WAIT_V(n) asm volatile("s_waitcnt vmcnt(" #n ")" ::: "memory")
#define PG8_WAIT_L(n) asm volatile("s_waitcnt lgkmcnt(" #n ")" ::: "memory")
#define PG8_BAR __builtin_amdgcn_s_barrier()
#define PG8_SCHED __builtin_amdgcn_sched_barrier(0)
    Unit cur, nxt; int ui = 0;
    if (!S.next(0, cur)) return;
    f32x4 acc[2][2][4][2];
    if constexpr (!F8) {
#pragma unroll
    for (int a = 0; a < 2; ++a)
#pragma unroll
        for (int b = 0; b < 2; ++b)
#pragma unroll
            for (int m = 0; m < 4; ++m)
#pragma unroll
                for (int n = 0; n < 2; ++n) acc[a][b][m][n] = (f32x4){0.f, 0.f, 0.f, 0.f};
    }
    bf16x8 At[4][2], B0[2][2], B1[2][2];
    const int f8scale = 0x7f7f7f7f;
    v8i32 At8[4], B08[2], B18[2];
    const char* cA = (const char*)g.A + (size_t)cur.pa * tstep; const char* cB = (const char*)g.Bt + (size_t)cur.pn * tstep;
    S.a_ready(cur);
    {
        PG8_STAGE(PG8_SB(0, 0), cB, voffB); PG8_STAGE(PG8_SB(0, 1), cB + hstep, voffB); PG8_STAGE(PG8_SA(0, 0), cA, voffA); PG8_STAGE(PG8_SA(0, 1), cA + hstep, voffA);
        if (wr == 1) PG8_BAR;
        PG8_WAIT_V(2); PG8_BAR;
        PG8_STAGE(PG8_SB(1, 0), cB + kstep, voffB); PG8_STAGE(PG8_SA(1, 0), cA + kstep, voffA); PG8_STAGE(PG8_SB(1, 1), cB + hstep + kstep, voffB);
        PG8_WAIT_V(6); PG8_BAR;
    }
    for (;;) {
        const bool has_next = S.next(ui + 1, nxt);
        const char* nA = has_next ? (const char*)g.A + (size_t)nxt.pa * tstep : cA; const char* nB = has_next ? (const char*)g.Bt + (size_t)nxt.pn * tstep : cB;
#define PG8_MMA_F(ai, bj, At, Bt) do { if (F8 && t == 0) PG8_MMA(ai, bj, At, Bt, true); else PG8_MMA(ai, bj, At, Bt, false); } while (0)
#pragma nounroll
        for (int t = 0; t < nt; t += 2) {
            const bool last = (t == nt - 2);
            const char* a1 = cA + (size_t)(t + 1) * kstep;
            const char* a2 = last ? nA : cA + (size_t)(t + 2) * kstep; const char* b2 = last ? nB : cB + (size_t)(t + 2) * kstep;
            const char* a3 = a2 + kstep; const char* b3 = b2 + kstep;
            if (last && has_next) S.a_ready(nxt);
            PG8_LDB(B0, 0, 0); PG8_LDB(B1, 0, 1); PG8_SCHED; PG8_LDA(At, 0, 0); PG8_STAGE(PG8_SA(1, 1), a1 + hstep, voffA);
            PG8_WAIT_V(8); PG8_WAIT_L(0); PG8_BAR; PG8_MMA_F(0, 0, At, B0); PG8_MMA_F(0, 1, At, B1); PG8_BAR; PG8_SCHED;
            PG8_LDA(At, 0, 1); PG8_STAGE(PG8_SB(0, 0), b2, voffB); PG8_STAGE(PG8_SB(0, 1), b2 + hstep, voffB); PG8_STAGE(PG8_SA(0, 0), a2, voffA);
            PG8_WAIT_V(8); PG8_WAIT_L(0); PG8_BAR; PG8_MMA_F(1, 0, At, B0); PG8_MMA_F(1, 1, At, B1); PG8_BAR; PG8_SCHED;
            PG8_LDB(B0, 1, 0); PG8_LDB(B1, 1, 1); PG8_SCHED; PG8_LDA(At, 1, 0); PG8_STAGE(PG8_SA(0, 1), a2 + hstep, voffA);
            PG8_WAIT_V(8); PG8_WAIT_L(0); PG8_BAR; PG8_MMA(0, 0, At, B0, false); PG8_MMA(0, 1, At, B1, false); PG8_BAR; PG8_SCHED;
            PG8_LDA(At, 1, 1); PG8_STAGE(PG8_SB(1, 0), b3, voffB); PG8_STAGE(PG8_SB(1, 1), b3 + hstep, voffB); PG8_STAGE(PG8_SA(1, 0), a3, voffA);
            PG8_WAIT_V(8); PG8_WAIT_L(0); PG8_BAR; PG8_MMA(1, 0, At, B0, false); PG8_MMA(1, 1, At, B1, false); PG8_BAR; PG8_SCHED;
        }
#undef PG8_MMA_F
        if constexpr (ALIGN_EPI) { if (wr == 0) PG8_BAR; }
        if constexpr (F8) asm volatile("s_nop 15\n\ts_nop 15" ::: "memory");
        if constexpr (!Epi::AFTER_DRAIN) { E(acc, cur, wr, wc, fr, fq); S.done(cur); }
        if (!has_next) break;
        if constexpr (!F8) {
#pragma unroll
        for (int a = 0; a < 2; ++a)
#pragma unroll
            for (int b = 0; b < 2; ++b)
#pragma unroll
                for (int m = 0; m < 4; ++m)
#pragma unroll
                    for (int n = 0; n < 2; ++n) acc[a][b][m][n] = (f32x4){0.f, 0.f, 0.f, 0.f};
        }
        cur = nxt; cA = nA; cB = nB; ++ui;
        if constexpr (ALIGN_EPI) { if (wr == 1) PG8_BAR; }
    }
    PG8_WAIT_V(0);
    if constexpr (!ALIGN_EPI) { if (wr == 0) PG8_BAR; }
    PG8_BAR;
    if constexpr (Epi::AFTER_DRAIN) { E.fused(acc, cur, wr, wc, fr, fq, lds, wid, lane); S.done(cur); }
#undef PG8_SA
#undef PG8_SB
#undef PG8_STAGE
#undef PG8_LDA
#undef PG8_LD16
#undef PG8_LDB
#undef PG8_MMA
#undef PG8_WAIT_V
#undef PG8_WAIT_L
#undef PG8_BAR
#undef PG8_SCHED
}
}

constexpr int NWAVES = 8, NTHR = NWAVES * 64;
constexpr int BATCH = 8, SEQ = 8192, D = 1024, M = BATCH * SEQ, DEPTH = 4, GWD = 256, INW = 2304, DFF = 3584, NE = 8;
constexpr float EPS = 1e-6f;
constexpr int MODW = 6 * D;
constexpr int CH = 128, NCH = SEQ / CH;
#ifndef F8_MASK
#define F8_MASK 0xE
#endif
#ifndef B8_MASK
#define B8_MASK 0xC
#endif
#define IS_B8(l_) (((B8_MASK) >> (l_)) & 1)
#define IS_F8(l_) (((F8_MASK) >> (l_)) & 1)
constexpr int F8_LAYER = 3;
constexpr float F8_S13 = 32.f, F8_S2 = 64.f;
constexpr bool MOE_XN8 = ((F8_MASK >> 1) & 1) && ((F8_MASK >> 3) & 1);
constexpr int MAXPAIR = 2 * M + NE * 256;

constexpr size_t MiB = 1u << 20;
constexpr size_t WS_CTL = 0, CTL_ZERO_BYTES = 1 * MiB;
constexpr size_t WS_MOD = 1 * MiB;
constexpr size_t WS_LB = WS_MOD + 786432;
constexpr size_t WS_POOLWT = 2 * MiB;
constexpr size_t WS_LRUWAT = WS_POOLWT + 131072;
constexpr size_t WS_LRUWXT = WS_LRUWAT + 131072;
constexpr size_t WS_SGUW = 3 * MiB;
constexpr size_t WS_TOKE = 4 * MiB;
constexpr size_t WS_TOKW = WS_TOKE + 262144;
constexpr size_t WS_HISTW = 5 * MiB;
constexpr size_t WS_TILEE = WS_HISTW + 65536;
constexpr size_t WS_NT = WS_TILEE + 4096;
constexpr size_t WS_PAIR = 6 * MiB;
constexpr size_t WS_AGG = 8 * MiB;
constexpr size_t WS_H0 = 9 * MiB;
constexpr size_t WS_DEC = 10 * MiB;
constexpr size_t WS_W = 16 * MiB;
constexpr size_t WS_WIN = WS_W, WS_WOUT = WS_W + 5 * MiB, WS_W13 = WS_W + 8 * MiB, WS_W2 = WS_W + 120 * MiB;
constexpr size_t WS_XN = 192 * MiB;
constexpr size_t WS_PROJ = 320 * MiB;
constexpr size_t WS_CAT = 608 * MiB;
constexpr size_t WS_ST = 736 * MiB;
constexpr size_t WS_LAB = 768 * MiB;
constexpr size_t WS_Y1 = 864 * MiB;
constexpr size_t WS_XB = 992 * MiB;
constexpr size_t WS_END = 1120 * MiB;
constexpr int CW_BAR = 4096;
constexpr int CW_ZT = 16384;
constexpr int RING_BYTES = 131072, MISC_OFF = RING_BYTES + 320, LDS_BYTES = 147456;

#define DI __device__ __forceinline__
#define LAS __attribute__((address_space(3)))
typedef unsigned short bf16;
typedef unsigned v4u __attribute__((ext_vector_type(4)));
typedef unsigned v2u __attribute__((ext_vector_type(2)));
typedef int v4i __attribute__((ext_vector_type(4)));
typedef int v2i __attribute__((ext_vector_type(2)));
typedef float f32x4 __attribute__((ext_vector_type(4)));
typedef float f32x2 __attribute__((ext_vector_type(2)));
typedef short bf16x8 __attribute__((ext_vector_type(8)));
#define LDS_WAIT() asm volatile("s_waitcnt lgkmcnt(0)" ::: "memory")
#define GAS __attribute__((address_space(1)))
typedef GAS const float* gcf; typedef GAS float* gf; typedef GAS const bf16* gcb; typedef GAS bf16* gb; typedef GAS const int* gci; typedef GAS int* gi;
typedef GAS const v2i* gcv2i; typedef GAS v2i* gv2i; typedef GAS const unsigned* gcu; typedef GAS unsigned char* gws;

DI float bf2f(bf16 v) { return __builtin_bit_cast(float, (unsigned)v << 16); }
DI float lo_bf(unsigned w) { return __builtin_bit_cast(float, w << 16); }
DI float hi_bf(unsigned w) { return __builtin_bit_cast(float, w & 0xffff0000u); }
DI unsigned pk2(float lo, float hi) { return pg8::cvt_pk_bf16(lo, hi); }
DI bf16 f2bf(float f) { return (bf16)(pk2(f, 0.f) & 0xffffu); }
DI float sigm(float x) { return __builtin_amdgcn_rcpf(1.f + __expf(-x)); }
DI float siluf(float x) { return x * sigm(x); }
DI float gelu_t(float x) { return x * sigm(1.5957691216057308f * (x + 0.044715f * x * x * x)); }
DI float neg_expm1(float x) {
    const float p = -x * (1.f + x * (0.5f + x * (0.16666667f + x * (0.041666668f + x * (0.0083333338f + x * 0.0013888889f)))));
    return x > -0.25f ? p : 1.f - __expf(x);
}
DI float wave_sum(float v) {
#pragma unroll
    for (int o = 1; o < 64; o <<= 1) v += __shfl_xor(v, o);
    return v;
}
template <int D_> DI float row_shr0(float src) { return __builtin_bit_cast(float, __builtin_amdgcn_update_dpp(0, __builtin_bit_cast(int, src), 0x110 + D_, 0xf, 0xf, true)); }
DI float wave_sum_dpp(float v) {
    v += row_shr0<1>(v); v += row_shr0<2>(v); v += row_shr0<4>(v); v += row_shr0<8>(v);
    const int iv = __builtin_bit_cast(int, v);
    const float a = __builtin_bit_cast(float, __builtin_amdgcn_readlane(iv, 15)), b2 = __builtin_bit_cast(float, __builtin_amdgcn_readlane(iv, 31));
    const float c2 = __builtin_bit_cast(float, __builtin_amdgcn_readlane(iv, 47)), d2 = __builtin_bit_cast(float, __builtin_amdgcn_readlane(iv, 63));
    return (a + b2) + (c2 + d2);
}
DI int wave_sum_i(int v) {
#pragma unroll
    for (int o = 1; o < 64; o <<= 1) v += __shfl_xor(v, o);
    return v;
}
DI f32x4 ld4(gcf p) { return *(GAS const f32x4*)p; }
DI f32x4 ld4_nt(gcf p) { return __builtin_nontemporal_load((GAS const f32x4*)p); }
DI void unpack8(const v4u x, float (&o)[8]) { o[0] = lo_bf(x.x); o[1] = hi_bf(x.x); o[2] = lo_bf(x.y); o[3] = hi_bf(x.y); o[4] = lo_bf(x.z); o[5] = hi_bf(x.z); o[6] = lo_bf(x.w); o[7] = hi_bf(x.w); }
DI f32x4 unpack4(const v2u x) { return (f32x4){lo_bf(x.x), hi_bf(x.x), lo_bf(x.y), hi_bf(x.y)}; }
DI v2u pack4(const f32x4 v) { v2u r; r.x = pk2(v.x, v.y); r.y = pk2(v.z, v.w); return r; }
DI float clamp_f8(float v) { return __builtin_amdgcn_fmed3f(v, -448.f, 448.f); }
DI unsigned pk4_f8(float a, float b, float c, float d) { int r = __builtin_amdgcn_cvt_pk_fp8_f32(clamp_f8(a), clamp_f8(b), 0, false); r = __builtin_amdgcn_cvt_pk_fp8_f32(clamp_f8(c), clamp_f8(d), r, true); return (unsigned)r; }
DI f32x4 mfma16(const bf16x8 a, const bf16x8 b, const f32x4 c) { return __builtin_amdgcn_mfma_f32_16x16x32_bf16(a, b, c, 0, 0, 0); }

#define XB_TMO      128
#define XB_XCNT(j)  (256  + 64 * (j))
#define XB_XSUB(j)  (1280 + 64 * (j))
#define XB_XGEN(j)  (2304 + 64 * (j))
#define XB_TOP      3328
#define XB_TOPGEN   3392
#define XCD_BAR_WORDS 3456
#define XB_SPIN_CAP (1u << 18)
__device__ __forceinline__ unsigned xb_ld(unsigned* p)              { return __hip_atomic_load(p, __ATOMIC_RELAXED, __HIP_MEMORY_SCOPE_AGENT); }
__device__ __forceinline__ unsigned xb_add(unsigned* p, unsigned v) { return __hip_atomic_fetch_add(p, v, __ATOMIC_RELAXED, __HIP_MEMORY_SCOPE_AGENT); }
__device__ __forceinline__ unsigned xb_xcc_id() { return (unsigned)__builtin_amdgcn_s_getreg((3 << 11) | 20) & 0xFu; }
#define XB_SPIN(cond, bar) do { unsigned _sp = 0; while (cond) { __builtin_amdgcn_s_sleep(1); \
    if ((++_sp & 255u) == 0u) { if (xb_ld(&(bar)[XB_TMO])) break; if (_sp > XB_SPIN_CAP) { atomicAdd(&(bar)[XB_TMO], 1u); break; } } } } while (0)
DI int hw_lane() { int l; asm volatile("v_mbcnt_lo_u32_b32 %0, -1, 0\n\tv_mbcnt_hi_u32_b32 %0, -1, %0" : "=v"(l)); return l; }
struct XcdBarrier { unsigned* bar; unsigned x; volatile LAS unsigned* st; int w0; };
__device__ __forceinline__ XcdBarrier xcd_barrier_post(unsigned* bar, volatile LAS unsigned* st) {
    XcdBarrier b; b.bar = bar; b.x = xb_xcc_id(); b.st = st; b.w0 = __builtin_amdgcn_readfirstlane((int)threadIdx.x >> 6);
    if (threadIdx.x == 0) (void)xb_add(&bar[XB_XCNT(b.x)], 1u);
    return b;
}
__device__ __forceinline__ void xcd_barrier_complete(unsigned* bar, unsigned x, unsigned& nloc, unsigned& nx) {
    const unsigned G = gridDim.x * gridDim.y * gridDim.z;
    unsigned sum, cnt, mine, sp = 0u;
    for (;;) {
        sum = 0u; cnt = 0u; mine = 0u;
#pragma unroll
        for (unsigned j = 0; j < 16; ++j) { const unsigned c = xb_ld(&bar[XB_XCNT(j)]); sum += c; cnt += (c > 0u) ? 1u : 0u; mine = (j == x) ? c : mine; }
        if (sum == G) break;
        __builtin_amdgcn_s_sleep(1);
        if ((++sp & 255u) == 0u) { if (xb_ld(&bar[XB_TMO])) break; if (sp > XB_SPIN_CAP) { atomicAdd(&bar[XB_TMO], 1u); break; } }
    }
    nloc = mine > 0u ? mine : 1u; nx = cnt > 0u ? cnt : 1u;
}
__device__ __forceinline__ void xcd_barrier(const XcdBarrier& b) {
    asm volatile("s_waitcnt vmcnt(0)" ::: "memory");
    __syncthreads();
    if (b.w0 == 0 && hw_lane() == 0) {
        unsigned* bar = b.bar;
        __builtin_amdgcn_s_waitcnt(0);
        unsigned nloc = b.st[0], nx = b.st[1];
        if (nloc == 0u) { xcd_barrier_complete(bar, b.x, nloc, nx); b.st[0] = nloc; b.st[1] = nx; }
        const unsigned old = xb_add(&bar[XB_XSUB(b.x)], 1u);
        const unsigned gen = old / nloc;
        if (old + 1u == (gen + 1u) * nloc) {
            __builtin_amdgcn_fence(__ATOMIC_RELEASE, "agent");
            asm volatile("s_waitcnt vmcnt(0)" ::: "memory");
            const unsigned og = xb_add(&bar[XB_TOP], 1u);
            const unsigned tg = og / nx;
            if (og + 1u == (tg + 1u) * nx) xb_add(&bar[XB_TOPGEN], 1u);
            else XB_SPIN(xb_ld(&bar[XB_TOPGEN]) == tg, bar);
            __builtin_amdgcn_fence(__ATOMIC_ACQUIRE, "agent");
            xb_add(&bar[XB_XGEN(b.x)], 1u);
            asm volatile("s_waitcnt vmcnt(0)" ::: "memory");
        } else {
            XB_SPIN(xb_ld(&bar[XB_XGEN(b.x)]) == gen, bar);
            __builtin_amdgcn_fence(__ATOMIC_ACQUIRE, "agent");
            asm volatile("s_waitcnt vmcnt(0)" ::: "memory");
        }
    }
    __syncthreads();
}

struct EpiProj {
    static constexpr bool PERM = true, AFTER_DRAIN = false, IDEMPOTENT = true;
    gb O; float mul;
    DI void operator()(const f32x4 (&acc)[2][2][4][2], const pg8::Unit& u, int wr, int wc, int fr, int fq) const {
        const int row0 = u.pm * 256 + wr * 64 + fr, col0 = u.pc * 256 + wc * 32 + 8 * fq;
#pragma unroll
        for (int ai = 0; ai < 2; ++ai)
#pragma unroll
            for (int m = 0; m < 4; ++m) { gb rowp = O + (size_t)(row0 + ai * 128 + m * 16) * INW + col0;
#pragma unroll
                for (int bj = 0; bj < 2; ++bj) { const f32x4 v0 = acc[ai][bj][m][0] * mul, v1 = acc[ai][bj][m][1] * mul;
                    v4u w; w.x = pk2(v0[0], v0[1]); w.y = pk2(v0[2], v0[3]); w.z = pk2(v1[0], v1[1]); w.w = pk2(v1[2], v1[3]);
                    *(GAS v4u*)(rowp + bj * 128) = w; } }
    }
};
struct EpiResid {
    static constexpr bool PERM = true, AFTER_DRAIN = false, IDEMPOTENT = false;
    gb x; gcf gate; float mul;
    DI void operator()(const f32x4 (&acc)[2][2][4][2], const pg8::Unit& u, int wr, int wc, int fr, int fq) const {
        const int b = u.pm >> 5, row0 = u.pm * 256 + wr * 64 + fr, col0 = u.pc * 256 + wc * 32 + 8 * fq;
        f32x4 gv[2][2];
#pragma unroll
        for (int bj = 0; bj < 2; ++bj)
#pragma unroll
            for (int n = 0; n < 2; ++n) gv[bj][n] = ld4(gate + (size_t)b * MODW + col0 + bj * 128 + n * 4) * mul;
        constexpr int PF = 6;
        v4u xr[8][2];
#define ER_LOAD(p) _Pragma("unroll") for (int bj = 0; bj < 2; ++bj) xr[p][bj] = *(GAS const v4u*)(x + (size_t)(row0 + ((p) >> 2) * 128 + ((p) & 3) * 16) * D + col0 + bj * 128)
#pragma unroll
        for (int p = 0; p < PF; ++p) { ER_LOAD(p); }
#pragma unroll
        for (int p = 0; p < 8; ++p) { const int ai = p >> 2, m = p & 3;
#pragma unroll
            for (int bj = 0; bj < 2; ++bj) { float xv[8]; unpack8(xr[p][bj], xv);
                const f32x4 v0 = (f32x4){xv[0], xv[1], xv[2], xv[3]} + gv[bj][0] * acc[ai][bj][m][0], v1 = (f32x4){xv[4], xv[5], xv[6], xv[7]} + gv[bj][1] * acc[ai][bj][m][1];
                v4u o; o.x = pk2(v0[0], v0[1]); o.y = pk2(v0[2], v0[3]); o.z = pk2(v1[0], v1[1]); o.w = pk2(v1[2], v1[3]);
                *(GAS v4u*)(x + (size_t)(row0 + ai * 128 + m * 16) * D + col0 + bj * 128) = o; }
            if (p + PF < 8) { ER_LOAD(p + PF); }
            asm volatile("" ::: "memory"); }
#undef ER_LOAD
    }
};
struct EpiSwiglu {
    static constexpr bool PERM = true, AFTER_DRAIN = false, IDEMPOTENT = true;
    gb ACT; int pm0;
    DI void operator()(const f32x4 (&acc)[2][2][4][2], const pg8::Unit& u, int wr, int wc, int fr, int fq) const {
        const int row0 = (u.pm - pm0) * 256 + wr * 64 + fr, col0 = u.pc * 128 + wc * 32 + 8 * fq;
#pragma unroll
        for (int ai = 0; ai < 2; ++ai)
#pragma unroll
            for (int m = 0; m < 4; ++m) { gb rowp = ACT + (size_t)(row0 + ai * 128 + m * 16) * DFF + col0;
                const f32x4 g0 = acc[ai][0][m][0], g1 = acc[ai][0][m][1], u0 = acc[ai][1][m][0], u1 = acc[ai][1][m][1];
                v4u w; w.x = pk2(siluf(g0[0]) * u0[0], siluf(g0[1]) * u0[1]); w.y = pk2(siluf(g0[2]) * u0[2], siluf(g0[3]) * u0[3]);
                w.z = pk2(siluf(g1[0]) * u1[0], siluf(g1[1]) * u1[1]); w.w = pk2(siluf(g1[2]) * u1[2], siluf(g1[3]) * u1[3]);
                *(GAS v4u*)rowp = w; }
    }
};
struct EpiSwiglu8 {
    static constexpr bool PERM = true, AFTER_DRAIN = false, IDEMPOTENT = true;
    GAS unsigned char* ACT; int pm0;
    DI void operator()(const f32x4 (&acc)[2][2][4][2], const pg8::Unit& u, int wr, int wc, int fr, int fq) const {
        const int row0 = (u.pm - pm0) * 256 + wr * 64 + fr, col0 = u.pc * 128 + wc * 32 + 8 * (fq & ~1);
        float c1 = -1.4426950408889634f / F8_S13, S2 = (float)F8_S13 * (float)F8_S13; asm volatile("" : "+v"(c1), "+v"(S2));
        const int oddq = fq & 1;
#pragma unroll
        for (int ai = 0; ai < 2; ++ai)
#pragma unroll
            for (int mp = 0; mp < 2; ++mp) {
                v2u w[2];
#pragma unroll
                for (int mm = 0; mm < 2; ++mm) { const int m = 2 * mp + mm;
                    f32x4 o[2];
#pragma unroll
                    for (int n = 0; n < 2; ++n) { const f32x4 g = acc[ai][0][m][n], uu = acc[ai][1][m][n]; f32x4 t = g * c1;
                        t.x = __builtin_amdgcn_exp2f(t.x); t.y = __builtin_amdgcn_exp2f(t.y); t.z = __builtin_amdgcn_exp2f(t.z); t.w = __builtin_amdgcn_exp2f(t.w);
                        t = t * S2 + S2;
                        t.x = __builtin_amdgcn_rcpf(t.x); t.y = __builtin_amdgcn_rcpf(t.y); t.z = __builtin_amdgcn_rcpf(t.z); t.w = __builtin_amdgcn_rcpf(t.w);
                        o[n] = (g * uu) * t; }
                    w[mm].x = pk4_f8(o[0][0], o[0][1], o[0][2], o[0][3]); w[mm].y = pk4_f8(o[1][0], o[1][1], o[1][2], o[1][3]); }
                const auto rx = __builtin_amdgcn_permlane16_swap(w[0].x, w[1].x, false, false), ry = __builtin_amdgcn_permlane16_swap(w[0].y, w[1].y, false, false);
                *(GAS v4u*)(ACT + (size_t)(row0 + ai * 128 + (2 * mp + oddq) * 16) * DFF + col0) = (v4u){rx[0], ry[0], rx[1], ry[1]}; }
    }
};
struct EpiScatter {
    static constexpr bool PERM = true, AFTER_DRAIN = false, IDEMPOTENT = true;
    gcv2i pair; gb Y0; gb Y1; gci toke; gcf tokw; float sc;
    DI void operator()(const f32x4 (&acc)[2][2][4][2], const pg8::Unit& u, int wr, int wc, int fr, int fq) const {
        const int row0 = u.pm * 256 + wr * 64 + fr, col0 = u.pc * 256 + wc * 32 + 8 * fq;
        int px[8]; float w[8];
#pragma unroll
        for (int p = 0; p < 8; ++p) px[p] = pair[row0 + (p >> 2) * 128 + (p & 3) * 16].x;
#pragma unroll
        for (int p = 0; p < 8; ++p) w[p] = tokw[px[p] >= 0 ? 2 * (px[p] & 0x3fffffff) + (px[p] >> 30) : 0] * sc;
#pragma unroll
        for (int p = 0; p < 8; ++p) { const int ai = p >> 2, m = p & 3;
            if (px[p] >= 0) { const int tok = px[p] & 0x3fffffff;
                gb rowp = ((px[p] >> 30) ? Y1 : Y0) + (size_t)tok * D + col0;
#pragma unroll
                for (int bj = 0; bj < 2; ++bj) { const f32x4 v0 = acc[ai][bj][m][0] * w[p], v1 = acc[ai][bj][m][1] * w[p];
                    v4u o; o.x = pk2(v0[0], v0[1]); o.y = pk2(v0[2], v0[3]); o.z = pk2(v1[0], v1[1]); o.w = pk2(v1[2], v1[3]);
                    *(GAS v4u*)(rowp + bj * 128) = o; } } }
    }
};


DI void p0_prologue(gcf c, gcf w_mod, gcf b_mod, gcf gamma, gcf pool_w, gcf lwa, gcf lwx, gcf sgu_ws,
                    gws ws, LAS unsigned char* lds, int wg, int G, int tid, int wave, int lane) {
    LAS float* CS = (LAS float*)lds; LAS float* RED = (LAS float*)(lds + 32768);
    gf MOD = (GAS float*)(ws + WS_MOD);
    if (wg < 96) {
        for (int idx = tid; idx < 8192; idx += NTHR) { const int k = idx >> 3, b = idx & 7; const float v = c[b * D + k]; CS[idx] = siluf(v); }
        __syncthreads();
        for (int item = wg; item < 96; item += G) {
            const int l = item / 24, jb = item % 24, col = jb * 256 + lane * 4;
            f32x4 acc[8];
#pragma unroll
            for (int b = 0; b < 8; ++b) acc[b] = (f32x4){0.f, 0.f, 0.f, 0.f};
            gcf wp = w_mod + ((size_t)(l * D + wave * 128)) * MODW + col;
#pragma unroll 32
            for (int kk = 0; kk < 128; ++kk) {
                const f32x4 w = ld4(wp + (size_t)kk * MODW);
                const f32x4 c0 = *(const LAS f32x4*)(CS + (wave * 128 + kk) * 8), c1 = *(const LAS f32x4*)(CS + (wave * 128 + kk) * 8 + 4);
                acc[0] += c0.x * w; acc[1] += c0.y * w; acc[2] += c0.z * w; acc[3] += c0.w * w; acc[4] += c1.x * w; acc[5] += c1.y * w; acc[6] += c1.z * w; acc[7] += c1.w * w;
            }
#pragma unroll
            for (int b = 0; b < 8; ++b) *(LAS f32x4*)(RED + (wave * 8 + b) * 256 + lane * 4) = acc[b];
            __syncthreads();
            for (int o = tid; o < 2048; o += NTHR) { const int b = o >> 8, cc = o & 255; float s = 0.f;
#pragma unroll
                for (int w = 0; w < 8; ++w) s += RED[(w * 8 + b) * 256 + cc];
                MOD[(size_t)(l * 8 + b) * MODW + jb * 256 + cc] = s + b_mod[l * MODW + jb * 256 + cc]; }
            __syncthreads();
        }
    }
    if (wg == G - 1 && tid < GWD) {
        gf LB = (GAS float*)(ws + WS_LB);
        const float g0 = gamma[tid], g1 = gamma[GWD + tid], g2 = gamma[2 * GWD + tid], g3 = gamma[3 * GWD + tid];
        const float mx = fmaxf(fmaxf(g0, g1), fmaxf(g2, g3));
        const float e0 = expf(g0 - mx), e1 = expf(g1 - mx), e2 = expf(g2 - mx), e3 = expf(g3 - mx), inv = 1.f / (e0 + e1 + e2 + e3);
        LB[tid] = 0.f; LB[GWD + tid] = e1 * inv; LB[2 * GWD + tid] = (e1 + e2) * inv; LB[3 * GWD + tid] = (e1 + e2 + e3) * inv;
    }
    gb POOLWT = (GAS bf16*)(ws + WS_POOLWT); gb LRUWAT = (GAS bf16*)(ws + WS_LRUWAT); gb LRUWXT = (GAS bf16*)(ws + WS_LRUWXT); gb SGUW = (GAS bf16*)(ws + WS_SGUW);
    const int gt = wg * NTHR + tid, NT = G * NTHR;
    for (int idx = gt; idx < 65536; idx += NT) { const int lg = idx >> 12, j = (idx >> 6) & 63, i = idx & 63, src = (lg * 64 + i) * 64 + j;
        POOLWT[idx] = f2bf(pool_w[src]); LRUWAT[idx] = f2bf(lwa[src]); LRUWXT[idx] = f2bf(lwx[src]); }
    for (int idx = gt; idx < 262144; idx += NT) { const int t = (idx >> 7) & 127, s = idx & 127; SGUW[idx] = (s <= t) ? f2bf(sgu_ws[idx]) : (bf16)0; }
}

struct CvItem { gcf W; gb WT; int K, N, mode, idx; float f8s; };
DI void cv_load(const CvItem& I, int lane, f32x4 (&v)[8]) {
    const int nblk = I.N / 32, kb = I.idx / nblk, nb = I.idx % nblk;
    gcf p = I.W + (size_t)(64 * kb + (lane >> 3)) * I.N + 32 * nb + 4 * (lane & 7);
#pragma unroll
    for (int i = 0; i < 8; ++i) v[i] = ld4_nt(p + (size_t)(8 * i) * I.N);
}
DI void cv_store(const CvItem& I, LAS float* scr, int lane, const f32x4 (&v)[8]) {
    const int nblk = I.N / 32, kb = I.idx / nblk, nb = I.idx % nblk, k0 = 64 * kb, n0 = 32 * nb;
#pragma unroll
    for (int i = 0; i < 8; ++i) { LAS float* d = scr + (8 * i + (lane >> 3)) * 33 + 4 * (lane & 7); d[0] = v[i].x; d[1] = v[i].y; d[2] = v[i].z; d[3] = v[i].w; }
    LDS_WAIT();
    const int c = lane & 7;
    const int drow0 = (I.mode == 0) ? n0 : ((n0 >> 7) * 256 + (n0 & 127) + (I.mode == 2 ? 128 : 0));
    if (I.f8s > 0.f) { const float sc = I.f8s; GAS unsigned char* W8 = (GAS unsigned char*)I.WT; const int c4 = lane & 3;
#pragma unroll
        for (int j = 0; j < 2; ++j) { const int n = (lane >> 2) + 16 * j; const LAS float* s = scr + (16 * c4) * 33 + n;
            v4u o; o.x = pk4_f8(s[0 * 33] * sc, s[1 * 33] * sc, s[2 * 33] * sc, s[3 * 33] * sc); o.y = pk4_f8(s[4 * 33] * sc, s[5 * 33] * sc, s[6 * 33] * sc, s[7 * 33] * sc);
            o.z = pk4_f8(s[8 * 33] * sc, s[9 * 33] * sc, s[10 * 33] * sc, s[11 * 33] * sc); o.w = pk4_f8(s[12 * 33] * sc, s[13 * 33] * sc, s[14 * 33] * sc, s[15 * 33] * sc);
            *(GAS v4u*)(W8 + (size_t)(drow0 + n) * I.K + k0 + 16 * c4) = o; }
    } else {
#pragma unroll
    for (int j = 0; j < 4; ++j) { const int n = (lane >> 3) + 8 * j; const LAS float* s = scr + (8 * c) * 33 + n;
        v4u o; o.x = pk2(s[0 * 33], s[1 * 33]); o.y = pk2(s[2 * 33], s[3 * 33]); o.z = pk2(s[4 * 33], s[5 * 33]); o.w = pk2(s[6 * 33], s[7 * 33]);
        *(GAS v4u*)(I.WT + (size_t)(drow0 + n) * I.K + k0 + 8 * c) = o; }
    }
    LDS_WAIT();
}
DI void convert_weights(int l, gcf w_in, gcf w_out, gcf f1, gcf f3, gcf f2, gcf m1, gcf m3, gcf m2,
                        gws ws, LAS unsigned char* lds, int wg, int G, int wave, int lane) {
    LAS float* scr = (LAS float*)(lds + wave * 16384);
    gb WIN = (GAS bf16*)(ws + WS_WIN); gb WOUT = (GAS bf16*)(ws + WS_WOUT); gb W13 = (GAS bf16*)(ws + WS_W13); gb W2 = (GAS bf16*)(ws + WS_W2);
    constexpr int n_in = 16 * 72, n_out = 16 * 32, n13 = 16 * 112, n2 = 56 * 32, per_e = 2 * n13 + n2;
    const int moe = l & 1, E = moe ? NE : 1, total = n_in + n_out + E * per_e, stride = G * NWAVES, f8 = IS_F8(l) ? 1 : 0;
#define CV_DECODE(it_, I_) do { int r = (it_); \
        if (r < n_in) { I_ = CvItem{w_in + (size_t)l * D * INW, WIN, D, INW, 0, r, IS_B8(l) ? F8_S13 : 0.f}; } \
        else if (r < n_in + n_out) { I_ = CvItem{w_out + (size_t)l * D * D, WOUT, D, D, 0, r - n_in, 0.f}; } \
        else { r -= n_in + n_out; const int e = r / per_e; r -= e * per_e; \
            const size_t mo = (size_t)((l >> 1) * (moe ? NE : 1) + e) * D * DFF; \
            const size_t o13 = ((size_t)e * 2 * DFF * D) >> f8, o2 = ((size_t)e * D * DFF) >> f8;     \
            if (r < n13) I_ = CvItem{(moe ? m1 : f1) + mo, W13 + o13, D, DFF, 1, r, f8 ? F8_S13 : 0.f}; \
            else if (r < 2 * n13) I_ = CvItem{(moe ? m3 : f3) + mo, W13 + o13, D, DFF, 2, r - n13, f8 ? F8_S13 : 0.f}; \
            else I_ = CvItem{(moe ? m2 : f2) + mo, W2 + o2, DFF, D, 0, r - 2 * n13, f8 ? F8_S2 : 0.f}; } } while (0)
    int it = wg * NWAVES + wave;
    if (it >= total) return;
    CvItem Ia, Ib; f32x4 va[8], vb[8];
    CV_DECODE(it, Ia); cv_load(Ia, lane, va);
    for (;;) {
        const bool hb = it + stride < total;
        if (hb) { CV_DECODE(it + stride, Ib); cv_load(Ib, lane, vb); }
        cv_store(Ia, scr, lane, va);
        if (!hb) break;
        it += stride;
        const bool ha = it + stride < total;
        if (ha) { CV_DECODE(it + stride, Ia); cv_load(Ia, lane, va); }
        cv_store(Ib, scr, lane, vb);
        if (!ha) break;
        it += stride;
    }
#undef CV_DECODE
}

template <bool COMBINE, bool ROUTER, bool FINAL, bool XF32, bool OUT8 = false>
DI void norm_phase(gcf xf, gb xb, gf outf, gcf gain, gcf shift, gcf scale, gcf gprev, gcb Y0, gcb Y1, gb XN,
                   gcf rw, gcf rb, gi toke, gf tokw, gi histw, gv2i pair, LAS unsigned char* lds, int wg, int G, int tid, int wave, int lane) {
    LAS float* RW = (LAS float*)lds;
    if (ROUTER) {
        for (int i = tid; i < 8192; i += NTHR) RW[i] = rw[i];
        { int m1 = -1, z0 = 0; asm volatile("" : "+v"(m1), "+v"(z0));
        for (int i = wg * NTHR + tid; i < MAXPAIR; i += G * NTHR) pair[i] = (v2i){m1, z0}; }
        __syncthreads();
    }
    for (int blk = wg; blk < M / 256; blk += G) {
        const int b = blk >> 5;
#define NCOL(j) (8 * lane + 512 * ((j) >> 1) + 4 * ((j) & 1))
        f32x4 gm[4], sh[4], gp[4];
#pragma unroll
        for (int j = 0; j < 4; ++j) { const int col = NCOL(j);
            if (FINAL) { gm[j] = ld4(gain + col); sh[j] = (f32x4){0.f, 0.f, 0.f, 0.f}; }
            else { gm[j] = ld4(gain + col) * (ld4(scale + (size_t)b * MODW + col) + 1.0f); sh[j] = ld4(shift + (size_t)b * MODW + col); }
            if (COMBINE) gp[j] = ld4(gprev + (size_t)b * MODW + col); else gp[j] = (f32x4){0.f, 0.f, 0.f, 0.f}; }
        int cnt[8];
#pragma unroll
        for (int e = 0; e < 8; ++e) cnt[e] = 0;
        constexpr int RG = (COMBINE || ROUTER) ? 1 : 2;
        v4u xr[2][XF32 ? 1 : RG][2]; f32x4 xfr[2][XF32 ? RG : 1][4]; v4u ya[2][COMBINE ? RG : 1][2], yb[2][COMBINE ? RG : 1][2];
#define NL_LOAD(B, R0) \
        _Pragma("unroll") for (int q = 0; q < RG; ++q) \
        _Pragma("unroll") for (int s = 0; s < 2; ++s) { const size_t off = (size_t)(blk * 256 + wave * 32 + (R0) + q) * D + 8 * lane + 512 * s; \
            if (XF32) { xfr[B][q][2 * s] = ld4_nt(xf + off); xfr[B][q][2 * s + 1] = ld4_nt(xf + off + 4); } else xr[B][q][s] = *(GAS const v4u*)(xb + off); \
            if (COMBINE) { ya[B][q][s] = *(GAS const v4u*)(Y0 + off); yb[B][q][s] = *(GAS const v4u*)(Y1 + off); } }
        NL_LOAD(0, 0)
#pragma unroll 1
        for (int r00 = 0; r00 < 32; r00 += 2 * RG) {
#pragma unroll
          for (int hb = 0; hb < 2; ++hb) {
            const int r0 = r00 + hb * RG;
            if (hb == 0) { NL_LOAD(1, r0 + RG) } else if (r0 + RG < 32) { NL_LOAD(0, r0 + RG) }
#pragma unroll
            for (int q = 0; q < RG; ++q) {
            const int row = blk * 256 + wave * 32 + r0 + q;
            f32x4 v[4]; float ss = 0.f;
#pragma unroll
            for (int s = 0; s < 2; ++s) { const size_t off = (size_t)row * D + 8 * lane + 512 * s;
                if (XF32) { v[2 * s] = xfr[hb][q][2 * s]; v[2 * s + 1] = xfr[hb][q][2 * s + 1]; }
                else { float t8[8]; unpack8(xr[hb][q][s], t8); v[2 * s] = (f32x4){t8[0], t8[1], t8[2], t8[3]}; v[2 * s + 1] = (f32x4){t8[4], t8[5], t8[6], t8[7]}; }
                if (COMBINE) { float a8[8], b8[8]; unpack8(ya[hb][q][s], a8); unpack8(yb[hb][q][s], b8);
                    v[2 * s] += gp[2 * s] * ((f32x4){a8[0], a8[1], a8[2], a8[3]} + (f32x4){b8[0], b8[1], b8[2], b8[3]}); v[2 * s + 1] += gp[2 * s + 1] * ((f32x4){a8[4], a8[5], a8[6], a8[7]} + (f32x4){b8[4], b8[5], b8[6], b8[7]}); }
                if ((COMBINE && !FINAL) || XF32) { v4u o; o.x = pk2(v[2 * s].x, v[2 * s].y); o.y = pk2(v[2 * s].z, v[2 * s].w); o.z = pk2(v[2 * s + 1].x, v[2 * s + 1].y); o.w = pk2(v[2 * s + 1].z, v[2 * s + 1].w); *(GAS v4u*)(xb + off) = o; }
                ss += (v[2 * s].x * v[2 * s].x + v[2 * s].y * v[2 * s].y) + (v[2 * s].z * v[2 * s].z + v[2 * s].w * v[2 * s].w) + (v[2 * s + 1].x * v[2 * s + 1].x + v[2 * s + 1].y * v[2 * s + 1].y) + (v[2 * s + 1].z * v[2 * s + 1].z + v[2 * s + 1].w * v[2 * s + 1].w); }
            const float rstd = rsqrtf(wave_sum_dpp(ss) * (1.f / D) + EPS);
            f32x4 h[4];
#pragma unroll
            for (int j = 0; j < 4; ++j) h[j] = v[j] * rstd * gm[j] + sh[j];
#pragma unroll
            for (int s = 0; s < 2; ++s) { const size_t off = (size_t)row * D + 8 * lane + 512 * s;
                if (FINAL) { __builtin_nontemporal_store(h[2 * s], (GAS f32x4*)(outf + off)); __builtin_nontemporal_store(h[2 * s + 1], (GAS f32x4*)(outf + off + 4)); }
                else if (OUT8) {
                    if (s == 1) { v2u o0, o1; o0.x = pk4_f8(h[0].x, h[0].y, h[0].z, h[0].w); o0.y = pk4_f8(h[1].x, h[1].y, h[1].z, h[1].w); o1.x = pk4_f8(h[2].x, h[2].y, h[2].z, h[2].w); o1.y = pk4_f8(h[3].x, h[3].y, h[3].z, h[3].w);
                        const bool odd = lane & 1; const unsigned sx = odd ? o0.x : o1.x, sy = odd ? o0.y : o1.y;
                        const unsigned tx = (unsigned)__builtin_amdgcn_update_dpp(0, (int)sx, 0xB1, 0xf, 0xf, true), ty = (unsigned)__builtin_amdgcn_update_dpp(0, (int)sy, 0xB1, 0xf, 0xf, true);
                        v4u w; if (odd) { w.x = tx; w.y = ty; w.z = o1.x; w.w = o1.y; } else { w.x = o0.x; w.y = o0.y; w.z = tx; w.w = ty; }
                        *(GAS v4u*)((GAS unsigned char*)XN + (size_t)row * D + (odd ? 512 + 8 * (lane - 1) : 8 * lane)) = w; } }
                else { v4u o; o.x = pk2(h[2 * s].x, h[2 * s].y); o.y = pk2(h[2 * s].z, h[2 * s].w); o.z = pk2(h[2 * s + 1].x, h[2 * s + 1].y); o.w = pk2(h[2 * s + 1].z, h[2 * s + 1].w); *(GAS v4u*)(XN + off) = o; } }
            if (ROUTER) {
                float lg[8];
#pragma unroll
                for (int e = 0; e < 8; ++e) lg[e] = 0.f;
#pragma unroll
                for (int j = 0; j < 4; ++j)
#pragma unroll
                    for (int i = 0; i < 4; ++i) { const int cc = NCOL(j) + i; const f32x4 w0 = *(const LAS f32x4*)(RW + cc * 8), w1 = *(const LAS f32x4*)(RW + cc * 8 + 4); const float hv = h[j][i];
                        lg[0] += hv * w0.x; lg[1] += hv * w0.y; lg[2] += hv * w0.z; lg[3] += hv * w0.w; lg[4] += hv * w1.x; lg[5] += hv * w1.y; lg[6] += hv * w1.z; lg[7] += hv * w1.w; }
#pragma unroll
                for (int e = 0; e < 8; ++e) lg[e] = wave_sum_dpp(lg[e]) + rb[e];
                int i0 = 0; float v0 = lg[0];
#pragma unroll
                for (int e = 1; e < 8; ++e) if (lg[e] > v0) { v0 = lg[e]; i0 = e; }
                int i1 = -1; float v1 = -3.0e38f;
#pragma unroll
                for (int e = 0; e < 8; ++e) if (e != i0 && lg[e] > v1) { v1 = lg[e]; i1 = e; }
                const float w0 = 1.f / (1.f + expf(v1 - v0)), w1 = 1.f - w0;
                if (lane == 0) { toke[row] = i0 | (i1 << 8); tokw[2 * row] = w0; tokw[2 * row + 1] = w1; }
#pragma unroll
                for (int e = 0; e < 8; ++e) cnt[e] += (i0 == e) + (i1 == e);
            }
            }
          }
        }
#undef NL_LOAD
        if (ROUTER && lane == 0) {
#pragma unroll
            for (int e = 0; e < 8; ++e) histw[(blk * 8 + wave) * 8 + e] = cnt[e]; }
    }
#undef NCOL
}

DI void route_phase(gcb XN, gb XG, gci toke, gcf tokw, gci histw, gv2i pair, gi tilee, gi ntp,
                    LAS unsigned char* lds, int wg, int G, int tid, int wave, int lane, int f8) {
    LAS int* L = (LAS int*)lds;
    for (int blk = wg; blk < M / 256; blk += G) {
        int tot[8], pre[8];
#pragma unroll
        for (int e = 0; e < 8; ++e) { tot[e] = 0; pre[e] = 0; }
        for (int q = tid; q < 2048; q += NTHR) { const v4i h0 = *(GAS const v4i*)(histw + q * 8), h1 = *(GAS const v4i*)(histw + q * 8 + 4); const int m = (q < blk * 8) ? 1 : 0;
            tot[0] += h0.x; tot[1] += h0.y; tot[2] += h0.z; tot[3] += h0.w; tot[4] += h1.x; tot[5] += h1.y; tot[6] += h1.z; tot[7] += h1.w;
            pre[0] += m * h0.x; pre[1] += m * h0.y; pre[2] += m * h0.z; pre[3] += m * h0.w; pre[4] += m * h1.x; pre[5] += m * h1.y; pre[6] += m * h1.z; pre[7] += m * h1.w; }
#pragma unroll
        for (int e = 0; e < 8; ++e) { tot[e] = wave_sum_i(tot[e]); pre[e] = wave_sum_i(pre[e]); }
        if (lane == 0) {
#pragma unroll
            for (int e = 0; e < 8; ++e) { L[wave * 16 + e] = tot[e]; L[wave * 16 + 8 + e] = pre[e]; } }
        __syncthreads();
        int start[9]; start[0] = 0;
#pragma unroll
        for (int e = 0; e < 8; ++e) { int t = 0, p = 0;
#pragma unroll
            for (int w = 0; w < 8; ++w) { t += L[w * 16 + e]; p += L[w * 16 + 8 + e]; }
            tot[e] = t; pre[e] = p; start[e + 1] = start[e] + ((t + 255) & ~255); }
        int e0 = -1, e1 = -1; const int tok = blk * 256 + tid;
        if (tid < 256) { const int te = toke[tok]; e0 = te & 255; e1 = te >> 8; }
        const unsigned long long lt = (1ull << lane) - 1ull;
        int r0 = 0, r1 = 0;
#pragma unroll
        for (int e = 0; e < 8; ++e) { const unsigned long long m0 = __ballot(e0 == e), m1 = __ballot(e1 == e);
            const int rr = __popcll(m0 & lt) + __popcll(m1 & lt);
            if (e0 == e) r0 = rr; if (e1 == e) r1 = rr;
            if (lane == 0) L[128 + wave * 8 + e] = __popcll(m0) + __popcll(m1);
            if (tid == 0) L[192 + e] = start[e] + pre[e]; }
        __syncthreads();
        if (tid < 256) {
            int p0 = L[192 + e0] + r0, p1 = L[192 + e1] + r1;
            for (int w = 0; w < wave; ++w) { p0 += L[128 + w * 8 + e0]; p1 += L[128 + w * 8 + e1]; }
            const f32x2 wv = *(GAS const f32x2*)(tokw + 2 * tok);
            pair[p0] = (v2i){tok, __builtin_bit_cast(int, wv.x)}; pair[p1] = (v2i){tok | (1 << 30), __builtin_bit_cast(int, wv.y)};
            L[256 + 2 * tid] = p0; L[256 + 2 * tid + 1] = p1;
        }
        __syncthreads();
        if (f8 && MOE_XN8) {
            const GAS unsigned char* S8 = (const GAS unsigned char*)XN; GAS unsigned char* X8 = (GAS unsigned char*)XG;
            for (int i0 = 0; i0 < 32; i0 += 8) {
                v4u ra[8]; int pp0[8], pp1[8];
#pragma unroll
                for (int q = 0; q < 8; ++q) { const int tl = wave * 32 + i0 + q; pp0[q] = L[256 + 2 * tl]; pp1[q] = L[256 + 2 * tl + 1]; ra[q] = *(GAS const v4u*)(S8 + (size_t)(blk * 256 + tl) * D + lane * 16); }
#pragma unroll
                for (int q = 0; q < 8; ++q) { *(GAS v4u*)(X8 + (size_t)pp0[q] * D + lane * 16) = ra[q]; *(GAS v4u*)(X8 + (size_t)pp1[q] * D + lane * 16) = ra[q]; } }
        } else
        for (int i0 = 0; i0 < 32; i0 += 4) {
            v4u ra[4], rb2[4]; int pp0[4], pp1[4];
#pragma unroll
            for (int q = 0; q < 4; ++q) { const int tl = wave * 32 + i0 + q; pp0[q] = L[256 + 2 * tl]; pp1[q] = L[256 + 2 * tl + 1];
                gcb srcp = XN + (size_t)(blk * 256 + tl) * D + lane * 16; ra[q] = *(GAS const v4u*)srcp; rb2[q] = *(GAS const v4u*)(srcp + 8); }
            if (f8) { GAS unsigned char* X8 = (GAS unsigned char*)XG;
#pragma unroll
                for (int q = 0; q < 4; ++q) { float xa[8], xb2[8]; unpack8(ra[q], xa); unpack8(rb2[q], xb2);
                    v4u o; o.x = pk4_f8(xa[0], xa[1], xa[2], xa[3]); o.y = pk4_f8(xa[4], xa[5], xa[6], xa[7]); o.z = pk4_f8(xb2[0], xb2[1], xb2[2], xb2[3]); o.w = pk4_f8(xb2[4], xb2[5], xb2[6], xb2[7]);
                    *(GAS v4u*)(X8 + (size_t)pp0[q] * D + lane * 16) = o; *(GAS v4u*)(X8 + (size_t)pp1[q] * D + lane * 16) = o; }
            } else {
#pragma unroll
            for (int q = 0; q < 4; ++q) { gb d0 = XG + (size_t)pp0[q] * D + lane * 16; gb d1 = XG + (size_t)pp1[q] * D + lane * 16;
                *(GAS v4u*)d0 = ra[q]; *(GAS v4u*)(d0 + 8) = rb2[q]; *(GAS v4u*)d1 = ra[q]; *(GAS v4u*)(d1 + 8) = rb2[q]; } } }
        if (blk == 0) { const int ntt = start[8] >> 8;
            for (int t = tid; t < ntt; t += NTHR) { int e = 0;
#pragma unroll
                for (int q = 1; q < 8; ++q) e += (t >= (start[q] >> 8)) ? 1 : 0;
                tilee[t] = e; }
            if (tid == 0) ntp[0] = ntt; }
        __syncthreads();
    }
}

DI void pool_unit(gcb PROJ, gb CAT, gcb WT, gcf pscale, gcf pnorm, LAS unsigned char* lds, int b, int t0, int tid, int wave, int lane) {
    asm volatile("" : "+v"(tid)); lane = tid & 63;
    LAS bf16* XT = (LAS bf16*)lds;
    LAS bf16* DT = (LAS bf16*)(lds + 80 * 264 * 2);
    LAS float* SSP = (LAS float*)(lds + (80 + 64) * 264 * 2);
    const int fr = lane & 15, fq = lane >> 4, tbh = wave & 3, gp = wave >> 2;
    bf16x8 Wf[2][2][4];
#pragma unroll
    for (int gl = 0; gl < 2; ++gl)
#pragma unroll
        for (int kk = 0; kk < 2; ++kk)
#pragma unroll
            for (int nb = 0; nb < 4; ++nb) Wf[gl][kk][nb] = *(GAS const bf16x8*)(WT + (((2 * gp + gl) * 64 + nb * 16 + fr) * 64 + kk * 32 + 8 * fq));
    for (int half = 0; half < 2; ++half) {
        const int t0h = t0 + 64 * half;
        __syncthreads();
        { v4u xr[5];
#pragma unroll
            for (int i = 0; i < 5; ++i) { const int cidx = tid + NTHR * i, row = cidx >> 5, cg = cidx & 31, tt = t0h - 16 + row, ttc = tt < 0 ? 0 : tt;
                xr[i] = *(GAS const v4u*)(PROJ + ((size_t)b * SEQ + ttc) * INW + cg * 8); }
#pragma unroll
            for (int i = 0; i < 5; ++i) { const int cidx = tid + NTHR * i, row = cidx >> 5, cg = cidx & 31, tt = t0h - 16 + row;
                *(LAS v4u*)(XT + row * 264 + cg * 8) = (tt < 0) ? (v4u){0u, 0u, 0u, 0u} : xr[i]; } }
        __syncthreads();
        { const int cg = tid & 31, run = tid >> 5, ch0 = cg * 8, win = 2 << (cg >> 3), tl0 = run * 4;
            float s[8];
#pragma unroll
            for (int k = 0; k < 8; ++k) s[k] = 0.f;
            for (int r = 1; r <= win; ++r) { float xv[8]; unpack8(*(const LAS v4u*)(XT + (tl0 + 16 - r) * 264 + ch0), xv);
#pragma unroll
                for (int k = 0; k < 8; ++k) s[k] += xv[k]; }
#pragma unroll
            for (int i = 0; i < 4; ++i) { float xv[8], yv[8]; unpack8(*(const LAS v4u*)(XT + (tl0 + i + 16) * 264 + ch0), xv); unpack8(*(const LAS v4u*)(XT + (tl0 + i + 16 - win) * 264 + ch0), yv);
                const int tt = t0h + tl0 + i; const float inv = 1.f / (float)((tt + 1 < win) ? tt + 1 : win);
#pragma unroll
                for (int k = 0; k < 8; ++k) s[k] += xv[k] - yv[k];
                v4u o; o.x = pk2(s[0] * inv - xv[0], s[1] * inv - xv[1]); o.y = pk2(s[2] * inv - xv[2], s[3] * inv - xv[3]); o.z = pk2(s[4] * inv - xv[4], s[5] * inv - xv[5]); o.w = pk2(s[6] * inv - xv[6], s[7] * inv - xv[7]);
                *(LAS v4u*)(DT + (tl0 + i) * 264 + ch0) = o; } }
        __syncthreads();
        f32x4 acc[2][4];
#pragma unroll
        for (int gl = 0; gl < 2; ++gl)
#pragma unroll
            for (int nb = 0; nb < 4; ++nb) acc[gl][nb] = (f32x4){0.f, 0.f, 0.f, 0.f};
#pragma unroll
        for (int gl = 0; gl < 2; ++gl)
#pragma unroll
            for (int kk = 0; kk < 2; ++kk) { const bf16x8 X = *(const LAS bf16x8*)(DT + (16 * tbh + fr) * 264 + (2 * gp + gl) * 64 + kk * 32 + 8 * fq);
#pragma unroll
                for (int nb = 0; nb < 4; ++nb) acc[gl][nb] = mfma16(Wf[gl][kk][nb], X, acc[gl][nb]); }
        float ss = 0.f;
#pragma unroll
        for (int gl = 0; gl < 2; ++gl)
#pragma unroll
            for (int nb = 0; nb < 4; ++nb) { const f32x4 y = acc[gl][nb] * ld4(pscale + (2 * gp + gl) * 64 + nb * 16 + 4 * fq); acc[gl][nb] = y; ss += (y.x * y.x + y.y * y.y) + (y.z * y.z + y.w * y.w); }
        ss += __shfl_xor(ss, 16); ss += __shfl_xor(ss, 32);
        if (fq == 0) SSP[gp * 64 + 16 * tbh + fr] = ss;
        __syncthreads();
        const float rstd = rsqrtf((SSP[16 * tbh + fr] + SSP[64 + 16 * tbh + fr]) * (1.f / GWD) + EPS);
        const size_t row = (size_t)b * SEQ + t0h + 16 * tbh + fr;
#pragma unroll
        for (int gl = 0; gl < 2; ++gl)
#pragma unroll
            for (int nb = 0; nb < 4; ++nb) { const int ch = (2 * gp + gl) * 64 + nb * 16 + 4 * fq; *(GAS v2u*)(CAT + row * D + ch) = pack4(acc[gl][nb] * rstd * ld4(pnorm + ch)); }
    }
}

DI void sgu_unit(gcb PROJ, gb CAT, gcb SW, gcf sbias, gcf snorm, LAS unsigned char* lds, int b, int t0, int tid, int wave, int lane) {
    asm volatile("" : "+v"(tid)); lane = tid & 63;
    __syncthreads();
    LAS bf16* VT = (LAS bf16*)lds;
    const int fr = lane & 15, fq = lane >> 4, tb = wave, nk = (tb >> 1) + 1;
    { v2u vr[16];
#pragma unroll
        for (int i = 0; i < 16; ++i) vr[i] = *(GAS const v2u*)(PROJ + ((size_t)b * SEQ + t0 + 16 * wave + i) * INW + 512 + 4 * lane);
#pragma unroll
        for (int i = 0; i < 8; ++i) { const int tl = 16 * wave + 2 * i;
            f32x4 va = unpack4(vr[2 * i]), vb = unpack4(vr[2 * i + 1]);
            va.x = gelu_t(va.x); va.y = gelu_t(va.y); va.z = gelu_t(va.z); va.w = gelu_t(va.w); vb.x = gelu_t(vb.x); vb.y = gelu_t(vb.y); vb.z = gelu_t(vb.z); vb.w = gelu_t(vb.w);
            const float mua = wave_sum_dpp((va.x + va.y) + (va.z + va.w)) * (1.f / GWD), mub = wave_sum_dpp((vb.x + vb.y) + (vb.z + vb.w)) * (1.f / GWD);
            va = va - mua; vb = vb - mub;
            const float vra = wave_sum_dpp((va.x * va.x + va.y * va.y) + (va.z * va.z + va.w * va.w)) * (1.f / GWD), vrb = wave_sum_dpp((vb.x * vb.x + vb.y * vb.y) + (vb.z * vb.z + vb.w * vb.w)) * (1.f / GWD);
            va = va * rsqrtf(vra + EPS); vb = vb * rsqrtf(vrb + EPS);
            *(LAS unsigned*)(VT + (4 * lane + 0) * 136 + tl) = pk2(va.x, vb.x); *(LAS unsigned*)(VT + (4 * lane + 1) * 136 + tl) = pk2(va.y, vb.y);
            *(LAS unsigned*)(VT + (4 * lane + 2) * 136 + tl) = pk2(va.z, vb.z); *(LAS unsigned*)(VT + (4 * lane + 3) * 136 + tl) = pk2(va.w, vb.w); } }
    const int tl = 16 * tb + fr; const size_t row = (size_t)b * SEQ + t0 + tl;
    v2u ur[4][4]; float bias4[4];
#pragma unroll
    for (int h = 0; h < 4; ++h) { bias4[h] = sbias[h * 128 + tl];
#pragma unroll
        for (int db = 0; db < 4; ++db) ur[h][db] = *(GAS const v2u*)(PROJ + row * INW + 256 + h * 64 + db * 16 + 4 * fq); }
    __syncthreads();
    f32x4 acc[4][4];
#pragma unroll
    for (int h = 0; h < 4; ++h)
#pragma unroll
        for (int db = 0; db < 4; ++db) acc[h][db] = (f32x4){0.f, 0.f, 0.f, 0.f};
    for (int kk = 0; kk < nk; ++kk) {
        bf16x8 Q[4];
#pragma unroll
        for (int h = 0; h < 4; ++h) Q[h] = *(GAS const bf16x8*)(SW + ((h * 128 + 16 * tb + fr) * 128 + kk * 32 + 8 * fq));
#pragma unroll
        for (int h = 0; h < 4; ++h)
#pragma unroll
            for (int db = 0; db < 4; ++db) { const bf16x8 P = *(const LAS bf16x8*)(VT + (h * 64 + db * 16 + fr) * 136 + kk * 32 + 8 * fq); acc[h][db] = mfma16(P, Q[h], acc[h][db]); } }
    float ss = 0.f;
#pragma unroll
    for (int h = 0; h < 4; ++h)
#pragma unroll
        for (int db = 0; db < 4; ++db) { f32x4 u = unpack4(ur[h][db]);
            u.x = gelu_t(u.x); u.y = gelu_t(u.y); u.z = gelu_t(u.z); u.w = gelu_t(u.w);
            const f32x4 y = u * (acc[h][db] + bias4[h]); acc[h][db] = y; ss += (y.x * y.x + y.y * y.y) + (y.z * y.z + y.w * y.w); }
    ss += __shfl_xor(ss, 16); ss += __shfl_xor(ss, 32);
    const float rstd = rsqrtf(ss * (1.f / GWD) + EPS);
#pragma unroll
    for (int h = 0; h < 4; ++h)
#pragma unroll
        for (int db = 0; db < 4; ++db) { const int ch = h * 64 + db * 16 + 4 * fq; *(GAS v2u*)(CAT + row * D + 256 + ch) = pack4(acc[h][db] * rstd * ld4(snorm + ch)); }
}

template <int D_> DI float row_shr(float ident, float src) {
    return __builtin_bit_cast(float, __builtin_amdgcn_update_dpp(__builtin_bit_cast(int, ident), __builtin_bit_cast(int, src), 0x110 + D_, 0xf, 0xf, false));
}
#define LRU_STEP_(D) \
    "v_fmac_f32_dpp %0, %0, %8 row_shr:" #D " row_mask:0xf bank_mask:0xf\n\tv_fmac_f32_dpp %1, %1, %9 row_shr:" #D " row_mask:0xf bank_mask:0xf\n\t" \
    "v_fmac_f32_dpp %2, %2, %10 row_shr:" #D " row_mask:0xf bank_mask:0xf\n\tv_fmac_f32_dpp %3, %3, %11 row_shr:" #D " row_mask:0xf bank_mask:0xf\n\t" \
    "v_fmac_f32_dpp %4, %4, %12 row_shr:" #D " row_mask:0xf bank_mask:0xf\n\tv_fmac_f32_dpp %5, %5, %13 row_shr:" #D " row_mask:0xf bank_mask:0xf\n\t" \
    "v_fmac_f32_dpp %6, %6, %14 row_shr:" #D " row_mask:0xf bank_mask:0xf\n\tv_fmac_f32_dpp %7, %7, %15 row_shr:" #D " row_mask:0xf bank_mask:0xf\n\t" \
    "v_mul_f32_dpp %8, %8, %8 row_shr:" #D " row_mask:0xf bank_mask:0xf\n\tv_mul_f32_dpp %9, %9, %9 row_shr:" #D " row_mask:0xf bank_mask:0xf\n\t" \
    "v_mul_f32_dpp %10, %10, %10 row_shr:" #D " row_mask:0xf bank_mask:0xf\n\tv_mul_f32_dpp %11, %11, %11 row_shr:" #D " row_mask:0xf bank_mask:0xf\n\t" \
    "v_mul_f32_dpp %12, %12, %12 row_shr:" #D " row_mask:0xf bank_mask:0xf\n\tv_mul_f32_dpp %13, %13, %13 row_shr:" #D " row_mask:0xf bank_mask:0xf\n\t" \
    "v_mul_f32_dpp %14, %14, %14 row_shr:" #D " row_mask:0xf bank_mask:0xf\n\tv_mul_f32_dpp %15, %15, %15 row_shr:" #D " row_mask:0xf bank_mask:0xf\n\t"
#define LRU_SCAN8(bv, av) asm("s_nop 1\n\t" LRU_STEP_(1) LRU_STEP_(2) LRU_STEP_(4) LRU_STEP_(8) \
    : "+v"(bv[0][0]), "+v"(bv[0][1]), "+v"(bv[0][2]), "+v"(bv[0][3]), "+v"(bv[1][0]), "+v"(bv[1][1]), "+v"(bv[1][2]), "+v"(bv[1][3]), \
      "+v"(av[0][0]), "+v"(av[0][1]), "+v"(av[0][2]), "+v"(av[0][3]), "+v"(av[1][0]), "+v"(av[1][1]), "+v"(av[1][2]), "+v"(av[1][3]))
DI float row_bcast15(float v) { return __builtin_bit_cast(float, __builtin_amdgcn_update_dpp(0, __builtin_bit_cast(int, v), 0x15F, 0xf, 0xf, true)); }
DI void lru_local_unit(gcb PROJ, gcf convw, gcf convb, gcf lba, gcf lbx, gcf lam, gcb WAT, gcb WXT, gf AGG, GAS unsigned* LAB, LAS unsigned char* lds, int b, int chunk, int tid, int wave, int lane) {
    asm volatile("" : "+v"(tid)); lane = tid & 63;
    __syncthreads();
    LAS bf16* TILE = (LAS bf16*)lds;
    const int t0 = chunk * CH;
    {
        const int cg = tid & 31, ch0 = cg * 8;
        f32x4 cw[4][2], cb[2];
#pragma unroll
        for (int k = 0; k < 4; ++k) { cw[k][0] = ld4(convw + k * GWD + ch0); cw[k][1] = ld4(convw + k * GWD + ch0 + 4); }
        cb[0] = ld4(convb + ch0); cb[1] = ld4(convb + ch0 + 4);
#pragma unroll
        for (int hb2 = 0; hb2 < 2; ++hb2) {
            v4u xr[4][4];
#pragma unroll
            for (int i = 0; i < 4; ++i) { const int tl = (tid >> 5) + 16 * (hb2 * 4 + i);
#pragma unroll
                for (int k = 0; k < 4; ++k) { const int tt = t0 + tl - 3 + k, ttc = tt < 0 ? 0 : tt; xr[i][k] = *(GAS const v4u*)(PROJ + ((size_t)b * SEQ + ttc) * INW + 768 + ch0); } }
#pragma unroll
            for (int i = 0; i < 4; ++i) { const int tl = (tid >> 5) + 16 * (hb2 * 4 + i);
                f32x4 x0 = cb[0], x1 = cb[1];
#pragma unroll
                for (int k = 0; k < 4; ++k) { const float m = (t0 + tl - 3 + k >= 0) ? 1.f : 0.f; float xv[8]; unpack8(xr[i][k], xv);
                    x0 += cw[k][0] * ((f32x4){xv[0], xv[1], xv[2], xv[3]} * m); x1 += cw[k][1] * ((f32x4){xv[4], xv[5], xv[6], xv[7]} * m); }
                v4u o; o.x = pk2(x0.x, x0.y); o.y = pk2(x0.z, x0.w); o.z = pk2(x1.x, x1.y); o.w = pk2(x1.z, x1.w);
                *(LAS v4u*)(TILE + tl * 264 + ch0) = o; }
        }
    }
    const int hb = wave & 3, nh = wave >> 2, fr = lane & 15, fq = lane >> 4;
    bf16x8 WA[2][2], WX[2][2];
#pragma unroll
    for (int kk = 0; kk < 2; ++kk)
#pragma unroll
        for (int nbl = 0; nbl < 2; ++nbl) { const int o = (hb * 64 + (2 * nh + nbl) * 16 + fr) * 64 + kk * 32 + 8 * fq; WA[kk][nbl] = *(GAS const bf16x8*)(WAT + o); WX[kk][nbl] = *(GAS const bf16x8*)(WXT + o); }
    f32x4 ba4[2], bx4[2], ls4[2], hc[2], ac[2];
#pragma unroll
    for (int nbl = 0; nbl < 2; ++nbl) { const int ch = hb * 64 + (2 * nh + nbl) * 16 + 4 * fq; ba4[nbl] = ld4(lba + ch); bx4[nbl] = ld4(lbx + ch);
        const f32x4 lm = ld4(lam + ch);
#pragma unroll
        for (int j = 0; j < 4; ++j) ls4[nbl][j] = -8.0f * log1pf(expf(-lm[j]));
        hc[nbl] = (f32x4){0.f, 0.f, 0.f, 0.f}; ac[nbl] = (f32x4){0.f, 0.f, 0.f, 0.f}; }
    __syncthreads();
#pragma unroll 1
    for (int tb = 0; tb < 8; ++tb) {
        const int tl = 16 * tb + fr; const size_t row = (size_t)b * SEQ + t0 + tl;
        bf16x8 X[2];
#pragma unroll
        for (int kk = 0; kk < 2; ++kk) X[kk] = *(const LAS bf16x8*)(TILE + tl * 264 + hb * 64 + kk * 32 + 8 * fq);
        float av[2][4], bv[2][4];
#pragma unroll
        for (int nbl = 0; nbl < 2; ++nbl) {
            f32x4 ra = (f32x4){0.f, 0.f, 0.f, 0.f}, rx = (f32x4){0.f, 0.f, 0.f, 0.f};
#pragma unroll
            for (int kk = 0; kk < 2; ++kk) { ra = mfma16(WA[kk][nbl], X[kk], ra); rx = mfma16(WX[kk][nbl], X[kk], rx); }
            const int ch = hb * 64 + (2 * nh + nbl) * 16 + 4 * fq;
            const f32x4 xcv = unpack4(*(const LAS v2u*)(TILE + tl * 264 + ch));
            v4u lab;
#pragma unroll
            for (int j = 0; j < 4; ++j) {
                const float e1 = __expf(-(ra[j] + ba4[nbl][j])), e2 = __expf(-(rx[j] + bx4[nbl][j]));
                const float rp = __builtin_amdgcn_rcpf((1.f + e1) * (1.f + e2)), r = (1.f + e2) * rp, ii = (1.f + e1) * rp;
                const float la = __builtin_bit_cast(float, pk2(r * ls4[nbl][j], 0.f) << 16);
                const float a = __expf(la), x2 = la + la;
                const float p = -x2 * (1.f + x2 * (0.5f + x2 * (0.16666667f + x2 * (0.041666668f + x2 * 0.0083333338f))));
                const float om = fmaxf((la > -0.0625f) ? p : __builtin_fmaf(-a, a, 1.f), 0.f);
                const float bb = __builtin_amdgcn_sqrtf(om) * ii * xcv[j];
                const unsigned pr = pk2(la, bb);
                lab[j] = pr;
                av[nbl][j] = a; bv[nbl][j] = __builtin_bit_cast(float, pr & 0xffff0000u);
                ac[nbl][j] += la;
            }
            *(GAS v4u*)(LAB + row * GWD + ch) = lab;
        }
        LRU_SCAN8(bv, av);
#pragma unroll
        for (int nbl = 0; nbl < 2; ++nbl)
#pragma unroll
            for (int j = 0; j < 4; ++j) hc[nbl][j] = row_bcast15(av[nbl][j] * hc[nbl][j] + bv[nbl][j]);
    }
#pragma unroll
    for (int nbl = 0; nbl < 2; ++nbl)
#pragma unroll
        for (int j = 0; j < 4; ++j) { float t = ac[nbl][j]; t += row_shr<1>(0.f, t); t += row_shr<2>(0.f, t); t += row_shr<4>(0.f, t); t += row_shr<8>(0.f, t); ac[nbl][j] = __expf(row_bcast15(t)); }
    if (fr == 0) {
#pragma unroll
        for (int nbl = 0; nbl < 2; ++nbl) { const int ch = hb * 64 + (2 * nh + nbl) * 16 + 4 * fq; gf ap = AGG + ((size_t)(b * NCH + chunk) * GWD + ch) * 2;
            *(GAS f32x4*)ap = (f32x4){ac[nbl][0], hc[nbl][0], ac[nbl][1], hc[nbl][1]}; *(GAS f32x4*)(ap + 4) = (f32x4){ac[nbl][2], hc[nbl][2], ac[nbl][3], hc[nbl][3]}; }
    }
}
DI void lru_out_unit(gcb PROJ, gb CAT, gcf lnorm, gcf H0, const GAS unsigned* LAB, LAS unsigned char* lds, int b, int chunk, int tid, int wave, int lane) {
    asm volatile("" : "+v"(tid)); lane = tid & 63;
    LAS float* SS = (LAS float*)lds;
    const int t0 = chunk * CH, hb = wave & 3, nh = wave >> 2, fr = lane & 15, fq = lane >> 4;
    v4u lab[8][2]; v2u gt[8][2];
#pragma unroll
    for (int tb = 0; tb < 8; ++tb)
#pragma unroll
        for (int nbl = 0; nbl < 2; ++nbl) { const size_t row = (size_t)b * SEQ + t0 + 16 * tb + fr; const int ch = hb * 64 + (2 * nh + nbl) * 16 + 4 * fq;
            lab[tb][nbl] = *(GAS const v4u*)(LAB + row * GWD + ch); gt[tb][nbl] = *(GAS const v2u*)(PROJ + row * INW + 1024 + ch); }
    f32x4 hc[2];
#pragma unroll
    for (int nbl = 0; nbl < 2; ++nbl) hc[nbl] = ld4(H0 + ((size_t)(b * NCH + chunk) * GWD + hb * 64 + (2 * nh + nbl) * 16 + 4 * fq));
    v2u yk[8][2];
    __syncthreads();
#pragma unroll
    for (int tb = 0; tb < 8; ++tb) {
        float ssq = 0.f;
        float av[2][4], bv[2][4];
#pragma unroll
        for (int nbl = 0; nbl < 2; ++nbl)
#pragma unroll
            for (int j = 0; j < 4; ++j) { const unsigned pr = lab[tb][nbl][j]; av[nbl][j] = __expf(__builtin_bit_cast(float, pr << 16)); bv[nbl][j] = __builtin_bit_cast(float, pr & 0xffff0000u); }
        LRU_SCAN8(bv, av);
#pragma unroll
        for (int nbl = 0; nbl < 2; ++nbl) { const f32x4 gt4 = unpack4(gt[tb][nbl]); f32x4 yv;
#pragma unroll
            for (int j = 0; j < 4; ++j) { const float h = av[nbl][j] * hc[nbl][j] + bv[nbl][j];
                hc[nbl][j] = row_bcast15(h);
                const float y = gelu_t(gt4[j]) * h; yv[j] = y; ssq += y * y; }
            yk[tb][nbl] = pack4(yv); }
        ssq += __shfl_xor(ssq, 16); ssq += __shfl_xor(ssq, 32); if (fq == 0) SS[wave * 128 + 16 * tb + fr] = ssq;
    }
    __syncthreads();
#pragma unroll
    for (int tb = 0; tb < 8; ++tb) { const int tl = 16 * tb + fr; const size_t row = (size_t)b * SEQ + t0 + tl; float tot = 0.f;
#pragma unroll
        for (int w = 0; w < 8; ++w) tot += SS[w * 128 + tl];
        const float rstd = rsqrtf(tot * (1.f / GWD) + EPS);
#pragma unroll
        for (int nbl = 0; nbl < 2; ++nbl) { const int ch = hb * 64 + (2 * nh + nbl) * 16 + 4 * fq; *(GAS v2u*)(CAT + row * D + 512 + ch) = pack4(unpack4(yk[tb][nbl]) * rstd * ld4(lnorm + ch)); } }
}

DI f32x4 mfma_p2(const v2u a0, const v2u a1, const v2u b0, const v2u b1, const f32x4 c) {
    v4u A, B; A.x = a0.x; A.y = a0.y; A.z = a1.x; A.w = a1.y; B.x = b0.x; B.y = b0.y; B.z = b1.x; B.w = b1.y;
    return __builtin_amdgcn_mfma_f32_16x16x32_bf16(__builtin_bit_cast(bf16x8, A), __builtin_bit_cast(bf16x8, B), c, 0, 0, 0);
}
template <bool OUT>
DI void hgrn_wave_unit(gcb PROJ, gb CAT, gcf LBl, gcf normg, gf ST, gf DEC, LAS float* wlf, int u, int lane) {
    asm volatile("" : "+v"(lane));
    const int hh = u & 3, c = (u >> 2) & (NCH - 1), b = u >> 8, fr = lane & 15, fq = lane >> 4;
    LAS bf16* QT = (LAS bf16*)wlf;
    LAS bf16* KT = QT + 16 * 72;
    LAS bf16* KH = KT + 16 * 72;
    LAS bf16* VT = KH + 64 * 20;
    LAS float* DC = (LAS float*)(VT + 64 * 20);
    const float lbv = LBl[hh * 64 + lane], oml = 1.f - lbv;
    gf stp = ST + ((size_t)((b * NCH + c) * 4 + hh)) * 4096;
    f32x4 S[4][4];
#pragma unroll
    for (int mi = 0; mi < 4; ++mi)
#pragma unroll
        for (int ni = 0; ni < 4; ++ni) S[mi][ni] = OUT ? *(GAS const f32x4*)(stp + ((mi * 4 + ni) * 64 + lane) * 4) : (f32x4){0.f, 0.f, 0.f, 0.f};
    float Dtot = 1.f;
    f32x4 ng4[4];
#pragma unroll
    for (int nv = 0; nv < 4; ++nv) ng4[nv] = OUT ? ld4(normg + hh * 64 + 16 * nv + 4 * fq) : (f32x4){0.f, 0.f, 0.f, 0.f};
    bf16 zr[16], vr[16], qr[16]; v2u gr[4];
#define HG_LOAD(sbn) do { const size_t r0_ = (size_t)b * SEQ + c * CH + (sbn) * 16; \
        _Pragma("unroll") for (int t = 0; t < 16; ++t) { gcb p = PROJ + (r0_ + t) * INW + hh * 64 + lane; zr[t] = p[1536]; vr[t] = p[1792]; if (OUT) qr[t] = p[1280]; else qr[t] = 0; } \
        _Pragma("unroll") for (int nv = 0; nv < 4; ++nv) { if (OUT) gr[nv] = *(GAS const v2u*)(PROJ + (r0_ + fr) * INW + 2048 + hh * 64 + 16 * nv + 4 * fq); else gr[nv] = (v2u){0u, 0u}; } } while (0)
    HG_LOAD(0);
    for (int sb = 0; sb < CH / 16; ++sb) {
        const size_t row0 = (size_t)b * SEQ + c * CH + sb * 16;
        float kk[16], Bt[16]; float Bc = 0.f;
#pragma unroll
        for (int t = 0; t < 16; ++t) {
            const float z = fminf(fmaxf(bf2f(zr[t]), -30.f), 30.f), ez = __expf(-z), sg = __builtin_amdgcn_rcpf(1.f + ez);
            const float f = fmaxf(lbv + oml * sg, 1e-30f);
            Bc += __logf(f); Bt[t] = Bc; kk[t] = oml * ez * sg;
            VT[lane * 20 + t] = vr[t];
            if (OUT) { const float q = siluf(bf2f(qr[t])); QT[t * 72 + lane] = f2bf(q * __expf(Bc)); KT[t * 72 + lane] = f2bf(kk[t] * __expf(fminf(-Bc, 60.f))); } }
#pragma unroll
        for (int t = 0; t < 16; ++t) KH[lane * 20 + t] = f2bf(kk[t] * __expf(Bc - Bt[t]));
        { const float dsub = __expf(Bc); DC[lane] = dsub; Dtot *= dsub; }
        v2u gcur[4];
#pragma unroll
        for (int nv = 0; nv < 4; ++nv) gcur[nv] = gr[nv];
        if (sb + 1 < CH / 16) HG_LOAD(sb + 1);
        LDS_WAIT();
        v2u vt[4]; const v2u zz = (v2u){0u, 0u};
#pragma unroll
        for (int nv = 0; nv < 4; ++nv) vt[nv] = *(const LAS v2u*)(VT + (16 * nv + fr) * 20 + 4 * fq);
        if (OUT) {
            f32x4 O[4], SC = (f32x4){0.f, 0.f, 0.f, 0.f};
            v2u qf[4], kf[4];
#pragma unroll
            for (int s = 0; s < 4; ++s) { qf[s] = *(const LAS v2u*)(QT + fr * 72 + 16 * s + 4 * fq); kf[s] = *(const LAS v2u*)(KT + fr * 72 + 16 * s + 4 * fq); }
            SC = mfma_p2(kf[0], kf[1], qf[0], qf[1], SC); SC = mfma_p2(kf[2], kf[3], qf[2], qf[3], SC);
#pragma unroll
            for (int nv = 0; nv < 4; ++nv) { O[nv] = (f32x4){0.f, 0.f, 0.f, 0.f};
                O[nv] = mfma_p2(pack4(S[nv][0]), pack4(S[nv][1]), qf[0], qf[1], O[nv]); O[nv] = mfma_p2(pack4(S[nv][2]), pack4(S[nv][3]), qf[2], qf[3], O[nv]); }
#pragma unroll
            for (int r = 0; r < 4; ++r) if (4 * fq + r > fr) SC[r] = 0.f;
            const v2u scp = pack4(SC);
            float ss = 0.f;
#pragma unroll
            for (int nv = 0; nv < 4; ++nv) { O[nv] = mfma_p2(vt[nv], zz, scp, zz, O[nv]); ss += (O[nv].x * O[nv].x + O[nv].y * O[nv].y) + (O[nv].z * O[nv].z + O[nv].w * O[nv].w); }
            ss += __shfl_xor(ss, 16); ss += __shfl_xor(ss, 32);
            const float rstd = rsqrtf(ss * (1.f / 64.f) + EPS);
            const size_t row = row0 + fr;
#pragma unroll
            for (int nv = 0; nv < 4; ++nv) { f32x4 g4 = unpack4(gcur[nv]);
                g4.x = siluf(g4.x); g4.y = siluf(g4.y); g4.z = siluf(g4.z); g4.w = siluf(g4.w);
                *(GAS v2u*)(CAT + row * D + 768 + hh * 64 + 16 * nv + 4 * fq) = pack4(O[nv] * rstd * ng4[nv] * g4); }
        }
#pragma unroll
        for (int ni = 0; ni < 4; ++ni) { const f32x4 dk = *(const LAS f32x4*)(DC + 16 * ni + 4 * fq); const v2u kh = *(const LAS v2u*)(KH + (16 * ni + fr) * 20 + 4 * fq);
#pragma unroll
            for (int mi = 0; mi < 4; ++mi) S[mi][ni] = mfma_p2(kh, zz, vt[mi], zz, S[mi][ni] * dk); }
        LDS_WAIT();
    }
    if (!OUT) {
#pragma unroll
        for (int mi = 0; mi < 4; ++mi)
#pragma unroll
            for (int ni = 0; ni < 4; ++ni) *(GAS f32x4*)(stp + ((mi * 4 + ni) * 64 + lane) * 4) = S[mi][ni];
        DEC[((size_t)((b * NCH + c) * 4 + hh)) * 64 + lane] = Dtot;
    }
}
#undef HG_LOAD

DI void carry_phase(gf ST, gcf DEC, gcf AGG, gf H0, int wg, int G, int tid) {
    const int gt = wg * NTHR + tid, NT = G * NTHR, lane = tid & 63, wv = gt >> 6;
    for (int idx = wv; idx < BATCH * GWD; idx += NT >> 6) { const int b = idx >> 8, ch = idx & 255;
        const f32x2 ah = *(GAS const f32x2*)(AGG + ((size_t)(b * NCH + lane) * GWD + ch) * 2); float a = ah.x, h = ah.y;
#pragma unroll
        for (int d = 1; d < 64; d <<= 1) { const float ap = __shfl_up(a, d), hp = __shfl_up(h, d); if (lane >= d) { h = a * hp + h; a = a * ap; } }
        const float hprev = __shfl_up(h, 1);
        H0[(size_t)(b * NCH + lane) * GWD + ch] = lane ? hprev : 0.f; }
    for (int idx = gt; idx < BATCH * 4 * 4096; idx += NT) { const int b = idx >> 14, hh = (idx >> 12) & 3, kv = idx & 4095, k = 16 * ((kv >> 8) & 3) + 4 * ((kv >> 6) & 3) + (kv & 3); float run = 0.f;
#pragma unroll 1
        for (int c0 = 0; c0 < NCH; c0 += 32) { float sl[32], d[32];
#pragma unroll
            for (int c = 0; c < 32; ++c) { sl[c] = ST[((size_t)((b * NCH + c0 + c) * 4 + hh)) * 4096 + kv]; d[c] = DEC[((size_t)((b * NCH + c0 + c) * 4 + hh)) * 64 + k]; }
#pragma unroll
            for (int c = 0; c < 32; ++c) { ST[((size_t)((b * NCH + c0 + c) * 4 + hh)) * 4096 + kv] = run; run = d[c] * run + sl[c]; } } }
}
struct Args { const float* in[33]; float* out; unsigned char* ws; int ph_lo, ph_hi; };
enum { I_X = 0, I_C, I_WMOD, I_BMOD, I_NMIX, I_NFFN, I_NFIN, I_WIN, I_WOUT, I_POOLW, I_POOLS, I_POOLN, I_SGUW, I_SGUB, I_SGUN, I_CONVW, I_CONVB, I_LWA, I_LBA, I_LWX, I_LBX, I_LAM, I_LN,
       I_HGAM, I_HN, I_F1, I_F3, I_F2, I_RW, I_RB, I_M1, I_M3, I_M2 };
constexpr int N_PHASES = 1 + (7 + 2) + (8 + (IS_F8(1) ? 4 : 8)) + (7 + 2) + (8 + (IS_F8(3) ? 4 : 8)) + 1;

DI gws launder(unsigned char* p) { asm volatile("" : "+s"(p)); return (gws)p; }
DI gcf inp(const Args& a, int i) { asm volatile("" : "+s"(i)); return (gcf)a.in[i]; }
#define WSP(T, off) ((GAS T*)(ws + (off)))
#define WSG(T, off) ((T*)((unsigned char*)ws + (off)))

__global__ void __launch_bounds__(NTHR, 2) mk_fwd(Args args) {
    extern __shared__ __attribute__((aligned(16))) unsigned char lds_raw[];
    LAS unsigned char* lds = (LAS unsigned char*)lds_raw;
    const int tid0 = threadIdx.x, wg0 = blockIdx.x, G0 = gridDim.x;
    for (int u = tid0; u < (LDS_BYTES - RING_BYTES) / 4; u += NTHR) ((LAS unsigned*)(lds + RING_BYTES))[u] = 0u;
    __syncthreads();
    const XcdBarrier bar = xcd_barrier_post((unsigned*)(args.ws + WS_CTL) + CW_BAR, (volatile LAS unsigned*)(lds + MISC_OFF) + 8);
    const int lo = args.ph_lo, hi = args.ph_hi;
#define XOUT ((gf)args.out)
    int pi = 0;
#define PH_IDS int tid = (bar.w0 << 6) | hw_lane(); asm volatile("" : "+v"(tid)); const int lane = tid & 63, wave = __builtin_amdgcn_readfirstlane(tid >> 6); int wg = wg0, G = G0; asm volatile("" : "+s"(wg), "+s"(G))
#define PH_ON (pi >= lo && pi < hi)
#define PH_END do { if (pi >= lo && pi + 1 < hi) xcd_barrier(bar); ++pi; } while (0)

    if (PH_ON) { gws ws = launder(args.ws); PH_IDS;
        p0_prologue(inp(args, I_C), inp(args, I_WMOD), inp(args, I_BMOD), inp(args, I_HGAM), inp(args, I_POOLW), inp(args, I_LWA), inp(args, I_LWX), inp(args, I_SGUW), ws, lds, wg, G, tid, wave, lane); }
    PH_END;

    for (int l = 0; l < DEPTH; ++l) {
        const int moe = l & 1;
        if (PH_ON) { gws ws = launder(args.ws); PH_IDS; gcf modl = WSP(float, WS_MOD) + (size_t)l * 8 * MODW;
            convert_weights(l, inp(args, I_WIN), inp(args, I_WOUT), inp(args, I_F1), inp(args, I_F3), inp(args, I_F2), inp(args, I_M1), inp(args, I_M3), inp(args, I_M2), ws, lds, wg, G, wave, lane);
            if (l == 2) norm_phase<true, false, false, false, (bool)IS_B8(2)>(nullptr, WSP(bf16, WS_XB), nullptr, inp(args, I_NMIX) + l * D, modl + 0 * D, modl + 1 * D, modl - 8 * MODW + 5 * D, WSP(bf16, WS_XN), WSP(bf16, WS_Y1), IS_B8(2) ? WSP(bf16, WS_CAT) : WSP(bf16, WS_XN), nullptr, nullptr, nullptr, nullptr, nullptr, nullptr, lds, wg, G, tid, wave, lane);
            else if (l == 0) norm_phase<false, false, false, true>(inp(args, I_X), WSP(bf16, WS_XB), nullptr, inp(args, I_NMIX) + l * D, modl + 0 * D, modl + 1 * D, nullptr, nullptr, nullptr, WSP(bf16, WS_XN), nullptr, nullptr, nullptr, nullptr, nullptr, nullptr, lds, wg, G, tid, wave, lane);
            else if (IS_B8(l)) norm_phase<false, false, false, false, true>(nullptr, WSP(bf16, WS_XB), nullptr, inp(args, I_NMIX) + l * D, modl + 0 * D, modl + 1 * D, nullptr, nullptr, nullptr, WSP(bf16, WS_XN), nullptr, nullptr, nullptr, nullptr, nullptr, nullptr, lds, wg, G, tid, wave, lane);
            else norm_phase<false, false, false, false>(nullptr, WSP(bf16, WS_XB), nullptr, inp(args, I_NMIX) + l * D, modl + 0 * D, modl + 1 * D, nullptr, nullptr, nullptr, WSP(bf16, WS_XN), nullptr, nullptr, nullptr, nullptr, nullptr, nullptr, lds, wg, G, tid, wave, lane);
        }
        PH_END;
        if (PH_ON && !IS_B8(l)) { gws ws = launder(args.ws); PH_IDS;
            pg8::Gemm g{WSG(bf16, WS_XN), WSG(bf16, WS_WIN), D}; pg8::TileOrder<INW / 256> S; S.init(M / 256, G, wg, 0, 0, nullptr);
            EpiProj E{WSP(bf16, WS_PROJ), 1.0f};
            pg8::gemm_phase<EpiProj, pg8::TileOrder<INW / 256>, true, true>(lds, g, S, E, tid);
        }
        if (PH_ON && IS_B8(l)) { gws ws = launder(args.ws); PH_IDS;
            pg8::Gemm g{l == 2 ? WSG(bf16, WS_CAT) : WSG(bf16, WS_XN), WSG(bf16, WS_WIN), D / 2}; pg8::TileOrder<INW / 256> S; S.init(M / 256, G, wg, 0, 0, nullptr);
            EpiProj E{WSP(bf16, WS_PROJ), 1.0f / F8_S13};
            pg8::gemm_phase<EpiProj, pg8::TileOrder<INW / 256>, true, true, true>(lds, g, S, E, tid);
        }
        PH_END;
        if (PH_ON) { gws ws = launder(args.ws); PH_IDS; gcb PROJ = WSP(bf16, WS_PROJ); gb CAT = WSP(bf16, WS_CAT);
            for (int unit = wg; unit < BATCH * NCH; unit += G) { const int b = unit >> 6, blk = unit & (NCH - 1);
                pool_unit(PROJ, CAT, WSP(bf16, WS_POOLWT) + l * 16384, inp(args, I_POOLS) + l * GWD, inp(args, I_POOLN) + l * GWD, lds, b, blk * CH, tid, wave, lane);
                sgu_unit(PROJ, CAT, WSP(bf16, WS_SGUW) + l * 65536, inp(args, I_SGUB) + l * 512, inp(args, I_SGUN) + l * GWD, lds, b, blk * CH, tid, wave, lane);
                lru_local_unit(PROJ, inp(args, I_CONVW) + l * 4 * GWD, inp(args, I_CONVB) + l * GWD, inp(args, I_LBA) + l * GWD, inp(args, I_LBX) + l * GWD, inp(args, I_LAM) + l * GWD,
                               WSP(bf16, WS_LRUWAT) + l * 16384, WSP(bf16, WS_LRUWXT) + l * 16384, WSP(float, WS_AGG), WSP(unsigned, WS_LAB), lds, b, blk, tid, wave, lane);
                __syncthreads(); }
            for (int u = wg * NWAVES + wave; u < BATCH * NCH * 4; u += G * NWAVES)
                hgrn_wave_unit<false>(PROJ, CAT, WSP(float, WS_LB) + l * GWD, inp(args, I_HN) + l * GWD, WSP(float, WS_ST), WSP(float, WS_DEC), (LAS float*)(lds + wave * 16384), u, lane);
        }
        PH_END;
        if (PH_ON) { gws ws = launder(args.ws); PH_IDS; carry_phase(WSP(float, WS_ST), WSP(float, WS_DEC), WSP(float, WS_AGG), WSP(float, WS_H0), wg, G, tid); }
        PH_END;
        if (PH_ON) { gws ws = launder(args.ws); PH_IDS; gcb PROJ = WSP(bf16, WS_PROJ); gb CAT = WSP(bf16, WS_CAT);
            for (int unit = wg; unit < BATCH * NCH; unit += G) { const int b = unit >> 6, blk = unit & (NCH - 1);
                lru_out_unit(PROJ, CAT, inp(args, I_LN) + l * GWD, WSP(float, WS_H0), WSP(unsigned, WS_LAB), lds, b, blk, tid, wave, lane); }
            __syncthreads();
            for (int u = wg * NWAVES + wave; u < BATCH * NCH * 4; u += G * NWAVES)
                hgrn_wave_unit<true>(PROJ, CAT, WSP(float, WS_LB) + l * GWD, inp(args, I_HN) + l * GWD, WSP(float, WS_ST), WSP(float, WS_DEC), (LAS float*)(lds + wave * 16384), u, lane);
        }
        PH_END;
        if (PH_ON) { gws ws = launder(args.ws); PH_IDS;
            pg8::Gemm g{WSG(bf16, WS_CAT), WSG(bf16, WS_WOUT), D}; pg8::TileOrder<D / 256> S; S.init(M / 256, G, wg, 0, 0, nullptr);
            EpiResid E{WSP(bf16, WS_XB), WSP(float, WS_MOD) + (size_t)l * 8 * MODW + 2 * D, 1.0f};
            pg8::gemm_phase<EpiResid, pg8::TileOrder<D / 256>, true, true>(lds, g, S, E, tid);
        }
        PH_END;
        if (PH_ON) { gws ws = launder(args.ws); PH_IDS; gcf modl = WSP(float, WS_MOD) + (size_t)l * 8 * MODW;
            if (moe) norm_phase<false, true, false, false, MOE_XN8>(nullptr, WSP(bf16, WS_XB), nullptr, inp(args, I_NFFN) + l * D, modl + 3 * D, modl + 4 * D, nullptr, nullptr, nullptr, WSP(bf16, WS_XN), inp(args, I_RW) + (l >> 1) * D * NE, inp(args, I_RB) + (l >> 1) * NE,
                                                    WSP(int, WS_TOKE), WSP(float, WS_TOKW), WSP(int, WS_HISTW), WSP(v2i, WS_PAIR), lds, wg, G, tid, wave, lane);
            else if (IS_F8(l)) norm_phase<false, false, false, false, true>(nullptr, WSP(bf16, WS_XB), nullptr, inp(args, I_NFFN) + l * D, modl + 3 * D, modl + 4 * D, nullptr, nullptr, nullptr, WSP(bf16, WS_XN), nullptr, nullptr, nullptr, nullptr, nullptr, nullptr, lds, wg, G, tid, wave, lane);
            else norm_phase<false, false, false, false>(nullptr, WSP(bf16, WS_XB), nullptr, inp(args, I_NFFN) + l * D, modl + 3 * D, modl + 4 * D, nullptr, nullptr, nullptr, WSP(bf16, WS_XN), nullptr, nullptr, nullptr, nullptr, nullptr, nullptr, lds, wg, G, tid, wave, lane);
        }
        PH_END;
        if (moe) {
            if (PH_ON) { gws ws = launder(args.ws); PH_IDS;
                    route_phase(WSP(bf16, WS_XN), WSP(bf16, WS_PROJ), WSP(int, WS_TOKE), WSP(float, WS_TOKW), WSP(int, WS_HISTW), WSP(v2i, WS_PAIR), WSP(int, WS_TILEE), WSP(int, WS_NT), lds, wg, G, tid, wave, lane, IS_F8(l)); }
            PH_END;
        }
        const int nck = moe ? (IS_F8(l) ? 2 : 4) : 1;
#define FFN_RANGE int pm0 = 0, nM = M / 256; if (moe) { const int ntl = __builtin_amdgcn_readfirstlane(__hip_atomic_load(WSP(int, WS_NT), __ATOMIC_RELAXED, __HIP_MEMORY_SCOPE_AGENT)); \
            if (IS_F8(l)) { pm0 = ck * 256; nM = (ck < 1) ? 256 : ntl - 256; if (nM > 292) nM = 292; } else { pm0 = ck * 128; nM = (ck < 3) ? 128 : ntl - 384; if (nM > 146) nM = 146; } if (nM < 0) nM = 0; }
        for (int ck = 0; ck < nck; ++ck) {
            if (PH_ON && !IS_F8(l)) { gws ws = launder(args.ws); PH_IDS; FFN_RANGE;
                pg8::Gemm g{moe ? WSG(bf16, WS_PROJ) : WSG(bf16, WS_XN), WSG(bf16, WS_W13), D}; pg8::TileOrder<DFF / 128> S; S.init(nM, G, wg, pm0, 0, moe ? WSG(int, WS_TILEE) : nullptr);
                EpiSwiglu E{moe ? WSP(bf16, WS_CAT) : WSP(bf16, WS_PROJ), pm0};
                pg8::gemm_phase<EpiSwiglu, pg8::TileOrder<DFF / 128>, true, true>(lds, g, S, E, tid);
            }
            if (PH_ON && IS_F8(l)) { gws ws = launder(args.ws); PH_IDS; FFN_RANGE;
                pg8::Gemm g{moe ? WSG(bf16, WS_PROJ) : WSG(bf16, WS_XN), WSG(bf16, WS_W13), D / 2}; pg8::TileOrder<DFF / 128> S; S.init(nM, G, wg, pm0, 0, moe ? WSG(int, WS_TILEE) : nullptr);
                EpiSwiglu8 E{moe ? WSP(unsigned char, WS_CAT) : WSP(unsigned char, WS_PROJ), pm0};
                pg8::gemm_phase<EpiSwiglu8, pg8::TileOrder<DFF / 128>, true, true, true>(lds, g, S, E, tid);
            }
            PH_END;
            if (PH_ON && !IS_F8(l) && moe) { gws ws = launder(args.ws); PH_IDS; FFN_RANGE;
                pg8::Gemm g{WSG(bf16, WS_CAT), WSG(bf16, WS_W2), DFF}; pg8::TileOrder<D / 256> S; S.init(nM, G, wg, pm0, 1, WSG(int, WS_TILEE));
                EpiScatter E{WSP(v2i, WS_PAIR), WSP(bf16, WS_XN), WSP(bf16, WS_Y1), WSP(int, WS_TOKE), WSP(float, WS_TOKW), 1.0f};
                pg8::gemm_phase<EpiScatter, pg8::TileOrder<D / 256>, true, true>(lds, g, S, E, tid);
            }
            if (PH_ON && !moe && !IS_F8(l)) { gws ws = launder(args.ws); PH_IDS; FFN_RANGE;
                pg8::Gemm g{WSG(bf16, WS_PROJ), WSG(bf16, WS_W2), DFF}; pg8::TileOrder<D / 256> S; S.init(nM, G, wg, pm0, 1, nullptr);
                EpiResid E{WSP(bf16, WS_XB), WSP(float, WS_MOD) + (size_t)l * 8 * MODW + 5 * D, 1.0f};
                pg8::gemm_phase<EpiResid, pg8::TileOrder<D / 256>, true, true>(lds, g, S, E, tid);
            }
            if (PH_ON && IS_F8(l) && !moe) { gws ws = launder(args.ws); PH_IDS; FFN_RANGE;
                pg8::Gemm g{WSG(bf16, WS_PROJ), WSG(bf16, WS_W2), DFF / 2}; pg8::TileOrder<D / 256> S; S.init(nM, G, wg, pm0, 1, nullptr);
                EpiResid E{WSP(bf16, WS_XB), WSP(float, WS_MOD) + (size_t)l * 8 * MODW + 5 * D, 1.0f / F8_S2};
                pg8::gemm_phase<EpiResid, pg8::TileOrder<D / 256>, true, true, true>(lds, g, S, E, tid);
            }
            if (PH_ON && IS_F8(l) && moe) { gws ws = launder(args.ws); PH_IDS; FFN_RANGE;
                pg8::Gemm g{WSG(bf16, WS_CAT), WSG(bf16, WS_W2), DFF / 2}; pg8::TileOrder<D / 256> S; S.init(nM, G, wg, pm0, 1, WSG(int, WS_TILEE));
                EpiScatter E{WSP(v2i, WS_PAIR), WSP(bf16, WS_XN), WSP(bf16, WS_Y1), WSP(int, WS_TOKE), WSP(float, WS_TOKW), 1.0f / F8_S2};
                pg8::gemm_phase<EpiScatter, pg8::TileOrder<D / 256>, true, true, true>(lds, g, S, E, tid);
            }
            PH_END;
        }
#undef FFN_RANGE
    }
    if (PH_ON) { gws ws = launder(args.ws); PH_IDS;
        norm_phase<true, false, true, false>(nullptr, WSP(bf16, WS_XB), XOUT, inp(args, I_NFIN), nullptr, nullptr, WSP(float, WS_MOD) + (size_t)3 * 8 * MODW + 5 * D, WSP(bf16, WS_XN), WSP(bf16, WS_Y1), nullptr, nullptr, nullptr, nullptr, nullptr, nullptr, nullptr, lds, wg, G, tid, wave, lane); }
#undef PH_ON
#undef PH_END
}

#ifndef MK_CUTS
#define MK_CUTS 0
#endif
extern "C" void kernel_launch(void* const* d_in, gci in_sizes, int n_in, void* d_out, int out_size, void* d_ws, size_t ws_size, hipStream_t stream) {
    static int grid = 0;
    if (grid == 0) {
        if (n_in != 33 || in_sizes[0] != M * D || out_size != M * D || ws_size < WS_END) { fprintf(stderr, "kernel_launch: unexpected shapes (n_in %d, in0 %d, out %d, ws %zu); nothing launched\n", n_in, n_in > 0 ? in_sizes[0] : -1, out_size, ws_size); grid = -1; return; }
        int dev = 0, cus = 0, per_cu = 0;
        if (hipGetDevice(&dev) != hipSuccess || hipDeviceGetAttribute(&cus, hipDeviceAttributeMultiprocessorCount, dev) != hipSuccess) { grid = -1; return; }
        if (hipFuncSetAttribute((const void*)mk_fwd, hipFuncAttributeMaxDynamicSharedMemorySize, LDS_BYTES) != hipSuccess) { fprintf(stderr, "kernel_launch: hipFuncSetAttribute failed\n"); grid = -1; return; }
        if (hipOccupancyMaxActiveBlocksPerMultiprocessor(&per_cu, (const void*)mk_fwd, NTHR, LDS_BYTES) != hipSuccess || per_cu < 1) fprintf(stderr, "kernel_launch: occupancy query reports %d workgroups per CU\n", per_cu);
        (void)hipGetLastError();
        grid = cus;
    }
    if (grid < 0) return;
    if (hipMemsetAsync((char*)d_ws + WS_CTL, 0, CTL_ZERO_BYTES, stream) != hipSuccess) return;
    Args a{};
    for (int i = 0; i < 33; ++i) a.in[i] = (const float*)d_in[i];
    a.out = (float*)d_out; a.ws = (unsigned char*)d_ws;
#if MK_CUTS
    for (int p = 0; p < N_PHASES; ++p) { a.ph_lo = p; a.ph_hi = p + 1; hipLaunchKernelGGL(mk_fwd, dim3(grid), dim3(NTHR), LDS_BYTES, stream, a); }
#else
    a.ph_lo = 0; a.ph_hi = N_PHASES;
    hipLaunchKernelGGL(mk_fwd, dim3(grid), dim3(NTHR), LDS_BYTES, stream, a);
#endif
}
```

```cpp
#include <hip/hip_runtime.h>
#include <cstdio>
#include <cstdint>

namespace pg8 {
#define PG8_LAS __attribute__((address_space(3)))
typedef unsigned short bf16_t;
typedef short bf16x8 __attribute__((ext_vector_type(8)));
typedef float f32x4 __attribute__((ext_vector_type(4)));
typedef unsigned u32x4 __attribute__((ext_vector_type(4)));
constexpr int BM = 256, BK = 64, HALF = 128, HTB = HALF * BK * 2  , STAGE_BYTES = 8 * HTB, NXCD = 8, WGM = 8;

__host__ __device__ __forceinline__ int lds_byte(int r, int c) { const int st = (r >> 4) * 2 + (c >> 5), rr = r & 15, cc = c & 31, ob = rr * 64 + cc * 2; return st * 1024 + (ob ^ (((ob >> 9) & 1) << 5)); }
__host__ __device__ __forceinline__ void stage_rc(int b, int& R, int& C) { const int st = b / 1024, sb = b % 1024, swz = sb ^ (((sb >> 9) & 1) << 5); R = (st >> 1) * 16 + swz / 64; C = (st & 1) * 32 + (swz % 64) / 2; }
__host__ __device__ __forceinline__ int perm32(int rho) { const int n = rho >> 4, i = rho & 15; return 8 * (i >> 2) + 4 * n + (i & 3); }

struct Unit { int pa, pn, pm, pc; };
struct Gemm { const bf16_t* A; const bf16_t* Bt; int K; };

template <int NN>
struct TileOrder {
    int nM, nwg, G, c, pm0, a_rel; const int* tile_e;
    __device__ __forceinline__ void init(int nM_, int G_, int c_, int pm0_, int a_rel_, const int* te) { nM = nM_; nwg = nM_ * NN; G = G_; c = c_; pm0 = pm0_; a_rel = a_rel_; tile_e = te; }
    __device__ __forceinline__ bool next(int i, Unit& u) const {
        const int L = i * G + c; if (L >= nwg) return false;
        int wgid = L; { const int q = nwg >> 3, r = nwg & 7, xcd = wgid & 7, off = wgid >> 3; wgid = (xcd < r ? xcd * (q + 1) : r * (q + 1) + (xcd - r) * q) + off; }
        constexpr int nig = WGM * NN;
        const int gid = wgid / nig, x = wgid - gid * nig, fm = gid * WGM, rem = nM - fm;
        int pml, pc;
        if (rem >= WGM) { pml = fm + (x & (WGM - 1)); pc = x >> 3; } else { pml = fm + (x % rem); pc = x / rem; }
        u.pm = pm0 + pml; u.pc = pc; u.pa = a_rel ? pml : u.pm;
        int e = 0; if (tile_e) e = __builtin_amdgcn_readfirstlane(__hip_atomic_load(tile_e + u.pm, __ATOMIC_RELAXED, __HIP_MEMORY_SCOPE_AGENT));
        u.pn = e * NN + pc; return true;
    }
    __device__ __forceinline__ void a_ready(const Unit&) const {}
    __device__ __forceinline__ void done(const Unit&) const {}
};
typedef int v8i32 __attribute__((ext_vector_type(8)));
typedef int v4i32 __attribute__((ext_vector_type(4)));
__device__ __forceinline__ unsigned cvt_pk_bf16(float lo, float hi) { unsigned r; asm("v_cvt_pk_bf16_f32 %0, %1, %2" : "=v"(r) : "v"(lo), "v"(hi)); return r; }

template <class Epi, class Sched, bool ALIGN_EPI = false, bool SP2 = false, bool F8 = false>
__device__ __forceinline__ void gemm_phase(PG8_LAS unsigned char* lds, const Gemm g, const Sched& S, const Epi& E, const int tid_in) {
    int tid = tid_in; asm volatile("" : "+v"(tid));
    const int wid = __builtin_amdgcn_readfirstlane(tid >> 6), lane = tid & 63, wr = wid >> 2, wc = wid & 3, fr = lane & 15, fq = lane >> 4;
    const int K = g.K, nt = K / BK;
    unsigned voffA[2], voffB[2];
#pragma unroll
    for (int i = 0; i < 2; ++i) { int R, C; stage_rc(tid * 16 + i * 8192, R, C); const int Rb = Epi::PERM ? ((R & ~31) + perm32(R & 31)) : R;
        voffA[i] = (unsigned)(R * K + C) * 2u; voffB[i] = (unsigned)(Rb * K + C) * 2u; }
    const size_t kstep = (size_t)(BK * 2);
    const size_t hstep = (size_t)HALF * K * 2;
    const size_t tstep = 2 * hstep;
    const unsigned ldsw = (unsigned)wid * 1024u;
    const int aoff = lds_byte(wr * 64 + fr, fq * 8), boff = lds_byte(wc * 32 + fr, fq * 8);
#define PG8_SA(b, h) (((b) * 2 + (h)) * HTB)
#define PG8_SB(b, h) ((4 + (b) * 2 + (h)) * HTB)
#define PG8_STAGE(bufoff, gbase, voff) do { _Pragma("unroll") for (int _i = 0; _i < 2; ++_i) \
        __builtin_amdgcn_global_load_lds((const unsigned*)((const char*)(gbase) + (voff)[_i]), (PG8_LAS unsigned*)(lds + (bufoff) + ldsw + _i * 8192), 16, 0, 0); } while (0)
#define PG8_LD16(off_) (*(const PG8_LAS v4i32*)(lds + (off_)))
#define PG8_LDA(dst, b, h) do { _Pragma("unroll") for (int m = 0; m < 4; ++m) { if constexpr (F8) dst##8[m] = __builtin_shufflevector(PG8_LD16(PG8_SA(b, h) + aoff + m * 2048), PG8_LD16(PG8_SA(b, h) + aoff + m * 2048 + 1024), 0, 1, 2, 3, 4, 5, 6, 7); \
        else { _Pragma("unroll") for (int k = 0; k < 2; ++k) dst[m][k] = *(const PG8_LAS bf16x8*)(lds + PG8_SA(b, h) + aoff + m * 2048 + k * 1024); } } } while (0)
#define PG8_LDB(dst, b, h) do { _Pragma("unroll") for (int n = 0; n < 2; ++n) { if constexpr (F8) dst##8[n] = __builtin_shufflevector(PG8_LD16(PG8_SB(b, h) + boff + n * 2048), PG8_LD16(PG8_SB(b, h) + boff + n * 2048 + 1024), 0, 1, 2, 3, 4, 5, 6, 7); \
        else { _Pragma("unroll") for (int k = 0; k < 2; ++k) dst[n][k] = *(const PG8_LAS bf16x8*)(lds + PG8_SB(b, h) + boff + n * 2048 + k * 1024); } } } while (0)
#define PG8_MMA(ai, bj, At, Bt, FIRST) do { __builtin_amdgcn_s_setprio(1); _Pragma("unroll") for (int m = 0; m < 4; ++m) _Pragma("unroll") for (int n = 0; n < 2; ++n) { \
        if constexpr (F8) { if constexpr (FIRST) asm volatile("v_mfma_scale_f32_16x16x128_f8f6f4 %0, %1, %2, 0, %3, %3 op_sel_hi:[0,0,0]" : "=&v"(acc[ai][bj][m][n]) : "v"(Bt##8[n]), "v"(At##8[m]), "v"(f8scale)); \
            else asm volatile("v_mfma_scale_f32_16x16x128_f8f6f4 %0, %1, %2, %0, %3, %3 op_sel_hi:[0,0,0]" : "+v"(acc[ai][bj][m][n]) : "v"(Bt##8[n]), "v"(At##8[m]), "v"(f8scale)); } \
        else { acc[ai][bj][m][n] = __builtin_amdgcn_mfma_f32_16x16x32_bf16(Bt[n][0], At[m][0], acc[ai][bj][m][n], 0, 0, 0); \
            acc[ai][bj][m][n] = __builtin_amdgcn_mfma_f32_16x16x32_bf16(Bt[n][1], At[m][1], acc[ai][bj][m][n], 0, 0, 0); } } __builtin_amdgcn_s_setprio(0); } while (0)
#define PG8_WAIT_V(n) asm volatile("s_waitcnt vmcnt(" #n ")" ::: "memory")
#define PG8_WAIT_L(n) asm volatile("s_waitcnt lgkmcnt(" #n ")" ::: "memory")
#define PG8_BAR __builtin_amdgcn_s_barrier()
#define PG8_SCHED __builtin_amdgcn_sched_barrier(0)
    Unit cur, nxt; int ui = 0;
    if (!S.next(0, cur)) return;
    f32x4 acc[2][2][4][2];
    if constexpr (!F8) {
#pragma unroll
    for (int a = 0; a < 2; ++a)
#pragma unroll
        for (int b = 0; b < 2; ++b)
#pragma unroll
            for (int m = 0; m < 4; ++m)
#pragma unroll
                for (int n = 0; n < 2; ++n) acc[a][b][m][n] = (f32x4){0.f, 0.f, 0.f, 0.f};
    }
    bf16x8 At[4][2], B0[2][2], B1[2][2];
    const int f8scale = 0x7f7f7f7f;
    v8i32 At8[4], B08[2], B18[2];
    const char* cA = (const char*)g.A + (size_t)cur.pa * tstep; const char* cB = (const char*)g.Bt + (size_t)cur.pn * tstep;
    S.a_ready(cur);
    {
        PG8_STAGE(PG8_SB(0, 0), cB, voffB); PG8_STAGE(PG8_SB(0, 1), cB + hstep, voffB); PG8_STAGE(PG8_SA(0, 0), cA, voffA); PG8_STAGE(PG8_SA(0, 1), cA + hstep, voffA);
        if (wr == 1) PG8_BAR;
        PG8_WAIT_V(2); PG8_BAR;
        PG8_STAGE(PG8_SB(1, 0), cB + kstep, voffB); PG8_STAGE(PG8_SA(1, 0), cA + kstep, voffA); PG8_STAGE(PG8_SB(1, 1), cB + hstep + kstep, voffB);
        PG8_WAIT_V(6); PG8_BAR;
    }
    for (;;) {
        const bool has_next = S.next(ui + 1, nxt);
        const char* nA = has_next ? (const char*)g.A + (size_t)nxt.pa * tstep : cA; const char* nB = has_next ? (const char*)g.Bt + (size_t)nxt.pn * tstep : cB;
#define PG8_MMA_F(ai, bj, At, Bt) do { if (F8 && t == 0) PG8_MMA(ai, bj, At, Bt, true); else PG8_MMA(ai, bj, At, Bt, false); } while (0)
#pragma nounroll
        for (int t = 0; t < nt; t += 2) {
            const bool last = (t == nt - 2);
            const char* a1 = cA + (size_t)(t + 1) * kstep;
            const char* a2 = last ? nA : cA + (size_t)(t + 2) * kstep; const char* b2 = last ? nB : cB + (size_t)(t + 2) * kstep;
            const char* a3 = a2 + kstep; const char* b3 = b2 + kstep;
            if (last && has_next) S.a_ready(nxt);
            PG8_LDB(B0, 0, 0); PG8_LDB(B1, 0, 1); PG8_SCHED; PG8_LDA(At, 0, 0); PG8_STAGE(PG8_SA(1, 1), a1 + hstep, voffA);
            PG8_WAIT_V(8); PG8_WAIT_L(0); PG8_BAR; PG8_MMA_F(0, 0, At, B0); PG8_MMA_F(0, 1, At, B1); PG8_BAR; PG8_SCHED;
            PG8_LDA(At, 0, 1); PG8_STAGE(PG8_SB(0, 0), b2, voffB); PG8_STAGE(PG8_SB(0, 1), b2 + hstep, voffB); PG8_STAGE(PG8_SA(0, 0), a2, voffA);
            PG8_WAIT_V(8); PG8_WAIT_L(0); PG8_BAR; PG8_MMA_F(1, 0, At, B0); PG8_MMA_F(1, 1, At, B1); PG8_BAR; PG8_SCHED;
            PG8_LDB(B0, 1, 0); PG8_LDB(B1, 1, 1); PG8_SCHED; PG8_LDA(At, 1, 0); PG8_STAGE(PG8_SA(0, 1), a2 + hstep, voffA);
            PG8_WAIT_V(8); PG8_WAIT_L(0); PG8_BAR; PG8_MMA(0, 0, At, B0, false); PG8_MMA(0, 1, At, B1, false); PG8_BAR; PG8_SCHED;
            PG8_LDA(At, 1, 1); PG8_STAGE(PG8_SB(1, 0), b3, voffB); PG8_STAGE(PG8_SB(1, 1), b3 + hstep, voffB); PG8_STAGE(PG8_SA(1, 0), a3, voffA);
            PG8_WAIT_V(8); PG8_WAIT_L(0); PG8_BAR; PG8_MMA(1, 0, At, B0, false); PG8_MMA(1, 1, At, B1, false); PG8_BAR; PG8_SCHED;
        }
#undef PG8_MMA_F
        if constexpr (ALIGN_EPI) { if (wr == 0) PG8_BAR; }
        if constexpr (F8) asm volatile("s_nop 15\n\ts_nop 15" ::: "memory");
        if constexpr (!Epi::AFTER_DRAIN) { E(acc, cur, wr, wc, fr, fq); S.done(cur); }
        if (!has_next) break;
        if constexpr (!F8) {
#pragma unroll
        for (int a = 0; a < 2; ++a)
#pragma unroll
            for (int b = 0; b < 2; ++b)
#pragma unroll
                for (int m = 0; m < 4; ++m)
#pragma unroll
                    for (int n = 0; n < 2; ++n) acc[a][b][m][n] = (f32x4){0.f, 0.f, 0.f, 0.f};
        }
        cur = nxt; cA = nA; cB = nB; ++ui;
        if constexpr (ALIGN_EPI) { if (wr == 1) PG8_BAR; }
    }
    PG8_WAIT_V(0);
    if constexpr (!ALIGN_EPI) { if (wr == 0) PG8_BAR; }
    PG8_BAR;
    if constexpr (Epi::AFTER_DRAIN) { E.fused(acc, cur, wr, wc, fr, fq, lds, wid, lane); S.done(cur); }
#undef PG8_SA
#undef PG8_SB
#undef PG8_STAGE
#undef PG8_LDA
#undef PG8_LD16
#undef PG8_LDB
#undef PG8_MMA
#undef PG8_WAIT_V
#undef PG8_WAIT_L
#undef PG8_BAR
#undef PG8_SCHED
}
}

constexpr int NWAVES = 8, NTHR = NWAVES * 64;
constexpr int BATCH = 8, SEQ = 8192, D = 1024, M = BATCH * SEQ, DEPTH = 4, GWD = 256, INW = 2304, DFF = 3584, NE = 8;
constexpr float EPS = 1e-6f;
constexpr int MODW = 6 * D;
constexpr int CH = 128, NCH = SEQ / CH;
#ifndef F8_MASK
#define F8_MASK 0xE
#endif
#ifndef B8_MASK
#define B8_MASK 0xC
#endif
#define IS_B8(l_) (((B8_MASK) >> (l_)) & 1)
#define IS_F8(l_) (((F8_MASK) >> (l_)) & 1)
constexpr int F8_LAYER = 3;
constexpr float F8_S13 = 32.f, F8_S2 = 64.f;
constexpr bool MOE_XN8 = ((F8_MASK >> 1) & 1) && ((F8_MASK >> 3) & 1);
constexpr int MAXPAIR = 2 * M + NE * 256;

constexpr size_t MiB = 1u << 20;
constexpr size_t WS_CTL = 0, CTL_ZERO_BYTES = 1 * MiB;
constexpr size_t WS_MOD = 1 * MiB;
constexpr size_t WS_LB = WS_MOD + 786432;
constexpr size_t WS_POOLWT = 2 * MiB;
constexpr size_t WS_LRUWAT = WS_POOLWT + 131072;
constexpr size_t WS_LRUWXT = WS_LRUWAT + 131072;
constexpr size_t WS_SGUW = 3 * MiB;
constexpr size_t WS_TOKE = 4 * MiB;
constexpr size_t WS_TOKW = WS_TOKE + 262144;
constexpr size_t WS_HISTW = 5 * MiB;
constexpr size_t WS_TILEE = WS_HISTW + 65536;
constexpr size_t WS_NT = WS_TILEE + 4096;
constexpr size_t WS_PAIR = 6 * MiB;
constexpr size_t WS_AGG = 8 * MiB;
constexpr size_t WS_H0 = 9 * MiB;
constexpr size_t WS_DEC = 10 * MiB;
constexpr size_t WS_W = 16 * MiB;
constexpr size_t WS_WIN = WS_W, WS_WOUT = WS_W + 5 * MiB, WS_W13 = WS_W + 8 * MiB, WS_W2 = WS_W + 120 * MiB;
constexpr size_t WS_XN = 192 * MiB;
constexpr size_t WS_PROJ = 320 * MiB;
constexpr size_t WS_CAT = 608 * MiB;
constexpr size_t WS_ST = 736 * MiB;
constexpr size_t WS_LAB = 768 * MiB;
constexpr size_t WS_Y1 = 864 * MiB;
constexpr size_t WS_XB = 992 * MiB;
constexpr size_t WS_END = 1120 * MiB;
constexpr int CW_BAR = 4096;
constexpr int CW_ZT = 16384;
constexpr int RING_BYTES = 131072, MISC_OFF = RING_BYTES + 320, LDS_BYTES = 147456;

#define DI __device__ __forceinline__
#define LAS __attribute__((address_space(3)))
typedef unsigned short bf16;
typedef unsigned v4u __attribute__((ext_vector_type(4)));
typedef unsigned v2u __attribute__((ext_vector_type(2)));
typedef int v4i __attribute__((ext_vector_type(4)));
typedef int v2i __attribute__((ext_vector_type(2)));
typedef float f32x4 __attribute__((ext_vector_type(4)));
typedef float f32x2 __attribute__((ext_vector_type(2)));
typedef short bf16x8 __attribute__((ext_vector_type(8)));
#define LDS_WAIT() asm volatile("s_waitcnt lgkmcnt(0)" ::: "memory")
#define GAS __attribute__((address_space(1)))
typedef GAS const float* gcf; typedef GAS float* gf; typedef GAS const bf16* gcb; typedef GAS bf16* gb; typedef GAS const int* gci; typedef GAS int* gi;
typedef GAS const v2i* gcv2i; typedef GAS v2i* gv2i; typedef GAS const unsigned* gcu; typedef GAS unsigned char* gws;

DI float bf2f(bf16 v) { return __builtin_bit_cast(float, (unsigned)v << 16); }
DI float lo_bf(unsigned w) { return __builtin_bit_cast(float, w << 16); }
DI float hi_bf(unsigned w) { return __builtin_bit_cast(float, w & 0xffff0000u); }
DI unsigned pk2(float lo, float hi) { return pg8::cvt_pk_bf16(lo, hi); }
DI bf16 f2bf(float f) { return (bf16)(pk2(f, 0.f) & 0xffffu); }
DI float sigm(float x) { return __builtin_amdgcn_rcpf(1.f + __expf(-x)); }
DI float siluf(float x) { return x * sigm(x); }
DI float gelu_t(float x) { return x * sigm(1.5957691216057308f * (x + 0.044715f * x * x * x)); }
DI float neg_expm1(float x) {
    const float p = -x * (1.f + x * (0.5f + x * (0.16666667f + x * (0.041666668f + x * (0.0083333338f + x * 0.0013888889f)))));
    return x > -0.25f ? p : 1.f - __expf(x);
}
DI float wave_sum(float v) {
#pragma unroll
    for (int o = 1; o < 64; o <<= 1) v += __shfl_xor(v, o);
    return v;
}
template <int D_> DI float row_shr0(float src) { return __builtin_bit_cast(float, __builtin_amdgcn_update_dpp(0, __builtin_bit_cast(int, src), 0x110 + D_, 0xf, 0xf, true)); }
DI float wave_sum_dpp(float v) {
    v += row_shr0<1>(v); v += row_shr0<2>(v); v += row_shr0<4>(v); v += row_shr0<8>(v);
    const int iv = __builtin_bit_cast(int, v);
    const float a = __builtin_bit_cast(float, __builtin_amdgcn_readlane(iv, 15)), b2 = __builtin_bit_cast(float, __builtin_amdgcn_readlane(iv, 31));
    const float c2 = __builtin_bit_cast(float, __builtin_amdgcn_readlane(iv, 47)), d2 = __builtin_bit_cast(float, __builtin_amdgcn_readlane(iv, 63));
    return (a + b2) + (c2 + d2);
}
DI int wave_sum_i(int v) {
#pragma unroll
    for (int o = 1; o < 64; o <<= 1) v += __shfl_xor(v, o);
    return v;
}
DI f32x4 ld4(gcf p) { return *(GAS const f32x4*)p; }
DI f32x4 ld4_nt(gcf p) { return __builtin_nontemporal_load((GAS const f32x4*)p); }
DI void unpack8(const v4u x, float (&o)[8]) { o[0] = lo_bf(x.x); o[1] = hi_bf(x.x); o[2] = lo_bf(x.y); o[3] = hi_bf(x.y); o[4] = lo_bf(x.z); o[5] = hi_bf(x.z); o[6] = lo_bf(x.w); o[7] = hi_bf(x.w); }
DI f32x4 unpack4(const v2u x) { return (f32x4){lo_bf(x.x), hi_bf(x.x), lo_bf(x.y), hi_bf(x.y)}; }
DI v2u pack4(const f32x4 v) { v2u r; r.x = pk2(v.x, v.y); r.y = pk2(v.z, v.w); return r; }
DI float clamp_f8(float v) { return __builtin_amdgcn_fmed3f(v, -448.f, 448.f); }
DI unsigned pk4_f8(float a, float b, float c, float d) { int r = __builtin_amdgcn_cvt_pk_fp8_f32(clamp_f8(a), clamp_f8(b), 0, false); r = __builtin_amdgcn_cvt_pk_fp8_f32(clamp_f8(c), clamp_f8(d), r, true); return (unsigned)r; }
DI f32x4 mfma16(const bf16x8 a, const bf16x8 b, const f32x4 c) { return __builtin_amdgcn_mfma_f32_16x16x32_bf16(a, b, c, 0, 0, 0); }

#define XB_TMO      128
#define XB_XCNT(j)  (256  + 64 * (j))
#define XB_XSUB(j)  (1280 + 64 * (j))
#define XB_XGEN(j)  (2304 + 64 * (j))
#define XB_TOP      3328
#define XB_TOPGEN   3392
#define XCD_BAR_WORDS 3456
#define XB_SPIN_CAP (1u << 18)
__device__ __forceinline__ unsigned xb_ld(unsigned* p)              { return __hip_atomic_load(p, __ATOMIC_RELAXED, __HIP_MEMORY_SCOPE_AGENT); }
__device__ __forceinline__ unsigned xb_add(unsigned* p, unsigned v) { return __hip_atomic_fetch_add(p, v, __ATOMIC_RELAXED, __HIP_MEMORY_SCOPE_AGENT); }
__device__ __forceinline__ unsigned xb_xcc_id() { return (unsigned)__builtin_amdgcn_s_getreg((3 << 11) | 20) & 0xFu; }
#define XB_SPIN(cond, bar) do { unsigned _sp = 0; while (cond) { __builtin_amdgcn_s_sleep(1); \
    if ((++_sp & 255u) == 0u) { if (xb_ld(&(bar)[XB_TMO])) break; if (_sp > XB_SPIN_CAP) { atomicAdd(&(bar)[XB_TMO], 1u); break; } } } } while (0)
DI int hw_lane() { int l; asm volatile("v_mbcnt_lo_u32_b32 %0, -1, 0\n\tv_mbcnt_hi_u32_b32 %0, -1, %0" : "=v"(l)); return l; }
struct XcdBarrier { unsigned* bar; unsigned x; volatile LAS unsigned* st; int w0; };
__device__ __forceinline__ XcdBarrier xcd_barrier_post(unsigned* bar, volatile LAS unsigned* st) {
    XcdBarrier b; b.bar = bar; b.x = xb_xcc_id(); b.st = st; b.w0 = __builtin_amdgcn_readfirstlane((int)threadIdx.x >> 6);
    if (threadIdx.x == 0) (void)xb_add(&bar[XB_XCNT(b.x)], 1u);
    return b;
}
__device__ __forceinline__ void xcd_barrier_complete(unsigned* bar, unsigned x, unsigned& nloc, unsigned& nx) {
    const unsigned G = gridDim.x * gridDim.y * gridDim.z;
    unsigned sum, cnt, mine, sp = 0u;
    for (;;) {
        sum = 0u; cnt = 0u; mine = 0u;
#pragma unroll
        for (unsigned j = 0; j < 16; ++j) { const unsigned c = xb_ld(&bar[XB_XCNT(j)]); sum += c; cnt += (c > 0u) ? 1u : 0u; mine = (j == x) ? c : mine; }
        if (sum == G) break;
        __builtin_amdgcn_s_sleep(1);
        if ((++sp & 255u) == 0u) { if (xb_ld(&bar[XB_TMO])) break; if (sp > XB_SPIN_CAP) { atomicAdd(&bar[XB_TMO], 1u); break; } }
    }
    nloc = mine > 0u ? mine : 1u; nx = cnt > 0u ? cnt : 1u;
}
__device__ __forceinline__ void xcd_barrier(const XcdBarrier& b) {
    asm volatile("s_waitcnt vmcnt(0)" ::: "memory");
    __syncthreads();
    if (b.w0 == 0 && hw_lane() == 0) {
        unsigned* bar = b.bar;
        __builtin_amdgcn_s_waitcnt(0);
        unsigned nloc = b.st[0], nx = b.st[1];
        if (nloc == 0u) { xcd_barrier_complete(bar, b.x, nloc, nx); b.st[0] = nloc; b.st[1] = nx; }
        const unsigned old = xb_add(&bar[XB_XSUB(b.x)], 1u);
        const unsigned gen = old / nloc;
        if (old + 1u == (gen + 1u) * nloc) {
            __builtin_amdgcn_fence(__ATOMIC_RELEASE, "agent");
            asm volatile("s_waitcnt vmcnt(0)" ::: "memory");
            const unsigned og = xb_add(&bar[XB_TOP], 1u);
            const unsigned tg = og / nx;
            if (og + 1u == (tg + 1u) * nx) xb_add(&bar[XB_TOPGEN], 1u);
            else XB_SPIN(xb_ld(&bar[XB_TOPGEN]) == tg, bar);
            __builtin_amdgcn_fence(__ATOMIC_ACQUIRE, "agent");
            xb_add(&bar[XB_XGEN(b.x)], 1u);
            asm volatile("s_waitcnt vmcnt(0)" ::: "memory");
        } else {
            XB_SPIN(xb_ld(&bar[XB_XGEN(b.x)]) == gen, bar);
            __builtin_amdgcn_fence(__ATOMIC_ACQUIRE, "agent");
            asm volatile("s_waitcnt vmcnt(0)" ::: "memory");
        }
    }
    __syncthreads();
}

struct EpiProj {
    static constexpr bool PERM = true, AFTER_DRAIN = false, IDEMPOTENT = true;
    gb O; float mul;
    DI void operator()(const f32x4 (&acc)[2][2][4][2], const pg8::Unit& u, int wr, int wc, int fr, int fq) const {
        const int row0 = u.pm * 256 + wr * 64 + fr, col0 = u.pc * 256 + wc * 32 + 8 * fq;
#pragma unroll
        for (int ai = 0; ai < 2; ++ai)
#pragma unroll
            for (int m = 0; m < 4; ++m) { gb rowp = O + (size_t)(row0 + ai * 128 + m * 16) * INW + col0;
#pragma unroll
                for (int bj = 0; bj < 2; ++bj) { const f32x4 v0 = acc[ai][bj][m][0] * mul, v1 = acc[ai][bj][m][1] * mul;
                    v4u w; w.x = pk2(v0[0], v0[1]); w.y = pk2(v0[2], v0[3]); w.z = pk2(v1[0], v1[1]); w.w = pk2(v1[2], v1[3]);
                    *(GAS v4u*)(rowp + bj * 128) = w; } }
    }
};
struct EpiResid {
    static constexpr bool PERM = true, AFTER_DRAIN = false, IDEMPOTENT = false;
    gb x; gcf gate; float mul;
    DI void operator()(const f32x4 (&acc)[2][2][4][2], const pg8::Unit& u, int wr, int wc, int fr, int fq) const {
        const int b = u.pm >> 5, row0 = u.pm * 256 + wr * 64 + fr, col0 = u.pc * 256 + wc * 32 + 8 * fq;
        f32x4 gv[2][2];
#pragma unroll
        for (int bj = 0; bj < 2; ++bj)
#pragma unroll
            for (int n = 0; n < 2; ++n) gv[bj][n] = ld4(gate + (size_t)b * MODW + col0 + bj * 128 + n * 4) * mul;
        constexpr int PF = 6;
        v4u xr[8][2];
#define ER_LOAD(p) _Pragma("unroll") for (int bj = 0; bj < 2; ++bj) xr[p][bj] = *(GAS const v4u*)(x + (size_t)(row0 + ((p) >> 2) * 128 + ((p) & 3) * 16) * D + col0 + bj * 128)
#pragma unroll
        for (int p = 0; p < PF; ++p) { ER_LOAD(p); }
#pragma unroll
        for (int p = 0; p < 8; ++p) { const int ai = p >> 2, m = p & 3;
#pragma unroll
            for (int bj = 0; bj < 2; ++bj) { float xv[8]; unpack8(xr[p][bj], xv);
                const f32x4 v0 = (f32x4){xv[0], xv[1], xv[2], xv[3]} + gv[bj][0] * acc[ai][bj][m][0], v1 = (f32x4){xv[4], xv[5], xv[6], xv[7]} + gv[bj][1] * acc[ai][bj][m][1];
                v4u o; o.x = pk2(v0[0], v0[1]); o.y = pk2(v0[2], v0[3]); o.z = pk2(v1[0], v1[1]); o.w = pk2(v1[2], v1[3]);
                *(GAS v4u*)(x + (size_t)(row0 + ai * 128 + m * 16) * D + col0 + bj * 128) = o; }
            if (p + PF < 8) { ER_LOAD(p + PF); }
            asm volatile("" ::: "memory"); }
#undef ER_LOAD
    }
};
struct EpiSwiglu {
    static constexpr bool PERM = true, AFTER_DRAIN = false, IDEMPOTENT = true;
    gb ACT; int pm0;
    DI void operator()(const f32x4 (&acc)[2][2][4][2], const pg8::Unit& u, int wr, int wc, int fr, int fq) const {
        const int row0 = (u.pm - pm0) * 256 + wr * 64 + fr, col0 = u.pc * 128 + wc * 32 + 8 * fq;
#pragma unroll
        for (int ai = 0; ai < 2; ++ai)
#pragma unroll
            for (int m = 0; m < 4; ++m) { gb rowp = ACT + (size_t)(row0 + ai * 128 + m * 16) * DFF + col0;
                const f32x4 g0 = acc[ai][0][m][0], g1 = acc[ai][0][m][1], u0 = acc[ai][1][m][0], u1 = acc[ai][1][m][1];
                v4u w; w.x = pk2(siluf(g0[0]) * u0[0], siluf(g0[1]) * u0[1]); w.y = pk2(siluf(g0[2]) * u0[2], siluf(g0[3]) * u0[3]);
                w.z = pk2(siluf(g1[0]) * u1[0], siluf(g1[1]) * u1[1]); w.w = pk2(siluf(g1[2]) * u1[2], siluf(g1[3]) * u1[3]);
                *(GAS v4u*)rowp = w; }
    }
};
struct EpiSwiglu8 {
    static constexpr bool PERM = true, AFTER_DRAIN = false, IDEMPOTENT = true;
    GAS unsigned char* ACT; int pm0;
    DI void operator()(const f32x4 (&acc)[2][2][4][2], const pg8::Unit& u, int wr, int wc, int fr, int fq) const {
        const int row0 = (u.pm - pm0) * 256 + wr * 64 + fr, col0 = u.pc * 128 + wc * 32 + 8 * (fq & ~1);
        float c1 = -1.4426950408889634f / F8_S13, S2 = (float)F8_S13 * (float)F8_S13; asm volatile("" : "+v"(c1), "+v"(S2));
        const int oddq = fq & 1;
#pragma unroll
        for (int ai = 0; ai < 2; ++ai)
#pragma unroll
            for (int mp = 0; mp < 2; ++mp) {
                v2u w[2];
#pragma unroll
                for (int mm = 0; mm < 2; ++mm) { const int m = 2 * mp + mm;
                    f32x4 o[2];
#pragma unroll
                    for (int n = 0; n < 2; ++n) { const f32x4 g = acc[ai][0][m][n], uu = acc[ai][1][m][n]; f32x4 t = g * c1;
                        t.x = __builtin_amdgcn_exp2f(t.x); t.y = __builtin_amdgcn_exp2f(t.y); t.z = __builtin_amdgcn_exp2f(t.z); t.w = __builtin_amdgcn_exp2f(t.w);
                        t = t * S2 + S2;
                        t.x = __builtin_amdgcn_rcpf(t.x); t.y = __builtin_amdgcn_rcpf(t.y); t.z = __builtin_amdgcn_rcpf(t.z); t.w = __builtin_amdgcn_rcpf(t.w);
                        o[n] = (g * uu) * t; }
                    w[mm].x = pk4_f8(o[0][0], o[0][1], o[0][2], o[0][3]); w[mm].y = pk4_f8(o[1][0], o[1][1], o[1][2], o[1][3]); }
                const auto rx = __builtin_amdgcn_permlane16_swap(w[0].x, w[1].x, false, false), ry = __builtin_amdgcn_permlane16_swap(w[0].y, w[1].y, false, false);
                *(GAS v4u*)(ACT + (size_t)(row0 + ai * 128 + (2 * mp + oddq) * 16) * DFF + col0) = (v4u){rx[0], ry[0], rx[1], ry[1]}; }
    }
};
struct EpiScatter {
    static constexpr bool PERM = true, AFTER_DRAIN = false, IDEMPOTENT = true;
    gcv2i pair; gb Y0; gb Y1; gci toke; gcf tokw; float sc;
    DI void operator()(const f32x4 (&acc)[2][2][4][2], const pg8::Unit& u, int wr, int wc, int fr, int fq) const {
        const int row0 = u.pm * 256 + wr * 64 + fr, col0 = u.pc * 256 + wc * 32 + 8 * fq;
        int px[8]; float w[8];
#pragma unroll
        for (int p = 0; p < 8; ++p) px[p] = pair[row0 + (p >> 2) * 128 + (p & 3) * 16].x;
#pragma unroll
        for (int p = 0; p < 8; ++p) w[p] = tokw[px[p] >= 0 ? 2 * (px[p] & 0x3fffffff) + (px[p] >> 30) : 0] * sc;
#pragma unroll
        for (int p = 0; p < 8; ++p) { const int ai = p >> 2, m = p & 3;
            if (px[p] >= 0) { const int tok = px[p] & 0x3fffffff;
                gb rowp = ((px[p] >> 30) ? Y1 : Y0) + (size_t)tok * D + col0;
#pragma unroll
                for (int bj = 0; bj < 2; ++bj) { const f32x4 v0 = acc[ai][bj][m][0] * w[p], v1 = acc[ai][bj][m][1] * w[p];
                    v4u o; o.x = pk2(v0[0], v0[1]); o.y = pk2(v0[2], v0[3]); o.z = pk2(v1[0], v1[1]); o.w = pk2(v1[2], v1[3]);
                    *(GAS v4u*)(rowp + bj * 128) = o; } } }
    }
};


DI void p0_prologue(gcf c, gcf w_mod, gcf b_mod, gcf gamma, gcf pool_w, gcf lwa, gcf lwx, gcf sgu_ws,
                    gws ws, LAS unsigned char* lds, int wg, int G, int tid, int wave, int lane) {
    LAS float* CS = (LAS float*)lds; LAS float* RED = (LAS float*)(lds + 32768);
    gf MOD = (GAS float*)(ws + WS_MOD);
    if (wg < 96) {
        for (int idx = tid; idx < 8192; idx += NTHR) { const int k = idx >> 3, b = idx & 7; const float v = c[b * D + k]; CS[idx] = siluf(v); }
        __syncthreads();
        for (int item = wg; item < 96; item += G) {
            const int l = item / 24, jb = item % 24, col = jb * 256 + lane * 4;
            f32x4 acc[8];
#pragma unroll
            for (int b = 0; b < 8; ++b) acc[b] = (f32x4){0.f, 0.f, 0.f, 0.f};
            gcf wp = w_mod + ((size_t)(l * D + wave * 128)) * MODW + col;
#pragma unroll 32
            for (int kk = 0; kk < 128; ++kk) {
                const f32x4 w = ld4(wp + (size_t)kk * MODW);
                const f32x4 c0 = *(const LAS f32x4*)(CS + (wave * 128 + kk) * 8), c1 = *(const LAS f32x4*)(CS + (wave * 128 + kk) * 8 + 4);
                acc[0] += c0.x * w; acc[1] += c0.y * w; acc[2] += c0.z * w; acc[3] += c0.w * w; acc[4] += c1.x * w; acc[5] += c1.y * w; acc[6] += c1.z * w; acc[7] += c1.w * w;
            }
#pragma unroll
            for (int b = 0; b < 8; ++b) *(LAS f32x4*)(RED + (wave * 8 + b) * 256 + lane * 4) = acc[b];
            __syncthreads();
            for (int o = tid; o < 2048; o += NTHR) { const int b = o >> 8, cc = o & 255; float s = 0.f;
#pragma unroll
                for (int w = 0; w < 8; ++w) s += RED[(w * 8 + b) * 256 + cc];
                MOD[(size_t)(l * 8 + b) * MODW + jb * 256 + cc] = s + b_mod[l * MODW + jb * 256 + cc]; }
            __syncthreads();
        }
    }
    if (wg == G - 1 && tid < GWD) {
        gf LB = (GAS float*)(ws + WS_LB);
        const float g0 = gamma[tid], g1 = gamma[GWD + tid], g2 = gamma[2 * GWD + tid], g3 = gamma[3 * GWD + tid];
        const float mx = fmaxf(fmaxf(g0, g1), fmaxf(g2, g3));
        const float e0 = expf(g0 - mx), e1 = expf(g1 - mx), e2 = expf(g2 - mx), e3 = expf(g3 - mx), inv = 1.f / (e0 + e1 + e2 + e3);
        LB[tid] = 0.f; LB[GWD + tid] = e1 * inv; LB[2 * GWD + tid] = (e1 + e2) * inv; LB[3 * GWD + tid] = (e1 + e2 + e3) * inv;
    }
    gb POOLWT = (GAS bf16*)(ws + WS_POOLWT); gb LRUWAT = (GAS bf16*)(ws + WS_LRUWAT); gb LRUWXT = (GAS bf16*)(ws + WS_LRUWXT); gb SGUW = (GAS bf16*)(ws + WS_SGUW);
    const int gt = wg * NTHR + tid, NT = G * NTHR;
    for (int idx = gt; idx < 65536; idx += NT) { const int lg = idx >> 12, j = (idx >> 6) & 63, i = idx & 63, src = (lg * 64 + i) * 64 + j;
        POOLWT[idx] = f2bf(pool_w[src]); LRUWAT[idx] = f2bf(lwa[src]); LRUWXT[idx] = f2bf(lwx[src]); }
    for (int idx = gt; idx < 262144; idx += NT) { const int t = (idx >> 7) & 127, s = idx & 127; SGUW[idx] = (s <= t) ? f2bf(sgu_ws[idx]) : (bf16)0; }
}

struct CvItem { gcf W; gb WT; int K, N, mode, idx; float f8s; };
DI void cv_load(const CvItem& I, int lane, f32x4 (&v)[8]) {
    const int nblk = I.N / 32, kb = I.idx / nblk, nb = I.idx % nblk;
    gcf p = I.W + (size_t)(64 * kb + (lane >> 3)) * I.N + 32 * nb + 4 * (lane & 7);
#pragma unroll
    for (int i = 0; i < 8; ++i) v[i] = ld4_nt(p + (size_t)(8 * i) * I.N);
}
DI void cv_store(const CvItem& I, LAS float* scr, int lane, const f32x4 (&v)[8]) {
    const int nblk = I.N / 32, kb = I.idx / nblk, nb = I.idx % nblk, k0 = 64 * kb, n0 = 32 * nb;
#pragma unroll
    for (int i = 0; i < 8; ++i) { LAS float* d = scr + (8 * i + (lane >> 3)) * 33 + 4 * (lane & 7); d[0] = v[i].x; d[1] = v[i].y; d[2] = v[i].z; d[3] = v[i].w; }
    LDS_WAIT();
    const int c = lane & 7;
    const int drow0 = (I.mode == 0) ? n0 : ((n0 >> 7) * 256 + (n0 & 127) + (I.mode == 2 ? 128 : 0));
    if (I.f8s > 0.f) { const float sc = I.f8s; GAS unsigned char* W8 = (GAS unsigned char*)I.WT; const int c4 = lane & 3;
#pragma unroll
        for (int j = 0; j < 2; ++j) { const int n = (lane >> 2) + 16 * j; const LAS float* s = scr + (16 * c4) * 33 + n;
            v4u o; o.x = pk4_f8(s[0 * 33] * sc, s[1 * 33] * sc, s[2 * 33] * sc, s[3 * 33] * sc); o.y = pk4_f8(s[4 * 33] * sc, s[5 * 33] * sc, s[6 * 33] * sc, s[7 * 33] * sc);
            o.z = pk4_f8(s[8 * 33] * sc, s[9 * 33] * sc, s[10 * 33] * sc, s[11 * 33] * sc); o.w = pk4_f8(s[12 * 33] * sc, s[13 * 33] * sc, s[14 * 33] * sc, s[15 * 33] * sc);
            *(GAS v4u*)(W8 + (size_t)(drow0 + n) * I.K + k0 + 16 * c4) = o; }
    } else {
#pragma unroll
    for (int j = 0; j < 4; ++j) { const int n = (lane >> 3) + 8 * j; const LAS float* s = scr + (8 * c) * 33 + n;
        v4u o; o.x = pk2(s[0 * 33], s[1 * 33]); o.y = pk2(s[2 * 33], s[3 * 33]); o.z = pk2(s[4 * 33], s[5 * 33]); o.w = pk2(s[6 * 33], s[7 * 33]);
        *(GAS v4u*)(I.WT + (size_t)(drow0 + n) * I.K + k0 + 8 * c) = o; }
    }
    LDS_WAIT();
}
DI void convert_weights(int l, gcf w_in, gcf w_out, gcf f1, gcf f3, gcf f2, gcf m1, gcf m3, gcf m2,
                        gws ws, LAS unsigned char* lds, int wg, int G, int wave, int lane) {
    LAS float* scr = (LAS float*)(lds + wave * 16384);
    gb WIN = (GAS bf16*)(ws + WS_WIN); gb WOUT = (GAS bf16*)(ws + WS_WOUT); gb W13 = (GAS bf16*)(ws + WS_W13); gb W2 = (GAS bf16*)(ws + WS_W2);
    constexpr int n_in = 16 * 72, n_out = 16 * 32, n13 = 16 * 112, n2 = 56 * 32, per_e = 2 * n13 + n2;
    const int moe = l & 1, E = moe ? NE : 1, total = n_in + n_out + E * per_e, stride = G * NWAVES, f8 = IS_F8(l) ? 1 : 0;
#define CV_DECODE(it_, I_) do { int r = (it_); \
        if (r < n_in) { I_ = CvItem{w_in + (size_t)l * D * INW, WIN, D, INW, 0, r, IS_B8(l) ? F8_S13 : 0.f}; } \
        else if (r < n_in + n_out) { I_ = CvItem{w_out + (size_t)l * D * D, WOUT, D, D, 0, r - n_in, 0.f}; } \
        else { r -= n_in + n_out; const int e = r / per_e; r -= e * per_e; \
            const size_t mo = (size_t)((l >> 1) * (moe ? NE : 1) + e) * D * DFF; \
            const size_t o13 = ((size_t)e * 2 * DFF * D) >> f8, o2 = ((size_t)e * D * DFF) >> f8;     \
            if (r < n13) I_ = CvItem{(moe ? m1 : f1) + mo, W13 + o13, D, DFF, 1, r, f8 ? F8_S13 : 0.f}; \
            else if (r < 2 * n13) I_ = CvItem{(moe ? m3 : f3) + mo, W13 + o13, D, DFF, 2, r - n13, f8 ? F8_S13 : 0.f}; \
            else I_ = CvItem{(moe ? m2 : f2) + mo, W2 + o2, DFF, D, 0, r - 2 * n13, f8 ? F8_S2 : 0.f}; } } while (0)
    int it = wg * NWAVES + wave;
    if (it >= total) return;
    CvItem Ia, Ib; f32x4 va[8], vb[8];
    CV_DECODE(it, Ia); cv_load(Ia, lane, va);
    for (;;) {
        const bool hb = it + stride < total;
        if (hb) { CV_DECODE(it + stride, Ib); cv_load(Ib, lane, vb); }
        cv_store(Ia, scr, lane, va);
        if (!hb) break;
        it += stride;
        const bool ha = it + stride < total;
        if (ha) { CV_DECODE(it + stride, Ia); cv_load(Ia, lane, va); }
        cv_store(Ib, scr, lane, vb);
        if (!ha) break;
        it += stride;
    }
#undef CV_DECODE
}

template <bool COMBINE, bool ROUTER, bool FINAL, bool XF32, bool OUT8 = false>
DI void norm_phase(gcf xf, gb xb, gf outf, gcf gain, gcf shift, gcf scale, gcf gprev, gcb Y0, gcb Y1, gb XN,
                   gcf rw, gcf rb, gi toke, gf tokw, gi histw, gv2i pair, LAS unsigned char* lds, int wg, int G, int tid, int wave, int lane) {
    LAS float* RW = (LAS float*)lds;
    if (ROUTER) {
        for (int i = tid; i < 8192; i += NTHR) RW[i] = rw[i];
        { int m1 = -1, z0 = 0; asm volatile("" : "+v"(m1), "+v"(z0));
        for (int i = wg * NTHR + tid; i < MAXPAIR; i += G * NTHR) pair[i] = (v2i){m1, z0}; }
        __syncthreads();
    }
    for (int blk = wg; blk < M / 256; blk += G) {
        const int b = blk >> 5;
#define NCOL(j) (8 * lane + 512 * ((j) >> 1) + 4 * ((j) & 1))
        f32x4 gm[4], sh[4], gp[4];
#pragma unroll
        for (int j = 0; j < 4; ++j) { const int col = NCOL(j);
            if (FINAL) { gm[j] = ld4(gain + col); sh[j] = (f32x4){0.f, 0.f, 0.f, 0.f}; }
            else { gm[j] = ld4(gain + col) * (ld4(scale + (size_t)b * MODW + col) + 1.0f); sh[j] = ld4(shift + (size_t)b * MODW + col); }
            if (COMBINE) gp[j] = ld4(gprev + (size_t)b * MODW + col); else gp[j] = (f32x4){0.f, 0.f, 0.f, 0.f}; }
        int cnt[8];
#pragma unroll
        for (int e = 0; e < 8; ++e) cnt[e] = 0;
        constexpr int RG = (COMBINE || ROUTER) ? 1 : (XF32 ? 2 : 4);
        v4u xr[2][XF32 ? 1 : RG][2]; f32x4 xfr[2][XF32 ? RG : 1][4]; v4u ya[2][COMBINE ? RG : 1][2], yb[2][COMBINE ? RG : 1][2];
#define NL_LOAD(B, R0) \
        _Pragma("unroll") for (int q = 0; q < RG; ++q) \
        _Pragma("unroll") for (int s = 0; s < 2; ++s) { const size_t off = (size_t)(blk * 256 + wave * 32 + (R0) + q) * D + 8 * lane + 512 * s; \
            if (XF32) { xfr[B][q][2 * s] = ld4_nt(xf + off); xfr[B][q][2 * s + 1] = ld4_nt(xf + off + 4); } else xr[B][q][s] = *(GAS const v4u*)(xb + off); \
            if (COMBINE) { ya[B][q][s] = *(GAS const v4u*)(Y0 + off); yb[B][q][s] = *(GAS const v4u*)(Y1 + off); } }
        NL_LOAD(0, 0)
#pragma unroll 1
        for (int r00 = 0; r00 < 32; r00 += 2 * RG) {
#pragma unroll
          for (int hb = 0; hb < 2; ++hb) {
            const int r0 = r00 + hb * RG;
            if (hb == 0) { NL_LOAD(1, r0 + RG) } else if (r0 + RG < 32) { NL_LOAD(0, r0 + RG) }
#pragma unroll
            for (int q = 0; q < RG; ++q) {
            const int row = blk * 256 + wave * 32 + r0 + q;
            f32x4 v[4]; float ss = 0.f;
#pragma unroll
            for (int s = 0; s < 2; ++s) { const size_t off = (size_t)row * D + 8 * lane + 512 * s;
                if (XF32) { v[2 * s] = xfr[hb][q][2 * s]; v[2 * s + 1] = xfr[hb][q][2 * s + 1]; }
                else { float t8[8]; unpack8(xr[hb][q][s], t8); v[2 * s] = (f32x4){t8[0], t8[1], t8[2], t8[3]}; v[2 * s + 1] = (f32x4){t8[4], t8[5], t8[6], t8[7]}; }
                if (COMBINE) { float a8[8], b8[8]; unpack8(ya[hb][q][s], a8); unpack8(yb[hb][q][s], b8);
                    v[2 * s] += gp[2 * s] * ((f32x4){a8[0], a8[1], a8[2], a8[3]} + (f32x4){b8[0], b8[1], b8[2], b8[3]}); v[2 * s + 1] += gp[2 * s + 1] * ((f32x4){a8[4], a8[5], a8[6], a8[7]} + (f32x4){b8[4], b8[5], b8[6], b8[7]}); }
                if ((COMBINE && !FINAL) || XF32) { v4u o; o.x = pk2(v[2 * s].x, v[2 * s].y); o.y = pk2(v[2 * s].z, v[2 * s].w); o.z = pk2(v[2 * s + 1].x, v[2 * s + 1].y); o.w = pk2(v[2 * s + 1].z, v[2 * s + 1].w); *(GAS v4u*)(xb + off) = o; }
                ss += (v[2 * s].x * v[2 * s].x + v[2 * s].y * v[2 * s].y) + (v[2 * s].z * v[2 * s].z + v[2 * s].w * v[2 * s].w) + (v[2 * s + 1].x * v[2 * s + 1].x + v[2 * s + 1].y * v[2 * s + 1].y) + (v[2 * s + 1].z * v[2 * s + 1].z + v[2 * s + 1].w * v[2 * s + 1].w); }
            const float rstd = rsqrtf(wave_sum_dpp(ss) * (1.f / D) + EPS);
            f32x4 h[4];
#pragma unroll
            for (int j = 0; j < 4; ++j) h[j] = v[j] * rstd * gm[j] + sh[j];
#pragma unroll
            for (int s = 0; s < 2; ++s) { const size_t off = (size_t)row * D + 8 * lane + 512 * s;
                if (FINAL) { __builtin_nontemporal_store(h[2 * s], (GAS f32x4*)(outf + off)); __builtin_nontemporal_store(h[2 * s + 1], (GAS f32x4*)(outf + off + 4)); }
                else if (OUT8) {
                    if (s == 1) { v2u o0, o1; o0.x = pk4_f8(h[0].x, h[0].y, h[0].z, h[0].w); o0.y = pk4_f8(h[1].x, h[1].y, h[1].z, h[1].w); o1.x = pk4_f8(h[2].x, h[2].y, h[2].z, h[2].w); o1.y = pk4_f8(h[3].x, h[3].y, h[3].z, h[3].w);
                        const bool odd = lane & 1; const unsigned sx = odd ? o0.x : o1.x, sy = odd ? o0.y : o1.y;
                        const unsigned tx = (unsigned)__builtin_amdgcn_update_dpp(0, (int)sx, 0xB1, 0xf, 0xf, true), ty = (unsigned)__builtin_amdgcn_update_dpp(0, (int)sy, 0xB1, 0xf, 0xf, true);
                        v4u w; if (odd) { w.x = tx; w.y = ty; w.z = o1.x; w.w = o1.y; } else { w.x = o0.x; w.y = o0.y; w.z = tx; w.w = ty; }
                        *(GAS v4u*)((GAS unsigned char*)XN + (size_t)row * D + (odd ? 512 + 8 * (lane - 1) : 8 * lane)) = w; } }
                else { v4u o; o.x = pk2(h[2 * s].x, h[2 * s].y); o.y = pk2(h[2 * s].z, h[2 * s].w); o.z = pk2(h[2 * s + 1].x, h[2 * s + 1].y); o.w = pk2(h[2 * s + 1].z, h[2 * s + 1].w); *(GAS v4u*)(XN + off) = o; } }
            if (ROUTER) {
                float lg[8];
#pragma unroll
                for (int e = 0; e < 8; ++e) lg[e] = 0.f;
#pragma unroll
                for (int j = 0; j < 4; ++j)
#pragma unroll
                    for (int i = 0; i < 4; ++i) { const int cc = NCOL(j) + i; const f32x4 w0 = *(const LAS f32x4*)(RW + cc * 8), w1 = *(const LAS f32x4*)(RW + cc * 8 + 4); const float hv = h[j][i];
                        lg[0] += hv * w0.x; lg[1] += hv * w0.y; lg[2] += hv * w0.z; lg[3] += hv * w0.w; lg[4] += hv * w1.x; lg[5] += hv * w1.y; lg[6] += hv * w1.z; lg[7] += hv * w1.w; }
#pragma unroll
                for (int e = 0; e < 8; ++e) lg[e] = wave_sum_dpp(lg[e]) + rb[e];
                int i0 = 0; float v0 = lg[0];
#pragma unroll
                for (int e = 1; e < 8; ++e) if (lg[e] > v0) { v0 = lg[e]; i0 = e; }
                int i1 = -1; float v1 = -3.0e38f;
#pragma unroll
                for (int e = 0; e < 8; ++e) if (e != i0 && lg[e] > v1) { v1 = lg[e]; i1 = e; }
                const float w0 = 1.f / (1.f + expf(v1 - v0)), w1 = 1.f - w0;
                if (lane == 0) { toke[row] = i0 | (i1 << 8); tokw[2 * row] = w0; tokw[2 * row + 1] = w1; }
#pragma unroll
                for (int e = 0; e < 8; ++e) cnt[e] += (i0 == e) + (i1 == e);
            }
            }
          }
        }
#undef NL_LOAD
        if (ROUTER && lane == 0) {
#pragma unroll
            for (int e = 0; e < 8; ++e) histw[(blk * 8 + wave) * 8 + e] = cnt[e]; }
    }
#undef NCOL
}

DI void route_phase(gcb XN, gb XG, gci toke, gcf tokw, gci histw, gv2i pair, gi tilee, gi ntp,
                    LAS unsigned char* lds, int wg, int G, int tid, int wave, int lane, int f8) {
    LAS int* L = (LAS int*)lds;
    for (int blk = wg; blk < M / 256; blk += G) {
        int tot[8], pre[8];
#pragma unroll
        for (int e = 0; e < 8; ++e) { tot[e] = 0; pre[e] = 0; }
        for (int q = tid; q < 2048; q += NTHR) { const v4i h0 = *(GAS const v4i*)(histw + q * 8), h1 = *(GAS const v4i*)(histw + q * 8 + 4); const int m = (q < blk * 8) ? 1 : 0;
            tot[0] += h0.x; tot[1] += h0.y; tot[2] += h0.z; tot[3] += h0.w; tot[4] += h1.x; tot[5] += h1.y; tot[6] += h1.z; tot[7] += h1.w;
            pre[0] += m * h0.x; pre[1] += m * h0.y; pre[2] += m * h0.z; pre[3] += m * h0.w; pre[4] += m * h1.x; pre[5] += m * h1.y; pre[6] += m * h1.z; pre[7] += m * h1.w; }
#pragma unroll
        for (int e = 0; e < 8; ++e) { tot[e] = wave_sum_i(tot[e]); pre[e] = wave_sum_i(pre[e]); }
        if (lane == 0) {
#pragma unroll
            for (int e = 0; e < 8; ++e) { L[wave * 16 + e] = tot[e]; L[wave * 16 + 8 + e] = pre[e]; } }
        __syncthreads();
        int start[9]; start[0] = 0;
#pragma unroll
        for (int e = 0; e < 8; ++e) { int t = 0, p = 0;
#pragma unroll
            for (int w = 0; w < 8; ++w) { t += L[w * 16 + e]; p += L[w * 16 + 8 + e]; }
            tot[e] = t; pre[e] = p; start[e + 1] = start[e] + ((t + 255) & ~255); }
        int e0 = -1, e1 = -1; const int tok = blk * 256 + tid;
        if (tid < 256) { const int te = toke[tok]; e0 = te & 255; e1 = te >> 8; }
        const unsigned long long lt = (1ull << lane) - 1ull;
        int r0 = 0, r1 = 0;
#pragma unroll
        for (int e = 0; e < 8; ++e) { const unsigned long long m0 = __ballot(e0 == e), m1 = __ballot(e1 == e);
            const int rr = __popcll(m0 & lt) + __popcll(m1 & lt);
            if (e0 == e) r0 = rr; if (e1 == e) r1 = rr;
            if (lane == 0) L[128 + wave * 8 + e] = __popcll(m0) + __popcll(m1);
            if (tid == 0) L[192 + e] = start[e] + pre[e]; }
        __syncthreads();
        if (tid < 256) {
            int p0 = L[192 + e0] + r0, p1 = L[192 + e1] + r1;
            for (int w = 0; w < wave; ++w) { p0 += L[128 + w * 8 + e0]; p1 += L[128 + w * 8 + e1]; }
            const f32x2 wv = *(GAS const f32x2*)(tokw + 2 * tok);
            pair[p0] = (v2i){tok, __builtin_bit_cast(int, wv.x)}; pair[p1] = (v2i){tok | (1 << 30), __builtin_bit_cast(int, wv.y)};
            L[256 + 2 * tid] = p0; L[256 + 2 * tid + 1] = p1;
        }
        __syncthreads();
        if (f8 && MOE_XN8) {
            const GAS unsigned char* S8 = (const GAS unsigned char*)XN; GAS unsigned char* X8 = (GAS unsigned char*)XG;
            for (int i0 = 0; i0 < 32; i0 += 8) {
                v4u ra[8]; int pp0[8], pp1[8];
#pragma unroll
                for (int q = 0; q < 8; ++q) { const int tl = wave * 32 + i0 + q; pp0[q] = L[256 + 2 * tl]; pp1[q] = L[256 + 2 * tl + 1]; ra[q] = *(GAS const v4u*)(S8 + (size_t)(blk * 256 + tl) * D + lane * 16); }
#pragma unroll
                for (int q = 0; q < 8; ++q) { *(GAS v4u*)(X8 + (size_t)pp0[q] * D + lane * 16) = ra[q]; *(GAS v4u*)(X8 + (size_t)pp1[q] * D + lane * 16) = ra[q]; } }
        } else
        for (int i0 = 0; i0 < 32; i0 += 4) {
            v4u ra[4], rb2[4]; int pp0[4], pp1[4];
#pragma unroll
            for (int q = 0; q < 4; ++q) { const int tl = wave * 32 + i0 + q; pp0[q] = L[256 + 2 * tl]; pp1[q] = L[256 + 2 * tl + 1];
                gcb srcp = XN + (size_t)(blk * 256 + tl) * D + lane * 16; ra[q] = *(GAS const v4u*)srcp; rb2[q] = *(GAS const v4u*)(srcp + 8); }
            if (f8) { GAS unsigned char* X8 = (GAS unsigned char*)XG;
#pragma unroll
                for (int q = 0; q < 4; ++q) { float xa[8], xb2[8]; unpack8(ra[q], xa); unpack8(rb2[q], xb2);
                    v4u o; o.x = pk4_f8(xa[0], xa[1], xa[2], xa[3]); o.y = pk4_f8(xa[4], xa[5], xa[6], xa[7]); o.z = pk4_f8(xb2[0], xb2[1], xb2[2], xb2[3]); o.w = pk4_f8(xb2[4], xb2[5], xb2[6], xb2[7]);
                    *(GAS v4u*)(X8 + (size_t)pp0[q] * D + lane * 16) = o; *(GAS v4u*)(X8 + (size_t)pp1[q] * D + lane * 16) = o; }
            } else {
#pragma unroll
            for (int q = 0; q < 4; ++q) { gb d0 = XG + (size_t)pp0[q] * D + lane * 16; gb d1 = XG + (size_t)pp1[q] * D + lane * 16;
                *(GAS v4u*)d0 = ra[q]; *(GAS v4u*)(d0 + 8) = rb2[q]; *(GAS v4u*)d1 = ra[q]; *(GAS v4u*)(d1 + 8) = rb2[q]; } } }
        if (blk == 0) { const int ntt = start[8] >> 8;
            for (int t = tid; t < ntt; t += NTHR) { int e = 0;
#pragma unroll
                for (int q = 1; q < 8; ++q) e += (t >= (start[q] >> 8)) ? 1 : 0;
                tilee[t] = e; }
            if (tid == 0) ntp[0] = ntt; }
        __syncthreads();
    }
}

DI void pool_unit(gcb PROJ, gb CAT, gcb WT, gcf pscale, gcf pnorm, LAS unsigned char* lds, int b, int t0, int tid, int wave, int lane) {
    asm volatile("" : "+v"(tid)); lane = tid & 63;
    LAS bf16* XT = (LAS bf16*)lds;
    LAS bf16* DT = (LAS bf16*)(lds + 80 * 264 * 2);
    LAS float* SSP = (LAS float*)(lds + (80 + 64) * 264 * 2);
    const int fr = lane & 15, fq = lane >> 4, tbh = wave & 3, gp = wave >> 2;
    bf16x8 Wf[2][2][4];
#pragma unroll
    for (int gl = 0; gl < 2; ++gl)
#pragma unroll
        for (int kk = 0; kk < 2; ++kk)
#pragma unroll
            for (int nb = 0; nb < 4; ++nb) Wf[gl][kk][nb] = *(GAS const bf16x8*)(WT + (((2 * gp + gl) * 64 + nb * 16 + fr) * 64 + kk * 32 + 8 * fq));
    for (int half = 0; half < 2; ++half) {
        const int t0h = t0 + 64 * half;
        __syncthreads();
        { v4u xr[5];
#pragma unroll
            for (int i = 0; i < 5; ++i) { const int cidx = tid + NTHR * i, row = cidx >> 5, cg = cidx & 31, tt = t0h - 16 + row, ttc = tt < 0 ? 0 : tt;
                xr[i] = *(GAS const v4u*)(PROJ + ((size_t)b * SEQ + ttc) * INW + cg * 8); }
#pragma unroll
            for (int i = 0; i < 5; ++i) { const int cidx = tid + NTHR * i, row = cidx >> 5, cg = cidx & 31, tt = t0h - 16 + row;
                *(LAS v4u*)(XT + row * 264 + cg * 8) = (tt < 0) ? (v4u){0u, 0u, 0u, 0u} : xr[i]; } }
        __syncthreads();
        { const int cg = tid & 31, run = tid >> 5, ch0 = cg * 8, win = 2 << (cg >> 3), tl0 = run * 4;
            float s[8];
#pragma unroll
            for (int k = 0; k < 8; ++k) s[k] = 0.f;
            for (int r = 1; r <= win; ++r) { float xv[8]; unpack8(*(const LAS v4u*)(XT + (tl0 + 16 - r) * 264 + ch0), xv);
#pragma unroll
                for (int k = 0; k < 8; ++k) s[k] += xv[k]; }
#pragma unroll
            for (int i = 0; i < 4; ++i) { float xv[8], yv[8]; unpack8(*(const LAS v4u*)(XT + (tl0 + i + 16) * 264 + ch0), xv); unpack8(*(const LAS v4u*)(XT + (tl0 + i + 16 - win) * 264 + ch0), yv);
                const int tt = t0h + tl0 + i; const float inv = 1.f / (float)((tt + 1 < win) ? tt + 1 : win);
#pragma unroll
                for (int k = 0; k < 8; ++k) s[k] += xv[k] - yv[k];
                v4u o; o.x = pk2(s[0] * inv - xv[0], s[1] * inv - xv[1]); o.y = pk2(s[2] * inv - xv[2], s[3] * inv - xv[3]); o.z = pk2(s[4] * inv - xv[4], s[5] * inv - xv[5]); o.w = pk2(s[6] * inv - xv[6], s[7] * inv - xv[7]);
                *(LAS v4u*)(DT + (tl0 + i) * 264 + ch0) = o; } }
        __syncthreads();
        f32x4 acc[2][4];
#pragma unroll
        for (int gl = 0; gl < 2; ++gl)
#pragma unroll
            for (int nb = 0; nb < 4; ++nb) acc[gl][nb] = (f32x4){0.f, 0.f, 0.f, 0.f};
#pragma unroll
        for (int gl = 0; gl < 2; ++gl)
#pragma unroll
            for (int kk = 0; kk < 2; ++kk) { const bf16x8 X = *(const LAS bf16x8*)(DT + (16 * tbh + fr) * 264 + (2 * gp + gl) * 64 + kk * 32 + 8 * fq);
#pragma unroll
                for (int nb = 0; nb < 4; ++nb) acc[gl][nb] = mfma16(Wf[gl][kk][nb], X, acc[gl][nb]); }
        float ss = 0.f;
#pragma unroll
        for (int gl = 0; gl < 2; ++gl)
#pragma unroll
            for (int nb = 0; nb < 4; ++nb) { const f32x4 y = acc[gl][nb] * ld4(pscale + (2 * gp + gl) * 64 + nb * 16 + 4 * fq); acc[gl][nb] = y; ss += (y.x * y.x + y.y * y.y) + (y.z * y.z + y.w * y.w); }
        ss += __shfl_xor(ss, 16); ss += __shfl_xor(ss, 32);
        if (fq == 0) SSP[gp * 64 + 16 * tbh + fr] = ss;
        __syncthreads();
        const float rstd = rsqrtf((SSP[16 * tbh + fr] + SSP[64 + 16 * tbh + fr]) * (1.f / GWD) + EPS);
        const size_t row = (size_t)b * SEQ + t0h + 16 * tbh + fr;
#pragma unroll
        for (int gl = 0; gl < 2; ++gl)
#pragma unroll
            for (int nb = 0; nb < 4; ++nb) { const int ch = (2 * gp + gl) * 64 + nb * 16 + 4 * fq; *(GAS v2u*)(CAT + row * D + ch) = pack4(acc[gl][nb] * rstd * ld4(pnorm + ch)); }
    }
}

DI void sgu_unit(gcb PROJ, gb CAT, gcb SW, gcf sbias, gcf snorm, LAS unsigned char* lds, int b, int t0, int tid, int wave, int lane) {
    asm volatile("" : "+v"(tid)); lane = tid & 63;
    __syncthreads();
    LAS bf16* VT = (LAS bf16*)lds;
    const int fr = lane & 15, fq = lane >> 4, tb = wave, nk = (tb >> 1) + 1;
    { v2u vr[16];
#pragma unroll
        for (int i = 0; i < 16; ++i) vr[i] = *(GAS const v2u*)(PROJ + ((size_t)b * SEQ + t0 + 16 * wave + i) * INW + 512 + 4 * lane);
#pragma unroll
        for (int i = 0; i < 8; ++i) { const int tl = 16 * wave + 2 * i;
            f32x4 va = unpack4(vr[2 * i]), vb = unpack4(vr[2 * i + 1]);
            va.x = gelu_t(va.x); va.y = gelu_t(va.y); va.z = gelu_t(va.z); va.w = gelu_t(va.w); vb.x = gelu_t(vb.x); vb.y = gelu_t(vb.y); vb.z = gelu_t(vb.z); vb.w = gelu_t(vb.w);
            const float mua = wave_sum_dpp((va.x + va.y) + (va.z + va.w)) * (1.f / GWD), mub = wave_sum_dpp((vb.x + vb.y) + (vb.z + vb.w)) * (1.f / GWD);
            va = va - mua; vb = vb - mub;
            const float vra = wave_sum_dpp((va.x * va.x + va.y * va.y) + (va.z * va.z + va.w * va.w)) * (1.f / GWD), vrb = wave_sum_dpp((vb.x * vb.x + vb.y * vb.y) + (vb.z * vb.z + vb.w * vb.w)) * (1.f / GWD);
            va = va * rsqrtf(vra + EPS); vb = vb * rsqrtf(vrb + EPS);
            *(LAS unsigned*)(VT + (4 * lane + 0) * 136 + tl) = pk2(va.x, vb.x); *(LAS unsigned*)(VT + (4 * lane + 1) * 136 + tl) = pk2(va.y, vb.y);
            *(LAS unsigned*)(VT + (4 * lane + 2) * 136 + tl) = pk2(va.z, vb.z); *(LAS unsigned*)(VT + (4 * lane + 3) * 136 + tl) = pk2(va.w, vb.w); } }
    const int tl = 16 * tb + fr; const size_t row = (size_t)b * SEQ + t0 + tl;
    v2u ur[4][4]; float bias4[4];
#pragma unroll
    for (int h = 0; h < 4; ++h) { bias4[h] = sbias[h * 128 + tl];
#pragma unroll
        for (int db = 0; db < 4; ++db) ur[h][db] = *(GAS const v2u*)(PROJ + row * INW + 256 + h * 64 + db * 16 + 4 * fq); }
    __syncthreads();
    f32x4 acc[4][4];
#pragma unroll
    for (int h = 0; h < 4; ++h)
#pragma unroll
        for (int db = 0; db < 4; ++db) acc[h][db] = (f32x4){0.f, 0.f, 0.f, 0.f};
    for (int kk = 0; kk < nk; ++kk) {
        bf16x8 Q[4];
#pragma unroll
        for (int h = 0; h < 4; ++h) Q[h] = *(GAS const bf16x8*)(SW + ((h * 128 + 16 * tb + fr) * 128 + kk * 32 + 8 * fq));
#pragma unroll
        for (int h = 0; h < 4; ++h)
#pragma unroll
            for (int db = 0; db < 4; ++db) { const bf16x8 P = *(const LAS bf16x8*)(VT + (h * 64 + db * 16 + fr) * 136 + kk * 32 + 8 * fq); acc[h][db] = mfma16(P, Q[h], acc[h][db]); } }
    float ss = 0.f;
#pragma unroll
    for (int h = 0; h < 4; ++h)
#pragma unroll
        for (int db = 0; db < 4; ++db) { f32x4 u = unpack4(ur[h][db]);
            u.x = gelu_t(u.x); u.y = gelu_t(u.y); u.z = gelu_t(u.z); u.w = gelu_t(u.w);
            const f32x4 y = u * (acc[h][db] + bias4[h]); acc[h][db] = y; ss += (y.x * y.x + y.y * y.y) + (y.z * y.z + y.w * y.w); }
    ss += __shfl_xor(ss, 16); ss += __shfl_xor(ss, 32);
    const float rstd = rsqrtf(ss * (1.f / GWD) + EPS);
#pragma unroll
    for (int h = 0; h < 4; ++h)
#pragma unroll
        for (int db = 0; db < 4; ++db) { const int ch = h * 64 + db * 16 + 4 * fq; *(GAS v2u*)(CAT + row * D + 256 + ch) = pack4(acc[h][db] * rstd * ld4(snorm + ch)); }
}

template <int D_> DI float row_shr(float ident, float src) {
    return __builtin_bit_cast(float, __builtin_amdgcn_update_dpp(__builtin_bit_cast(int, ident), __builtin_bit_cast(int, src), 0x110 + D_, 0xf, 0xf, false));
}
#define LRU_STEP_(D) \
    "v_fmac_f32_dpp %0, %0, %8 row_shr:" #D " row_mask:0xf bank_mask:0xf\n\tv_fmac_f32_dpp %1, %1, %9 row_shr:" #D " row_mask:0xf bank_mask:0xf\n\t" \
    "v_fmac_f32_dpp %2, %2, %10 row_shr:" #D " row_mask:0xf bank_mask:0xf\n\tv_fmac_f32_dpp %3, %3, %11 row_shr:" #D " row_mask:0xf bank_mask:0xf\n\t" \
    "v_fmac_f32_dpp %4, %4, %12 row_shr:" #D " row_mask:0xf bank_mask:0xf\n\tv_fmac_f32_dpp %5, %5, %13 row_shr:" #D " row_mask:0xf bank_mask:0xf\n\t" \
    "v_fmac_f32_dpp %6, %6, %14 row_shr:" #D " row_mask:0xf bank_mask:0xf\n\tv_fmac_f32_dpp %7, %7, %15 row_shr:" #D " row_mask:0xf bank_mask:0xf\n\t" \
    "v_mul_f32_dpp %8, %8, %8 row_shr:" #D " row_mask:0xf bank_mask:0xf\n\tv_mul_f32_dpp %9, %9, %9 row_shr:" #D " row_mask:0xf bank_mask:0xf\n\t" \
    "v_mul_f32_dpp %10, %10, %10 row_shr:" #D " row_mask:0xf bank_mask:0xf\n\tv_mul_f32_dpp %11, %11, %11 row_shr:" #D " row_mask:0xf bank_mask:0xf\n\t" \
    "v_mul_f32_dpp %12, %12, %12 row_shr:" #D " row_mask:0xf bank_mask:0xf\n\tv_mul_f32_dpp %13, %13, %13 row_shr:" #D " row_mask:0xf bank_mask:0xf\n\t" \
    "v_mul_f32_dpp %14, %14, %14 row_shr:" #D " row_mask:0xf bank_mask:0xf\n\tv_mul_f32_dpp %15, %15, %15 row_shr:" #D " row_mask:0xf bank_mask:0xf\n\t"
#define LRU_SCAN8(bv, av) asm("s_nop 1\n\t" LRU_STEP_(1) LRU_STEP_(2) LRU_STEP_(4) LRU_STEP_(8) \
    : "+v"(bv[0][0]), "+v"(bv[0][1]), "+v"(bv[0][2]), "+v"(bv[0][3]), "+v"(bv[1][0]), "+v"(bv[1][1]), "+v"(bv[1][2]), "+v"(bv[1][3]), \
      "+v"(av[0][0]), "+v"(av[0][1]), "+v"(av[0][2]), "+v"(av[0][3]), "+v"(av[1][0]), "+v"(av[1][1]), "+v"(av[1][2]), "+v"(av[1][3]))
DI float row_bcast15(float v) { return __builtin_bit_cast(float, __builtin_amdgcn_update_dpp(0, __builtin_bit_cast(int, v), 0x15F, 0xf, 0xf, true)); }
DI void lru_local_unit(gcb PROJ, gcf convw, gcf convb, gcf lba, gcf lbx, gcf lam, gcb WAT, gcb WXT, gf AGG, GAS unsigned* LAB, LAS unsigned char* lds, int b, int chunk, int tid, int wave, int lane) {
    asm volatile("" : "+v"(tid)); lane = tid & 63;
    __syncthreads();
    LAS bf16* TILE = (LAS bf16*)lds;
    const int t0 = chunk * CH;
    {
        const int cg = tid & 31, ch0 = cg * 8;
        f32x4 cw[4][2], cb[2];
#pragma unroll
        for (int k = 0; k < 4; ++k) { cw[k][0] = ld4(convw + k * GWD + ch0); cw[k][1] = ld4(convw + k * GWD + ch0 + 4); }
        cb[0] = ld4(convb + ch0); cb[1] = ld4(convb + ch0 + 4);
#pragma unroll
        for (int hb2 = 0; hb2 < 2; ++hb2) {
            v4u xr[4][4];
#pragma unroll
            for (int i = 0; i < 4; ++i) { const int tl = (tid >> 5) + 16 * (hb2 * 4 + i);
#pragma unroll
                for (int k = 0; k < 4; ++k) { const int tt = t0 + tl - 3 + k, ttc = tt < 0 ? 0 : tt; xr[i][k] = *(GAS const v4u*)(PROJ + ((size_t)b * SEQ + ttc) * INW + 768 + ch0); } }
#pragma unroll
            for (int i = 0; i < 4; ++i) { const int tl = (tid >> 5) + 16 * (hb2 * 4 + i);
                f32x4 x0 = cb[0], x1 = cb[1];
#pragma unroll
                for (int k = 0; k < 4; ++k) { const float m = (t0 + tl - 3 + k >= 0) ? 1.f : 0.f; float xv[8]; unpack8(xr[i][k], xv);
                    x0 += cw[k][0] * ((f32x4){xv[0], xv[1], xv[2], xv[3]} * m); x1 += cw[k][1] * ((f32x4){xv[4], xv[5], xv[6], xv[7]} * m); }
                v4u o; o.x = pk2(x0.x, x0.y); o.y = pk2(x0.z, x0.w); o.z = pk2(x1.x, x1.y); o.w = pk2(x1.z, x1.w);
                *(LAS v4u*)(TILE + tl * 264 + ch0) = o; }
        }
    }
    const int hb = wave & 3, nh = wave >> 2, fr = lane & 15, fq = lane >> 4;
    bf16x8 WA[2][2], WX[2][2];
#pragma unroll
    for (int kk = 0; kk < 2; ++kk)
#pragma unroll
        for (int nbl = 0; nbl < 2; ++nbl) { const int o = (hb * 64 + (2 * nh + nbl) * 16 + fr) * 64 + kk * 32 + 8 * fq; WA[kk][nbl] = *(GAS const bf16x8*)(WAT + o); WX[kk][nbl] = *(GAS const bf16x8*)(WXT + o); }
    f32x4 ba4[2], bx4[2], ls4[2], hc[2], ac[2];
#pragma unroll
    for (int nbl = 0; nbl < 2; ++nbl) { const int ch = hb * 64 + (2 * nh + nbl) * 16 + 4 * fq; ba4[nbl] = ld4(lba + ch); bx4[nbl] = ld4(lbx + ch);
        const f32x4 lm = ld4(lam + ch);
#pragma unroll
        for (int j = 0; j < 4; ++j) ls4[nbl][j] = -8.0f * log1pf(expf(-lm[j]));
        hc[nbl] = (f32x4){0.f, 0.f, 0.f, 0.f}; ac[nbl] = (f32x4){0.f, 0.f, 0.f, 0.f}; }
    __syncthreads();
#pragma unroll 1
    for (int tb = 0; tb < 8; ++tb) {
        const int tl = 16 * tb + fr; const size_t row = (size_t)b * SEQ + t0 + tl;
        bf16x8 X[2];
#pragma unroll
        for (int kk = 0; kk < 2; ++kk) X[kk] = *(const LAS bf16x8*)(TILE + tl * 264 + hb * 64 + kk * 32 + 8 * fq);
        float av[2][4], bv[2][4];
#pragma unroll
        for (int nbl = 0; nbl < 2; ++nbl) {
            f32x4 ra = (f32x4){0.f, 0.f, 0.f, 0.f}, rx = (f32x4){0.f, 0.f, 0.f, 0.f};
#pragma unroll
            for (int kk = 0; kk < 2; ++kk) { ra = mfma16(WA[kk][nbl], X[kk], ra); rx = mfma16(WX[kk][nbl], X[kk], rx); }
            const int ch = hb * 64 + (2 * nh + nbl) * 16 + 4 * fq;
            const f32x4 xcv = unpack4(*(const LAS v2u*)(TILE + tl * 264 + ch));
            v4u lab;
#pragma unroll
            for (int j = 0; j < 4; ++j) {
                const float e1 = __expf(-(ra[j] + ba4[nbl][j])), e2 = __expf(-(rx[j] + bx4[nbl][j]));
                const float rp = __builtin_amdgcn_rcpf((1.f + e1) * (1.f + e2)), r = (1.f + e2) * rp, ii = (1.f + e1) * rp;
                const float la = __builtin_bit_cast(float, pk2(r * ls4[nbl][j], 0.f) << 16);
                const float a = __expf(la), x2 = la + la;
                const float p = -x2 * (1.f + x2 * (0.5f + x2 * (0.16666667f + x2 * (0.041666668f + x2 * 0.0083333338f))));
                const float om = fmaxf((la > -0.0625f) ? p : __builtin_fmaf(-a, a, 1.f), 0.f);
                const float bb = __builtin_amdgcn_sqrtf(om) * ii * xcv[j];
                const unsigned pr = pk2(la, bb);
                lab[j] = pr;
                av[nbl][j] = a; bv[nbl][j] = __builtin_bit_cast(float, pr & 0xffff0000u);
                ac[nbl][j] += la;
            }
            *(GAS v4u*)(LAB + row * GWD + ch) = lab;
        }
        LRU_SCAN8(bv, av);
#pragma unroll
        for (int nbl = 0; nbl < 2; ++nbl)
#pragma unroll
            for (int j = 0; j < 4; ++j) hc[nbl][j] = row_bcast15(av[nbl][j] * hc[nbl][j] + bv[nbl][j]);
    }
#pragma unroll
    for (int nbl = 0; nbl < 2; ++nbl)
#pragma unroll
        for (int j = 0; j < 4; ++j) { float t = ac[nbl][j]; t += row_shr<1>(0.f, t); t += row_shr<2>(0.f, t); t += row_shr<4>(0.f, t); t += row_shr<8>(0.f, t); ac[nbl][j] = __expf(row_bcast15(t)); }
    if (fr == 0) {
#pragma unroll
        for (int nbl = 0; nbl < 2; ++nbl) { const int ch = hb * 64 + (2 * nh + nbl) * 16 + 4 * fq; gf ap = AGG + ((size_t)(b * NCH + chunk) * GWD + ch) * 2;
            *(GAS f32x4*)ap = (f32x4){ac[nbl][0], hc[nbl][0], ac[nbl][1], hc[nbl][1]}; *(GAS f32x4*)(ap + 4) = (f32x4){ac[nbl][2], hc[nbl][2], ac[nbl][3], hc[nbl][3]}; }
    }
}
DI void lru_out_unit(gcb PROJ, gb CAT, gcf lnorm, gcf H0, const GAS unsigned* LAB, LAS unsigned char* lds, int b, int chunk, int tid, int wave, int lane) {
    asm volatile("" : "+v"(tid)); lane = tid & 63;
    LAS float* SS = (LAS float*)lds;
    const int t0 = chunk * CH, hb = wave & 3, nh = wave >> 2, fr = lane & 15, fq = lane >> 4;
    v4u lab[8][2]; v2u gt[8][2];
#pragma unroll
    for (int tb = 0; tb < 8; ++tb)
#pragma unroll
        for (int nbl = 0; nbl < 2; ++nbl) { const size_t row = (size_t)b * SEQ + t0 + 16 * tb + fr; const int ch = hb * 64 + (2 * nh + nbl) * 16 + 4 * fq;
            lab[tb][nbl] = *(GAS const v4u*)(LAB + row * GWD + ch); gt[tb][nbl] = *(GAS const v2u*)(PROJ + row * INW + 1024 + ch); }
    f32x4 hc[2];
#pragma unroll
    for (int nbl = 0; nbl < 2; ++nbl) hc[nbl] = ld4(H0 + ((size_t)(b * NCH + chunk) * GWD + hb * 64 + (2 * nh + nbl) * 16 + 4 * fq));
    v2u yk[8][2];
    __syncthreads();
#pragma unroll
    for (int tb = 0; tb < 8; ++tb) {
        float ssq = 0.f;
        float av[2][4], bv[2][4];
#pragma unroll
        for (int nbl = 0; nbl < 2; ++nbl)
#pragma unroll
            for (int j = 0; j < 4; ++j) { const unsigned pr = lab[tb][nbl][j]; av[nbl][j] = __expf(__builtin_bit_cast(float, pr << 16)); bv[nbl][j] = __builtin_bit_cast(float, pr & 0xffff0000u); }
        LRU_SCAN8(bv, av);
#pragma unroll
        for (int nbl = 0; nbl < 2; ++nbl) { const f32x4 gt4 = unpack4(gt[tb][nbl]); f32x4 yv;
#pragma unroll
            for (int j = 0; j < 4; ++j) { const float h = av[nbl][j] * hc[nbl][j] + bv[nbl][j];
                hc[nbl][j] = row_bcast15(h);
                const float y = gelu_t(gt4[j]) * h; yv[j] = y; ssq += y * y; }
            yk[tb][nbl] = pack4(yv); }
        ssq += __shfl_xor(ssq, 16); ssq += __shfl_xor(ssq, 32); if (fq == 0) SS[wave * 128 + 16 * tb + fr] = ssq;
    }
    __syncthreads();
#pragma unroll
    for (int tb = 0; tb < 8; ++tb) { const int tl = 16 * tb + fr; const size_t row = (size_t)b * SEQ + t0 + tl; float tot = 0.f;
#pragma unroll
        for (int w = 0; w < 8; ++w) tot += SS[w * 128 + tl];
        const float rstd = rsqrtf(tot * (1.f / GWD) + EPS);
#pragma unroll
        for (int nbl = 0; nbl < 2; ++nbl) { const int ch = hb * 64 + (2 * nh + nbl) * 16 + 4 * fq; *(GAS v2u*)(CAT + row * D + 512 + ch) = pack4(unpack4(yk[tb][nbl]) * rstd * ld4(lnorm + ch)); } }
}

DI f32x4 mfma_p2(const v2u a0, const v2u a1, const v2u b0, const v2u b1, const f32x4 c) {
    v4u A, B; A.x = a0.x; A.y = a0.y; A.z = a1.x; A.w = a1.y; B.x = b0.x; B.y = b0.y; B.z = b1.x; B.w = b1.y;
    return __builtin_amdgcn_mfma_f32_16x16x32_bf16(__builtin_bit_cast(bf16x8, A), __builtin_bit_cast(bf16x8, B), c, 0, 0, 0);
}
template <bool OUT>
DI void hgrn_wave_unit(gcb PROJ, gb CAT, gcf LBl, gcf normg, gf ST, gf DEC, LAS float* wlf, int u, int lane) {
    asm volatile("" : "+v"(lane));
    const int hh = u & 3, c = (u >> 2) & (NCH - 1), b = u >> 8, fr = lane & 15, fq = lane >> 4;
    LAS bf16* QT = (LAS bf16*)wlf;
    LAS bf16* KT = QT + 16 * 72;
    LAS bf16* KH = KT + 16 * 72;
    LAS bf16* VT = KH + 64 * 20;
    LAS float* DC = (LAS float*)(VT + 64 * 20);
    const float lbv = LBl[hh * 64 + lane], oml = 1.f - lbv;
    gf stp = ST + ((size_t)((b * NCH + c) * 4 + hh)) * 4096;
    f32x4 S[4][4];
#pragma unroll
    for (int mi = 0; mi < 4; ++mi)
#pragma unroll
        for (int ni = 0; ni < 4; ++ni) S[mi][ni] = OUT ? *(GAS const f32x4*)(stp + ((mi * 4 + ni) * 64 + lane) * 4) : (f32x4){0.f, 0.f, 0.f, 0.f};
    float Dtot = 1.f;
    f32x4 ng4[4];
#pragma unroll
    for (int nv = 0; nv < 4; ++nv) ng4[nv] = OUT ? ld4(normg + hh * 64 + 16 * nv + 4 * fq) : (f32x4){0.f, 0.f, 0.f, 0.f};
    bf16 zr[16], vr[16], qr[16]; v2u gr[4];
#define HG_LOAD(sbn) do { const size_t r0_ = (size_t)b * SEQ + c * CH + (sbn) * 16; \
        _Pragma("unroll") for (int t = 0; t < 16; ++t) { gcb p = PROJ + (r0_ + t) * INW + hh * 64 + lane; zr[t] = p[1536]; vr[t] = p[1792]; if (OUT) qr[t] = p[1280]; else qr[t] = 0; } \
        _Pragma("unroll") for (int nv = 0; nv < 4; ++nv) { if (OUT) gr[nv] = *(GAS const v2u*)(PROJ + (r0_ + fr) * INW + 2048 + hh * 64 + 16 * nv + 4 * fq); else gr[nv] = (v2u){0u, 0u}; } } while (0)
    HG_LOAD(0);
    for (int sb = 0; sb < CH / 16; ++sb) {
        const size_t row0 = (size_t)b * SEQ + c * CH + sb * 16;
        float kk[16], Bt[16]; float Bc = 0.f;
#pragma unroll
        for (int t = 0; t < 16; ++t) {
            const float z = fminf(fmaxf(bf2f(zr[t]), -30.f), 30.f), ez = __expf(-z), sg = __builtin_amdgcn_rcpf(1.f + ez);
            const float f = fmaxf(lbv + oml * sg, 1e-30f);
            Bc += __logf(f); Bt[t] = Bc; kk[t] = oml * ez * sg;
            VT[lane * 20 + t] = vr[t];
            if (OUT) { const float q = siluf(bf2f(qr[t])); QT[t * 72 + lane] = f2bf(q * __expf(Bc)); KT[t * 72 + lane] = f2bf(kk[t] * __expf(fminf(-Bc, 60.f))); } }
#pragma unroll
        for (int t = 0; t < 16; ++t) KH[lane * 20 + t] = f2bf(kk[t] * __expf(Bc - Bt[t]));
        { const float dsub = __expf(Bc); DC[lane] = dsub; Dtot *= dsub; }
        v2u gcur[4];
#pragma unroll
        for (int nv = 0; nv < 4; ++nv) gcur[nv] = gr[nv];
        if (sb + 1 < CH / 16) HG_LOAD(sb + 1);
        LDS_WAIT();
        v2u vt[4]; const v2u zz = (v2u){0u, 0u};
#pragma unroll
        for (int nv = 0; nv < 4; ++nv) vt[nv] = *(const LAS v2u*)(VT + (16 * nv + fr) * 20 + 4 * fq);
        if (OUT) {
            f32x4 O[4], SC = (f32x4){0.f, 0.f, 0.f, 0.f};
            v2u qf[4], kf[4];
#pragma unroll
            for (int s = 0; s < 4; ++s) { qf[s] = *(const LAS v2u*)(QT + fr * 72 + 16 * s + 4 * fq); kf[s] = *(const LAS v2u*)(KT + fr * 72 + 16 * s + 4 * fq); }
            SC = mfma_p2(kf[0], kf[1], qf[0], qf[1], SC); SC = mfma_p2(kf[2], kf[3], qf[2], qf[3], SC);
#pragma unroll
            for (int nv = 0; nv < 4; ++nv) { O[nv] = (f32x4){0.f, 0.f, 0.f, 0.f};
                O[nv] = mfma_p2(pack4(S[nv][0]), pack4(S[nv][1]), qf[0], qf[1], O[nv]); O[nv] = mfma_p2(pack4(S[nv][2]), pack4(S[nv][3]), qf[2], qf[3], O[nv]); }
#pragma unroll
            for (int r = 0; r < 4; ++r) if (4 * fq + r > fr) SC[r] = 0.f;
            const v2u scp = pack4(SC);
            float ss = 0.f;
#pragma unroll
            for (int nv = 0; nv < 4; ++nv) { O[nv] = mfma_p2(vt[nv], zz, scp, zz, O[nv]); ss += (O[nv].x * O[nv].x + O[nv].y * O[nv].y) + (O[nv].z * O[nv].z + O[nv].w * O[nv].w); }
            ss += __shfl_xor(ss, 16); ss += __shfl_xor(ss, 32);
            const float rstd = rsqrtf(ss * (1.f / 64.f) + EPS);
            const size_t row = row0 + fr;
#pragma unroll
            for (int nv = 0; nv < 4; ++nv) { f32x4 g4 = unpack4(gcur[nv]);
                g4.x = siluf(g4.x); g4.y = siluf(g4.y); g4.z = siluf(g4.z); g4.w = siluf(g4.w);
                *(GAS v2u*)(CAT + row * D + 768 + hh * 64 + 16 * nv + 4 * fq) = pack4(O[nv] * rstd * ng4[nv] * g4); }
        }
#pragma unroll
        for (int ni = 0; ni < 4; ++ni) { const f32x4 dk = *(const LAS f32x4*)(DC + 16 * ni + 4 * fq); const v2u kh = *(const LAS v2u*)(KH + (16 * ni + fr) * 20 + 4 * fq);
#pragma unroll
            for (int mi = 0; mi < 4; ++mi) S[mi][ni] = mfma_p2(kh, zz, vt[mi], zz, S[mi][ni] * dk); }
        LDS_WAIT();
    }
    if (!OUT) {
#pragma unroll
        for (int mi = 0; mi < 4; ++mi)
#pragma unroll
            for (int ni = 0; ni < 4; ++ni) *(GAS f32x4*)(stp + ((mi * 4 + ni) * 64 + lane) * 4) = S[mi][ni];
        DEC[((size_t)((b * NCH + c) * 4 + hh)) * 64 + lane] = Dtot;
    }
}
#undef HG_LOAD

DI void carry_phase(gf ST, gcf DEC, gcf AGG, gf H0, int wg, int G, int tid) {
    const int gt = wg * NTHR + tid, NT = G * NTHR, lane = tid & 63, wv = gt >> 6;
    for (int idx = wv; idx < BATCH * GWD; idx += NT >> 6) { const int b = idx >> 8, ch = idx & 255;
        const f32x2 ah = *(GAS const f32x2*)(AGG + ((size_t)(b * NCH + lane) * GWD + ch) * 2); float a = ah.x, h = ah.y;
#pragma unroll
        for (int d = 1; d < 64; d <<= 1) { const float ap = __shfl_up(a, d), hp = __shfl_up(h, d); if (lane >= d) { h = a * hp + h; a = a * ap; } }
        const float hprev = __shfl_up(h, 1);
        H0[(size_t)(b * NCH + lane) * GWD + ch] = lane ? hprev : 0.f; }
    for (int idx = gt; idx < BATCH * 4 * 4096; idx += NT) { const int b = idx >> 14, hh = (idx >> 12) & 3, kv = idx & 4095, k = 16 * ((kv >> 8) & 3) + 4 * ((kv >> 6) & 3) + (kv & 3); float run = 0.f;
#pragma unroll 1
        for (int c0 = 0; c0 < NCH; c0 += 32) { float sl[32], d[32];
#pragma unroll
            for (int c = 0; c < 32; ++c) { sl[c] = ST[((size_t)((b * NCH + c0 + c) * 4 + hh)) * 4096 + kv]; d[c] = DEC[((size_t)((b * NCH + c0 + c) * 4 + hh)) * 64 + k]; }
#pragma unroll
            for (int c = 0; c < 32; ++c) { ST[((size_t)((b * NCH + c0 + c) * 4 + hh)) * 4096 + kv] = run; run = d[c] * run + sl[c]; } } }
}
struct Args { const float* in[33]; float* out; unsigned char* ws; int ph_lo, ph_hi; };
enum { I_X = 0, I_C, I_WMOD, I_BMOD, I_NMIX, I_NFFN, I_NFIN, I_WIN, I_WOUT, I_POOLW, I_POOLS, I_POOLN, I_SGUW, I_SGUB, I_SGUN, I_CONVW, I_CONVB, I_LWA, I_LBA, I_LWX, I_LBX, I_LAM, I_LN,
       I_HGAM, I_HN, I_F1, I_F3, I_F2, I_RW, I_RB, I_M1, I_M3, I_M2 };
constexpr int N_PHASES = 1 + (7 + 2) + (8 + (IS_F8(1) ? 4 : 8)) + (7 + 2) + (8 + (IS_F8(3) ? 4 : 8)) + 1;

DI gws launder(unsigned char* p) { asm volatile("" : "+s"(p)); return (gws)p; }
DI gcf inp(const Args& a, int i) { asm volatile("" : "+s"(i)); return (gcf)a.in[i]; }
#define WSP(T, off) ((GAS T*)(ws + (off)))
#define WSG(T, off) ((T*)((unsigned char*)ws + (off)))

__global__ void __launch_bounds__(NTHR, 2) mk_fwd(Args args) {
    extern __shared__ __attribute__((aligned(16))) unsigned char lds_raw[];
    LAS unsigned char* lds = (LAS unsigned char*)lds_raw;
    const int tid0 = threadIdx.x, wg0 = blockIdx.x, G0 = gridDim.x;
    for (int u = tid0; u < (LDS_BYTES - RING_BYTES) / 4; u += NTHR) ((LAS unsigned*)(lds + RING_BYTES))[u] = 0u;
    __syncthreads();
    const XcdBarrier bar = xcd_barrier_post((unsigned*)(args.ws + WS_CTL) + CW_BAR, (volatile LAS unsigned*)(lds + MISC_OFF) + 8);
    const int lo = args.ph_lo, hi = args.ph_hi;
#define XOUT ((gf)args.out)
    int pi = 0;
#define PH_IDS int tid = (bar.w0 << 6) | hw_lane(); asm volatile("" : "+v"(tid)); const int lane = tid & 63, wave = __builtin_amdgcn_readfirstlane(tid >> 6); int wg = wg0, G = G0; asm volatile("" : "+s"(wg), "+s"(G))
#define PH_ON (pi >= lo && pi < hi)
#define PH_END do { if (pi >= lo && pi + 1 < hi) xcd_barrier(bar); ++pi; } while (0)

    if (PH_ON) { gws ws = launder(args.ws); PH_IDS;
        p0_prologue(inp(args, I_C), inp(args, I_WMOD), inp(args, I_BMOD), inp(args, I_HGAM), inp(args, I_POOLW), inp(args, I_LWA), inp(args, I_LWX), inp(args, I_SGUW), ws, lds, wg, G, tid, wave, lane); }
    PH_END;

    for (int l = 0; l < DEPTH; ++l) {
        const int moe = l & 1;
        if (PH_ON) { gws ws = launder(args.ws); PH_IDS; gcf modl = WSP(float, WS_MOD) + (size_t)l * 8 * MODW;
            convert_weights(l, inp(args, I_WIN), inp(args, I_WOUT), inp(args, I_F1), inp(args, I_F3), inp(args, I_F2), inp(args, I_M1), inp(args, I_M3), inp(args, I_M2), ws, lds, wg, G, wave, lane);
            if (l == 2) norm_phase<true, false, false, false, (bool)IS_B8(2)>(nullptr, WSP(bf16, WS_XB), nullptr, inp(args, I_NMIX) + l * D, modl + 0 * D, modl + 1 * D, modl - 8 * MODW + 5 * D, WSP(bf16, WS_XN), WSP(bf16, WS_Y1), IS_B8(2) ? WSP(bf16, WS_CAT) : WSP(bf16, WS_XN), nullptr, nullptr, nullptr, nullptr, nullptr, nullptr, lds, wg, G, tid, wave, lane);
            else if (l == 0) norm_phase<false, false, false, true>(inp(args, I_X), WSP(bf16, WS_XB), nullptr, inp(args, I_NMIX) + l * D, modl + 0 * D, modl + 1 * D, nullptr, nullptr, nullptr, WSP(bf16, WS_XN), nullptr, nullptr, nullptr, nullptr, nullptr, nullptr, lds, wg, G, tid, wave, lane);
            else if (IS_B8(l)) norm_phase<false, false, false, false, true>(nullptr, WSP(bf16, WS_XB), nullptr, inp(args, I_NMIX) + l * D, modl + 0 * D, modl + 1 * D, nullptr, nullptr, nullptr, WSP(bf16, WS_XN), nullptr, nullptr, nullptr, nullptr, nullptr, nullptr, lds, wg, G, tid, wave, lane);
            else norm_phase<false, false, false, false>(nullptr, WSP(bf16, WS_XB), nullptr, inp(args, I_NMIX) + l * D, modl + 0 * D, modl + 1 * D, nullptr, nullptr, nullptr, WSP(bf16, WS_XN), nullptr, nullptr, nullptr, nullptr, nullptr, nullptr, lds, wg, G, tid, wave, lane);
        }
        PH_END;
        if (PH_ON && !IS_B8(l)) { gws ws = launder(args.ws); PH_IDS;
            pg8::Gemm g{WSG(bf16, WS_XN), WSG(bf16, WS_WIN), D}; pg8::TileOrder<INW / 256> S; S.init(M / 256, G, wg, 0, 0, nullptr);
            EpiProj E{WSP(bf16, WS_PROJ), 1.0f};
            pg8::gemm_phase<EpiProj, pg8::TileOrder<INW / 256>, true, true>(lds, g, S, E, tid);
        }
        if (PH_ON && IS_B8(l)) { gws ws = launder(args.ws); PH_IDS;
            pg8::Gemm g{l == 2 ? WSG(bf16, WS_CAT) : WSG(bf16, WS_XN), WSG(bf16, WS_WIN), D / 2}; pg8::TileOrder<INW / 256> S; S.init(M / 256, G, wg, 0, 0, nullptr);
            EpiProj E{WSP(bf16, WS_PROJ), 1.0f / F8_S13};
            pg8::gemm_phase<EpiProj, pg8::TileOrder<INW / 256>, true, true, true>(lds, g, S, E, tid);
        }
        PH_END;
        if (PH_ON) { gws ws = launder(args.ws); PH_IDS; gcb PROJ = WSP(bf16, WS_PROJ); gb CAT = WSP(bf16, WS_CAT);
            for (int unit = wg; unit < BATCH * NCH; unit += G) { const int b = unit >> 6, blk = unit & (NCH - 1);
                pool_unit(PROJ, CAT, WSP(bf16, WS_POOLWT) + l * 16384, inp(args, I_POOLS) + l * GWD, inp(args, I_POOLN) + l * GWD, lds, b, blk * CH, tid, wave, lane);
                sgu_unit(PROJ, CAT, WSP(bf16, WS_SGUW) + l * 65536, inp(args, I_SGUB) + l * 512, inp(args, I_SGUN) + l * GWD, lds, b, blk * CH, tid, wave, lane);
                lru_local_unit(PROJ, inp(args, I_CONVW) + l * 4 * GWD, inp(args, I_CONVB) + l * GWD, inp(args, I_LBA) + l * GWD, inp(args, I_LBX) + l * GWD, inp(args, I_LAM) + l * GWD,
                               WSP(bf16, WS_LRUWAT) + l * 16384, WSP(bf16, WS_LRUWXT) + l * 16384, WSP(float, WS_AGG), WSP(unsigned, WS_LAB), lds, b, blk, tid, wave, lane);
                __syncthreads(); }
            for (int u = wg * NWAVES + wave; u < BATCH * NCH * 4; u += G * NWAVES)
                hgrn_wave_unit<false>(PROJ, CAT, WSP(float, WS_LB) + l * GWD, inp(args, I_HN) + l * GWD, WSP(float, WS_ST), WSP(float, WS_DEC), (LAS float*)(lds + wave * 16384), u, lane);
        }
        PH_END;
        if (PH_ON) { gws ws = launder(args.ws); PH_IDS; carry_phase(WSP(float, WS_ST), WSP(float, WS_DEC), WSP(float, WS_AGG), WSP(float, WS_H0), wg, G, tid); }
        PH_END;
        if (PH_ON) { gws ws = launder(args.ws); PH_IDS; gcb PROJ = WSP(bf16, WS_PROJ); gb CAT = WSP(bf16, WS_CAT);
            for (int unit = wg; unit < BATCH * NCH; unit += G) { const int b = unit >> 6, blk = unit & (NCH - 1);
                lru_out_unit(PROJ, CAT, inp(args, I_LN) + l * GWD, WSP(float, WS_H0), WSP(unsigned, WS_LAB), lds, b, blk, tid, wave, lane); }
            __syncthreads();
            for (int u = wg * NWAVES + wave; u < BATCH * NCH * 4; u += G * NWAVES)
                hgrn_wave_unit<true>(PROJ, CAT, WSP(float, WS_LB) + l * GWD, inp(args, I_HN) + l * GWD, WSP(float, WS_ST), WSP(float, WS_DEC), (LAS float*)(lds + wave * 16384), u, lane);
        }
        PH_END;
        if (PH_ON) { gws ws = launder(args.ws); PH_IDS;
            pg8::Gemm g{WSG(bf16, WS_CAT), WSG(bf16, WS_WOUT), D}; pg8::TileOrder<D / 256> S; S.init(M / 256, G, wg, 0, 0, nullptr);
            EpiResid E{WSP(bf16, WS_XB), WSP(float, WS_MOD) + (size_t)l * 8 * MODW + 2 * D, 1.0f};
            pg8::gemm_phase<EpiResid, pg8::TileOrder<D / 256>, true, true>(lds, g, S, E, tid);
        }
        PH_END;
        if (PH_ON) { gws ws = launder(args.ws); PH_IDS; gcf modl = WSP(float, WS_MOD) + (size_t)l * 8 * MODW;
            if (moe) norm_phase<false, true, false, false, MOE_XN8>(nullptr, WSP(bf16, WS_XB), nullptr, inp(args, I_NFFN) + l * D, modl + 3 * D, modl + 4 * D, nullptr, nullptr, nullptr, WSP(bf16, WS_XN), inp(args, I_RW) + (l >> 1) * D * NE, inp(args, I_RB) + (l >> 1) * NE,
                                                    WSP(int, WS_TOKE), WSP(float, WS_TOKW), WSP(int, WS_HISTW), WSP(v2i, WS_PAIR), lds, wg, G, tid, wave, lane);
            else if (IS_F8(l)) norm_phase<false, false, false, false, true>(nullptr, WSP(bf16, WS_XB), nullptr, inp(args, I_NFFN) + l * D, modl + 3 * D, modl + 4 * D, nullptr, nullptr, nullptr, WSP(bf16, WS_XN), nullptr, nullptr, nullptr, nullptr, nullptr, nullptr, lds, wg, G, tid, wave, lane);
            else norm_phase<false, false, false, false>(nullptr, WSP(bf16, WS_XB), nullptr, inp(args, I_NFFN) + l * D, modl + 3 * D, modl + 4 * D, nullptr, nullptr, nullptr, WSP(bf16, WS_XN), nullptr, nullptr, nullptr, nullptr, nullptr, nullptr, lds, wg, G, tid, wave, lane);
        }
        PH_END;
        if (moe) {
            if (PH_ON) { gws ws = launder(args.ws); PH_IDS;
                    route_phase(WSP(bf16, WS_XN), WSP(bf16, WS_PROJ), WSP(int, WS_TOKE), WSP(float, WS_TOKW), WSP(int, WS_HISTW), WSP(v2i, WS_PAIR), WSP(int, WS_TILEE), WSP(int, WS_NT), lds, wg, G, tid, wave, lane, IS_F8(l)); }
            PH_END;
        }
        const int nck = moe ? (IS_F8(l) ? 2 : 4) : 1;
#define FFN_RANGE int pm0 = 0, nM = M / 256; if (moe) { const int ntl = __builtin_amdgcn_readfirstlane(__hip_atomic_load(WSP(int, WS_NT), __ATOMIC_RELAXED, __HIP_MEMORY_SCOPE_AGENT)); \
            if (IS_F8(l)) { pm0 = ck * 256; nM = (ck < 1) ? 256 : ntl - 256; if (nM > 292) nM = 292; } else { pm0 = ck * 128; nM = (ck < 3) ? 128 : ntl - 384; if (nM > 146) nM = 146; } if (nM < 0) nM = 0; }
        for (int ck = 0; ck < nck; ++ck) {
            if (PH_ON && !IS_F8(l)) { gws ws = launder(args.ws); PH_IDS; FFN_RANGE;
                pg8::Gemm g{moe ? WSG(bf16, WS_PROJ) : WSG(bf16, WS_XN), WSG(bf16, WS_W13), D}; pg8::TileOrder<DFF / 128> S; S.init(nM, G, wg, pm0, 0, moe ? WSG(int, WS_TILEE) : nullptr);
                EpiSwiglu E{moe ? WSP(bf16, WS_CAT) : WSP(bf16, WS_PROJ), pm0};
                pg8::gemm_phase<EpiSwiglu, pg8::TileOrder<DFF / 128>, true, true>(lds, g, S, E, tid);
            }
            if (PH_ON && IS_F8(l)) { gws ws = launder(args.ws); PH_IDS; FFN_RANGE;
                pg8::Gemm g{moe ? WSG(bf16, WS_PROJ) : WSG(bf16, WS_XN), WSG(bf16, WS_W13), D / 2}; pg8::TileOrder<DFF / 128> S; S.init(nM, G, wg, pm0, 0, moe ? WSG(int, WS_TILEE) : nullptr);
                EpiSwiglu8 E{moe ? WSP(unsigned char, WS_CAT) : WSP(unsigned char, WS_PROJ), pm0};
                pg8::gemm_phase<EpiSwiglu8, pg8::TileOrder<DFF / 128>, true, true, true>(lds, g, S, E, tid);
            }
            PH_END;
            if (PH_ON && !IS_F8(l) && moe) { gws ws = launder(args.ws); PH_IDS; FFN_RANGE;
                pg8::Gemm g{WSG(bf16, WS_CAT), WSG(bf16, WS_W2), DFF}; pg8::TileOrder<D / 256> S; S.init(nM, G, wg, pm0, 1, WSG(int, WS_TILEE));
                EpiScatter E{WSP(v2i, WS_PAIR), WSP(bf16, WS_XN), WSP(bf16, WS_Y1), WSP(int, WS_TOKE), WSP(float, WS_TOKW), 1.0f};
                pg8::gemm_phase<EpiScatter, pg8::TileOrder<D / 256>, true, true>(lds, g, S, E, tid);
            }
            if (PH_ON && !moe && !IS_F8(l)) { gws ws = launder(args.ws); PH_IDS; FFN_RANGE;
                pg8::Gemm g{WSG(bf16, WS_PROJ), WSG(bf16, WS_W2), DFF}; pg8::TileOrder<D / 256> S; S.init(nM, G, wg, pm0, 1, nullptr);
                EpiResid E{WSP(bf16, WS_XB), WSP(float, WS_MOD) + (size_t)l * 8 * MODW + 5 * D, 1.0f};
                pg8::gemm_phase<EpiResid, pg8::TileOrder<D / 256>, true, true>(lds, g, S, E, tid);
            }
            if (PH_ON && IS_F8(l) && !moe) { gws ws = launder(args.ws); PH_IDS; FFN_RANGE;
                pg8::Gemm g{WSG(bf16, WS_PROJ), WSG(bf16, WS_W2), DFF / 2}; pg8::TileOrder<D / 256> S; S.init(nM, G, wg, pm0, 1, nullptr);
                EpiResid E{WSP(bf16, WS_XB), WSP(float, WS_MOD) + (size_t)l * 8 * MODW + 5 * D, 1.0f / F8_S2};
                pg8::gemm_phase<EpiResid, pg8::TileOrder<D / 256>, true, true, true>(lds, g, S, E, tid);
            }
            if (PH_ON && IS_F8(l) && moe) { gws ws = launder(args.ws); PH_IDS; FFN_RANGE;
                pg8::Gemm g{WSG(bf16, WS_CAT), WSG(bf16, WS_W2), DFF / 2}; pg8::TileOrder<D / 256> S; S.init(nM, G, wg, pm0, 1, WSG(int, WS_TILEE));
                EpiScatter E{WSP(v2i, WS_PAIR), WSP(bf16, WS_XN), WSP(bf16, WS_Y1), WSP(int, WS_TOKE), WSP(float, WS_TOKW), 1.0f / F8_S2};
                pg8::gemm_phase<EpiScatter, pg8::TileOrder<D / 256>, true, true, true>(lds, g, S, E, tid);
            }
            PH_END;
        }
#undef FFN_RANGE
    }
    if (PH_ON) { gws ws = launder(args.ws); PH_IDS;
        norm_phase<true, false, true, false>(nullptr, WSP(bf16, WS_XB), XOUT, inp(args, I_NFIN), nullptr, nullptr, WSP(float, WS_MOD) + (size_t)3 * 8 * MODW + 5 * D, WSP(bf16, WS_XN), WSP(bf16, WS_Y1), nullptr, nullptr, nullptr, nullptr, nullptr, nullptr, nullptr, lds, wg, G, tid, wave, lane); }
#undef PH_ON
#undef PH_END
}

#ifndef MK_CUTS
#define MK_CUTS 0
#endif
extern "C" void kernel_launch(void* const* d_in, gci in_sizes, int n_in, void* d_out, int out_size, void* d_ws, size_t ws_size, hipStream_t stream) {
    static int grid = 0;
    if (grid == 0) {
        if (n_in != 33 || in_sizes[0] != M * D || out_size != M * D || ws_size < WS_END) { fprintf(stderr, "kernel_launch: unexpected shapes (n_in %d, in0 %d, out %d, ws %zu); nothing launched\n", n_in, n_in > 0 ? in_sizes[0] : -1, out_size, ws_size); grid = -1; return; }
        int dev = 0, cus = 0, per_cu = 0;
        if (hipGetDevice(&dev) != hipSuccess || hipDeviceGetAttribute(&cus, hipDeviceAttributeMultiprocessorCount, dev) != hipSuccess) { grid = -1; return; }
        if (hipFuncSetAttribute((const void*)mk_fwd, hipFuncAttributeMaxDynamicSharedMemorySize, LDS_BYTES) != hipSuccess) { fprintf(stderr, "kernel_launch: hipFuncSetAttribute failed\n"); grid = -1; return; }
        if (hipOccupancyMaxActiveBlocksPerMultiprocessor(&per_cu, (const void*)mk_fwd, NTHR, LDS_BYTES) != hipSuccess || per_cu < 1) fprintf(stderr, "kernel_launch: occupancy query reports %d workgroups per CU\n", per_cu);
        (void)hipGetLastError();
        grid = cus;
    }
    if (grid < 0) return;
    if (hipMemsetAsync((char*)d_ws + WS_CTL, 0, CTL_ZERO_BYTES, stream) != hipSuccess) return;
    Args a{};
    for (int i = 0; i < 33; ++i) a.in[i] = (const float*)d_in[i];
    a.out = (float*)d_out; a.ws = (unsigned char*)d_ws;
#if MK_CUTS
    for (int p = 0; p < N_PHASES; ++p) { a.ph_lo = p; a.ph_hi = p + 1; hipLaunchKernelGGL(mk_fwd, dim3(grid), dim3(NTHR), LDS_BYTES, stream, a); }
#else
    a.ph_lo = 0; a.ph_hi = N_PHASES;
    hipLaunchKernelGGL(mk_fwd, dim3(grid), dim3(NTHR), LDS_BYTES, stream, a);
#endif
}
```
